# Optimizing an MI355X kernel written in HIP

```python
import math
import jax, jax.numpy as jnp
from jax import lax
import numpy as np

D_MODEL = 1024
BATCH = 8
SEQ = 4096
DEPTH = 4

RET_HEADS = 4
RET_DK = 128
RET_DV = 128
RET_CHUNK = 128
ROPE_BASE = 10000.0
NSA_HEADS = 8
NSA_KV_GROUPS = 2
NSA_HPG = NSA_HEADS // NSA_KV_GROUPS
NSA_HD = 64
CMP_BLOCK = 32
CMP_STRIDE = 16
SLC_BLOCK = 64
N_SELECT = 8
FORCED_LOCAL = 2
FORCE_BONUS = 1.0e4
WINDOW = 512
Q_BLOCK = 128
HGRN_HEADS = 8
HGRN_DK = D_MODEL // HGRN_HEADS
HGRN_DV = D_MODEL // HGRN_HEADS
HGRN_CHUNK = 64
D_FF = -(-8 * D_MODEL // (3 * 256)) * 256
EPS = 1e-6

EVEN_SIZES = ([RET_HEADS * RET_DK] * 2 + [RET_HEADS * RET_DV] * 2 + [NSA_HEADS * NSA_HD]
              + [NSA_KV_GROUPS * NSA_HD] * 6 + [3 * NSA_HEADS])
EVEN_IN = sum(EVEN_SIZES)
EVEN_MIX = RET_HEADS * RET_DV + NSA_HEADS * NSA_HD
ODD_SIZES = [HGRN_HEADS * HGRN_DK] * 2 + [HGRN_HEADS * HGRN_DV] * 2
ODD_IN = sum(ODD_SIZES)
ODD_MIX = HGRN_HEADS * HGRN_DV
N_EVEN = (DEPTH + 1) // 2
N_ODD = DEPTH // 2

kernel_name = "retnet_nsa_hgrn2_hybrid_trunk"


def _split(a, sizes):
    return jnp.split(a, list(np.cumsum(sizes)[:-1]), axis=-1)


def rmsnorm(x, g):
    xf = x.astype(jnp.float32)
    y = xf * lax.rsqrt(jnp.mean(xf * xf, axis=-1, keepdims=True) + EPS)
    return (y * g.astype(jnp.float32)).astype(x.dtype)


def rotary(x):
    S, d = x.shape[-2], x.shape[-1]
    half = d // 2
    inv = ROPE_BASE ** (-jnp.arange(half, dtype=jnp.float32) / half)
    ang = jnp.arange(S, dtype=jnp.float32)[:, None] * inv[None, :]
    cos, sin = jnp.cos(ang), jnp.sin(ang)
    x1, x2 = x[..., :half], x[..., half:]
    return jnp.concatenate([x1 * cos - x2 * sin, x1 * sin + x2 * cos], axis=-1)


def masked_softmax(s, mask):
    s = jnp.where(mask, s, -jnp.inf)
    m = jnp.max(s, axis=-1, keepdims=True)
    m = jnp.where(jnp.isfinite(m), m, 0.0)
    p = jnp.exp(s - m)
    return p / jnp.maximum(jnp.sum(p, axis=-1, keepdims=True), 1e-30)


def retention_chunkwise(q, k, v):
    B, H, S, dk = q.shape
    dv = v.shape[-1]
    C = min(RET_CHUNK, S)
    NC = S // C
    log_gamma = jnp.log(1.0 - 2.0 ** (-5.0 - jnp.arange(H, dtype=jnp.float32)))
    q = q.reshape(B, H, NC, C, dk)
    k = k.reshape(B, H, NC, C, dk)
    v = v.reshape(B, H, NC, C, dv)
    idx = jnp.arange(C, dtype=jnp.float32)
    diff = idx[:, None] - idx[None, :]
    causal = diff >= 0
    dmat = jnp.where(causal, jnp.exp(log_gamma[:, None, None] * jnp.where(causal, diff, 0.0)), 0.0)
    scores = jnp.einsum('bhncd,bhnsd->bhncs', q, k) * dmat[None, :, None]
    o_inner = jnp.einsum('bhncs,bhnse->bhnce', scores, v)
    k_dec = k * jnp.exp(log_gamma[:, None] * (C - 1 - idx)[None, :])[None, :, None, :, None]
    chunk_kv = jnp.einsum('bhncd,bhnce->nbhde', k_dec, v)
    gamma_c = jnp.exp(log_gamma * C)[None, :, None, None]

    def step(state, kv):
        return gamma_c * state + kv, state

    _, r_prev = lax.scan(step, jnp.zeros((B, H, dk, dv), jnp.float32), chunk_kv)
    q_dec = q * jnp.exp(log_gamma[:, None] * (idx + 1.0)[None, :])[None, :, None, :, None]
    o_cross = jnp.einsum('bhncd,nbhde->bhnce', q_dec, r_prev)
    return (o_inner + o_cross).reshape(B, H, S, dv)


def nsa_compress(kv, pos_emb, w1, w2):
    B, G, S, d = kv.shape
    r = CMP_BLOCK // CMP_STRIDE
    parts = kv.reshape(B, G, S // CMP_STRIDE, CMP_STRIDE, d)
    n = S // CMP_STRIDE - r + 1
    blocks = jnp.concatenate([parts[:, :, j:j + n] for j in range(r)], axis=3)
    flat = (blocks + pos_emb.astype(jnp.float32)).reshape(B, G, n, CMP_BLOCK * d)
    return jax.nn.gelu(flat @ w1.astype(jnp.float32)) @ w2.astype(jnp.float32)


def nsa_attention(q, k_cmp, v_cmp, k_slc, v_slc, k_win, v_win, gates):
    B, G, HPG, S, d = q.shape
    scale = d ** -0.5
    n_cmp = k_cmp.shape[2]
    n_slc = S // SLC_BLOCK
    n_sel = min(N_SELECT, n_slc)
    cs = np.arange(n_cmp) * CMP_STRIDE
    ce = cs + CMP_BLOCK - 1
    ss = np.arange(n_slc) * SLC_BLOCK
    se = ss + SLC_BLOCK - 1
    overlap = jnp.asarray(((cs[:, None] <= se[None, :]) & (ce[:, None] >= ss[None, :])).astype(np.float32))
    cmp_end = jnp.asarray(ce.astype(np.int32))
    ks_blocks = k_slc.reshape(B, G, n_slc, SLC_BLOCK, d)
    vs_blocks = v_slc.reshape(B, G, n_slc, SLC_BLOCK, d)
    kw_pad = jnp.pad(k_win, ((0, 0), (0, 0), (WINDOW, 0), (0, 0)))
    vw_pad = jnp.pad(v_win, ((0, 0), (0, 0), (WINDOW, 0), (0, 0)))
    bi = jnp.arange(B)[:, None, None, None]
    gi = jnp.arange(G)[None, :, None, None]
    jblk = jnp.arange(n_slc)
    offs = jnp.arange(SLC_BLOCK)

    def block(i):
        q0 = i * Q_BLOCK
        t = q0 + jnp.arange(Q_BLOCK)
        qb = lax.dynamic_slice_in_dim(q, q0, Q_BLOCK, axis=3)
        s_c = jnp.einsum('bghqd,bgnd->bghqn', qb, k_cmp) * scale
        p_c = masked_softmax(s_c, cmp_end[None, :] <= t[:, None])
        o_c = jnp.einsum('bghqn,bgnd->bghqd', p_c, v_cmp)
        imp = jnp.einsum('bgqn,nj->bgqj', jnp.sum(p_c, axis=2), overlap)
        bt = (t // SLC_BLOCK)[:, None]
        valid_s = jblk[None, :] <= bt
        forced = (jblk[None, :] == 0) | ((bt - jblk[None, :] >= 0) & (bt - jblk[None, :] < FORCED_LOCAL))
        score = jnp.where(valid_s, imp + jnp.where(forced, FORCE_BONUS, 0.0), -1e30)
        _, idx = lax.top_k(score, n_sel)
        kg = ks_blocks[bi, gi, idx].reshape(B, G, Q_BLOCK, n_sel * SLC_BLOCK, d)
        vg = vs_blocks[bi, gi, idx].reshape(B, G, Q_BLOCK, n_sel * SLC_BLOCK, d)
        kpos = (idx[..., None] * SLC_BLOCK + offs).reshape(B, G, Q_BLOCK, n_sel * SLC_BLOCK)
        s_s = jnp.einsum('bghqd,bgqkd->bghqk', qb, kg) * scale
        p_s = masked_softmax(s_s, (kpos <= t[None, None, :, None])[:, :, None])
        o_s = jnp.einsum('bghqk,bgqkd->bghqd', p_s, vg)
        kw = lax.dynamic_slice_in_dim(kw_pad, q0, WINDOW + Q_BLOCK, axis=2)
        vw = lax.dynamic_slice_in_dim(vw_pad, q0, WINDOW + Q_BLOCK, axis=2)
        spos = q0 - WINDOW + jnp.arange(WINDOW + Q_BLOCK)
        dist = t[:, None] - spos[None, :]
        valid_w = (dist >= 0) & (dist < WINDOW) & (spos[None, :] >= 0)
        s_w = jnp.einsum('bghqd,bgkd->bghqk', qb, kw) * scale
        o_w = jnp.einsum('bghqk,bgkd->bghqd', masked_softmax(s_w, valid_w), vw)
        gb = lax.dynamic_slice_in_dim(gates, q0, Q_BLOCK, axis=4)[..., None]
        return gb[0] * o_c + gb[1] * o_s + gb[2] * o_w

    out = lax.map(block, jnp.arange(S // Q_BLOCK))
    return jnp.transpose(out, (1, 2, 3, 0, 4, 5)).reshape(B, G * HPG, S, d)


def retention_nsa_mixer(h, w_in, w_out, pos_k, w1_k, w2_k, pos_v, w1_v, w2_v):
    B, S, _ = h.shape
    proj = (h @ w_in).astype(jnp.float32)
    (rq, rk, rv, rg, nq, kc, vc, ks, vs, kw, vw, ng) = _split(proj, EVEN_SIZES)
    heads = lambda a, n: jnp.transpose(a.reshape(B, S, n, -1), (0, 2, 1, 3))
    q_r = rotary(heads(rq, RET_HEADS))
    k_r = rotary(heads(rk, RET_HEADS)) * RET_DK ** -0.5
    o_r = retention_chunkwise(q_r, k_r, heads(rv, RET_HEADS))
    mu = jnp.mean(o_r, axis=-1, keepdims=True)
    var = jnp.mean(jnp.square(o_r - mu), axis=-1, keepdims=True)
    o_r = (o_r - mu) * lax.rsqrt(var + 1e-5)
    o_r = jnp.transpose(o_r, (0, 2, 1, 3)).reshape(B, S, RET_HEADS * RET_DV) * jax.nn.silu(rg)
    q_n = jnp.transpose(nq.reshape(B, S, NSA_KV_GROUPS, NSA_HPG, NSA_HD), (0, 2, 3, 1, 4))
    kvh = lambda a: jnp.transpose(a.reshape(B, S, NSA_KV_GROUPS, NSA_HD), (0, 2, 1, 3))
    k_cmp = nsa_compress(kvh(kc), pos_k, w1_k, w2_k)
    v_cmp = nsa_compress(kvh(vc), pos_v, w1_v, w2_v)
    gates = jnp.transpose(jax.nn.sigmoid(ng).reshape(B, S, 3, NSA_KV_GROUPS, NSA_HPG), (2, 0, 3, 4, 1))
    o_n = nsa_attention(q_n, k_cmp, v_cmp, kvh(ks), kvh(vs), kvh(kw), kvh(vw), gates)
    o_n = jnp.transpose(o_n, (0, 2, 1, 3)).reshape(B, S, NSA_HEADS * NSA_HD)
    mixed = jnp.concatenate([o_r, o_n], axis=-1).astype(h.dtype)
    return mixed @ w_out


def hgrn2_chunkwise(q, k, v, log_f):
    B, H, S, dk = q.shape
    dv = v.shape[-1]
    C = min(HGRN_CHUNK, S)
    NC = S // C
    to_chunks = lambda a: jnp.moveaxis(a.reshape(B, H, NC, C, a.shape[-1]), 2, 0)
    causal = jnp.tril(jnp.ones((C, C), dtype=bool))[:, :, None]

    def step(state, xs):
        qc, kc, vc, gc = xs
        b = jnp.cumsum(gc, axis=2)
        diff = b[:, :, :, None, :] - b[:, :, None, :, :]
        decay = jnp.exp(jnp.where(causal, diff, -jnp.inf))
        attn = jnp.sum(qc[:, :, :, None, :] * decay * kc[:, :, None, :, :], axis=-1)
        o = (jnp.einsum('bhnm,bhme->bhne', attn, vc)
             + jnp.einsum('bhnd,bhde->bhne', qc * jnp.exp(b), state))
        b_last = b[:, :, -1:, :]
        new_state = (jnp.exp(b_last[:, :, 0, :])[..., None] * state
                     + jnp.einsum('bhmd,bhme->bhde', kc * jnp.exp(b_last - b), vc))
        return new_state, o

    _, o = lax.scan(step, jnp.zeros((B, H, dk, dv), jnp.float32),
                    (to_chunks(q), to_chunks(k), to_chunks(v), to_chunks(log_f)))
    return jnp.moveaxis(o, 0, 2).reshape(B, H, S, dv)


def hgrn2_mixer(h, w_in, w_out, norm_g, lb):
    B, S, _ = h.shape
    proj = (h @ w_in).astype(jnp.float32)
    qp, fp, ip, gp = _split(proj, ODD_SIZES)
    heads = lambda a: jnp.transpose(a.reshape(B, S, HGRN_HEADS, -1), (0, 2, 1, 3))
    lb = jnp.maximum(lb, 0.0)
    log_f = jnp.logaddexp(jnp.log(lb), jnp.log1p(-lb) + jax.nn.log_sigmoid(fp))
    k = (1.0 - lb) * jax.nn.sigmoid(-fp)
    q = jax.nn.silu(qp) * HGRN_DK ** -0.5
    o = hgrn2_chunkwise(heads(q), heads(k), heads(ip), heads(log_f))
    o = o * lax.rsqrt(jnp.mean(o * o, axis=-1, keepdims=True) + EPS) * norm_g.astype(jnp.float32)
    o = jnp.transpose(o, (0, 2, 1, 3)).reshape(B, S, ODD_MIX) * jax.nn.sigmoid(gp)
    return o.astype(h.dtype) @ w_out


def swiglu(h, w1, w3, w2):
    return (jax.nn.silu(h @ w1) * (h @ w3)) @ w2


def setup_inputs(seed: int = 0) -> dict:
    key = jax.random.key(seed)
    ks = jax.random.split(key, 20)
    nrm = lambda k, shape, s: jax.random.normal(k, shape, jnp.float32) * s
    return {
        "x": nrm(ks[0], (BATCH, SEQ, D_MODEL), 1.0),
        "norm_mix_g": 1.0 + nrm(ks[1], (DEPTH, D_MODEL), 0.05),
        "norm_ffn_g": 1.0 + nrm(ks[2], (DEPTH, D_MODEL), 0.05),
        "final_norm_g": 1.0 + nrm(ks[3], (D_MODEL,), 0.05),
        "even_w_in": nrm(ks[4], (N_EVEN, D_MODEL, EVEN_IN), D_MODEL ** -0.5),
        "even_w_out": nrm(ks[5], (N_EVEN, EVEN_MIX, D_MODEL), EVEN_MIX ** -0.5),
        "cmp_pos_k": nrm(ks[6], (N_EVEN, CMP_BLOCK, NSA_HD), 0.1),
        "cmp_w1_k": nrm(ks[7], (N_EVEN, CMP_BLOCK * NSA_HD, NSA_HD), (CMP_BLOCK * NSA_HD) ** -0.5),
        "cmp_w2_k": nrm(ks[8], (N_EVEN, NSA_HD, NSA_HD), NSA_HD ** -0.5),
        "cmp_pos_v": nrm(ks[9], (N_EVEN, CMP_BLOCK, NSA_HD), 0.1),
        "cmp_w1_v": nrm(ks[10], (N_EVEN, CMP_BLOCK * NSA_HD, NSA_HD), (CMP_BLOCK * NSA_HD) ** -0.5),
        "cmp_w2_v": nrm(ks[11], (N_EVEN, NSA_HD, NSA_HD), NSA_HD ** -0.5),
        "odd_w_in": nrm(ks[12], (N_ODD, D_MODEL, ODD_IN), D_MODEL ** -0.5),
        "odd_w_out": nrm(ks[13], (N_ODD, ODD_MIX, D_MODEL), ODD_MIX ** -0.5),
        "hgrn_norm_g": 1.0 + nrm(ks[14], (N_ODD, HGRN_DV), 0.05),
        "hgrn_lb_logits": nrm(ks[15], (N_ODD, HGRN_HEADS * HGRN_DK), 1.0),
        "ffn_w1": nrm(ks[16], (DEPTH, D_MODEL, D_FF), D_MODEL ** -0.5),
        "ffn_w3": nrm(ks[17], (DEPTH, D_MODEL, D_FF), D_MODEL ** -0.5),
        "ffn_w2": nrm(ks[18], (DEPTH, D_FF, D_MODEL), D_FF ** -0.5),
    }


def reference(x, norm_mix_g, norm_ffn_g, final_norm_g, even_w_in, even_w_out,
              cmp_pos_k, cmp_w1_k, cmp_w2_k, cmp_pos_v, cmp_w1_v, cmp_w2_v,
              odd_w_in, odd_w_out, hgrn_norm_g, hgrn_lb_logits,
              ffn_w1, ffn_w3, ffn_w2):
    lb_sm = jax.nn.softmax(hgrn_lb_logits.astype(jnp.float32), axis=0)
    lb_all = jnp.cumsum(lb_sm, axis=0) - lb_sm[0:1]
    for layer in range(DEPTH):
        h = rmsnorm(x, norm_mix_g[layer])
        j = layer // 2
        if layer % 2 == 0:
            mix = retention_nsa_mixer(h, even_w_in[j], even_w_out[j],
                                      cmp_pos_k[j], cmp_w1_k[j], cmp_w2_k[j],
                                      cmp_pos_v[j], cmp_w1_v[j], cmp_w2_v[j])
        else:
            mix = hgrn2_mixer(h, odd_w_in[j], odd_w_out[j], hgrn_norm_g[j], lb_all[j])
        x = x + mix.astype(x.dtype)
        h = rmsnorm(x, norm_ffn_g[layer])
        x = x + swiglu(h, ffn_w1[layer], ffn_w3[layer], ffn_w2[layer]).astype(x.dtype)
    return rmsnorm(x, final_norm_g)
```

```cpp
#include <hip/hip_runtime.h>
#include <cstdio>
#include <cstdint>

#ifndef ONE_LAUNCH
#define ONE_LAUNCH 1
#define PROBE_ML 0
#endif

namespace pg8 {
#define PG8_LAS __attribute__((address_space(3)))
typedef unsigned short bf16_t;
typedef short bf16x8 __attribute__((ext_vector_type(8)));
typedef float f32x4 __attribute__((ext_vector_type(4)));
typedef unsigned u32x4 __attribute__((ext_vector_type(4)));
constexpr int BM = 256, BK = 64, HALF = 128, HTB = HALF * BK * 2  , STAGE_BYTES = 8 * HTB, NXCD = 8, WGM = 8;

__host__ __device__ __forceinline__ int lds_byte(int r, int c) { const int st = (r >> 4) * 2 + (c >> 5), rr = r & 15, cc = c & 31, ob = rr * 64 + cc * 2; return st * 1024 + (ob ^ (((ob >> 9) & 1) << 5)); }
__host__ __device__ __forceinline__ void stage_rc(int b, int& R, int& C) { const int st = b / 1024, sb = b % 1024, swz = sb ^ (((sb >> 9) & 1) << 5); R = (st >> 1) * 16 + swz / 64; C = (st & 1) * 32 + (swz % 64) / 2; }
__host__ __device__ __forceinline__ int perm32(int rho) { const int n = rho >> 4, i = rho & 15; return 8 * (i >> 2) + 4 * n + (i & 3); }

struct Unit { int pm, pn; };
struct Gemm { const bf16_t* A; const bf16_t* Bt; int M, N, K; };

struct StaticOrder {
    int nM, nN, nwg, G, c;
    __host__ __device__ void init(int M, int N, int G_, int c_) { nM = M / BM; nN = N / BM; nwg = nM * nN; G = G_; c = c_; }
    __host__ __device__ bool next(int i, Unit& u) const {
        const long L = (long)i * G + c; if (L >= nwg) return false;
        int wgid = (int)L; { const int q = nwg / NXCD, r = nwg % NXCD, xcd = wgid % NXCD, off = wgid / NXCD; wgid = (xcd < r ? xcd * (q + 1) : r * (q + 1) + (xcd - r) * q) + off; }
        const int nig = WGM * nN, gid = wgid / nig, fm = gid * WGM, gsz = (nM - fm) < WGM ? (nM - fm) : WGM;
        u.pm = fm + ((wgid % nig) % gsz); u.pn = (wgid % nig) / gsz; return true;
    }
    __device__ __forceinline__ void a_ready(const Unit&) const {}
    __device__ __forceinline__ void done(const Unit&) const {}
};

__device__ __forceinline__ unsigned cvt_pk_bf16(float lo, float hi) { unsigned r; asm volatile("v_cvt_pk_bf16_f32 %0, %1, %2" : "=v"(r) : "v"(lo), "v"(hi)); return r; }
__device__ __forceinline__ float fast_silu(float x) { return x * __builtin_amdgcn_rcpf(1.0f + __expf(-x)); }

__device__ __forceinline__ void row_rstd8(const PG8_LAS int* tbl, const PG8_LAS float* rsl, const Unit& u, int rl0, float (&rs)[2][4]) {
    const PG8_LAS float* p = rsl + tbl[u.pm] * 256 + rl0;
#pragma unroll
    for (int ai = 0; ai < 2; ++ai)
#pragma unroll
        for (int m = 0; m < 4; ++m) rs[ai][m] = p[ai * HALF + m * 16];
}
struct EpiBf16Plain {
    static constexpr bool PERM = true, AFTER_DRAIN = false;
    bf16_t* O; int ldc; const PG8_LAS int* tbl; const PG8_LAS float* rsl;
    __device__ __forceinline__ void operator()(const f32x4 (&acc)[2][2][4][2], const Unit& u, int wr, int wc, int fr, int fq) const {
        const int row0 = u.pm * BM + wr * 64 + fr, col0 = u.pn * BM + wc * 32 + 8 * fq;
        float rs[2][4]; row_rstd8(tbl, rsl, u, wr * 64 + fr, rs);
#pragma unroll
        for (int ai = 0; ai < 2; ++ai)
#pragma unroll
            for (int m = 0; m < 4; ++m) { bf16_t* rowp = O + (size_t)(row0 + ai * HALF + m * 16) * ldc + col0; const float r = rs[ai][m];
#pragma unroll
                for (int bj = 0; bj < 2; ++bj) { const f32x4 v0 = acc[ai][bj][m][0] * r, v1 = acc[ai][bj][m][1] * r;
                    u32x4 w; w.x = cvt_pk_bf16(v0[0], v0[1]); w.y = cvt_pk_bf16(v0[2], v0[3]); w.z = cvt_pk_bf16(v1[0], v1[1]); w.w = cvt_pk_bf16(v1[2], v1[3]);
                    *(u32x4*)(rowp + bj * HALF) = w; } }
    }
};

__device__ __forceinline__ float dpp_scan16(float x) {
    x += __builtin_bit_cast(float, __builtin_amdgcn_update_dpp(0, __builtin_bit_cast(int, x), 0x111, 0xf, 0xf, true));
    x += __builtin_bit_cast(float, __builtin_amdgcn_update_dpp(0, __builtin_bit_cast(int, x), 0x112, 0xf, 0xf, true));
    x += __builtin_bit_cast(float, __builtin_amdgcn_update_dpp(0, __builtin_bit_cast(int, x), 0x114, 0xf, 0xf, true));
    x += __builtin_bit_cast(float, __builtin_amdgcn_update_dpp(0, __builtin_bit_cast(int, x), 0x118, 0xf, 0xf, true));
    return x;
}
struct EpiInProj {
    static constexpr bool PERM = true, AFTER_DRAIN = false;
    bf16_t* O; int ldc; const PG8_LAS int* tbl; const PG8_LAS float* rsl;
    int mode; const float* rope; const float* lb; float* Eg; int dbg;
    __device__ __forceinline__ void operator()(const f32x4 (&acc)[2][2][4][2], const Unit& u, int wr, int wc, int fr, int fq) const {
        if (dbg == 3) return;
        const int row0 = u.pm * BM + wr * 64 + fr;
        float rs[2][4]; row_rstd8(tbl, rsl, u, wr * 64 + fr, rs);
        const int lane = threadIdx.x & 63;
        if (mode == 0 && u.pn < 4) {
            const int hd = u.pn; const int i0 = 16 * wc + 4 * fq;
            const float lg = __builtin_amdgcn_logf(1.0f - __builtin_amdgcn_exp2f(-5.0f - (float)hd));
#pragma unroll
            for (int ai = 0; ai < 2; ++ai)
#pragma unroll
                for (int m = 0; m < 4; ++m) { const int row = row0 + ai * HALF + m * 16; const float r = rs[ai][m];
                    const int pos = row & 4095; const float tl1 = (float)((row & 31) + 1);
                    const float gp = __builtin_amdgcn_exp2f(tl1 * lg), gi = 0.08838834764831845f * __builtin_amdgcn_exp2f(-tl1 * lg);
                    const f32x4* cs = (const f32x4*)(rope + ((size_t)pos * 64 + i0) * 2);
                    const f32x4 cs01 = cs[0], cs23 = cs[1];
                    const float c[4] = {cs01[0], cs01[2], cs23[0], cs23[2]}, sn[4] = {cs01[1], cs01[3], cs23[1], cs23[3]};
                    typedef unsigned u32x2 __attribute__((ext_vector_type(2)));
#pragma unroll
                    for (int bj = 0; bj < 2; ++bj) { const f32x4 x1 = acc[ai][bj][m][0] * r, x2 = acc[ai][bj][m][1] * r; const float sc = bj ? gi : gp;
                        float a[4], b[4];
#pragma unroll
                        for (int k = 0; k < 4; ++k) { a[k] = (x1[k] * c[k] - x2[k] * sn[k]) * sc; b[k] = (x1[k] * sn[k] + x2[k] * c[k]) * sc; }
                        bf16_t* dst = O + (size_t)row * ldc + (bj ? 512 : 0) + hd * 128 + i0;
                        u32x2 w0; w0.x = cvt_pk_bf16(a[0], a[1]); w0.y = cvt_pk_bf16(a[2], a[3]); *(u32x2*)dst = w0;
                        u32x2 w1; w1.x = cvt_pk_bf16(b[0], b[1]); w1.y = cvt_pk_bf16(b[2], b[3]); *(u32x2*)(dst + 64) = w1; } }
        } else if (mode == 1 && u.pn < 8) {
            const int hd = u.pn; const int ch0 = 32 * wc + 8 * fq;
            const f32x4 lb0 = *(const f32x4*)(lb + hd * 128 + ch0), lb1 = *(const f32x4*)(lb + hd * 128 + ch0 + 4);
            const int src15 = ((lane & 48) | 15) << 2;
#pragma unroll
            for (int ai = 0; ai < 2; ++ai)
#pragma unroll
                for (int mp = 0; mp < 2; ++mp) {
                    float carry[8];
#pragma unroll
                    for (int mm = 0; mm < 2; ++mm) { const int m = 2 * mp + mm; const int row = row0 + ai * HALF + m * 16; const float r = rs[ai][m];
                        float qt[8], kt[8], ev[8];
#pragma unroll
                        for (int k = 0; k < 8; ++k) { const float l = k < 4 ? lb0[k & 3] : lb1[k & 3];
                            const float fp = acc[ai][1][m][k >> 2][k & 3] * r, qp = acc[ai][0][m][k >> 2][k & 3] * r;
                            const float sg = __builtin_amdgcn_rcpf(1.0f + __expf(-fp));
                            float B = dpp_scan16(__logf(l + (1.0f - l) * sg));
                            if (mm == 1) B += carry[k];
                            if (mm == 0) carry[k] = __builtin_bit_cast(float, __builtin_amdgcn_ds_bpermute(src15, __builtin_bit_cast(int, B)));
                            const float e = __expf(B);
                            qt[k] = qp * __builtin_amdgcn_rcpf(1.0f + __expf(-qp)) * 0.08838834764831845f * e;
                            kt[k] = (1.0f - l) * (1.0f - sg) * __builtin_amdgcn_rcpf(e); ev[k] = e; }
                        bf16_t* dst = O + (size_t)row * ldc + hd * 128 + ch0;
                        u32x4 wq; wq.x = cvt_pk_bf16(qt[0], qt[1]); wq.y = cvt_pk_bf16(qt[2], qt[3]); wq.z = cvt_pk_bf16(qt[4], qt[5]); wq.w = cvt_pk_bf16(qt[6], qt[7]); *(u32x4*)dst = wq;
                        u32x4 wk; wk.x = cvt_pk_bf16(kt[0], kt[1]); wk.y = cvt_pk_bf16(kt[2], kt[3]); wk.z = cvt_pk_bf16(kt[4], kt[5]); wk.w = cvt_pk_bf16(kt[6], kt[7]); *(u32x4*)(dst + 1024) = wk;
                        if (mm == 1 && fr == 15) { float* ep = Eg + ((size_t)((row >> 12) * 8 + hd) * 128 + ((row & 4095) >> 5)) * 128 + ch0;
                            *(f32x4*)ep = (f32x4){ev[0], ev[1], ev[2], ev[3]}; *(f32x4*)(ep + 4) = (f32x4){ev[4], ev[5], ev[6], ev[7]}; } }
                }
        } else {
            const int col0 = u.pn * BM + wc * 32 + 8 * fq;
#pragma unroll
            for (int ai = 0; ai < 2; ++ai)
#pragma unroll
                for (int m = 0; m < 4; ++m) { bf16_t* rowp = O + (size_t)(row0 + ai * HALF + m * 16) * ldc + col0; const float r = rs[ai][m];
#pragma unroll
                    for (int bj = 0; bj < 2; ++bj) { const f32x4 v0 = acc[ai][bj][m][0] * r, v1 = acc[ai][bj][m][1] * r;
                        u32x4 w; w.x = cvt_pk_bf16(v0[0], v0[1]); w.y = cvt_pk_bf16(v0[2], v0[3]); w.z = cvt_pk_bf16(v1[0], v1[1]); w.w = cvt_pk_bf16(v1[2], v1[3]);
                        *(u32x4*)(rowp + bj * HALF) = w; } }
        }
    }
};
struct EpiResF32 {
    static constexpr bool PERM = true, AFTER_DRAIN = false;
    bf16_t* xb; int ldc; float scale; float* rowss; int M_; int dbg;
    __device__ __forceinline__ void operator()(const f32x4 (&acc)[2][2][4][2], const Unit& u, int wr, int wc, int fr, int fq) const {
        if (dbg == 3) return;
        const int row0 = u.pm * BM + wr * 64 + fr, col0 = u.pn * BM + wc * 32 + 8 * fq;
        u32x4 r[2][4][2];
#pragma unroll
        for (int ai = 0; ai < 2; ++ai)
#pragma unroll
            for (int m = 0; m < 4; ++m) { const size_t ro = (size_t)(row0 + ai * HALF + m * 16) * ldc + col0;
#pragma unroll
                for (int bj = 0; bj < 2; ++bj) r[ai][m][bj] = *(const u32x4*)(xb + ro + bj * HALF); }
        __builtin_amdgcn_sched_barrier(0);
#pragma unroll
        for (int ai = 0; ai < 2; ++ai) {
#pragma unroll
            for (int m = 0; m < 4; ++m) { const size_t ro = (size_t)(row0 + ai * HALF + m * 16) * ldc + col0; float q = 0.f;
#pragma unroll
                for (int bj = 0; bj < 2; ++bj) { const u32x4 rw = r[ai][m][bj]; const unsigned rr[4] = {rw.x, rw.y, rw.z, rw.w}; unsigned ow[4];
#pragma unroll
                    for (int k = 0; k < 4; ++k) { const f32x4 a = acc[ai][bj][m][k >> 1];
                        const float lo = __builtin_bit_cast(float, rr[k] << 16) + a[2 * (k & 1)] * scale, hi = __builtin_bit_cast(float, rr[k] & 0xffff0000u) + a[2 * (k & 1) + 1] * scale;
                        const unsigned w = cvt_pk_bf16(lo, hi); ow[k] = w;
                        const float l2 = __builtin_bit_cast(float, w << 16), h2 = __builtin_bit_cast(float, w & 0xffff0000u); q += l2 * l2 + h2 * h2; }
                    u32x4 o; o.x = ow[0]; o.y = ow[1]; o.z = ow[2]; o.w = ow[3]; *(u32x4*)(xb + ro + bj * HALF) = o; }
                q += __shfl_xor(q, 16); q += __shfl_xor(q, 32);
                if (fq == 0) rowss[(size_t)(u.pn * 4 + wc) * M_ + row0 + ai * HALF + m * 16] = q; }
            __builtin_amdgcn_sched_barrier(0);
        }
    }
};
struct EpiSwiGLU {
    static constexpr bool PERM = true, AFTER_DRAIN = false;
    bf16_t* O; int ldc; const PG8_LAS int* tbl; const PG8_LAS float* rsl; int dbg;
    __device__ __forceinline__ void operator()(const f32x4 (&acc)[2][2][4][2], const Unit& u, int wr, int wc, int fr, int fq) const {
        if (dbg == 3) return;
        const int row0 = u.pm * BM + wr * 64 + fr, col0 = u.pn * HALF + wc * 32 + 8 * fq;
        float rs[2][4]; row_rstd8(tbl, rsl, u, wr * 64 + fr, rs);
#pragma unroll
        for (int ai = 0; ai < 2; ++ai)
#pragma unroll
            for (int m = 0; m < 4; ++m) { bf16_t* rowp = O + (size_t)(row0 + ai * HALF + m * 16) * ldc + col0; const float r = rs[ai][m];
                const f32x4 g0 = acc[ai][0][m][0] * r, g1 = acc[ai][0][m][1] * r, u0 = acc[ai][1][m][0] * r, u1 = acc[ai][1][m][1] * r;
                u32x4 w; w.x = cvt_pk_bf16(fast_silu(g0[0]) * u0[0], fast_silu(g0[1]) * u0[1]); w.y = cvt_pk_bf16(fast_silu(g0[2]) * u0[2], fast_silu(g0[3]) * u0[3]);
                w.z = cvt_pk_bf16(fast_silu(g1[0]) * u1[0], fast_silu(g1[1]) * u1[1]); w.w = cvt_pk_bf16(fast_silu(g1[2]) * u1[2], fast_silu(g1[3]) * u1[3]);
                if (dbg != 2 || w.x == 0x12345u) *(u32x4*)rowp = w; }
    }
};

template <class Epi, class Sched, bool ALIGN_EPI = false, bool SP2 = false>
__device__ __forceinline__ void gemm_phase(PG8_LAS unsigned char* lds, const Gemm g, const Sched& S, const Epi& E, const int tid_in) {
    const int tid = tid_in, wid = __builtin_amdgcn_readfirstlane(tid >> 6), lane = tid & 63, wr = wid >> 2, wc = wid & 3, fr = lane & 15, fq = lane >> 4;
    const int K = g.K, nt = K / BK;
    unsigned voffA[2], voffB[2];
#pragma unroll
    for (int i = 0; i < 2; ++i) { int R, C; stage_rc(tid * 16 + i * 8192, R, C); const int Rb = Epi::PERM ? ((R & ~31) + perm32(R & 31)) : R;
        voffA[i] = (unsigned)(R * K + C) * 2u; voffB[i] = (unsigned)(Rb * K + C) * 2u; }
    const size_t kstep = (size_t)(BK * 2);
    const size_t hstep = (size_t)HALF * K * 2;
    const size_t tstep = 2 * hstep;
    const unsigned ldsw = (unsigned)wid * 1024u;
    const int aoff = lds_byte(wr * 64 + fr, fq * 8), boff = lds_byte(wc * 32 + fr, fq * 8);
#define PG8_SA(b, h) (((b) * 2 + (h)) * HTB)
#define PG8_SB(b, h) ((4 + (b) * 2 + (h)) * HTB)
#define PG8_STAGE(bufoff, gbase, voff) do { _Pragma("unroll") for (int _i = 0; _i < 2; ++_i) \
        __builtin_amdgcn_global_load_lds((const unsigned*)((const char*)(gbase) + (voff)[_i]), (PG8_LAS unsigned*)(lds + (bufoff) + ldsw + _i * 8192), 16, 0, 0); } while (0)
#define PG8_LDA(dst, b, h) do { _Pragma("unroll") for (int m = 0; m < 4; ++m) _Pragma("unroll") for (int k = 0; k < 2; ++k) dst[m][k] = *(const PG8_LAS bf16x8*)(lds + PG8_SA(b, h) + aoff + m * 2048 + k * 1024); } while (0)
#define PG8_LDB(dst, b, h) do { _Pragma("unroll") for (int n = 0; n < 2; ++n) _Pragma("unroll") for (int k = 0; k < 2; ++k) dst[n][k] = *(const PG8_LAS bf16x8*)(lds + PG8_SB(b, h) + boff + n * 2048 + k * 1024); } while (0)
#define PG8_MMA(ai, bj, At, Bt) do { __builtin_amdgcn_s_setprio(1); _Pragma("unroll") for (int m = 0; m < 4; ++m) _Pragma("unroll") for (int n = 0; n < 2; ++n) _Pragma("unroll") for (int k = 0; k < 2; ++k) \
        acc[ai][bj][m][n] = __builtin_amdgcn_mfma_f32_16x16x32_bf16(Bt[n][k], At[m][k], acc[ai][bj][m][n], 0, 0, 0); __builtin_amdgcn_s_setprio(0); } while (0)
#define PG8_WAIT_V(n) asm volatile("s_waitcnt vmcnt(" #n ")" ::: "memory")
#define PG8_WAIT_L(n) asm volatile("s_waitcnt lgkmcnt(" #n ")" ::: "memory")
#define PG8_BAR __builtin_amdgcn_s_barrier()
#define PG8_SCHED __builtin_amdgcn_sched_barrier(0)
    Unit cur, nxt; int ui = 0;
    if (!S.next(0, cur)) return;
    f32x4 acc[2][2][4][2];
#pragma unroll
    for (int a = 0; a < 2; ++a)
#pragma unroll
        for (int b = 0; b < 2; ++b)
#pragma unroll
            for (int m = 0; m < 4; ++m)
#pragma unroll
                for (int n = 0; n < 2; ++n) acc[a][b][m][n] = (f32x4){0.f, 0.f, 0.f, 0.f};
    bf16x8 At[4][2], B0[2][2], B1[2][2];
    const char* cA = (const char*)g.A + (size_t)cur.pm * tstep; const char* cB = (const char*)g.Bt + (size_t)cur.pn * tstep;
    S.a_ready(cur);
    if constexpr (SP2) {
        PG8_STAGE(PG8_SB(0, 0), cB, voffB); PG8_STAGE(PG8_SB(0, 1), cB + hstep, voffB); PG8_STAGE(PG8_SA(0, 0), cA, voffA); PG8_STAGE(PG8_SA(0, 1), cA + hstep, voffA);
        if (wr == 1) PG8_BAR;
        PG8_WAIT_V(2); PG8_BAR;
        PG8_STAGE(PG8_SB(1, 0), cB + kstep, voffB); PG8_STAGE(PG8_SA(1, 0), cA + kstep, voffA); PG8_STAGE(PG8_SB(1, 1), cB + hstep + kstep, voffB);
        PG8_WAIT_V(6); PG8_BAR;
    } else {
        PG8_STAGE(PG8_SB(0, 0), cB, voffB); PG8_STAGE(PG8_SA(0, 0), cA, voffA); PG8_STAGE(PG8_SB(0, 1), cB + hstep, voffB); PG8_STAGE(PG8_SA(0, 1), cA + hstep, voffA);
        if (wr == 1) PG8_BAR;
        PG8_WAIT_V(4); PG8_BAR;
        PG8_STAGE(PG8_SB(1, 0), cB + kstep, voffB); PG8_STAGE(PG8_SA(1, 0), cA + kstep, voffA); PG8_STAGE(PG8_SB(1, 1), cB + hstep + kstep, voffB);
        PG8_WAIT_V(6); PG8_BAR;
    }
    for (;;) {
        const bool has_next = S.next(ui + 1, nxt);
        const char* nA = has_next ? (const char*)g.A + (size_t)nxt.pm * tstep : cA; const char* nB = has_next ? (const char*)g.Bt + (size_t)nxt.pn * tstep : cB;
        for (int t = 0; t < nt; t += 2) {
            const bool last = (t == nt - 2);
            const char* a1 = cA + (size_t)(t + 1) * kstep;
            const char* a2 = last ? nA : cA + (size_t)(t + 2) * kstep; const char* b2 = last ? nB : cB + (size_t)(t + 2) * kstep;
            const char* a3 = a2 + kstep; const char* b3 = b2 + kstep;
            if (last && has_next) S.a_ready(nxt);
            if constexpr (SP2) {
            PG8_LDB(B0, 0, 0); PG8_LDB(B1, 0, 1); PG8_SCHED; PG8_LDA(At, 0, 0); PG8_STAGE(PG8_SA(1, 1), a1 + hstep, voffA);
            PG8_WAIT_V(8); PG8_WAIT_L(0); PG8_BAR; PG8_MMA(0, 0, At, B0); PG8_MMA(0, 1, At, B1); PG8_BAR; PG8_SCHED;
            PG8_LDA(At, 0, 1); PG8_STAGE(PG8_SB(0, 0), b2, voffB); PG8_STAGE(PG8_SB(0, 1), b2 + hstep, voffB); PG8_STAGE(PG8_SA(0, 0), a2, voffA);
            PG8_WAIT_V(8); PG8_WAIT_L(0); PG8_BAR; PG8_MMA(1, 0, At, B0); PG8_MMA(1, 1, At, B1); PG8_BAR; PG8_SCHED;
            PG8_LDB(B0, 1, 0); PG8_LDB(B1, 1, 1); PG8_SCHED; PG8_LDA(At, 1, 0); PG8_STAGE(PG8_SA(0, 1), a2 + hstep, voffA);
            PG8_WAIT_V(8); PG8_WAIT_L(0); PG8_BAR; PG8_MMA(0, 0, At, B0); PG8_MMA(0, 1, At, B1); PG8_BAR; PG8_SCHED;
            PG8_LDA(At, 1, 1); PG8_STAGE(PG8_SB(1, 0), b3, voffB); PG8_STAGE(PG8_SB(1, 1), b3 + hstep, voffB); PG8_STAGE(PG8_SA(1, 0), a3, voffA);
            PG8_WAIT_V(8); PG8_WAIT_L(0); PG8_BAR; PG8_MMA(1, 0, At, B0); PG8_MMA(1, 1, At, B1); PG8_BAR; PG8_SCHED;
            } else {
            PG8_LDB(B0, 0, 0); PG8_SCHED; PG8_LDA(At, 0, 0); PG8_STAGE(PG8_SA(1, 1), a1 + hstep, voffA);
            PG8_WAIT_L(8); PG8_BAR; PG8_WAIT_L(0); PG8_MMA(0, 0, At, B0); PG8_BAR; PG8_SCHED;
            PG8_LDB(B1, 0, 1); PG8_STAGE(PG8_SB(0, 0), b2, voffB);
            PG8_BAR; PG8_WAIT_L(0); PG8_MMA(0, 1, At, B1); PG8_BAR;
            PG8_LDA(At, 0, 1); PG8_STAGE(PG8_SA(0, 0), a2, voffA);
            PG8_BAR; PG8_WAIT_L(0); PG8_MMA(1, 0, At, B0); PG8_BAR; PG8_SCHED;
            PG8_STAGE(PG8_SB(0, 1), b2 + hstep, voffB);
            PG8_WAIT_V(6); PG8_BAR; PG8_MMA(1, 1, At, B1); PG8_BAR;
            PG8_LDB(B0, 1, 0); PG8_SCHED; PG8_LDA(At, 1, 0); PG8_STAGE(PG8_SA(0, 1), a2 + hstep, voffA);
            PG8_WAIT_L(8); PG8_BAR; PG8_WAIT_L(0); PG8_MMA(0, 0, At, B0); PG8_BAR; PG8_SCHED;
            PG8_LDB(B1, 1, 1); PG8_STAGE(PG8_SB(1, 0), b3, voffB);
            PG8_BAR; PG8_WAIT_L(0); PG8_MMA(0, 1, At, B1); PG8_BAR;
            PG8_LDA(At, 1, 1); PG8_STAGE(PG8_SA(1, 0), a3, voffA);
            PG8_BAR; PG8_WAIT_L(0); PG8_MMA(1, 0, At, B0); PG8_BAR; PG8_SCHED;
            PG8_STAGE(PG8_SB(1, 1), b3 + hstep, voffB);
            PG8_WAIT_V(6); PG8_BAR; PG8_MMA(1, 1, At, B1); PG8_BAR;
            }
        }
        if constexpr (ALIGN_EPI) { if (wr == 0) PG8_BAR; }
        if constexpr (!Epi::AFTER_DRAIN) { E(acc, cur, wr, wc, fr, fq); S.done(cur); }
        if (!has_next) break;
#pragma unroll
        for (int a = 0; a < 2; ++a)
#pragma unroll
            for (int b = 0; b < 2; ++b)
#pragma unroll
                for (int m = 0; m < 4; ++m)
#pragma unroll
                    for (int n = 0; n < 2; ++n) acc[a][b][m][n] = (f32x4){0.f, 0.f, 0.f, 0.f};
        cur = nxt; cA = nA; cB = nB; ++ui;
        if constexpr (ALIGN_EPI) { if (wr == 1) PG8_BAR; }
    }
    PG8_WAIT_V(0);
    if constexpr (!ALIGN_EPI) { if (wr == 0) PG8_BAR; }
    PG8_BAR;
    if constexpr (Epi::AFTER_DRAIN) { E.fused(acc, cur, wr, wc, fr, fq, lds, wid, lane); S.done(cur); }
#undef PG8_SA
#undef PG8_SB
#undef PG8_STAGE
#undef PG8_LDA
#undef PG8_LDB
#undef PG8_MMA
#undef PG8_WAIT_V
#undef PG8_WAIT_L
#undef PG8_BAR
#undef PG8_SCHED
}
}

#define PG8_SP2 true
#ifndef REP_MODE
#define REP_MODE 1
#endif
#ifndef NSA_NAIVE
#define NSA_NAIVE 0
#endif
#ifndef REC_NAIVE
#define REC_NAIVE 0
#endif
#define PG8_ALIGN true

constexpr int NWAVES = 8, NT = NWAVES * 64;
constexpr int BATCH = 8, SEQ = 4096, D = 1024, DEPTH = 4, M = BATCH * SEQ;
constexpr int EVEN_IN = 3352, PE = 3584;
constexpr int PO = 4096;
constexpr int FF = 2816, FF2 = 2 * FF;
constexpr int C_RQ = 0, C_RK = 512, C_RV = 1024, C_RG = 1536, C_NQ = 2048, C_KC = 2560, C_VC = 2688, C_KS = 2816, C_VS = 2944, C_KW = 3072, C_VW = 3200, C_NG = 3328;
constexpr int C_HQ = 0, C_HF = 1024, C_HI = 2048, C_HG = 3072;
constexpr int NCMP = 255;
constexpr float RMS_EPS = 1e-6f;

constexpr size_t MiB = 1u << 20;
constexpr size_t WS_CTL = 0, CTL_ZERO_BYTES = 1 * MiB;
constexpr size_t WS_ROPE = 1 * MiB;
constexpr size_t WS_LB = 3 * MiB;
constexpr size_t WS_KCMP = 4 * MiB;
constexpr size_t WS_CBIAS = 3 * MiB + 16 * 1024;
constexpr size_t WS_W1T = 4 * MiB;
constexpr size_t WS_ROWSS = 5 * MiB;
constexpr size_t WS_SEL = 6 * MiB;
constexpr size_t WS_WEIN = 8 * MiB;
constexpr size_t WS_WEOUT = 22 * MiB;
constexpr size_t WS_WOIN = 26 * MiB;
constexpr size_t WS_WOOUT = 42 * MiB;
constexpr size_t WS_W13 = 46 * MiB;
constexpr size_t WS_W2 = 90 * MiB;
constexpr size_t WS_H = 112 * MiB;
constexpr size_t WS_PROJ = 176 * MiB;
constexpr size_t WS_MIXED = 432 * MiB;
constexpr size_t WS_KCB = 7 * MiB;
constexpr size_t WS_VCTB = 7 * MiB + 512 * 1024;
constexpr size_t WS_VT = 496 * MiB;
constexpr size_t WS_KT = 400 * MiB;
constexpr size_t WS_END = 512 * MiB;
constexpr int CW_BAR = 4096, CW_Q = 8192;

constexpr int RING_BYTES = 131072;
constexpr int LDSCTL_OFF = 146944, MISC_OFF = LDSCTL_OFF + 320;
constexpr int LDS_BYTES = 147456;

#define GAS __attribute__((address_space(1)))
#define LAS __attribute__((address_space(3)))
typedef unsigned short bf16;
typedef unsigned v4u __attribute__((ext_vector_type(4)));
typedef unsigned v2u __attribute__((ext_vector_type(2)));
typedef float f32x4 __attribute__((ext_vector_type(4)));
typedef float f32x2 __attribute__((ext_vector_type(2)));
typedef GAS unsigned gu32;
#define RLX_AGENT __ATOMIC_RELAXED, __HIP_MEMORY_SCOPE_AGENT
#define LDS_WAIT() asm volatile("s_waitcnt lgkmcnt(0)" ::: "memory")
#define VM_WAIT() asm volatile("s_waitcnt vmcnt(0)" ::: "memory")
__device__ __forceinline__ unsigned f2bf(float f) { unsigned u = __builtin_bit_cast(unsigned, f); return (u + 0x7fffu + ((u >> 16) & 1u)) >> 16; }
typedef float f32x2_t __attribute__((ext_vector_type(2)));
typedef __bf16 bf16x2_t __attribute__((ext_vector_type(2)));
__device__ __forceinline__ unsigned pk2(float lo, float hi) { f32x2_t v = {lo, hi}; bf16x2_t r = __builtin_convertvector(v, bf16x2_t); return __builtin_bit_cast(unsigned, r); }
__device__ __forceinline__ float bf2f(unsigned v) { return __builtin_bit_cast(float, v << 16); }
__device__ __forceinline__ float bflo(unsigned w) { return __builtin_bit_cast(float, w << 16); }
__device__ __forceinline__ float bfhi(unsigned w) { return __builtin_bit_cast(float, w & 0xffff0000u); }
__device__ __forceinline__ float sigmoidf_(float x) { return __builtin_amdgcn_rcpf(1.0f + __expf(-x)); }
__device__ __forceinline__ float siluf_(float x) { return x * __builtin_amdgcn_rcpf(1.0f + __expf(-x)); }

#define XB_TMO      128
#define XB_XCNT(j)  (256  + 64 * (j))
#define XB_XSUB(j)  (1280 + 64 * (j))
#define XB_XGEN(j)  (2304 + 64 * (j))
#define XB_TOP      3328
#define XB_TOPGEN   3392
#define XCD_BAR_WORDS 3456
#define XB_SPIN_CAP (1u << 18)
__device__ __forceinline__ unsigned xb_ld(unsigned* p)              { return __hip_atomic_load(p, __ATOMIC_RELAXED, __HIP_MEMORY_SCOPE_AGENT); }
__device__ __forceinline__ unsigned xb_add(unsigned* p, unsigned v) { return __hip_atomic_fetch_add(p, v, __ATOMIC_RELAXED, __HIP_MEMORY_SCOPE_AGENT); }
__device__ __forceinline__ unsigned xb_xcc_id() { return (unsigned)__builtin_amdgcn_s_getreg((3 << 11) | 20) & 0xFu; }
#define XB_SPIN(cond, bar) do { unsigned _sp = 0; while (cond) { __builtin_amdgcn_s_sleep(1); \
    if ((++_sp & 255u) == 0u) { if (xb_ld(&(bar)[XB_TMO])) break; if (_sp > XB_SPIN_CAP) { atomicAdd(&(bar)[XB_TMO], 1u); break; } } } } while (0)
struct XcdBarrier { unsigned* bar; unsigned x; volatile LAS unsigned* st; };
__device__ __forceinline__ XcdBarrier xcd_barrier_post(unsigned* bar, volatile LAS unsigned* st) {
    XcdBarrier b; b.bar = bar; b.x = xb_xcc_id(); b.st = st;
    if (threadIdx.x == 0) (void)xb_add(&bar[XB_XCNT(b.x)], 1u);
    return b;
}
__device__ __forceinline__ void xcd_barrier_complete(unsigned* bar, unsigned x, unsigned& nloc, unsigned& nx) {
    const unsigned G = gridDim.x * gridDim.y * gridDim.z;
    unsigned sum, cnt, mine, sp = 0u;
    for (;;) {
        sum = 0u; cnt = 0u; mine = 0u;
#pragma unroll
        for (unsigned j = 0; j < 16; ++j) { const unsigned c = xb_ld(&bar[XB_XCNT(j)]); sum += c; cnt += (c > 0u) ? 1u : 0u; mine = (j == x) ? c : mine; }
        if (sum == G) break;
        __builtin_amdgcn_s_sleep(1);
        if ((++sp & 255u) == 0u) { if (xb_ld(&bar[XB_TMO])) break; if (sp > XB_SPIN_CAP) { atomicAdd(&bar[XB_TMO], 1u); break; } }
    }
    nloc = mine > 0u ? mine : 1u; nx = cnt > 0u ? cnt : 1u;
}
__device__ __forceinline__ void xcd_barrier(const XcdBarrier& b) {
    asm volatile("s_waitcnt vmcnt(0)" ::: "memory");
    __syncthreads();
    if (threadIdx.x == 0) {
        unsigned* bar = b.bar;
        __builtin_amdgcn_s_waitcnt(0);
        unsigned nloc = b.st[0], nx = b.st[1];
        if (nloc == 0u) { xcd_barrier_complete(bar, b.x, nloc, nx); b.st[0] = nloc; b.st[1] = nx; }
        const unsigned old = xb_add(&bar[XB_XSUB(b.x)], 1u);
        const unsigned gen = old / nloc;
        if (old + 1u == (gen + 1u) * nloc) {
            __builtin_amdgcn_fence(__ATOMIC_RELEASE, "agent");
            asm volatile("s_waitcnt vmcnt(0)" ::: "memory");
            const unsigned og = xb_add(&bar[XB_TOP], 1u);
            const unsigned tg = og / nx;
            if (og + 1u == (tg + 1u) * nx) xb_add(&bar[XB_TOPGEN], 1u);
            else XB_SPIN(xb_ld(&bar[XB_TOPGEN]) == tg, bar);
            __builtin_amdgcn_fence(__ATOMIC_ACQUIRE, "agent");
            xb_add(&bar[XB_XGEN(b.x)], 1u);
            asm volatile("s_waitcnt vmcnt(0)" ::: "memory");
        } else {
            XB_SPIN(xb_ld(&bar[XB_XGEN(b.x)]) == gen, bar);
            __builtin_amdgcn_fence(__ATOMIC_ACQUIRE, "agent");
            asm volatile("s_waitcnt vmcnt(0)" ::: "memory");
        }
    }
    __syncthreads();
}

__device__ __forceinline__ float wave_sum(float v) {
#pragma unroll
    for (int o = 1; o < 64; o <<= 1) v += __shfl_xor(v, o);
    return v;
}
__device__ __forceinline__ float wave_max(float v) {
#pragma unroll
    for (int o = 1; o < 64; o <<= 1) v = fmaxf(v, __shfl_xor(v, o));
    return v;
}

__device__ __forceinline__ int inproj_row(int rmode, int cs) {
    if (rmode == 1 && cs < 1024) { const int isk = cs >> 9, hd = (cs & 511) >> 7, ch = cs & 127, half = ch >> 6, i = ch & 63; return 256 * hd + 128 * isk + 32 * (i >> 4) + 8 * ((i >> 2) & 3) + 4 * half + (i & 3); }
    if (rmode == 2 && cs < 2048) { const int isf = cs >> 10, hd = (cs & 1023) >> 7, ch = cs & 127; return 256 * hd + 128 * isf + ch; }
    return cs;
}
__device__ __forceinline__ void tr_item64(const float* W, int K, int N, bf16* WT, int k0, int n0, int drow0, LAS unsigned* scr, int lane, const float* gain = nullptr, int rmode = 0) {
    const int q = lane >> 4, nl4 = 4 * (lane & 15); const bool ok = n0 + nl4 < N;
    const GAS float* src = (const GAS float*)W + (size_t)(k0 + 2 * q) * N + n0 + nl4;
    f32x4 v[16]; f32x2 g[8];
#pragma unroll
    for (int j = 0; j < 16; ++j) { const int kr = 8 * (j >> 1) + (j & 1); v[j] = ok ? *(const GAS f32x4*)(src + (size_t)kr * N) : (f32x4){0.f, 0.f, 0.f, 0.f}; }
#pragma unroll
    for (int i = 0; i < 8; ++i) g[i] = gain ? *(const GAS f32x2*)((const GAS float*)gain + k0 + 2 * q + 8 * i) : (f32x2){1.0f, 1.0f};
    __builtin_amdgcn_sched_barrier(0);
#pragma unroll
    for (int i = 0; i < 8; ++i) { const f32x4 a = v[2 * i] * g[i].x, b = v[2 * i + 1] * g[i].y; LAS unsigned* d = scr + (4 * i + q) * 66 + nl4;
        v2u w0; w0.x = pk2(a.x, b.x); w0.y = pk2(a.y, b.y); v2u w1; w1.x = pk2(a.z, b.z); w1.y = pk2(a.w, b.w);
        *(LAS v2u*)d = w0; *(LAS v2u*)(d + 2) = w1; }
    LDS_WAIT(); asm volatile("" ::: "memory");
    const int c = lane & 7;
#pragma unroll
    for (int jj = 0; jj < 8; ++jj) { const int n = (lane >> 3) + 8 * jj; const LAS unsigned* sp = scr + (4 * c) * 66 + n;
        v4u o; o.x = sp[0]; o.y = sp[66]; o.z = sp[132]; o.w = sp[198];
        *(GAS v4u*)(WT + (size_t)(rmode ? inproj_row(rmode, n0 + n) : drow0 + n) * K + k0 + 8 * c) = o; }
    LDS_WAIT(); asm volatile("" ::: "memory");
}
__device__ __forceinline__ void rms_row_to_bf16(const float* xrow, const float* g, bf16* orow, int lane) {
    const GAS f32x4* xr = (const GAS f32x4*)xrow + lane; const GAS f32x4* gr = (const GAS f32x4*)g + lane;
    f32x4 v[4]; float s = 0.f;
#pragma unroll
    for (int j = 0; j < 4; ++j) { v[j] = xr[64 * j]; s += (v[j].x * v[j].x + v[j].y * v[j].y) + (v[j].z * v[j].z + v[j].w * v[j].w); }
    const float r = 1.0f / sqrtf(wave_sum(s) * (1.f / D) + RMS_EPS);
    GAS v2u* o8 = (GAS v2u*)orow + lane;
#pragma unroll
    for (int j = 0; j < 4; ++j) { const f32x4 gg = gr[64 * j]; v2u w; w.x = pk2(v[j].x * r * gg.x, v[j].y * r * gg.y); w.y = pk2(v[j].z * r * gg.z, v[j].w * r * gg.w); o8[64 * j] = w; }
}
__device__ __forceinline__ void row_to_bf16_ss(const float* xrow, bf16* orow, float* rowss, int m, int lane) {
    const GAS f32x4* xr = (const GAS f32x4*)xrow + lane;
    f32x4 v[4]; float s = 0.f;
#pragma unroll
    for (int j = 0; j < 4; ++j) { v[j] = xr[64 * j]; s += (v[j].x * v[j].x + v[j].y * v[j].y) + (v[j].z * v[j].z + v[j].w * v[j].w); }
    s = wave_sum(s);
    GAS v2u* o8 = (GAS v2u*)orow + lane;
#pragma unroll
    for (int j = 0; j < 4; ++j) { v2u w; w.x = pk2(v[j].x, v[j].y); w.y = pk2(v[j].z, v[j].w); o8[64 * j] = w; }
    if (lane < 16) rowss[(size_t)lane * M + m] = lane == 0 ? s : 0.f;
}
__device__ __forceinline__ void rows2_to_bf16_ss(const float* xa, const float* xb, bf16* oa, bf16* ob, float* rowss, int ma, int mb, int lane) {
    const GAS f32x4* xr0 = (const GAS f32x4*)xa + lane; const GAS f32x4* xr1 = (const GAS f32x4*)xb + lane;
    f32x4 v[2][4]; float s0 = 0.f, s1 = 0.f;
#pragma unroll
    for (int j = 0; j < 4; ++j) { v[0][j] = xr0[64 * j]; v[1][j] = xr1[64 * j]; }
#pragma unroll
    for (int j = 0; j < 4; ++j) { s0 += (v[0][j].x * v[0][j].x + v[0][j].y * v[0][j].y) + (v[0][j].z * v[0][j].z + v[0][j].w * v[0][j].w); s1 += (v[1][j].x * v[1][j].x + v[1][j].y * v[1][j].y) + (v[1][j].z * v[1][j].z + v[1][j].w * v[1][j].w); }
#pragma unroll
    for (int o = 1; o < 64; o <<= 1) { s0 += __shfl_xor(s0, o); s1 += __shfl_xor(s1, o); }
    GAS v2u* o0 = (GAS v2u*)oa + lane; GAS v2u* o1 = (GAS v2u*)ob + lane;
#pragma unroll
    for (int j = 0; j < 4; ++j) { v2u w; w.x = pk2(v[0][j].x, v[0][j].y); w.y = pk2(v[0][j].z, v[0][j].w); o0[64 * j] = w; v2u w2; w2.x = pk2(v[1][j].x, v[1][j].y); w2.y = pk2(v[1][j].z, v[1][j].w); o1[64 * j] = w2; }
    if (lane < 16) { rowss[(size_t)lane * M + ma] = lane == 0 ? s0 : 0.f; rowss[(size_t)lane * M + mb] = lane == 0 ? s1 : 0.f; }
}
__device__ __forceinline__ void rms_row_bf16_to_f32(const bf16* xrow, const float* g, float* orow, int lane) {
    const GAS v4u* xr = (const GAS v4u*)xrow + lane; const GAS f32x4* gr = (const GAS f32x4*)g + 2 * lane;
    v4u w[2]; float v[2][8]; float s = 0.f;
#pragma unroll
    for (int j = 0; j < 2; ++j) { w[j] = xr[64 * j]; const unsigned ww[4] = {w[j].x, w[j].y, w[j].z, w[j].w};
#pragma unroll
        for (int k = 0; k < 4; ++k) { v[j][2 * k] = bflo(ww[k]); v[j][2 * k + 1] = bfhi(ww[k]); s += v[j][2 * k] * v[j][2 * k] + v[j][2 * k + 1] * v[j][2 * k + 1]; } }
    const float r = __builtin_amdgcn_rsqf(wave_sum(s) * (1.f / D) + RMS_EPS);
    GAS f32x4* o = (GAS f32x4*)orow + 2 * lane;
#pragma unroll
    for (int j = 0; j < 2; ++j) { const f32x4 g0 = gr[128 * j], g1 = gr[128 * j + 1];
        o[128 * j] = (f32x4){v[j][0] * r * g0.x, v[j][1] * r * g0.y, v[j][2] * r * g0.z, v[j][3] * r * g0.w}; o[128 * j + 1] = (f32x4){v[j][4] * r * g1.x, v[j][5] * r * g1.y, v[j][6] * r * g1.z, v[j][7] * r * g1.w}; }
}
__device__ __forceinline__ void rms_row_to_f32(float* xrow, const float* g, int lane) {
    GAS f32x4* xr = (GAS f32x4*)xrow + lane; const GAS f32x4* gr = (const GAS f32x4*)g + lane;
    f32x4 v[4]; float s = 0.f;
#pragma unroll
    for (int j = 0; j < 4; ++j) { v[j] = xr[64 * j]; s += (v[j].x * v[j].x + v[j].y * v[j].y) + (v[j].z * v[j].z + v[j].w * v[j].w); }
    const float r = 1.0f / sqrtf(wave_sum(s) * (1.f / D) + RMS_EPS);
#pragma unroll
    for (int j = 0; j < 4; ++j) { const f32x4 gg = gr[64 * j]; xr[64 * j] = (f32x4){v[j].x * r * gg.x, v[j].y * r * gg.y, v[j].z * r * gg.z, v[j].w * r * gg.w}; }
}

__device__ __forceinline__ void convert_weights(const float* const* in, unsigned char* ws, int half, LAS unsigned* scr, int w0, int nw, int lane) {
    constexpr int I_EIN = 16 * 56, I_SQ = 16 * 16, I_OIN = 16 * 64, I_W1 = 16 * 44, I_W2 = 44 * 16;
    constexpr int NITEMS = I_EIN + I_SQ + I_OIN + I_SQ + 2 * I_W1 + 2 * I_W1 + 2 * I_W2;
    const int j = half;
    for (int it = w0; it < NITEMS; it += nw) {
        int r = it;
        if (r < I_EIN) { tr_item64(in[4] + (size_t)j * D * EVEN_IN, D, EVEN_IN, (bf16*)(ws + WS_WEIN) + (size_t)j * PE * D, (r / 56) * 64, (r % 56) * 64, (r % 56) * 64, scr, lane, in[1] + (size_t)(2 * j) * D, 1); continue; } r -= I_EIN;
        if (r < I_SQ) { tr_item64(in[5] + (size_t)j * D * D, D, D, (bf16*)(ws + WS_WEOUT) + (size_t)j * D * D, (r / 16) * 64, (r % 16) * 64, (r % 16) * 64, scr, lane); continue; } r -= I_SQ;
        if (r < I_OIN) { tr_item64(in[12] + (size_t)j * D * PO, D, PO, (bf16*)(ws + WS_WOIN) + (size_t)j * PO * D, (r / 64) * 64, (r % 64) * 64, (r % 64) * 64, scr, lane, in[1] + (size_t)(2 * j + 1) * D, 2); continue; } r -= I_OIN;
        if (r < I_SQ) { tr_item64(in[13] + (size_t)j * D * D, D, D, (bf16*)(ws + WS_WOOUT) + (size_t)j * D * D, (r / 16) * 64, (r % 16) * 64, (r % 16) * 64, scr, lane); continue; } r -= I_SQ;
        if (r < 4 * I_W1) { const int which = r / (2 * I_W1); r %= 2 * I_W1; const int l = 2 * half + r / I_W1; r %= I_W1; const int n0 = (r % 44) * 64;
            tr_item64(in[which ? 17 : 16] + (size_t)l * D * FF, D, FF, (bf16*)(ws + WS_W13) + (size_t)l * FF2 * D, (r / 44) * 64, n0, 256 * (n0 / 128) + (n0 % 128) + 128 * which, scr, lane, in[2] + (size_t)l * D); continue; } r -= 4 * I_W1;
        { const int l = 2 * half + r / I_W2; r %= I_W2; tr_item64(in[18] + (size_t)l * FF * D, FF, D, (bf16*)(ws + WS_W2) + (size_t)l * D * FF, (r / 16) * 64, (r % 16) * 64, (r % 16) * 64, scr, lane); }
    }
}

constexpr int RS_TBL_OFF = RING_BYTES, RS_TAB_OFF = RING_BYTES + 1024;
template <class Sched>
__device__ __forceinline__ void build_rstd_table(LAS unsigned char* lds, const Sched& S, const float* rowss, int tid) {
    LAS int* tbl = (LAS int*)(lds + RS_TBL_OFF); LAS float* rsl = (LAS float*)(lds + RS_TAB_OFF); LAS int* spm = tbl + 128;
    if (tid < 16) { pg8::Unit u; const bool ok = tid < 14 && S.next(tid, u); spm[tid] = ok ? u.pm : -1; if (ok) tbl[u.pm] = tid; }
    __syncthreads();
#pragma unroll 1
    for (int sl = tid >> 8; sl < 14; sl += 2) { const int pm = spm[sl]; if (pm < 0) break;
        const int row = pm * 256 + (tid & 255); float p[16];
#pragma unroll
        for (int pl = 0; pl < 16; ++pl) p[pl] = rowss[(size_t)pl * M + row];
        float q = 0.f;
#pragma unroll
        for (int pl = 0; pl < 16; ++pl) q += p[pl];
        rsl[sl * 256 + (tid & 255)] = __builtin_amdgcn_rsqf(q * (1.0f / 1024.0f) + RMS_EPS); }
    __syncthreads();
}

template <int MODE>
__device__ __forceinline__ void recur_unit(LAS unsigned char* lds, int b, int hd, const bf16* proj, int ldp, const float2* rope, const float* lb, const float* ng, bf16* mixed, int tid, int lane, int wave) {
    LAS float* sq = (LAS float*)lds;
    LAS float* sk = sq + 2048;
    LAS float* sv = sk + 2048;
    LAS float* so = sv + 2048;
    LAS float* sf = so + 2048;
    const int e = tid >> 2, ds = tid & 3;
    float S[32];
#pragma unroll
    for (int i = 0; i < 32; ++i) S[i] = 0.f;
    const float gamma = 1.0f - exp2f(-5.0f - (float)hd);
    for (int blk = 0; blk < SEQ / 16; ++blk) {
        {
            const int tt = tid >> 5, ii = tid & 31; const int pos = blk * 16 + tt; const size_t row = (size_t)(b * SEQ + pos) * ldp;
            if (MODE == 0) {
#pragma unroll
                for (int h2 = 0; h2 < 2; ++h2) { const int i = ii + 32 * h2; const float2 cs = rope[pos * 64 + i];
                    const float q1 = bf2f(proj[row + C_RQ + hd * 128 + i]), q2 = bf2f(proj[row + C_RQ + hd * 128 + i + 64]);
                    const float k1 = bf2f(proj[row + C_RK + hd * 128 + i]), k2 = bf2f(proj[row + C_RK + hd * 128 + i + 64]);
                    sq[tt * 128 + i] = q1 * cs.x - q2 * cs.y; sq[tt * 128 + i + 64] = q1 * cs.y + q2 * cs.x;
                    sk[tt * 128 + i] = (k1 * cs.x - k2 * cs.y) * 0.08838834764831845f; sk[tt * 128 + i + 64] = (k1 * cs.y + k2 * cs.x) * 0.08838834764831845f; }
#pragma unroll
                for (int h4 = 0; h4 < 4; ++h4) sv[tt * 128 + ii + 32 * h4] = bf2f(proj[row + C_RV + hd * 128 + ii + 32 * h4]);
            } else {
#pragma unroll
                for (int h4 = 0; h4 < 4; ++h4) { const int d = ii + 32 * h4; const float qp = bf2f(proj[row + C_HQ + hd * 128 + d]), fp = bf2f(proj[row + C_HF + hd * 128 + d]);
                    const float l = lb[hd * 128 + d]; const float sg = sigmoidf_(fp);
                    sq[tt * 128 + d] = siluf_(qp) * 0.08838834764831845f; sf[tt * 128 + d] = l + (1.0f - l) * sg; sk[tt * 128 + d] = (1.0f - l) * (1.0f - sg);
                    sv[tt * 128 + d] = bf2f(proj[row + C_HI + hd * 128 + d]); }
            }
        }
        __syncthreads();
#pragma unroll 1
        for (int tt = 0; tt < 16; ++tt) {
            const float ve = sv[tt * 128 + e]; float po = 0.f;
#pragma unroll
            for (int i4 = 0; i4 < 8; ++i4) {
                const f32x4 q4 = *(const LAS f32x4*)(sq + tt * 128 + ds * 32 + i4 * 4), k4 = *(const LAS f32x4*)(sk + tt * 128 + ds * 32 + i4 * 4);
                f32x4 f4; if (MODE == 1) f4 = *(const LAS f32x4*)(sf + tt * 128 + ds * 32 + i4 * 4); else f4 = (f32x4){gamma, gamma, gamma, gamma};
                S[i4 * 4 + 0] = f4.x * S[i4 * 4 + 0] + k4.x * ve; po += q4.x * S[i4 * 4 + 0];
                S[i4 * 4 + 1] = f4.y * S[i4 * 4 + 1] + k4.y * ve; po += q4.y * S[i4 * 4 + 1];
                S[i4 * 4 + 2] = f4.z * S[i4 * 4 + 2] + k4.z * ve; po += q4.z * S[i4 * 4 + 2];
                S[i4 * 4 + 3] = f4.w * S[i4 * 4 + 3] + k4.w * ve; po += q4.w * S[i4 * 4 + 3];
            }
            po += __shfl_xor(po, 1); po += __shfl_xor(po, 2);
            if (ds == 0) so[tt * 128 + e] = po;
        }
        __syncthreads();
        {
#pragma unroll
            for (int r = 0; r < 2; ++r) { const int tt = wave * 2 + r; const int pos = blk * 16 + tt; const size_t trow = (size_t)(b * SEQ + pos);
                const float o0 = so[tt * 128 + lane], o1 = so[tt * 128 + lane + 64];
                float y0, y1;
                if (MODE == 0) {
                    const float mu = wave_sum(o0 + o1) * (1.f / 128.f); const float d0 = o0 - mu, d1 = o1 - mu;
                    const float var = wave_sum(d0 * d0 + d1 * d1) * (1.f / 128.f); const float rs = 1.0f / sqrtf(var + 1e-5f);
                    y0 = d0 * rs * siluf_(bf2f(proj[trow * ldp + C_RG + hd * 128 + lane])); y1 = d1 * rs * siluf_(bf2f(proj[trow * ldp + C_RG + hd * 128 + lane + 64]));
                } else {
                    const float ms = wave_sum(o0 * o0 + o1 * o1) * (1.f / 128.f); const float rs = 1.0f / sqrtf(ms + RMS_EPS);
                    y0 = o0 * rs * ng[lane] * sigmoidf_(bf2f(proj[trow * ldp + C_HG + hd * 128 + lane])); y1 = o1 * rs * ng[lane + 64] * sigmoidf_(bf2f(proj[trow * ldp + C_HG + hd * 128 + lane + 64]));
                }
                mixed[trow * D + hd * 128 + lane] = (bf16)f2bf(y0); mixed[trow * D + hd * 128 + lane + 64] = (bf16)f2bf(y1); }
        }
    }
    __syncthreads();
}

__device__ __forceinline__ float gelu_tanh(float x) { const float u = 0.7978845608028654f * (x + 0.044715f * x * x * x); const float t = 1.0f - 2.0f / (__expf(2.0f * u) + 1.0f); return 0.5f * x * (1.0f + t); }

__device__ __forceinline__ void compress_task(LAS float* xs  , int task, const bf16* proj, const float* pos_k, const float* w1_k, const float* w2_k, const float* pos_v, const float* w1_v, const float* w2_v, float* kcmp, bf16* kcb, bf16* vctb, int lane) {
    const int kv = task / (16 * NCMP); const int rem = task % (16 * NCMP); const int bg = rem / NCMP, i = rem % NCMP; const int b = bg >> 1, g = bg & 1;
    const float* pos = kv ? pos_v : pos_k; const float* w1 = kv ? w1_v : w1_k; const float* w2 = kv ? w2_v : w2_k;
    const int col = (kv ? C_VC : C_KC) + 64 * g + lane;
#pragma unroll 4
    for (int l = 0; l < 32; ++l) xs[l * 64 + lane] = bf2f(proj[(size_t)(b * SEQ + 16 * i + l) * PE + col]) + pos[l * 64 + lane];
    LDS_WAIT(); asm volatile("" ::: "memory");
    float pre = 0.f;
#pragma unroll 4
    for (int k = 0; k < 2048; k += 4) { const f32x4 a = *(const LAS f32x4*)(xs + k);
        pre += a.x * w1[(k + 0) * 64 + lane]; pre += a.y * w1[(k + 1) * 64 + lane]; pre += a.z * w1[(k + 2) * 64 + lane]; pre += a.w * w1[(k + 3) * 64 + lane]; }
    xs[2048 + lane] = gelu_tanh(pre);
    LDS_WAIT(); asm volatile("" ::: "memory");
    float o = 0.f;
#pragma unroll 4
    for (int c = 0; c < 64; c += 4) { const f32x4 a = *(const LAS f32x4*)(xs + 2048 + c);
        o += a.x * w2[(c + 0) * 64 + lane]; o += a.y * w2[(c + 1) * 64 + lane]; o += a.z * w2[(c + 2) * 64 + lane]; o += a.w * w2[(c + 3) * 64 + lane]; }
    kcmp[((size_t)(kv * 16 + bg) * 256 + i) * 64 + lane] = o;
    (kv == 0 ? kcb : vctb)[((size_t)bg * 256 + i) * 64 + lane] = (bf16)f2bf(o);
    LDS_WAIT(); asm volatile("" ::: "memory");
}

__device__ __forceinline__ void cmp_attn_task(LAS float* wl  , int task, const bf16* proj, const float* kcmp, float* accn, unsigned long long* sel, int lane) {
    LAS float* q4 = wl; LAS float* pl = wl + 256; LAS float* cs = wl + 512;
    const int bg = task >> 12, t = task & 4095; const int b = bg >> 1, g = bg & 1; const size_t trow = (size_t)(b * SEQ + t);
    const float* kc = kcmp + (size_t)bg * 256 * 64; const float* vc = kcmp + (size_t)(16 + bg) * 256 * 64;
#pragma unroll
    for (int hh = 0; hh < 4; ++hh) q4[hh * 64 + lane] = bf2f(proj[trow * PE + C_NQ + (g * 4 + hh) * 64 + lane]) * 0.125f;
    const int nvalid = t >= 31 ? (((t - 31) >> 4) + 1 > NCMP ? NCMP : ((t - 31) >> 4) + 1) : 0;
    float c4[4] = {0.f, 0.f, 0.f, 0.f};
    LDS_WAIT(); asm volatile("" ::: "memory");
#pragma unroll 1
    for (int hh = 0; hh < 4; ++hh) {
        float s4[4]; float mx = -INFINITY;
#pragma unroll
        for (int r = 0; r < 4; ++r) { const int n = lane + 64 * r; float s = -INFINITY;
            if (64 * r < nvalid) { if (n < nvalid) { float a = 0.f; const GAS f32x4* kr = (const GAS f32x4*)(kc + (size_t)n * 64);
#pragma unroll 4
                    for (int c = 0; c < 16; ++c) { const f32x4 kk = kr[c]; const f32x4 qq = *(const LAS f32x4*)(q4 + hh * 64 + c * 4); a += kk.x * qq.x + kk.y * qq.y + kk.z * qq.z + kk.w * qq.w; }
                    s = a; } }
            s4[r] = s; mx = fmaxf(mx, s); }
        mx = wave_max(mx); if (!(mx > -INFINITY)) mx = 0.f;
        float sum = 0.f;
#pragma unroll
        for (int r = 0; r < 4; ++r) { s4[r] = (s4[r] > -INFINITY) ? __expf(s4[r] - mx) : 0.f; sum += s4[r]; }
        sum = wave_sum(sum); const float inv = 1.0f / fmaxf(sum, 1e-30f);
#pragma unroll
        for (int r = 0; r < 4; ++r) { s4[r] *= inv; c4[r] += s4[r]; pl[lane + 64 * r] = s4[r]; }
        LDS_WAIT(); asm volatile("" ::: "memory");
        float o = 0.f;
        for (int n = 0; n < nvalid; ++n) o += pl[n] * vc[(size_t)n * 64 + lane];
        const float gate = sigmoidf_(bf2f(proj[trow * PE + C_NG + 0 * 8 + g * 4 + hh]));
        accn[trow * 512 + (g * 4 + hh) * 64 + lane] = gate * o;
        LDS_WAIT(); asm volatile("" ::: "memory");
    }
#pragma unroll
    for (int r = 0; r < 4; ++r) cs[lane + 64 * r] = c4[r];
    LDS_WAIT(); asm volatile("" ::: "memory");
    float imp = 0.f;
#pragma unroll
    for (int dn = -1; dn <= 3; ++dn) { const int n = 4 * lane + dn; if (n >= 0 && n < NCMP) imp += cs[n]; }
    const int bt = t >> 6; const bool valid = lane <= bt; const bool forced = (lane == 0) || (bt - lane >= 0 && bt - lane < 2);
    float score = valid ? imp + (forced ? 1.0e4f : 0.f) : -1e30f;
    unsigned long long mask = 0ull;
#pragma unroll 1
    for (int k = 0; k < 8; ++k) { const float mv = wave_max(score); const unsigned long long bal = __ballot(score == mv); const int j = __ffsll((long long)bal) - 1; mask |= 1ull << j; if (lane == j) score = -INFINITY; }
    if (lane == 0) sel[(size_t)bg * SEQ + t] = mask;
    LDS_WAIT(); asm volatile("" ::: "memory");
}

template <int MODE>
__device__ __forceinline__ void blk_attn_task(LAS float* wl  , int task, const bf16* proj, const unsigned long long* sel, float* accn, bf16* mixed, int lane) {
    LAS float* q4 = wl; LAS float* p4 = wl + 256;
    const int bg = task >> 12, t = task & 4095; const int b = bg >> 1, g = bg & 1; const size_t trow = (size_t)(b * SEQ + t);
    const int kcol = (MODE == 0 ? C_KS : C_KW) + 64 * g, vcol = (MODE == 0 ? C_VS : C_VW) + 64 * g;
#pragma unroll
    for (int hh = 0; hh < 4; ++hh) q4[hh * 64 + lane] = bf2f(proj[trow * PE + C_NQ + (g * 4 + hh) * 64 + lane]) * 0.125f;
    LDS_WAIT(); asm volatile("" ::: "memory");
    const int bt = t >> 6;
    unsigned long long todo;
    if (MODE == 0) { todo = sel[(size_t)bg * SEQ + t]; todo &= (bt >= 63) ? ~0ull : ((1ull << (bt + 1)) - 1ull); }
    else { const int lo = (t - 511) > 0 ? ((t - 511) >> 6) : 0; todo = ((bt >= 63) ? ~0ull : ((1ull << (bt + 1)) - 1ull)) & ~((1ull << lo) - 1ull); }
    float m4[4] = {-INFINITY, -INFINITY, -INFINITY, -INFINITY}, l4[4] = {0.f, 0.f, 0.f, 0.f}, o4[4] = {0.f, 0.f, 0.f, 0.f};
    while (todo) {
        const int j = __ffsll((long long)todo) - 1; todo &= todo - 1ull;
        const int pos = 64 * j + lane; const bool valid = (pos <= t) && (MODE == 0 || (t - pos) < 512);
        const GAS v4u* kr = (const GAS v4u*)(proj + (size_t)(b * SEQ + pos) * PE + kcol);
        v4u kk[8];
#pragma unroll
        for (int c = 0; c < 8; ++c) kk[c] = kr[c];
#pragma unroll
        for (int hh = 0; hh < 4; ++hh) { float a = 0.f;
#pragma unroll
            for (int c = 0; c < 8; ++c) { const f32x4 qa = *(const LAS f32x4*)(q4 + hh * 64 + c * 8), qb = *(const LAS f32x4*)(q4 + hh * 64 + c * 8 + 4);
                a += bflo(kk[c].x) * qa.x + bfhi(kk[c].x) * qa.y + bflo(kk[c].y) * qa.z + bfhi(kk[c].y) * qa.w + bflo(kk[c].z) * qb.x + bfhi(kk[c].z) * qb.y + bflo(kk[c].w) * qb.z + bfhi(kk[c].w) * qb.w; }
            const float s = valid ? a : -INFINITY;
            const float mn = fmaxf(m4[hh], wave_max(s));
            const float sc = __expf(m4[hh] - mn); const float p = valid ? __expf(s - mn) : 0.f;
            l4[hh] = l4[hh] * sc + wave_sum(p); o4[hh] *= sc; m4[hh] = mn; p4[hh * 64 + lane] = p; }
        LDS_WAIT(); asm volatile("" ::: "memory");
        const bf16* vr = proj + (size_t)(b * SEQ + 64 * j) * PE + vcol + lane;
#pragma unroll 4
        for (int k4 = 0; k4 < 64; k4 += 4) {
            const float v0 = bf2f(vr[(size_t)(k4 + 0) * PE]), v1 = bf2f(vr[(size_t)(k4 + 1) * PE]), v2 = bf2f(vr[(size_t)(k4 + 2) * PE]), v3 = bf2f(vr[(size_t)(k4 + 3) * PE]);
#pragma unroll
            for (int hh = 0; hh < 4; ++hh) { const f32x4 pp = *(const LAS f32x4*)(p4 + hh * 64 + k4); o4[hh] += pp.x * v0 + pp.y * v1 + pp.z * v2 + pp.w * v3; }
        }
        LDS_WAIT(); asm volatile("" ::: "memory");
    }
#pragma unroll
    for (int hh = 0; hh < 4; ++hh) { const float gate = sigmoidf_(bf2f(proj[trow * PE + C_NG + (MODE == 0 ? 1 : 2) * 8 + g * 4 + hh])); const float o = gate * o4[hh] / l4[hh];
        const size_t idx = trow * 512 + (g * 4 + hh) * 64 + lane;
        if (MODE == 0) accn[idx] += o; else mixed[trow * D + 512 + (g * 4 + hh) * 64 + lane] = (bf16)f2bf(accn[idx] + o); }
}


typedef float f32x16 __attribute__((ext_vector_type(16)));
typedef short s16x8 __attribute__((ext_vector_type(8)));
typedef short s16x4 __attribute__((ext_vector_type(4)));
constexpr int A_KC = 0;
constexpr int A_VCT = 36864;
constexpr int A_K0 = 71168;
constexpr int A_V0 = 89600;
constexpr int A_OT = 107008;
constexpr int A_KSTRIDE = 9216, A_VSTRIDE = 8704;
#define EXP2(x) __builtin_amdgcn_exp2f(x)
constexpr float SM_C = 0.125f * 1.4426950408889634f;
constexpr float LAZY_TAU = 5.0f;

__device__ __forceinline__ unsigned cvtpk(float lo, float hi) { f32x2_t v = {lo, hi}; bf16x2_t b = __builtin_convertvector(v, bf16x2_t); return __builtin_bit_cast(unsigned, b); }
__device__ __forceinline__ s16x8 pack8(const f32x16& p, int o) {
    v4u w; w.x = cvtpk(p[o + 0], p[o + 1]); w.y = cvtpk(p[o + 2], p[o + 3]); w.z = cvtpk(p[o + 4], p[o + 5]); w.w = cvtpk(p[o + 6], p[o + 7]);
    return __builtin_bit_cast(s16x8, w);
}
__device__ __forceinline__ s16x8 lds_a128(const LAS unsigned char* p) { return *(const LAS s16x8*)p; }
__device__ __forceinline__ s16x8 lds_a64x2(const LAS unsigned char* p) {
    const v2u lo = *(const LAS v2u*)p, hi = *(const LAS v2u*)(p + 16); v4u w; w.x = lo.x; w.y = lo.y; w.z = hi.x; w.w = hi.y; return __builtin_bit_cast(s16x8, w);
}
#define MFMA32(a, b, c) __builtin_amdgcn_mfma_f32_32x32x16_bf16((a), (b), (c), 0, 0, 0)
constexpr int rowc(int r) { return (r & 3) + 8 * (r >> 2); }

template <int MASKED>
__device__ __forceinline__ void attn_block_rf(const s16x8 (&kf)[4][2], const s16x8 (&vf)[2][4], const s16x8 (&qf)[4], int h, int key0, int klo, int khi, bool en, float& m, float& l, f32x16 (&O)[2]) {
    f32x16 s0, s1;
#pragma unroll
    for (int i = 0; i < 16; ++i) { s0[i] = 0.f; s1[i] = 0.f; }
#pragma unroll
    for (int ks = 0; ks < 4; ++ks) { s0 = MFMA32(kf[ks][0], qf[ks], s0); s1 = MFMA32(kf[ks][1], qf[ks], s1); }
    if (MASKED == 1) {
        const int lo0 = klo - key0 - 4 * h, hi0 = khi - key0 - 4 * h;
#pragma unroll
        for (int i = 0; i < 16; ++i) { const int c = rowc(i);
            s0[i] = (en && c >= lo0 && c <= hi0) ? s0[i] : -INFINITY; s1[i] = (en && c + 32 >= lo0 && c + 32 <= hi0) ? s1[i] : -INFINITY; }
    }
    float mx = -INFINITY;
#pragma unroll
    for (int i = 0; i < 16; ++i) { mx = __builtin_elementwise_max(mx, s0[i]); mx = __builtin_elementwise_max(mx, s1[i]); }
    if (MASKED == 2) mx = en ? mx : -INFINITY;
    mx = __builtin_elementwise_max(mx, __shfl_xor(mx, 32));
    if (__builtin_amdgcn_ballot_w64((mx - m) * SM_C > LAZY_TAU) != 0ull) {
        const float mn = __builtin_elementwise_max(m, mx);
        const float alpha = EXP2((m - mn) * SM_C); m = mn; l *= alpha;
#pragma unroll
        for (int i = 0; i < 16; ++i) { O[0][i] *= alpha; O[1][i] *= alpha; }
    }
    const float mc = (MASKED == 2 && !en) ? INFINITY : m * SM_C;
    float ls = 0.f;
#pragma unroll
    for (int i = 0; i < 16; ++i) { s0[i] = EXP2(fmaf(s0[i], SM_C, -mc)); s1[i] = EXP2(fmaf(s1[i], SM_C, -mc)); ls += s0[i] + s1[i]; }
    l += ls;
    const s16x8 p00 = pack8(s0, 0), p01 = pack8(s0, 8), p10 = pack8(s1, 0), p11 = pack8(s1, 8);
#pragma unroll
    for (int dt = 0; dt < 2; ++dt) { O[dt] = MFMA32(vf[dt][0], p00, O[dt]); O[dt] = MFMA32(vf[dt][1], p01, O[dt]); O[dt] = MFMA32(vf[dt][2], p10, O[dt]); O[dt] = MFMA32(vf[dt][3], p11, O[dt]); }
}
__device__ __forceinline__ void nsa_load_k(const bf16* Kt, int bgx, int j, int lane, s16x8 (&kf)[4][2]) {
    const GAS v4u* p = (const GAS v4u*)(Kt + ((size_t)bgx * 64 + j) * 4096) + lane;
#pragma unroll
    for (int ks = 0; ks < 4; ++ks) { kf[ks][0] = __builtin_bit_cast(s16x8, p[(ks * 2 + 0) * 64]); kf[ks][1] = __builtin_bit_cast(s16x8, p[(ks * 2 + 1) * 64]); }
}
__device__ __forceinline__ void nsa_load_v(const bf16* Vt, int bgx, int j, int lane, s16x8 (&vf)[2][4]) {
    const GAS v4u* p = (const GAS v4u*)(Vt + ((size_t)bgx * 64 + j) * 4096) + lane;
#pragma unroll
    for (int dt = 0; dt < 2; ++dt)
#pragma unroll
        for (int kk = 0; kk < 4; ++kk) vf[dt][kk] = __builtin_bit_cast(s16x8, p[(dt * 4 + kk) * 64]);
}

__device__ __forceinline__ void nsa_subunit(LAS unsigned char* lds, int bg, int qt, const bf16* proj, const bf16* kcb, const bf16* vctb, const bf16* Kt, const bf16* Vt, bf16* mixed, int tid_in, int wave) {
    int tid = tid_in; asm volatile("" : "+v"(tid)); const int lane = tid & 63;
    const int b = bg >> 1, g = bg & 1; const int t0 = qt * 64, bt = qt;
    const int r32 = lane & 31, h = lane >> 5, head = r32 >> 3, ql = lane & 7;
    const int t = t0 + 8 * wave + ql; const size_t trow = (size_t)(b * SEQ + t);
    {
        const bf16* ksrc = kcb + (size_t)bg * 256 * 64; const bf16* vsrc = vctb + (size_t)bg * 256 * 64;
#pragma unroll
        for (int i = 0; i < 4; ++i) { const int p = tid + i * NT;
            { const int row = p >> 3, c = p & 7; const v4u v = *(const GAS v4u*)(ksrc + row * 64 + 8 * c); *(LAS v4u*)(lds + A_KC + row * 144 + 16 * c) = v; }
            { const int n = p >> 3, c = p & 7; const v4u v = *(const GAS v4u*)(vsrc + n * 64 + 8 * c); LAS unsigned short* d = (LAS unsigned short*)(lds + A_VCT + (8 * c) * 536 + n * 2);
              d[0 * 268] = (unsigned short)(v.x & 0xffffu); d[1 * 268] = (unsigned short)(v.x >> 16); d[2 * 268] = (unsigned short)(v.y & 0xffffu); d[3 * 268] = (unsigned short)(v.y >> 16);
              d[4 * 268] = (unsigned short)(v.z & 0xffffu); d[5 * 268] = (unsigned short)(v.z >> 16); d[6 * 268] = (unsigned short)(v.w & 0xffffu); d[7 * 268] = (unsigned short)(v.w >> 16); } }
    }
    s16x8 qf[4];
    { const bf16* qp = proj + trow * PE + C_NQ + (g * 4 + head) * 64 + 8 * h;
#pragma unroll
      for (int ks = 0; ks < 4; ++ks) qf[ks] = __builtin_bit_cast(s16x8, *(const GAS v4u*)(qp + 16 * ks)); }
    __syncthreads();
    f32x16 OT[2];
#pragma unroll
    for (int i = 0; i < 16; ++i) { OT[0][i] = 0.f; OT[1][i] = 0.f; }
    unsigned long long selmask;
    {
        const int nmax = t >= 31 ? ((t - 31) >> 4) : -1;
        const int ntile = ((t0 + 63 - 31) >= 0) ? ((((t0 + 63 - 31) >> 4) + 1 + 31) >> 5) : 0;
        float m = -3.0e38f, l = 0.f;
#pragma unroll
        for (int T = 0; T < 8; ++T) if (T < ntile) {
            f32x16 s;
#pragma unroll
            for (int i = 0; i < 16; ++i) s[i] = 0.f;
#pragma unroll
            for (int ks = 0; ks < 4; ++ks) s = MFMA32(lds_a128(lds + A_KC + (32 * T + r32) * 144 + (16 * ks + 8 * h) * 2), qf[ks], s);
            const int lim = nmax - 32 * T - 4 * h; float mx = -INFINITY;
#pragma unroll
            for (int i = 0; i < 16; ++i) { s[i] = (rowc(i) <= lim) ? s[i] : -INFINITY; mx = __builtin_elementwise_max(mx, s[i]); }
            mx = __builtin_elementwise_max(mx, __shfl_xor(mx, 32));
            const float mn = __builtin_elementwise_max(m, mx); const float alpha = EXP2((m - mn) * SM_C); const float mc = mn * SM_C; m = mn; float ls = 0.f;
#pragma unroll
            for (int i = 0; i < 16; ++i) ls += EXP2(fmaf(s[i], SM_C, -mc));
            l = l * alpha + ls;
        }
        l += __shfl_xor(l, 32);
        const float invl = l > 0.f ? 1.0f / l : 0.f; const float mc = m * SM_C;
        float imp[32];
#pragma unroll
        for (int k = 0; k < 32; ++k) imp[k] = 0.f;
        const float gate_c = sigmoidf_(bf2f(proj[trow * PE + C_NG + 0 * 8 + g * 4 + head]));
        float carry = 0.f;
#pragma unroll
        for (int T = 0; T < 8; ++T) if (T < ntile) {
            f32x16 s;
#pragma unroll
            for (int i = 0; i < 16; ++i) s[i] = 0.f;
#pragma unroll
            for (int ks = 0; ks < 4; ++ks) s = MFMA32(lds_a128(lds + A_KC + (32 * T + r32) * 144 + (16 * ks + 8 * h) * 2), qf[ks], s);
            const int lim = nmax - 32 * T - 4 * h;
#pragma unroll
            for (int i = 0; i < 16; ++i) s[i] = (rowc(i) <= lim) ? EXP2(fmaf(s[i], SM_C, -mc)) * invl : 0.f;
            float Gs[4], Es[4], Xs[4];
#pragma unroll
            for (int rg = 0; rg < 4; ++rg) { Gs[rg] = (s[4 * rg] + s[4 * rg + 1]) + (s[4 * rg + 2] + s[4 * rg + 3]); Es[rg] = s[4 * rg + 3];
                Gs[rg] += __shfl_xor(Gs[rg], 8); Gs[rg] += __shfl_xor(Gs[rg], 16); Es[rg] += __shfl_xor(Es[rg], 8); Es[rg] += __shfl_xor(Es[rg], 16); Xs[rg] = __shfl_xor(Es[rg], 32); }
#pragma unroll
            for (int rg = 0; rg < 4; ++rg) imp[4 * T + rg] = Gs[rg] + (h ? Xs[rg] : (rg ? Xs[rg > 0 ? rg - 1 : 0] : carry));
            carry = Xs[3];
#pragma unroll
            for (int i = 0; i < 16; ++i) s[i] *= gate_c;
            const s16x8 p0 = pack8(s, 0), p1 = pack8(s, 8);
#pragma unroll
            for (int dt = 0; dt < 2; ++dt) { const LAS unsigned char* vr = lds + A_VCT + (32 * dt + r32) * 536 + (32 * T + 4 * h) * 2;
                OT[dt] = MFMA32(lds_a64x2(vr), p0, OT[dt]); OT[dt] = MFMA32(lds_a64x2(vr + 32), p1, OT[dt]); }
        }
#pragma unroll
        for (int k = 0; k < 32; ++k) { const int j = 2 * k + h; const bool ok = (j <= bt) && (j != 0) && (j != bt) && (j != bt - 1); imp[k] = ok ? imp[k] : -1.0f; }
        selmask = 1ull | (1ull << bt) | (bt >= 1 ? (1ull << (bt - 1)) : 0ull);
        const int rounds = 8 - (bt == 0 ? 1 : (bt == 1 ? 2 : 3));
#pragma unroll 1
        for (int rd = 0; rd < rounds; ++rd) {
            float mx = imp[0];
#pragma unroll
            for (int k = 1; k < 32; ++k) mx = __builtin_elementwise_max(mx, imp[k]);
            const float gm = __builtin_elementwise_max(mx, __shfl_xor(mx, 32));
            int jb = 64;
#pragma unroll
            for (int k = 31; k >= 0; --k) jb = (imp[k] == gm) ? (2 * k + h) : jb;
            const int jo = __shfl_xor(jb, 32); jb = jb < jo ? jb : jo;
            selmask |= 1ull << jb;
#pragma unroll
            for (int k = 0; k < 32; ++k) imp[k] = (2 * k + h == jb) ? -INFINITY : imp[k];
        }
    }
    const int wlo = bt >= 8 ? bt - 8 : 0;
    {
        LAS v4u* otp = (LAS v4u*)(lds + A_OT + (wave * 64 + lane) * 64);
#pragma unroll
        for (int dt = 0; dt < 2; ++dt)
#pragma unroll
            for (int q = 0; q < 2; ++q) { v4u w; w.x = cvtpk(OT[dt][8 * q], OT[dt][8 * q + 1]); w.y = cvtpk(OT[dt][8 * q + 2], OT[dt][8 * q + 3]); w.z = cvtpk(OT[dt][8 * q + 4], OT[dt][8 * q + 5]); w.w = cvtpk(OT[dt][8 * q + 6], OT[dt][8 * q + 7]); otp[2 * dt + q] = w; }
    }
    const float gate_s = sigmoidf_(bf2f(proj[trow * PE + C_NG + 1 * 8 + g * 4 + head])), gate_w = sigmoidf_(bf2f(proj[trow * PE + C_NG + 2 * 8 + g * 4 + head]));
    unsigned long long wact = 0ull;
#pragma unroll 1
    for (int j = 0; j <= bt; ++j) if (__ballot((selmask >> j) & 1ull) != 0ull) wact |= 1ull << j;
    float m = -3.0e38f, l = 0.f;
    f32x16 O[2];
#pragma unroll
    for (int i = 0; i < 16; ++i) { O[0][i] = 0.f; O[1][i] = 0.f; }
    int cj = __ffsll((long long)wact) - 1; wact &= wact - 1ull; bool cwin = false; int wj = wlo;
    s16x8 kf[4][2], kn[4][2], vf[2][4];
    nsa_load_k(Kt, bg * 2 + 0, cj, lane, kf);
#pragma unroll 1
    for (;;) {
        int nj; bool nwin, nvalid = true;
        if (!cwin && wact != 0ull) { nj = __ffsll((long long)wact) - 1; wact &= wact - 1ull; nwin = false; }
        else if (wj <= bt) { nj = wj++; nwin = true; }
        else { nj = 0; nwin = true; nvalid = false; }
        nsa_load_v(Vt, bg * 2 + (cwin ? 1 : 0), cj, lane, vf);
        if (nvalid) nsa_load_k(Kt, bg * 2 + (nwin ? 1 : 0), nj, lane, kn);
        if (!cwin) {
            const bool en = (selmask >> cj) & 1ull;
            if (cj == bt) attn_block_rf<1>(kf, vf, qf, h, 64 * cj, 0, t, en, m, l, O);
            else attn_block_rf<2>(kf, vf, qf, h, 64 * cj, 0, t, en, m, l, O);
        } else {
            if (cj == bt || (bt >= 8 && cj == wlo)) attn_block_rf<1>(kf, vf, qf, h, 64 * cj, t - 511, t, true, m, l, O);
            else attn_block_rf<0>(kf, vf, qf, h, 64 * cj, 0, t, true, m, l, O);
        }
        if ((!cwin && nwin) || !nvalid) {
            const float lt = l + __shfl_xor(l, 32);
            const float gate = (cwin ? gate_w : gate_s) * __builtin_amdgcn_rcpf(lt);
            LAS v4u* otp = (LAS v4u*)(lds + A_OT + (wave * 64 + lane) * 64);
#pragma unroll
            for (int dt = 0; dt < 2; ++dt)
#pragma unroll
                for (int q = 0; q < 2; ++q) { const v4u w = otp[2 * dt + q];
                    const unsigned ww[4] = {w.x, w.y, w.z, w.w};
#pragma unroll
                    for (int k = 0; k < 4; ++k) { O[dt][8 * q + 2 * k] = bflo(ww[k]) + gate * O[dt][8 * q + 2 * k]; O[dt][8 * q + 2 * k + 1] = bfhi(ww[k]) + gate * O[dt][8 * q + 2 * k + 1]; } }
            if (!nvalid) break;
#pragma unroll
            for (int dt = 0; dt < 2; ++dt)
#pragma unroll
                for (int q = 0; q < 2; ++q) { v4u w; w.x = cvtpk(O[dt][8 * q], O[dt][8 * q + 1]); w.y = cvtpk(O[dt][8 * q + 2], O[dt][8 * q + 3]); w.z = cvtpk(O[dt][8 * q + 4], O[dt][8 * q + 5]); w.w = cvtpk(O[dt][8 * q + 6], O[dt][8 * q + 7]); otp[2 * dt + q] = w; }
#pragma unroll
            for (int i = 0; i < 16; ++i) { O[0][i] = 0.f; O[1][i] = 0.f; }
            m = -3.0e38f; l = 0.f;
        }
        cj = nj; cwin = nwin;
#pragma unroll
        for (int ks = 0; ks < 4; ++ks) { kf[ks][0] = kn[ks][0]; kf[ks][1] = kn[ks][1]; }
    }
    {
        bf16* op = mixed + trow * D + 512 + (g * 4 + head) * 64 + 4 * h;
#pragma unroll
        for (int dt = 0; dt < 2; ++dt)
#pragma unroll
            for (int rg = 0; rg < 4; ++rg) { v2u w; w.x = cvtpk(O[dt][4 * rg], O[dt][4 * rg + 1]); w.y = cvtpk(O[dt][4 * rg + 2], O[dt][4 * rg + 3]); *(GAS v2u*)(op + 32 * dt + 8 * rg) = w; }
    }
    __syncthreads();
}

__device__ __forceinline__ void kv_tile_item(LAS unsigned short* scr  , int item, const bf16* proj, bf16* Kt, bf16* Vt, int lane) {
    const int bgx = item >> 6, kb = item & 63; const int bg = bgx >> 1, x = bgx & 1; const int b = bg >> 1, g = bg & 1; const int r = lane & 31, h = lane >> 5;
    const bf16* ksrc = proj + (size_t)(b * SEQ + 64 * kb) * PE + (x ? C_KW : C_KS) + 64 * g;
    GAS v4u* kd = (GAS v4u*)(Kt + (size_t)item * 4096) + lane;
#pragma unroll
    for (int ks = 0; ks < 4; ++ks)
#pragma unroll
        for (int kt = 0; kt < 2; ++kt) kd[(ks * 2 + kt) * 64] = *(const GAS v4u*)(ksrc + (size_t)(32 * kt + r) * PE + 16 * ks + 8 * h);
    const bf16* vsrc = proj + (size_t)(b * SEQ + 64 * kb + lane) * PE + (x ? C_VW : C_VS) + 64 * g;
#pragma unroll
    for (int c = 0; c < 8; ++c) { const v4u v = *(const GAS v4u*)(vsrc + 8 * c); LAS unsigned* d = (LAS unsigned*)(scr + lane * 66 + 8 * c); d[0] = v.x; d[1] = v.y; d[2] = v.z; d[3] = v.w; }
    LDS_WAIT(); asm volatile("" ::: "memory");
    GAS v4u* vd = (GAS v4u*)(Vt + (size_t)item * 4096) + lane;
#pragma unroll
    for (int dt = 0; dt < 2; ++dt)
#pragma unroll
        for (int kk = 0; kk < 4; ++kk) { const int dim = 32 * dt + r, k0 = 16 * kk + 4 * h; v4u o;
            o.x = (unsigned)scr[(k0 + 0) * 66 + dim] | ((unsigned)scr[(k0 + 1) * 66 + dim] << 16); o.y = (unsigned)scr[(k0 + 2) * 66 + dim] | ((unsigned)scr[(k0 + 3) * 66 + dim] << 16);
            o.z = (unsigned)scr[(k0 + 8) * 66 + dim] | ((unsigned)scr[(k0 + 9) * 66 + dim] << 16); o.w = (unsigned)scr[(k0 + 10) * 66 + dim] | ((unsigned)scr[(k0 + 11) * 66 + dim] << 16);
            vd[(dt * 4 + kk) * 64] = o; }
    LDS_WAIT(); asm volatile("" ::: "memory");
}

__device__ __forceinline__ float gelu_tanh_f(float x) { const float u = 0.7978845608028654f * (x + 0.044715f * x * x * x); const float t = 1.0f - 2.0f * __builtin_amdgcn_rcpf(__expf(2.0f * u) + 1.0f); return 0.5f * x * (1.0f + t); }
__device__ __forceinline__ void compress_unit(LAS unsigned char* lds, int unit, const bf16* proj, const bf16* W1T  , const float* cbias  , const float* w2k, const float* w2v,
                                              bf16* kcb, bf16* vcb, int tid_in, int wave) {
    int tid = tid_in; asm volatile("" : "+v"(tid)); const int lane = tid & 63;
    const int kv = unit >> 7, bg = (unit >> 3) & 15, tile = unit & 7; const int b = bg >> 1, g = bg & 1;
    const int r32 = lane & 31, h = lane >> 5; const int i = 32 * tile + r32;
    const bf16* w1 = W1T + (size_t)kv * 64 * 2048; const int col = (kv ? C_VC : C_KC) + 64 * g;
    f32x16 acc0, acc1;
#pragma unroll
    for (int q = 0; q < 16; ++q) { acc0[q] = 0.f; acc1[q] = 0.f; }
#pragma unroll
    for (int ks = 0; ks < 16; ++ks) {
        int tok = 16 * i + 4 * wave + (ks >> 2); tok = tok > SEQ - 1 ? SEQ - 1 : tok;
        const s16x8 av = __builtin_bit_cast(s16x8, *(const GAS v4u*)(proj + (size_t)(b * SEQ + tok) * PE + col + 16 * (ks & 3) + 8 * h));
        const int k0 = 256 * wave + 16 * ks + 8 * h;
        const s16x8 b0 = __builtin_bit_cast(s16x8, *(const GAS v4u*)(w1 + (size_t)r32 * 2048 + k0)), b1 = __builtin_bit_cast(s16x8, *(const GAS v4u*)(w1 + (size_t)(32 + r32) * 2048 + k0));
        acc0 = MFMA32(av, b0, acc0); acc1 = MFMA32(av, b1, acc1);
    }
    LAS float* part = (LAS float*)lds;
    LAS float* hidl = (LAS float*)(lds + 65536);
#pragma unroll
    for (int q = 0; q < 16; ++q) { const int row = (q & 3) + 8 * (q >> 2) + 4 * h; part[(wave * 32 + row) * 64 + r32] = acc0[q]; part[(wave * 32 + row) * 64 + 32 + r32] = acc1[q]; }
    __syncthreads();
    const int il = tid >> 4, c4 = (tid & 15) * 4;
    {
        f32x4 s = (f32x4){0.f, 0.f, 0.f, 0.f};
#pragma unroll 8
        for (int ksg = 0; ksg < 32; ++ksg) s = s + *(const GAS f32x4*)(cbias + (kv * 32 + ksg) * 64 + c4);
#pragma unroll
        for (int w = 0; w < 8; ++w) s = s + *(const LAS f32x4*)(part + (w * 32 + il) * 64 + c4);
        *(LAS f32x4*)(hidl + il * 64 + c4) = (f32x4){gelu_tanh_f(s.x), gelu_tanh_f(s.y), gelu_tanh_f(s.z), gelu_tanh_f(s.w)};
    }
    __syncthreads();
    {
        const float* w2 = kv ? w2v : w2k; f32x4 o = (f32x4){0.f, 0.f, 0.f, 0.f};
#pragma unroll 8
        for (int c = 0; c < 64; ++c) { const float hv = hidl[il * 64 + c]; o = o + *(const GAS f32x4*)(w2 + c * 64 + c4) * hv; }
        const int irow = 32 * tile + il; if (irow == 255) o = (f32x4){0.f, 0.f, 0.f, 0.f};
        v2u w; w.x = cvtpk(o.x, o.y); w.y = cvtpk(o.z, o.w);
        *(GAS v2u*)((kv ? vcb : kcb) + ((size_t)bg * 256 + irow) * 64 + c4) = w;
    }
    __syncthreads();
}


typedef float f32x4v __attribute__((ext_vector_type(4)));
#define MFMA16(a, b, c) __builtin_amdgcn_mfma_f32_16x16x32_bf16((a), (b), (c), 0, 0, 0)
constexpr int R_QT = 0, R_KT = 8704, R_KTT = 17920, R_VTT = 30208, R_E = 42496, R_BUF = 43008;
constexpr int S_QT = 0, S_KT = 24576, S_V = 49152, S_E = 65536, S_PF = 66560, S_OB = 71680, S_END = 105472;
__device__ __forceinline__ unsigned off_b(unsigned row, unsigned ch) { return 256u * row + 16u * (ch ^ (((row & 3u) << 2) | ((row >> 2) & 3u))); }
__device__ __forceinline__ unsigned tr_addr(unsigned lane, unsigned c, unsigned ks, unsigned t) { const unsigned h = lane >> 5, blk = (lane >> 4) & 1u, q = (lane & 15u) >> 2, pp = lane & 3u; return off_b(16u * ks + 8u * h + 4u * t + q, 4u * c + 2u * blk + (pp >> 1)) + 8u * (pp & 1u); }
typedef short v4i16_t __attribute__((ext_vector_type(4)));
__device__ __forceinline__ s16x8 tr_frag(const LAS unsigned char* tile, unsigned lane, unsigned c, unsigned ks) {
    const v4i16_t a = __builtin_amdgcn_ds_read_tr16_b64_v4i16((LAS v4i16_t*)(tile + tr_addr(lane, c, ks, 0))), b = __builtin_amdgcn_ds_read_tr16_b64_v4i16((LAS v4i16_t*)(tile + tr_addr(lane, c, ks, 1)));
    s16x8 r; r[0] = a[0]; r[1] = a[1]; r[2] = a[2]; r[3] = a[3]; r[4] = b[0]; r[5] = b[1]; r[6] = b[2]; r[7] = b[3]; return r; }
constexpr float REC_SCALE = 0.08838834764831845f;

__device__ __forceinline__ s16x8 lds_2x64(const LAS unsigned char* p, const LAS unsigned char* q) { const v2u lo = *(const LAS v2u*)p, hi = *(const LAS v2u*)q; v4u w; w.x = lo.x; w.y = lo.y; w.z = hi.x; w.w = hi.y; return __builtin_bit_cast(s16x8, w); }

template <int MODE>
__device__ __forceinline__ void rec_prep_task(int task, bf16* proj, const float2* rope, const float* lb, float* Eg, int lane) {
    constexpr int NH = MODE ? 8 : 4, LDP = MODE ? PO : PE, CQ = MODE ? C_HQ : C_RQ, CK = MODE ? C_HF : C_RK, CV = MODE ? C_HI : C_RV;
    const int chunk = task & 127, bh = task >> 7; const int b = bh / NH, hd = bh % NH;
    const size_t row0 = (size_t)(b * SEQ + 32 * chunk);
    if (MODE == 1) {
        const float l0 = lb[hd * 128 + 2 * lane], l1 = lb[hd * 128 + 2 * lane + 1];
        float B0 = 0.f, B1 = 0.f;
        bf16* rp0 = proj + row0 * LDP + hd * 128 + 2 * lane;
        unsigned qw[32], fw[32];
#pragma unroll
        for (int t = 0; t < 32; ++t) { qw[t] = *(const GAS unsigned*)(rp0 + (size_t)t * LDP + CQ); fw[t] = *(const GAS unsigned*)(rp0 + (size_t)t * LDP + CK); }
        __builtin_amdgcn_sched_barrier(0);
#pragma unroll
        for (int t = 0; t < 32; ++t) {
            bf16* rp = rp0 + (size_t)t * LDP;
            const float f0 = bflo(fw[t]), f1 = bfhi(fw[t]), q0 = bflo(qw[t]), q1 = bfhi(qw[t]);
            const float s0 = sigmoidf_(f0), s1 = sigmoidf_(f1);
            B0 += __logf(l0 + (1.0f - l0) * s0); B1 += __logf(l1 + (1.0f - l1) * s1);
            const float e0 = __expf(B0), e1 = __expf(B1);
            const float qt0 = siluf_(q0) * REC_SCALE * e0, qt1 = siluf_(q1) * REC_SCALE * e1;
            const float kt0 = (1.0f - l0) * (1.0f - s0) * __builtin_amdgcn_rcpf(e0), kt1 = (1.0f - l1) * (1.0f - s1) * __builtin_amdgcn_rcpf(e1);
            *(GAS unsigned*)(rp + CQ) = pk2(qt0, qt1);
            const unsigned kw = pk2(kt0, kt1);
            *(GAS unsigned*)(rp + CK) = kw;
            if (t == 31) { *(GAS f32x2*)(Eg + ((size_t)bh * 128 + chunk) * 128 + 2 * lane) = (f32x2){e0, e1}; }
        }
    } else {
        const float gamma = 1.0f - exp2f(-5.0f - (float)hd); const float ginv = 1.0f / gamma;
        float gp = 1.0f, gi = 1.0f;
        bf16* rp0 = proj + row0 * LDP + hd * 128 + lane;
#pragma unroll
        for (int half = 0; half < 2; ++half) {
            unsigned short q1h[16], q2h[16], k1h[16], k2h[16]; float2 csh[16];
#pragma unroll
            for (int i = 0; i < 16; ++i) { const int t = 16 * half + i; const bf16* rp = rp0 + (size_t)t * LDP;
                q1h[i] = rp[CQ]; q2h[i] = rp[CQ + 64]; k1h[i] = rp[CK]; k2h[i] = rp[CK + 64]; csh[i] = rope[(32 * chunk + t) * 64 + lane]; }
            __builtin_amdgcn_sched_barrier(0);
#pragma unroll
            for (int i = 0; i < 16; ++i) { const int t = 16 * half + i; bf16* rp = rp0 + (size_t)t * LDP;
                gp *= gamma; gi *= ginv;
                const float2 cs = csh[i];
                const float q1 = bf2f(q1h[i]), q2 = bf2f(q2h[i]), k1 = bf2f(k1h[i]), k2 = bf2f(k2h[i]);
                const unsigned qa = f2bf((q1 * cs.x - q2 * cs.y) * gp), qb = f2bf((q1 * cs.y + q2 * cs.x) * gp);
                const unsigned ka = f2bf((k1 * cs.x - k2 * cs.y) * (REC_SCALE * gi)), kb = f2bf((k1 * cs.y + k2 * cs.x) * (REC_SCALE * gi));
                rp[CQ] = (bf16)qa; rp[CQ + 64] = (bf16)qb; rp[CK] = (bf16)ka; rp[CK + 64] = (bf16)kb;
            }
        }
    }
}


struct RecSet { v4u q[2], k[2], v[2]; f32x4v e; v4u g[2]; f32x4v ec[2]; };

template <int MODE, int SEGS>
__device__ __forceinline__ void rec_issue(RecSet& R, int c, int bh, int hd, size_t rowbase, const bf16* proj, const float* Eg, int hid) {
    constexpr int NCH = SEQ / 32 / SEGS, LDP = MODE ? PO : PE, CQ = MODE ? C_HQ : C_RQ, CK = MODE ? C_HF : C_RK, CV = MODE ? C_HI : C_RV, CG = MODE ? C_HG : C_RG;
    if (c + 2 < NCH) { const size_t r2 = rowbase + 32 * (c + 2);
#pragma unroll
        for (int i = 0; i < 2; ++i) { const int p = hid + 256 * i, tq = p >> 4, cq = p & 15;
            R.q[i] = *(const GAS v4u*)(proj + (r2 + tq) * LDP + CQ + hd * 128 + 8 * cq); R.k[i] = *(const GAS v4u*)(proj + (r2 + tq) * LDP + CK + hd * 128 + 8 * cq); } }
    if (c + 1 < NCH) { const size_t r1 = rowbase + 32 * (c + 1);
#pragma unroll
        for (int i = 0; i < 2; ++i) { const int p = hid + 256 * i, tq = p >> 4, cq = p & 15; R.v[i] = *(const GAS v4u*)(proj + (r1 + tq) * LDP + CV + hd * 128 + 8 * cq); }
        if (MODE == 1 && hid < 32) R.e = *(const GAS f32x4v*)(Eg + ((size_t)bh * 128 + c + 1) * 128 + 4 * hid);
        if (SEGS > 1) { const GAS f32x4v* ep = (const GAS f32x4v*)(Eg + ((size_t)bh * 128 + c + 1) * 128 + 8 * (hid & 15)); R.ec[0] = ep[0]; R.ec[1] = ep[1]; } }
    if (SEGS == 1 && c >= 1) { const GAS v4u* gp = (const GAS v4u*)(proj + (rowbase + 32 * (c - 1) + (hid >> 3)) * LDP + CG + hd * 128 + 16 * (hid & 7)); R.g[0] = gp[0]; R.g[1] = gp[1]; }
}
__device__ __forceinline__ v4u scale8(v4u q, const float (&f)[8]) {
    v4u o; o.x = pk2(bflo(q.x) * f[0], bfhi(q.x) * f[1]); o.y = pk2(bflo(q.y) * f[2], bfhi(q.y) * f[3]); o.z = pk2(bflo(q.z) * f[4], bfhi(q.z) * f[5]); o.w = pk2(bflo(q.w) * f[6], bfhi(q.w) * f[7]); return o; }
template <int MODE, int SEGS>
__device__ __forceinline__ void rec_stage(const RecSet& R, LAS unsigned char* lds, int c, int hid, float (&ecum)[8], bool fix, bf16* projw, int hd, size_t rowbase) {
    constexpr int NCH = SEQ / 32 / SEGS, LDP = MODE ? PO : PE, CQ = MODE ? C_HQ : C_RQ;
    if (SEGS > 1 && c + 1 < NCH) {
        ecum[0] *= R.ec[0][0]; ecum[1] *= R.ec[0][1]; ecum[2] *= R.ec[0][2]; ecum[3] *= R.ec[0][3]; ecum[4] *= R.ec[1][0]; ecum[5] *= R.ec[1][1]; ecum[6] *= R.ec[1][2]; ecum[7] *= R.ec[1][3]; }
    if (c + 2 < NCH) {
#pragma unroll
        for (int i = 0; i < 2; ++i) { const int p = hid + 256 * i; const unsigned o = off_b(p >> 4, p & 15);
            *(LAS v4u*)(lds + S_QT + ((c + 2) % 3) * 8192 + o) = R.q[i]; *(LAS v4u*)(lds + S_KT + ((c + 2) % 3) * 8192 + o) = R.k[i];
            if (SEGS > 1 && fix) *(GAS v4u*)(projw + (rowbase + 32 * (c + 2) + (p >> 4)) * LDP + CQ + hd * 128 + 8 * (p & 15)) = scale8(R.q[i], ecum); } }
    if (c + 1 < NCH) {
#pragma unroll
        for (int i = 0; i < 2; ++i) { const int p = hid + 256 * i; *(LAS v4u*)(lds + S_V + ((c + 1) & 1) * 8192 + off_b(p >> 4, p & 15)) = R.v[i]; }
        if (MODE == 1 && hid < 32) *(LAS f32x4v*)(lds + S_E + ((c + 1) & 1) * 512 + 16 * hid) = R.e; }
}
__device__ __forceinline__ void rec_store_raw(const LAS unsigned char* lds, int cp, int hd, size_t rowbase, bf16* mixed, int hid) {
    const int t = hid >> 3, seg = hid & 7;
    const LAS f32x4v* ob = (const LAS f32x4v*)(lds + S_OB + (cp & 1) * 16896 + t * 528 + seg * 64);
    const f32x4v o0 = ob[0], o1 = ob[1], o2 = ob[2], o3 = ob[3];
    GAS v4u* dst = (GAS v4u*)(mixed + (rowbase + 32 * cp + t) * D + hd * 128 + 16 * seg);
    dst[0] = (v4u){pk2(o0[0], o0[1]), pk2(o0[2], o0[3]), pk2(o1[0], o1[1]), pk2(o1[2], o1[3])}; dst[1] = (v4u){pk2(o2[0], o2[1]), pk2(o2[2], o2[3]), pk2(o3[0], o3[1]), pk2(o3[2], o3[3])};
}
__device__ __forceinline__ void rec_ptile3(LAS unsigned char* lds, int cn, int hw, int lane) {
    const int c16 = lane & 15, q4 = lane >> 4; const int si = hw == 2 ? 1 : 0, ti = hw == 0 ? 0 : 1;
    const LAS unsigned char* kb = lds + S_KT + (cn % 3) * 8192; const LAS unsigned char* qb = lds + S_QT + (cn % 3) * 8192;
    s16x8 ka[4], qa[4];
#pragma unroll
    for (int ks = 0; ks < 4; ++ks) { ka[ks] = lds_a128(kb + off_b(16 * si + c16, 4 * ks + q4)); qa[ks] = lds_a128(qb + off_b(16 * ti + c16, 4 * ks + q4)); }
    __builtin_amdgcn_sched_barrier(0);
    f32x4v p = (f32x4v){0.f, 0.f, 0.f, 0.f};
#pragma unroll
    for (int ks = 0; ks < 4; ++ks) p = MFMA16(ka[ks], qa[ks], p);
    if (hw != 1) {
#pragma unroll
        for (int r = 0; r < 4; ++r) p[r] = ((4 * q4 + r) <= c16) ? p[r] : 0.f;
    }
    v2u w; w.x = cvtpk(p[0], p[1]); w.y = cvtpk(p[2], p[3]);
    *(LAS v2u*)(lds + S_PF + (cn & 1) * 2560 + (16 * ti + c16) * 80 + (16 * si + 4 * q4) * 2) = w;
}
template <int MODE>
__device__ __forceinline__ void rec_finish(const LAS unsigned char* lds, int cp, const v4u (&g)[2], const float (&ngl)[16], int hd, size_t rowbase, bf16* mixed, int hid) {
    const int t = hid >> 3, seg = hid & 7;
    const LAS f32x4v* ob = (const LAS f32x4v*)(lds + S_OB + (cp & 1) * 16896 + t * 528 + seg * 64);
    f32x4v o[4];
#pragma unroll
    for (int i = 0; i < 4; ++i) o[i] = ob[i];
    float s1 = 0.f, s2 = 0.f;
#pragma unroll
    for (int i = 0; i < 4; ++i) { s1 += (o[i][0] + o[i][1]) + (o[i][2] + o[i][3]); s2 += (o[i][0] * o[i][0] + o[i][1] * o[i][1]) + (o[i][2] * o[i][2] + o[i][3] * o[i][3]); }
    s1 += __shfl_xor(s1, 1); s2 += __shfl_xor(s2, 1); s1 += __shfl_xor(s1, 2); s2 += __shfl_xor(s2, 2); s1 += __shfl_xor(s1, 4); s2 += __shfl_xor(s2, 4);
    float mu = 0.f, rs;
    if (MODE == 0) { mu = s1 * (1.f / 128.f); rs = __builtin_amdgcn_rsqf(fmaxf(s2 * (1.f / 128.f) - mu * mu, 0.f) + 1e-5f); }
    else rs = __builtin_amdgcn_rsqf(s2 * (1.f / 128.f) + RMS_EPS);
    v4u out[2];
#pragma unroll
    for (int hv = 0; hv < 2; ++hv) { unsigned w[4];
#pragma unroll
        for (int k = 0; k < 4; ++k) { const int e0 = 8 * hv + 2 * k; const unsigned gw = k == 0 ? g[hv].x : (k == 1 ? g[hv].y : (k == 2 ? g[hv].z : g[hv].w));
            const float a = o[e0 >> 2][e0 & 3], bq = o[(e0 + 1) >> 2][(e0 + 1) & 3]; float y0, y1;
            if (MODE == 0) { y0 = (a - mu) * rs * siluf_(bflo(gw)); y1 = (bq - mu) * rs * siluf_(bfhi(gw)); }
            else { y0 = a * rs * ngl[e0] * sigmoidf_(bflo(gw)); y1 = bq * rs * ngl[e0 + 1] * sigmoidf_(bfhi(gw)); }
            w[k] = pk2(y0, y1); }
        out[hv] = (v4u){w[0], w[1], w[2], w[3]}; }
    GAS v4u* dst = (GAS v4u*)(mixed + (rowbase + 32 * cp + t) * D + hd * 128 + 16 * seg);
    dst[0] = out[0]; dst[1] = out[1];
}

template <int MODE>
__device__ __forceinline__ void rec_compute(LAS unsigned char* lds, int c, f32x16 (&Sacc)[4], float egam, int w, int lane) {
    const int r32 = lane & 31, h = lane >> 5;
    const LAS unsigned char* qt = lds + S_QT + (c % 3) * 8192; const LAS unsigned char* ktl = lds + S_KT + (c % 3) * 8192; const LAS unsigned char* vtl = lds + S_V + (c & 1) * 8192;
    const LAS unsigned char* pf = lds + S_PF + (c & 1) * 2560 + r32 * 80 + 16 * h;
    const s16x8 pf0 = lds_a128(pf), pf1 = lds_a128(pf + 32);
    const s16x8 vf0 = tr_frag(vtl, lane, w, 0), vf1 = tr_frag(vtl, lane, w, 1);
    s16x8 qp[4][2];
#pragma unroll
    for (int dt = 0; dt < 4; ++dt)
#pragma unroll
        for (int sp = 0; sp < 2; ++sp) qp[dt][sp] = lds_2x64(qt + off_b(r32, 4 * dt + 2 * sp) + 8 * h, qt + off_b(r32, 4 * dt + 2 * sp + 1) + 8 * h);
    __builtin_amdgcn_sched_barrier(0);
    f32x16 o;
#pragma unroll
    for (int i = 0; i < 16; ++i) o[i] = 0.f;
    o = MFMA32(vf0, pf0, o); o = MFMA32(vf1, pf1, o);
#pragma unroll
    for (int dt = 0; dt < 4; ++dt)
#pragma unroll
        for (int sp = 0; sp < 2; ++sp) o = MFMA32(pack8(Sacc[dt], 8 * sp), qp[dt][sp], o);
    __builtin_amdgcn_sched_barrier(0);
    s16x8 kf[4][2];
#pragma unroll
    for (int dt = 0; dt < 4; ++dt) { kf[dt][0] = tr_frag(ktl, lane, dt, 0); kf[dt][1] = tr_frag(ktl, lane, dt, 1); }
    __builtin_amdgcn_sched_barrier(0);
#pragma unroll
    for (int dt = 0; dt < 4; ++dt) { Sacc[dt] = MFMA32(kf[dt][0], vf0, Sacc[dt]); Sacc[dt] = MFMA32(kf[dt][1], vf1, Sacc[dt]); }
    {
        LAS unsigned char* ob = lds + S_OB + (c & 1) * 16896 + r32 * 528 + (32 * w + 4 * h) * 4;
#pragma unroll
        for (int g = 0; g < 4; ++g) *(LAS f32x4v*)(ob + 32 * g) = (f32x4v){o[4 * g], o[4 * g + 1], o[4 * g + 2], o[4 * g + 3]};
    }
    if (MODE == 1) { const LAS unsigned char* eb = lds + S_E + (c & 1) * 512 + 16 * h;
#pragma unroll
        for (int dt = 0; dt < 4; ++dt)
#pragma unroll
            for (int g = 0; g < 4; ++g) { const f32x4v e4 = *(const LAS f32x4v*)(eb + (32 * dt + 8 * g) * 4);
                Sacc[dt][4 * g] *= e4[0]; Sacc[dt][4 * g + 1] *= e4[1]; Sacc[dt][4 * g + 2] *= e4[2]; Sacc[dt][4 * g + 3] *= e4[3]; }
    } else {
#pragma unroll
        for (int dt = 0; dt < 4; ++dt)
#pragma unroll
            for (int i = 0; i < 16; ++i) Sacc[dt][i] *= egam;
    }
}

#define REC_BAR() do { asm volatile("s_waitcnt lgkmcnt(0)" ::: "memory"); __builtin_amdgcn_s_barrier(); asm volatile("" ::: "memory"); } while (0)

template <int MODE, int SEGS>
__device__ __forceinline__ void rec_serial_unit(LAS unsigned char* lds, int unit, bf16* proj, const float* Eg0, const float* ng, bf16* mixed, float* Send, float* Dseg, int tid_in, int wave) {
    constexpr int NH = MODE ? 8 : 4, NCH = SEQ / 32 / SEGS, LDP = MODE ? PO : PE, CQ = MODE ? C_HQ : C_RQ, CK = MODE ? C_HF : C_RK, CV = MODE ? C_HI : C_RV;
    int tid = tid_in; asm volatile("" : "+v"(tid)); const int lane = tid & 63;
    const int bh = unit / SEGS, sg = unit % SEGS;
    const int b = bh / NH, hd = bh % NH; const size_t rowbase = (size_t)b * SEQ + (size_t)sg * NCH * 32;
    const float* Eg = Eg0 + (size_t)sg * NCH * 128;
    const bool fix = SEGS > 1 && sg > 0;
    float ecum[8] = {1.f, 1.f, 1.f, 1.f, 1.f, 1.f, 1.f, 1.f};
    {
        const int tq = tid >> 4, cq = tid & 15; const unsigned o = off_b(tq, cq);
        if (SEGS > 1) { const GAS f32x4v* ep = (const GAS f32x4v*)(Eg + ((size_t)bh * 128) * 128 + 8 * cq); const f32x4v e0 = ep[0], e1 = ep[1];
            ecum[0] = e0[0]; ecum[1] = e0[1]; ecum[2] = e0[2]; ecum[3] = e0[3]; ecum[4] = e1[0]; ecum[5] = e1[1]; ecum[6] = e1[2]; ecum[7] = e1[3]; }
#pragma unroll
        for (int cc = 0; cc < 2; ++cc) { const size_t r = rowbase + 32 * cc + tq;
            const v4u qv = *(const GAS v4u*)(proj + r * LDP + CQ + hd * 128 + 8 * cq);
            *(LAS v4u*)(lds + S_QT + cc * 8192 + o) = qv;
            if (SEGS > 1 && fix && cc == 1) *(GAS v4u*)(proj + r * LDP + CQ + hd * 128 + 8 * cq) = scale8(qv, ecum);
            *(LAS v4u*)(lds + S_KT + cc * 8192 + o) = *(const GAS v4u*)(proj + r * LDP + CK + hd * 128 + 8 * cq); }
        *(LAS v4u*)(lds + S_V + o) = *(const GAS v4u*)(proj + (rowbase + tq) * LDP + CV + hd * 128 + 8 * cq);
        if (MODE == 1 && tid < 32) *(LAS f32x4v*)(lds + S_E + 16 * tid) = *(const GAS f32x4v*)(Eg + ((size_t)bh * 128) * 128 + 4 * tid);
        if (tid < 128) { const int par = tid >> 6, t16 = (tid >> 2) & 15, q = tid & 3; unsigned z = 0u; asm volatile("" : "+v"(z)); *(LAS v2u*)(lds + S_PF + par * 2560 + t16 * 80 + 32 + 8 * q) = (v2u){z, z}; }
    }
    __syncthreads();
    if (wave >= 4 && wave < 7) rec_ptile3(lds, 0, wave - 4, lane);
    __syncthreads();
    if (wave < 4) {
        f32x16 Sacc[4];
#pragma unroll
        for (int dt = 0; dt < 4; ++dt)
#pragma unroll
            for (int i = 0; i < 16; ++i) Sacc[dt][i] = 0.f;
        const float egam = MODE ? 1.f : exp2f(32.0f * log2f(1.0f - exp2f(-5.0f - (float)hd)));
#pragma unroll 1
        for (int c = 0; c <= NCH; ++c) { if (c < NCH) rec_compute<MODE>(lds, c, Sacc, egam, wave, lane); REC_BAR(); }
        if (SEGS > 1 && sg + 1 < SEGS) {
            const int r32 = lane & 31, h = lane >> 5; float* sp = Send + ((size_t)(bh * (SEGS - 1) + sg) * 128) * 128 + 32 * wave + r32;
#pragma unroll
            for (int dt = 0; dt < 4; ++dt)
#pragma unroll
                for (int i = 0; i < 16; ++i) sp[(size_t)(32 * dt + (i & 3) + 8 * (i >> 2) + 4 * h) * 128] = Sacc[dt][i];
        }
    } else {
        const int hid = tid - 256, hw = wave - 4;
        RecSet RA, RB;
        float ngl[16];
#pragma unroll
        for (int i = 0; i < 16; ++i) ngl[i] = (MODE && SEGS == 1) ? ng[16 * (hid & 7) + i] : 1.f;
        rec_issue<MODE, SEGS>(RA, 0, bh, hd, rowbase, proj, Eg, hid); rec_issue<MODE, SEGS>(RB, 1, bh, hd, rowbase, proj, Eg, hid);
#pragma unroll 1
        for (int c = 0; c <= NCH; c += 2) {
            if (c >= 1) { if (SEGS == 1) rec_finish<MODE>(lds, c - 1, RA.g, ngl, hd, rowbase, mixed, hid); else rec_store_raw(lds, c - 1, hd, rowbase, mixed, hid); }
            if (hw < 3 && c + 1 < NCH) rec_ptile3(lds, c + 1, hw, lane);
            rec_stage<MODE, SEGS>(RA, lds, c, hid, ecum, fix, proj, hd, rowbase);
            if (c + 2 <= NCH) rec_issue<MODE, SEGS>(RA, c + 2, bh, hd, rowbase, proj, Eg, hid);
            REC_BAR();
            if (c + 1 <= NCH) {
                if (SEGS == 1) rec_finish<MODE>(lds, c, RB.g, ngl, hd, rowbase, mixed, hid); else rec_store_raw(lds, c, hd, rowbase, mixed, hid);
                if (hw < 3 && c + 2 < NCH) rec_ptile3(lds, c + 2, hw, lane);
                rec_stage<MODE, SEGS>(RB, lds, c + 1, hid, ecum, fix, proj, hd, rowbase);
                if (c + 3 <= NCH) rec_issue<MODE, SEGS>(RB, c + 3, bh, hd, rowbase, proj, Eg, hid);
                REC_BAR();
            }
        }
        if (SEGS > 1 && hid < 16) { float* dp = Dseg + (size_t)(bh * SEGS + sg) * 128 + 8 * hid;
            *(GAS f32x4v*)dp = (f32x4v){ecum[0], ecum[1], ecum[2], ecum[3]}; *(GAS f32x4v*)(dp + 4) = (f32x4v){ecum[4], ecum[5], ecum[6], ecum[7]}; }
    }
    __syncthreads();
}

__device__ __forceinline__ void rec_fix_unit(LAS unsigned char* lds, int unit, const bf16* proj, const float* Send, const float* Dseg, const float* ng, bf16* mixed, int tid_in, int wave) {
    int tid = tid_in; asm volatile("" : "+v"(tid)); const int lane = tid & 63;
    const int sg = unit & 3, bh = unit >> 2; const int b = bh >> 3, hd = bh & 7;
    const int r32 = lane & 31, h = lane >> 5;
    LAS unsigned char* ST = lds;
    if (sg > 0) {
        const int e = tid & 127, d0 = 32 * (tid >> 7); float sv[32], t1[32];
        const float* s0p = Send + ((size_t)(bh * 3 + 0) * 128 + d0) * 128 + e;
#pragma unroll
        for (int dd = 0; dd < 32; ++dd) sv[dd] = s0p[(size_t)dd * 128];
        __builtin_amdgcn_sched_barrier(0);
        if (sg >= 2) { const float* s1p = Send + ((size_t)(bh * 3 + 1) * 128 + d0) * 128 + e; const float* dp = Dseg + (size_t)(bh * 4 + 1) * 128 + d0;
#pragma unroll
            for (int dd = 0; dd < 32; ++dd) t1[dd] = s1p[(size_t)dd * 128];
            __builtin_amdgcn_sched_barrier(0);
#pragma unroll
            for (int dd = 0; dd < 32; ++dd) sv[dd] = dp[dd] * sv[dd] + t1[dd]; }
        if (sg >= 3) { const float* s2p = Send + ((size_t)(bh * 3 + 2) * 128 + d0) * 128 + e; const float* dp = Dseg + (size_t)(bh * 4 + 2) * 128 + d0;
#pragma unroll
            for (int dd = 0; dd < 32; ++dd) t1[dd] = s2p[(size_t)dd * 128];
            __builtin_amdgcn_sched_barrier(0);
#pragma unroll
            for (int dd = 0; dd < 32; ++dd) sv[dd] = dp[dd] * sv[dd] + t1[dd]; }
#pragma unroll
        for (int q = 0; q < 4; ++q) *(LAS v4u*)(ST + e * 272 + d0 * 2 + 16 * q) = (v4u){pk2(sv[8 * q], sv[8 * q + 1]), pk2(sv[8 * q + 2], sv[8 * q + 3]), pk2(sv[8 * q + 4], sv[8 * q + 5]), pk2(sv[8 * q + 6], sv[8 * q + 7])};
    }
    __syncthreads();
#pragma unroll 1
    for (int blk = 0; blk < 4; ++blk) {
        f32x16 O[4];
#pragma unroll
        for (int et = 0; et < 4; ++et)
#pragma unroll
            for (int i = 0; i < 16; ++i) O[et][i] = 0.f;
        const size_t trow = (size_t)b * SEQ + 1024 * sg + 256 * blk + 32 * wave + r32;
        if (sg > 0) {
            s16x8 qf[8];
            { const bf16* qp = proj + trow * PO + C_HQ + hd * 128 + 8 * h;
#pragma unroll
              for (int ks = 0; ks < 8; ++ks) qf[ks] = __builtin_bit_cast(s16x8, *(const GAS v4u*)(qp + 16 * ks)); }
#pragma unroll
            for (int et = 0; et < 4; ++et)
#pragma unroll
                for (int ks = 0; ks < 8; ++ks) O[et] = MFMA32(lds_a128(ST + (32 * et + r32) * 272 + (16 * ks + 8 * h) * 2), qf[ks], O[et]);
        }
        bf16* mp = mixed + trow * D + hd * 128 + 4 * h; const bf16* gp = proj + trow * PO + C_HG + hd * 128 + 4 * h;
        v2u ol[4][4], gl[4][4];
#pragma unroll
        for (int et = 0; et < 4; ++et)
#pragma unroll
            for (int g = 0; g < 4; ++g) { ol[et][g] = *(const GAS v2u*)(mp + 32 * et + 8 * g); gl[et][g] = *(const GAS v2u*)(gp + 32 * et + 8 * g); }
        __builtin_amdgcn_sched_barrier(0);
        float s2 = 0.f;
#pragma unroll
        for (int et = 0; et < 4; ++et)
#pragma unroll
            for (int g = 0; g < 4; ++g) { const v2u w = ol[et][g];
                O[et][4 * g] += bflo(w.x); O[et][4 * g + 1] += bfhi(w.x); O[et][4 * g + 2] += bflo(w.y); O[et][4 * g + 3] += bfhi(w.y);
                s2 += (O[et][4 * g] * O[et][4 * g] + O[et][4 * g + 1] * O[et][4 * g + 1]) + (O[et][4 * g + 2] * O[et][4 * g + 2] + O[et][4 * g + 3] * O[et][4 * g + 3]); }
        s2 += __shfl_xor(s2, 32);
        const float rs = __builtin_amdgcn_rsqf(s2 * (1.f / 128.f) + RMS_EPS);
#pragma unroll
        for (int et = 0; et < 4; ++et)
#pragma unroll
            for (int g = 0; g < 4; ++g) { const v2u gw = gl[et][g]; const f32x4v nv = *(const GAS f32x4v*)(ng + 32 * et + 8 * g + 4 * h);
                v2u w; w.x = pk2(O[et][4 * g] * rs * nv[0] * sigmoidf_(bflo(gw.x)), O[et][4 * g + 1] * rs * nv[1] * sigmoidf_(bfhi(gw.x)));
                w.y = pk2(O[et][4 * g + 2] * rs * nv[2] * sigmoidf_(bflo(gw.y)), O[et][4 * g + 3] * rs * nv[3] * sigmoidf_(bfhi(gw.y)));
                *(GAS v2u*)(mp + 32 * et + 8 * g) = w; }
    }
    __syncthreads();
}
struct Args { const float* in[19]; float* out; unsigned char* ws; int ph_lo, ph_hi, rep, pad; };
constexpr int NPH_LAYER = 11, NPHASES = 1 + DEPTH * NPH_LAYER;

__global__ void __launch_bounds__(NT, 2) trunk_fwd(Args args) {
    extern __shared__ __attribute__((aligned(16))) unsigned char lds_raw[];
    LAS unsigned char* lds = (LAS unsigned char*)lds_raw;
    volatile LAS unsigned* MISC = (volatile LAS unsigned*)(lds + MISC_OFF);
    const int tid0 = threadIdx.x; const int wave = __builtin_amdgcn_readfirstlane(tid0 >> 6);
#define PHASE_TID() int tid = threadIdx.x; asm volatile("" : "+v"(tid)); const int lane = tid & 63; (void)lane
    const int G = gridDim.x; const int bx = blockIdx.x; const int vcu = (G % 8 == 0) ? (bx % 8) * (G / 8) + bx / 8 : bx;
    const int gw = vcu * NWAVES + wave, NGW = G * NWAVES;
    unsigned char* ws = args.ws;
    gu32* ctl = (gu32*)(ws + WS_CTL);
    for (int u = tid0; u < (LDS_BYTES - LDSCTL_OFF) / 4; u += NT) ((LAS unsigned*)(lds + LDSCTL_OFF))[u] = 0u;
    __syncthreads();
    XcdBarrier bar; bar.bar = (unsigned*)(ctl + CW_BAR); bar.x = 0; bar.st = nullptr;
#if ONE_LAUNCH
    bar = xcd_barrier_post((unsigned*)(ctl + CW_BAR), MISC + 8);
#define GRID_BAR() xcd_barrier(bar)
#else
#define GRID_BAR() do {} while (0)
#endif
    const int lo = args.ph_lo, hi = args.ph_hi;
#define IN(k) (lo <= (k) && (k) < hi)
    const float* x_in = args.in[0]; float* xres = args.out;
    float2* rope = (float2*)(ws + WS_ROPE); float* lbv = (float*)(ws + WS_LB); float* kcmp = (float*)(ws + WS_KCMP); unsigned long long* sel = (unsigned long long*)(ws + WS_SEL);
    bf16* Hb = (bf16*)(ws + WS_H); float* accn = (float*)(ws + WS_H); bf16* proj = (bf16*)(ws + WS_PROJ); bf16* hid = (bf16*)(ws + WS_PROJ); bf16* mixed = (bf16*)(ws + WS_MIXED);
    float* rowss = (float*)(ws + WS_ROWSS); bf16* kcb = (bf16*)(ws + WS_KCB); bf16* vctb = (bf16*)(ws + WS_VCTB); bf16* VTb = (bf16*)(ws + WS_VT); bf16* KTb = (bf16*)(ws + WS_KT);

    if (IN(0)) { PHASE_TID();
        LAS unsigned* scr = (LAS unsigned*)(lds + wave * 16384);
#if PROBE_ML
        const int pr = args.rep;
#else
        const int pr = 0;
#endif
        if (pr == 0 || pr == 1 || pr == 2) { convert_weights(args.in, ws, 0, scr, gw, NGW, lane); convert_weights(args.in, ws, 1, scr, gw, NGW, lane); }
        if (pr == 0 || pr == 1 || pr == 4) {
        for (int it = gw; it < 4 * 32; it += NGW) { const int m = it >> 5, r = it & 31; const int jj = m >> 1, kv = m & 1;
            tr_item64(args.in[kv ? 10 : 7] + (size_t)jj * 2048 * 64, 2048, 64, (bf16*)(ws + WS_W1T) + (size_t)m * 64 * 2048, r * 64, 0, 0, scr, lane); }
        for (int mt = gw; mt < 4 * 32; mt += NGW) { const int m = mt >> 5, ksg = mt & 31; const int jj = m >> 1, kv = m & 1;
            const float* pos = args.in[kv ? 9 : 6] + (size_t)jj * 2048 + 64 * ksg; const float* w1 = args.in[kv ? 10 : 7] + (size_t)jj * 2048 * 64 + (size_t)64 * ksg * 64;
            float acc = 0.f;
#pragma unroll 16
            for (int k = 0; k < 64; ++k) acc += pos[k] * w1[k * 64 + lane];
            ((float*)(ws + WS_CBIAS))[(m * 32 + ksg) * 64 + lane] = acc; }
        for (int idx = vcu * NT + tid; idx < SEQ * 64; idx += G * NT) { const int s = idx >> 6, i = idx & 63;
            const float inv = exp2f(-(float)i * (13.287712379549449f / 64.0f));
            double tt = (double)s * (double)inv * 0.15915494309189535; tt -= floor(tt); const float tf = (float)tt;
            rope[idx] = make_float2(__builtin_amdgcn_cosf(tf), __builtin_amdgcn_sinf(tf)); }
        for (int c = vcu * NT + tid; c < 1024; c += G * NT) { const float l0 = args.in[15][c], l1 = args.in[15][1024 + c]; lbv[c] = 0.f; lbv[1024 + c] = 1.0f / (1.0f + expf(l0 - l1)); }
        }
        if (pr == 0 || pr == 1 || pr == 3) {
        if (M % (G * 2 * NWAVES) == 0) { const int per = M / G; for (int m = vcu * per + wave; m < (vcu + 1) * per; m += 2 * NWAVES) rows2_to_bf16_ss(x_in + (size_t)m * D, x_in + (size_t)(m + NWAVES) * D, Hb + (size_t)m * D, Hb + (size_t)(m + NWAVES) * D, rowss, m, m + NWAVES, lane); }
        else if (M % G == 0) { const int per = M / G; for (int m = vcu * per + wave; m < (vcu + 1) * per; m += NWAVES) row_to_bf16_ss(x_in + (size_t)m * D, Hb + (size_t)m * D, rowss, m, lane); }
        else for (int m = gw; m < M; m += NGW) row_to_bf16_ss(x_in + (size_t)m * D, Hb + (size_t)m * D, rowss, m, lane);
        }
        __syncthreads();
        GRID_BAR();
    }

#pragma unroll 1
    for (int L = 0; L < DEPTH; ++L) {
        const int pb = 1 + L * NPH_LAYER; const int j = L >> 1; const bool even = (L & 1) == 0;
        if (IN(pb + 0)) { PHASE_TID();
            const int N = even ? PE : PO; const bf16* Wt = even ? (const bf16*)(ws + WS_WEIN) + (size_t)j * PE * D : (const bf16*)(ws + WS_WOIN) + (size_t)j * PO * D;
            pg8::Gemm g{Hb, Wt, M, N, D}; pg8::StaticOrder S; S.init(M, N, G, bx);
            build_rstd_table(lds, S, rowss, tid);
            pg8::EpiInProj E{proj, N, (const LAS int*)(lds + RS_TBL_OFF), (const LAS float*)(lds + RS_TAB_OFF), even ? 0 : 1, (const float*)rope, lbv + (size_t)j * 1024, (float*)(ws + WS_VT), PROBE_ML ? args.rep : 0};
            pg8::gemm_phase<pg8::EpiInProj, pg8::StaticOrder, PG8_ALIGN, PG8_SP2>(lds, g, S, E, tid);
            GRID_BAR();
        }
        if (even && IN(pb + 1)) { PHASE_TID();
#if REC_NAIVE
            const int nret = (G > 64) ? 32 : 0;
            if (nret == 0 || vcu < nret) for (int u = vcu; u < 32; u += (nret ? nret : G)) recur_unit<0>(lds, u >> 2, u & 3, proj, PE, rope, nullptr, nullptr, mixed, tid, lane, wave);
            if (nret == 0 || vcu >= nret)
#else
            const int nret = 0;
#endif
            {
                LAS float* xs = (LAS float*)(lds + wave * 16384);
                const int w0 = nret ? (vcu - nret) * NWAVES + wave : gw, nw = nret ? (G - nret) * NWAVES : NGW;
                for (int item = w0; item < 16 * 2 * 64; item += nw) kv_tile_item((LAS unsigned short*)xs, item, proj, KTb, VTb, lane);
                __syncthreads();
                for (int u = vcu; u < 256; u += G) compress_unit(lds, u, proj, (const bf16*)(ws + WS_W1T) + (size_t)j * 2 * 64 * 2048, (const float*)(ws + WS_CBIAS) + j * 2 * 32 * 64, args.in[8] + (size_t)j * 4096, args.in[11] + (size_t)j * 4096, kcb, vctb, tid, wave);
            }
            __syncthreads();
            GRID_BAR();
        }
#if NSA_NAIVE
        if (even && IN(pb + 2)) { PHASE_TID();
            LAS float* wl = (LAS float*)(lds + wave * 4096);
            for (int task = gw; task < 16 * SEQ; task += NGW) cmp_attn_task(wl, task, proj, kcmp, accn, sel, lane);
            __syncthreads();
            GRID_BAR();
        }
        if (even && IN(pb + 3)) { PHASE_TID();
            LAS float* wl = (LAS float*)(lds + wave * 4096);
            for (int task = gw; task < 16 * SEQ; task += NGW) blk_attn_task<0>(wl, task, proj, sel, accn, mixed, lane);
            __syncthreads();
            GRID_BAR();
        }
        if (even && IN(pb + 4)) { PHASE_TID();
            LAS float* wl = (LAS float*)(lds + wave * 4096);
            for (int task = gw; task < 16 * SEQ; task += NGW) blk_attn_task<1>(wl, task, proj, sel, accn, mixed, lane);
            __syncthreads();
            GRID_BAR();
        }
#else
        if (even && IN(pb + 2)) { PHASE_TID();
            const int per = (G % 8 == 0 && G >= 64) ? G / 8 : 0;
            { const int ru0 = per ? (((vcu % per) % 8 == 0 && (vcu % per) / 8 < 4) ? (vcu / per) * 4 + (vcu % per) / 8 : BATCH * 4) : vcu, rstep = per ? BATCH * 4 : G;
              for (int u = ru0; u < BATCH * 4; u += rstep) rec_serial_unit<0, 1>(lds, u, proj, nullptr, nullptr, mixed, nullptr, nullptr, tid, wave); }
            const int xq = per ? vcu / per : 0; const unsigned nitem = per ? 128u : 1024u;
            for (;;) {
                if (tid == 0) MISC[0] = __hip_atomic_fetch_add((unsigned*)(ctl + CW_Q + 64 * (j * 8 + xq + 16 * args.rep)), 1u, __ATOMIC_RELAXED, __HIP_MEMORY_SCOPE_AGENT);
                __syncthreads();
                const unsigned it = MISC[0];
                __syncthreads();
                if (it >= nitem) break;
                nsa_subunit(lds, per ? 2 * xq + (int)(it & 1u) : (int)(it & 15u), 63 - (int)(per ? it >> 1 : it >> 4), proj, kcb, vctb, KTb, VTb, mixed, tid, wave);
            }
            __syncthreads();
            GRID_BAR();
        }
#endif
#if REC_NAIVE
        if (!even && IN(pb + 5)) { PHASE_TID();
            for (int u = vcu; u < 64; u += G) recur_unit<1>(lds, u >> 3, u & 7, proj, PO, nullptr, lbv + (size_t)j * 1024, args.in[14] + (size_t)j * 128, mixed, tid, lane, wave);
            __syncthreads();
            GRID_BAR();
        }
#else
        if (!even && IN(pb + 3)) { PHASE_TID();
            for (int u = vcu; u < BATCH * 8 * 4; u += G) rec_serial_unit<1, 4>(lds, u, proj, (const float*)(ws + WS_VT), nullptr, mixed, (float*)(ws + WS_VT + 4 * MiB), (float*)(ws + WS_KCB), tid, wave);
            __syncthreads();
            GRID_BAR();
        }
        if (!even && IN(pb + 5)) { PHASE_TID();
            for (int u = vcu; u < BATCH * 8 * 4; u += G) rec_fix_unit(lds, u, proj, (const float*)(ws + WS_VT + 4 * MiB), (const float*)(ws + WS_KCB), args.in[14] + (size_t)j * 128, mixed, tid, wave);
            __syncthreads();
            GRID_BAR();
        }
#endif
        if (IN(pb + 6)) { PHASE_TID();
            const bf16* Wt = even ? (const bf16*)(ws + WS_WEOUT) + (size_t)j * D * D : (const bf16*)(ws + WS_WOOUT) + (size_t)j * D * D;
            pg8::Gemm g{mixed, Wt, M, D, D}; pg8::StaticOrder S; S.init(M, D, G, bx);
            pg8::EpiResF32 E{Hb, D, args.rep ? 0.f : 1.f, rowss, M, PROBE_ML ? args.rep : 0};
            pg8::gemm_phase<pg8::EpiResF32, pg8::StaticOrder, PG8_ALIGN, PG8_SP2>(lds, g, S, E, tid);
            GRID_BAR();
        }
        if (IN(pb + 8)) { PHASE_TID();
            pg8::Gemm g{Hb, (const bf16*)(ws + WS_W13) + (size_t)L * FF2 * D, M, FF2, D}; pg8::StaticOrder S; S.init(M, FF2, G, bx);
            build_rstd_table(lds, S, rowss, tid);
            pg8::EpiSwiGLU E{hid, FF, (const LAS int*)(lds + RS_TBL_OFF), (const LAS float*)(lds + RS_TAB_OFF), PROBE_ML ? args.rep : 0};
            pg8::gemm_phase<pg8::EpiSwiGLU, pg8::StaticOrder, PG8_ALIGN, PG8_SP2>(lds, g, S, E, tid);
            GRID_BAR();
        }
        if (IN(pb + 9)) { PHASE_TID();
            pg8::Gemm g{hid, (const bf16*)(ws + WS_W2) + (size_t)L * D * FF, M, D, FF}; pg8::StaticOrder S; S.init(M, D, G, bx);
            pg8::EpiResF32 E{Hb, D, args.rep ? 0.f : 1.f, rowss, M, PROBE_ML ? args.rep : 0};
            pg8::gemm_phase<pg8::EpiResF32, pg8::StaticOrder, PG8_ALIGN, PG8_SP2>(lds, g, S, E, tid);
            GRID_BAR();
        }
        if (L + 1 == DEPTH && IN(pb + 10)) { PHASE_TID();
#if PROBE_ML
            if (args.rep == 5) {
                typedef short bf16x8_ __attribute__((ext_vector_type(8)));
                bf16x8_ af[4], bfm[4];
                for (int i = 0; i < 4; ++i) { af[i] = *(const bf16x8_*)(Hb + (size_t)(gw * 64 + lane) * D + i * 8); bfm[i] = *(const bf16x8_*)(Hb + (size_t)(gw * 64 + lane) * D + 512 + i * 8); }
                f32x4 c[4][4];
                for (int i = 0; i < 4; ++i) for (int k = 0; k < 4; ++k) c[i][k] = (f32x4){0.f, 0.f, 0.f, 0.f};
#pragma unroll 1
                for (int it = 0; it < 4096; ++it) {
#pragma unroll
                    for (int i = 0; i < 4; ++i)
#pragma unroll
                        for (int k = 0; k < 4; ++k) c[i][k] = __builtin_amdgcn_mfma_f32_16x16x32_bf16(af[i], bfm[k], c[i][k], 0, 0, 0);
                }
                f32x4 sacc = (f32x4){0.f, 0.f, 0.f, 0.f};
                for (int i = 0; i < 4; ++i) for (int k = 0; k < 4; ++k) sacc += c[i][k];
                ((f32x4*)(ws + WS_CTL + 512 * 1024))[gw * 64 + lane] = sacc;
            } else if (args.rep == 6) {
                float a = bf2f(Hb[(size_t)(gw * 64 + lane) * D]), b = 1.0000001f, c0 = 1e-9f;
#pragma unroll 1
                for (int it = 0; it < 131072 / 16; ++it) {
#pragma unroll
                    for (int k = 0; k < 16; ++k) asm volatile("v_fma_f32 %0, %0, %1, %2" : "+v"(a) : "v"(b), "v"(c0));
                }
                ((float*)(ws + WS_CTL + 512 * 1024))[gw * 64 + lane] = a;
            } else
#endif
            for (int m = gw; m < M; m += NGW) rms_row_bf16_to_f32(Hb + (size_t)m * D, args.in[3], xres + (size_t)m * D, lane);
        }
    }
#undef IN
}

extern "C" void kernel_launch(void* const* d_in, const int* in_sizes, int n_in, void* d_out, int out_size, void* d_ws, size_t ws_size, hipStream_t stream) {
    static int grid = 0;
    if (grid == 0) {
        if (n_in != 19 || in_sizes[0] != M * D || out_size != M * D || ws_size < WS_END) { fprintf(stderr, "kernel_launch: unexpected shapes/workspace (n_in %d, in0 %d, out %d, ws %zu); nothing launched\n", n_in, n_in > 0 ? in_sizes[0] : -1, out_size, ws_size); grid = -1; return; }
        int dev = 0, cus = 0;
        if (hipGetDevice(&dev) != hipSuccess || hipDeviceGetAttribute(&cus, hipDeviceAttributeMultiprocessorCount, dev) != hipSuccess) { grid = -1; return; }
        if (hipFuncSetAttribute((const void*)trunk_fwd, hipFuncAttributeMaxDynamicSharedMemorySize, LDS_BYTES) != hipSuccess) { fprintf(stderr, "kernel_launch: hipFuncSetAttribute failed\n"); grid = -1; return; }
        int per_cu = 0;
        if (hipOccupancyMaxActiveBlocksPerMultiprocessor(&per_cu, (const void*)trunk_fwd, NT, LDS_BYTES) != hipSuccess || per_cu < 1) fprintf(stderr, "kernel_launch: occupancy query reports %d\n", per_cu);
        (void)hipGetLastError();
        grid = cus;
    }
    if (grid < 0) return;
    (void)hipMemsetAsync((char*)d_ws + WS_CTL, 0, CTL_ZERO_BYTES, stream);
    Args a{};
    for (int i = 0; i < 19; ++i) a.in[i] = (const float*)d_in[i];
    a.out = (float*)d_out; a.ws = (unsigned char*)d_ws;
#if ONE_LAUNCH && !PROBE_ML
    a.ph_lo = 0; a.ph_hi = NPHASES;
    hipLaunchKernelGGL(trunk_fwd, dim3(grid), dim3(NT), LDS_BYTES, stream, a);
#else
#if ONE_LAUNCH
#define PROBE_RESET() (void)hipMemsetAsync((char*)d_ws + WS_CTL + CW_BAR * 4, 0, (CW_Q - CW_BAR) * 4, stream)
#else
#define PROBE_RESET() do {} while (0)
#endif
    for (int p = 0; p < NPHASES; ++p) {
        if (p > 0) { const int L = (p - 1) / NPH_LAYER, k = (p - 1) % NPH_LAYER; const bool even = (L & 1) == 0; if (even && (k == 5 || ((k == 3 || k == 4) && !NSA_NAIVE))) continue; if (!even && (k == 1 || k == 2 || k == 4)) continue; if (k == 7 || (k == 10 && L + 1 < DEPTH)) continue; }
        a.ph_lo = p; a.ph_hi = p + 1; a.rep = 0;
        PROBE_RESET();
        hipLaunchKernelGGL(trunk_fwd, dim3(grid), dim3(NT), LDS_BYTES, stream, a);
#ifdef REP_K
        if ((p == 0 && REP_K == -2) || (p > 0 && (p - 1) % NPH_LAYER == REP_K)) { a.rep = REP_MODE; PROBE_RESET(); hipLaunchKernelGGL(trunk_fwd, dim3(grid), dim3(NT), LDS_BYTES, stream, a); }
#endif
    }
#endif
}
```

```cpp
#include <hip/hip_runtime.h>
#include <cstdio>
#include <cstdint>

#ifndef ONE_LAUNCH
#define ONE_LAUNCH 1
#define PROBE_ML 0
#endif

namespace pg8 {
#define PG8_LAS __attribute__((address_space(3)))
typedef unsigned short bf16_t;
typedef short bf16x8 __attribute__((ext_vector_type(8)));
typedef float f32x4 __attribute__((ext_vector_type(4)));
typedef unsigned u32x4 __attribute__((ext_vector_type(4)));
constexpr int BM = 256, BK = 64, HALF = 128, HTB = HALF * BK * 2  , STAGE_BYTES = 8 * HTB, NXCD = 8, WGM = 8;

__host__ __device__ __forceinline__ int lds_byte(int r, int c) { const int st = (r >> 4) * 2 + (c >> 5), rr = r & 15, cc = c & 31, ob = rr * 64 + cc * 2; return st * 1024 + (ob ^ (((ob >> 9) & 1) << 5)); }
__host__ __device__ __forceinline__ void stage_rc(int b, int& R, int& C) { const int st = b / 1024, sb = b % 1024, swz = sb ^ (((sb >> 9) & 1) << 5); R = (st >> 1) * 16 + swz / 64; C = (st & 1) * 32 + (swz % 64) / 2; }
__host__ __device__ __forceinline__ int perm32(int rho) { const int n = rho >> 4, i = rho & 15; return 8 * (i >> 2) + 4 * n + (i & 3); }

struct Unit { int pm, pn; };
struct Gemm { const bf16_t* A; const bf16_t* Bt; int M, N, K; };

struct StaticOrder {
    int nM, nN, nwg, G, c;
    __host__ __device__ void init(int M, int N, int G_, int c_) { nM = M / BM; nN = N / BM; nwg = nM * nN; G = G_; c = c_; }
    __host__ __device__ bool next(int i, Unit& u) const {
        const long L = (long)i * G + c; if (L >= nwg) return false;
        int wgid = (int)L; { const int q = nwg / NXCD, r = nwg % NXCD, xcd = wgid % NXCD, off = wgid / NXCD; wgid = (xcd < r ? xcd * (q + 1) : r * (q + 1) + (xcd - r) * q) + off; }
        const int nig = WGM * nN, gid = wgid / nig, fm = gid * WGM, gsz = (nM - fm) < WGM ? (nM - fm) : WGM;
        u.pm = fm + ((wgid % nig) % gsz); u.pn = (wgid % nig) / gsz; return true;
    }
    __device__ __forceinline__ void a_ready(const Unit&) const {}
    __device__ __forceinline__ void done(const Unit&) const {}
};

#ifndef NST_INPROJ
#define NST_INPROJ (PROBE_ML ? 0 : 16)
#endif
__device__ __forceinline__ unsigned cvt_pk_bf16(float lo, float hi) { unsigned r; asm volatile("v_cvt_pk_bf16_f32 %0, %1, %2" : "=v"(r) : "v"(lo), "v"(hi)); return r; }
__device__ __forceinline__ float fast_silu(float x) { return x * __builtin_amdgcn_rcpf(1.0f + __expf(-x)); }

__device__ __forceinline__ void row_rstd8(const PG8_LAS int* tbl, const PG8_LAS float* rsl, const Unit& u, int rl0, float (&rs)[2][4]) {
    const PG8_LAS float* p = rsl + tbl[u.pm] * 256 + rl0;
#pragma unroll
    for (int ai = 0; ai < 2; ++ai)
#pragma unroll
        for (int m = 0; m < 4; ++m) rs[ai][m] = p[ai * HALF + m * 16];
}
struct EpiBf16Plain {
    static constexpr bool PERM = true, AFTER_DRAIN = false; static constexpr int NST = PROBE_ML ? 0 : 16;
    bf16_t* O; int ldc; const PG8_LAS int* tbl; const PG8_LAS float* rsl;
    __device__ __forceinline__ void operator()(const f32x4 (&acc)[2][2][4][2], const Unit& u, int wr, int wc, int fr, int fq) const {
        const int row0 = u.pm * BM + wr * 64 + fr, col0 = u.pn * BM + wc * 32 + 8 * fq;
        float rs[2][4]; row_rstd8(tbl, rsl, u, wr * 64 + fr, rs);
#pragma unroll
        for (int ai = 0; ai < 2; ++ai)
#pragma unroll
            for (int m = 0; m < 4; ++m) { bf16_t* rowp = O + (size_t)(row0 + ai * HALF + m * 16) * ldc + col0; const float r = rs[ai][m];
#pragma unroll
                for (int bj = 0; bj < 2; ++bj) { const f32x4 v0 = acc[ai][bj][m][0] * r, v1 = acc[ai][bj][m][1] * r;
                    u32x4 w; w.x = cvt_pk_bf16(v0[0], v0[1]); w.y = cvt_pk_bf16(v0[2], v0[3]); w.z = cvt_pk_bf16(v1[0], v1[1]); w.w = cvt_pk_bf16(v1[2], v1[3]);
                    *(u32x4*)(rowp + bj * HALF) = w; } }
    }
};

__device__ __forceinline__ float dpp_scan16(float x) {
    x += __builtin_bit_cast(float, __builtin_amdgcn_update_dpp(0, __builtin_bit_cast(int, x), 0x111, 0xf, 0xf, true));
    x += __builtin_bit_cast(float, __builtin_amdgcn_update_dpp(0, __builtin_bit_cast(int, x), 0x112, 0xf, 0xf, true));
    x += __builtin_bit_cast(float, __builtin_amdgcn_update_dpp(0, __builtin_bit_cast(int, x), 0x114, 0xf, 0xf, true));
    x += __builtin_bit_cast(float, __builtin_amdgcn_update_dpp(0, __builtin_bit_cast(int, x), 0x118, 0xf, 0xf, true));
    return x;
}
struct EpiInProj {
    static constexpr bool PERM = true, AFTER_DRAIN = false; static constexpr int NST = NST_INPROJ;
    bf16_t* O; int ldc; const PG8_LAS int* tbl; const PG8_LAS float* rsl;
    int mode; const float* rope; const float* lb; float* Eg; int dbg;
    __device__ __forceinline__ void operator()(const f32x4 (&acc)[2][2][4][2], const Unit& u, int wr, int wc, int fr, int fq) const {
        if (dbg == 3) return;
        const int row0 = u.pm * BM + wr * 64 + fr;
        float rs[2][4]; row_rstd8(tbl, rsl, u, wr * 64 + fr, rs);
        const int lane = (fq << 4) | fr;
        if (mode == 0 && u.pn < 4) {
            const int hd = u.pn; const int i0 = 16 * wc + 4 * fq;
            const float lg = __builtin_amdgcn_logf(1.0f - __builtin_amdgcn_exp2f(-5.0f - (float)hd));
            const int pos0 = row0 & 4095;
            const f32x4* cs = (const f32x4*)(rope + ((size_t)pos0 * 64 + i0) * 2); const f32x4* c16p = (const f32x4*)(rope + ((size_t)16 * 64 + i0) * 2); const f32x4* c128p = (const f32x4*)(rope + ((size_t)128 * 64 + i0) * 2);
            const f32x4 b01 = cs[0], b23 = cs[1], s01 = c16p[0], s23 = c16p[1], t01 = c128p[0], t23 = c128p[1];
            float cb[4] = {b01[0], b01[2], b23[0], b23[2]}, sb[4] = {b01[1], b01[3], b23[1], b23[3]};
            const float c16[4] = {s01[0], s01[2], s23[0], s23[2]}, s16[4] = {s01[1], s01[3], s23[1], s23[3]}, c128[4] = {t01[0], t01[2], t23[0], t23[2]}, s128[4] = {t01[1], t01[3], t23[1], t23[3]};
            float gpv[2], giv[2]; float k884 = 0.08838834764831845f; asm volatile("" : "+v"(k884));
#pragma unroll
            for (int par = 0; par < 2; ++par) { const float tl1 = (float)(fr + 16 * par + 1); gpv[par] = __builtin_amdgcn_exp2f(tl1 * lg); giv[par] = k884 * __builtin_amdgcn_exp2f(-tl1 * lg); }
            typedef unsigned u32x2 __attribute__((ext_vector_type(2)));
#pragma unroll
            for (int ai = 0; ai < 2; ++ai) {
                float c[4], sn[4];
#pragma unroll
                for (int k = 0; k < 4; ++k) { c[k] = cb[k]; sn[k] = sb[k]; }
#pragma unroll
                for (int m = 0; m < 4; ++m) { const int row = row0 + ai * HALF + m * 16; const float r = rs[ai][m];
#pragma unroll
                    for (int bj = 0; bj < 2; ++bj) { const f32x4 x1 = acc[ai][bj][m][0] * r, x2 = acc[ai][bj][m][1] * r; const float sc = bj ? giv[m & 1] : gpv[m & 1];
                        float a[4], b[4];
#pragma unroll
                        for (int k = 0; k < 4; ++k) { a[k] = (x1[k] * c[k] - x2[k] * sn[k]) * sc; b[k] = (x1[k] * sn[k] + x2[k] * c[k]) * sc; }
                        bf16_t* dst = O + (size_t)row * ldc + (bj ? 512 : 0) + hd * 128 + i0;
                        u32x2 w0; w0.x = cvt_pk_bf16(a[0], a[1]); w0.y = cvt_pk_bf16(a[2], a[3]); *(u32x2*)dst = w0;
                        u32x2 w1; w1.x = cvt_pk_bf16(b[0], b[1]); w1.y = cvt_pk_bf16(b[2], b[3]); *(u32x2*)(dst + 64) = w1; }
                    if (m < 3) {
#pragma unroll
                        for (int k = 0; k < 4; ++k) { const float cn = c[k] * c16[k] - sn[k] * s16[k]; sn[k] = sn[k] * c16[k] + c[k] * s16[k]; c[k] = cn; } }
                }
                if (ai == 0) {
#pragma unroll
                    for (int k = 0; k < 4; ++k) { const float cn = cb[k] * c128[k] - sb[k] * s128[k]; sb[k] = sb[k] * c128[k] + cb[k] * s128[k]; cb[k] = cn; } }
            }
        } else if (mode == 1 && u.pn < 8) {
            const int hd = u.pn; const int ch0 = 32 * wc + 8 * fq;
            const f32x4 lb0 = *(const f32x4*)(lb + hd * 128 + ch0), lb1 = *(const f32x4*)(lb + hd * 128 + ch0 + 4);
            float lw[8], oml[8];
#pragma unroll
            for (int k = 0; k < 8; ++k) { lw[k] = k < 4 ? lb0[k & 3] : lb1[k & 3]; oml[k] = 1.0f - lw[k]; }
            const int src15 = ((lane & 48) | 15) << 2;
#pragma unroll
            for (int ai = 0; ai < 2; ++ai)
#pragma unroll
                for (int mp = 0; mp < 2; ++mp) {
                    float carry[8];
#pragma unroll
                    for (int mm = 0; mm < 2; ++mm) { const int m = 2 * mp + mm; const int row = row0 + ai * HALF + m * 16; const float r = rs[ai][m];
                        const float rn = -1.4426950408889634f * r, rc = 0.08838834764831845f * r;
                        float B[8], sg[8], Ef[8];
#pragma unroll
                        for (int k = 0; k < 8; ++k) { Ef[k] = __builtin_amdgcn_exp2f(acc[ai][1][m][k >> 2][k & 3] * rn);
                            sg[k] = __builtin_amdgcn_rcpf(1.0f + Ef[k]); B[k] = __builtin_amdgcn_logf(fmaf(oml[k], sg[k], lw[k])); }
#pragma unroll
                        for (int k = 0; k < 8; ++k) B[k] += __builtin_bit_cast(float, __builtin_amdgcn_update_dpp(0, __builtin_bit_cast(int, B[k]), 0x111, 0xf, 0xf, true));
#pragma unroll
                        for (int k = 0; k < 8; ++k) B[k] += __builtin_bit_cast(float, __builtin_amdgcn_update_dpp(0, __builtin_bit_cast(int, B[k]), 0x112, 0xf, 0xf, true));
#pragma unroll
                        for (int k = 0; k < 8; ++k) B[k] += __builtin_bit_cast(float, __builtin_amdgcn_update_dpp(0, __builtin_bit_cast(int, B[k]), 0x114, 0xf, 0xf, true));
#pragma unroll
                        for (int k = 0; k < 8; ++k) B[k] += __builtin_bit_cast(float, __builtin_amdgcn_update_dpp(0, __builtin_bit_cast(int, B[k]), 0x118, 0xf, 0xf, true));
                        if (mm == 1) {
#pragma unroll
                            for (int k = 0; k < 8; ++k) B[k] += carry[k]; }
                        if (mm == 0) {
#pragma unroll
                            for (int k = 0; k < 8; ++k) carry[k] = __builtin_bit_cast(float, __builtin_amdgcn_ds_bpermute(src15, __builtin_bit_cast(int, B[k]))); }
                        float qt[8], kt[8], ev[8];
#pragma unroll
                        for (int k = 0; k < 8; ++k) { const float aq = acc[ai][0][m][k >> 2][k & 3];
                            const float e = __builtin_amdgcn_exp2f(B[k]), ei = __builtin_amdgcn_exp2f(-B[k]);
                            const float iq = __builtin_amdgcn_rcpf(1.0f + __builtin_amdgcn_exp2f(aq * rn));
                            qt[k] = (aq * rc) * (iq * e);
                            kt[k] = (oml[k] * Ef[k]) * (sg[k] * ei); ev[k] = e; }
                        bf16_t* dst = O + (size_t)row * ldc + hd * 128 + ch0;
                        u32x4 wq; wq.x = cvt_pk_bf16(qt[0], qt[1]); wq.y = cvt_pk_bf16(qt[2], qt[3]); wq.z = cvt_pk_bf16(qt[4], qt[5]); wq.w = cvt_pk_bf16(qt[6], qt[7]); *(u32x4*)dst = wq;
                        u32x4 wk; wk.x = cvt_pk_bf16(kt[0], kt[1]); wk.y = cvt_pk_bf16(kt[2], kt[3]); wk.z = cvt_pk_bf16(kt[4], kt[5]); wk.w = cvt_pk_bf16(kt[6], kt[7]); *(u32x4*)(dst + 1024) = wk;
                        if (mm == 1 && fr == 15) { float* ep = Eg + ((size_t)((row >> 12) * 8 + hd) * 128 + ((row & 4095) >> 5)) * 128 + ch0;
                            *(f32x4*)ep = (f32x4){ev[0], ev[1], ev[2], ev[3]}; *(f32x4*)(ep + 4) = (f32x4){ev[4], ev[5], ev[6], ev[7]}; } }
                }
        } else {
            const int col0 = u.pn * BM + wc * 32 + 8 * fq;
#pragma unroll
            for (int ai = 0; ai < 2; ++ai)
#pragma unroll
                for (int m = 0; m < 4; ++m) { bf16_t* rowp = O + (size_t)(row0 + ai * HALF + m * 16) * ldc + col0; const float r = rs[ai][m];
#pragma unroll
                    for (int bj = 0; bj < 2; ++bj) { const f32x4 v0 = acc[ai][bj][m][0] * r, v1 = acc[ai][bj][m][1] * r;
                        u32x4 w; w.x = cvt_pk_bf16(v0[0], v0[1]); w.y = cvt_pk_bf16(v0[2], v0[3]); w.z = cvt_pk_bf16(v1[0], v1[1]); w.w = cvt_pk_bf16(v1[2], v1[3]);
                        *(u32x4*)(rowp + bj * HALF) = w; } }
        }
    }
};
struct EpiResF32 {
    static constexpr bool PERM = true, AFTER_DRAIN = false; static constexpr int NST = PROBE_ML ? 0 : 16;
    bf16_t* xb; int ldc; float scale; float* rowss; int M_; int dbg;
    __device__ __forceinline__ void operator()(const f32x4 (&acc)[2][2][4][2], const Unit& u, int wr, int wc, int fr, int fq) const {
        if (dbg == 3) return;
        const int row0 = u.pm * BM + wr * 64 + fr, col0 = u.pn * BM + wc * 32 + 8 * fq;
        u32x4 r[2][4][2];
#pragma unroll
        for (int ai = 0; ai < 2; ++ai)
#pragma unroll
            for (int m = 0; m < 4; ++m) { const size_t ro = (size_t)(row0 + ai * HALF + m * 16) * ldc + col0;
#pragma unroll
                for (int bj = 0; bj < 2; ++bj) r[ai][m][bj] = *(const u32x4*)(xb + ro + bj * HALF); }
        __builtin_amdgcn_sched_barrier(0);
#pragma unroll
        for (int ai = 0; ai < 2; ++ai) {
#pragma unroll
            for (int m = 0; m < 4; ++m) { const size_t ro = (size_t)(row0 + ai * HALF + m * 16) * ldc + col0; float q = 0.f;
#pragma unroll
                for (int bj = 0; bj < 2; ++bj) { const u32x4 rw = r[ai][m][bj]; const unsigned rr[4] = {rw.x, rw.y, rw.z, rw.w}; unsigned ow[4];
#pragma unroll
                    for (int k = 0; k < 4; ++k) { const f32x4 a = acc[ai][bj][m][k >> 1];
                        const float lo = __builtin_bit_cast(float, rr[k] << 16) + a[2 * (k & 1)] * scale, hi = __builtin_bit_cast(float, rr[k] & 0xffff0000u) + a[2 * (k & 1) + 1] * scale;
                        const unsigned w = cvt_pk_bf16(lo, hi); ow[k] = w;
                        const float l2 = __builtin_bit_cast(float, w << 16), h2 = __builtin_bit_cast(float, w & 0xffff0000u); q += l2 * l2 + h2 * h2; }
                    u32x4 o; o.x = ow[0]; o.y = ow[1]; o.z = ow[2]; o.w = ow[3]; *(u32x4*)(xb + ro + bj * HALF) = o; }
                q += __shfl_xor(q, 16); q += __shfl_xor(q, 32);
                if (fq == 0) rowss[(size_t)(u.pn * 4 + wc) * M_ + row0 + ai * HALF + m * 16] = q; }
            __builtin_amdgcn_sched_barrier(0);
        }
    }
};
struct EpiSwiGLU {
    static constexpr bool PERM = true, AFTER_DRAIN = false; static constexpr int NST = PROBE_ML ? 0 : 8;
    bf16_t* O; int ldc; const PG8_LAS int* tbl; const PG8_LAS float* rsl; int dbg;
    __device__ __forceinline__ void operator()(const f32x4 (&acc)[2][2][4][2], const Unit& u, int wr, int wc, int fr, int fq) const {
        if (dbg == 3) return;
        const int row0 = u.pm * BM + wr * 64 + fr, col0 = u.pn * HALF + wc * 32 + 8 * fq;
        float rs[2][4]; row_rstd8(tbl, rsl, u, wr * 64 + fr, rs);
#pragma unroll
        for (int ai = 0; ai < 2; ++ai)
#pragma unroll
            for (int m = 0; m < 4; ++m) { bf16_t* rowp = O + (size_t)(row0 + ai * HALF + m * 16) * ldc + col0; const float r = rs[ai][m];
                const f32x4 g0 = acc[ai][0][m][0] * r, g1 = acc[ai][0][m][1] * r, u0 = acc[ai][1][m][0] * r, u1 = acc[ai][1][m][1] * r;
                u32x4 w; w.x = cvt_pk_bf16(fast_silu(g0[0]) * u0[0], fast_silu(g0[1]) * u0[1]); w.y = cvt_pk_bf16(fast_silu(g0[2]) * u0[2], fast_silu(g0[3]) * u0[3]);
                w.z = cvt_pk_bf16(fast_silu(g1[0]) * u1[0], fast_silu(g1[1]) * u1[1]); w.w = cvt_pk_bf16(fast_silu(g1[2]) * u1[2], fast_silu(g1[3]) * u1[3]);
                if (dbg != 2 || w.x == 0x12345u) *(u32x4*)rowp = w; }
    }
};

template <class Epi, class Sched, bool ALIGN_EPI = false, bool SP2 = false>
__device__ __forceinline__ void gemm_phase(PG8_LAS unsigned char* lds, const Gemm g, const Sched& S, const Epi& E, const int tid_in) {
    const int tid = tid_in, wid = __builtin_amdgcn_readfirstlane(tid >> 6), lane = tid & 63, wr = wid >> 2, wc = wid & 3, fr = lane & 15, fq = lane >> 4;
    const int K = g.K, nt = K / BK;
    constexpr bool RELAX = SP2 && ALIGN_EPI && (Epi::NST > 0);
    unsigned voffA[2], voffB[2];
#pragma unroll
    for (int i = 0; i < 2; ++i) { int R, C; stage_rc(tid * 16 + i * 8192, R, C); const int Rb = Epi::PERM ? ((R & ~31) + perm32(R & 31)) : R;
        voffA[i] = (unsigned)(R * K + C) * 2u; voffB[i] = (unsigned)(Rb * K + C) * 2u; }
    const size_t kstep = (size_t)(BK * 2);
    const size_t hstep = (size_t)HALF * K * 2;
    const size_t tstep = 2 * hstep;
    const unsigned ldsw = (unsigned)wid * 1024u;
    const int aoff = lds_byte(wr * 64 + fr, fq * 8), boff = lds_byte(wc * 32 + fr, fq * 8);
#define PG8_SA(b, h) (((b) * 2 + (h)) * HTB)
#define PG8_SB(b, h) ((4 + (b) * 2 + (h)) * HTB)
#define PG8_STAGE(bufoff, gbase, voff) do { _Pragma("unroll") for (int _i = 0; _i < 2; ++_i) \
        __builtin_amdgcn_global_load_lds((const unsigned*)((const char*)(gbase) + (voff)[_i]), (PG8_LAS unsigned*)(lds + (bufoff) + ldsw + _i * 8192), 16, 0, 0); } while (0)
#define PG8_LDA(dst, b, h) do { _Pragma("unroll") for (int m = 0; m < 4; ++m) _Pragma("unroll") for (int k = 0; k < 2; ++k) dst[m][k] = *(const PG8_LAS bf16x8*)(lds + PG8_SA(b, h) + aoff + m * 2048 + k * 1024); } while (0)
#define PG8_LDB(dst, b, h) do { _Pragma("unroll") for (int n = 0; n < 2; ++n) _Pragma("unroll") for (int k = 0; k < 2; ++k) dst[n][k] = *(const PG8_LAS bf16x8*)(lds + PG8_SB(b, h) + boff + n * 2048 + k * 1024); } while (0)
#define PG8_MMA(ai, bj, At, Bt) do { __builtin_amdgcn_s_setprio(1); _Pragma("unroll") for (int m = 0; m < 4; ++m) _Pragma("unroll") for (int n = 0; n < 2; ++n) _Pragma("unroll") for (int k = 0; k < 2; ++k) \
        acc[ai][bj][m][n] = __builtin_amdgcn_mfma_f32_16x16x32_bf16(Bt[n][k], At[m][k], acc[ai][bj][m][n], 0, 0, 0); __builtin_amdgcn_s_setprio(0); } while (0)
#define PG8_WAIT_V(n) asm volatile("s_waitcnt vmcnt(" #n ")" ::: "memory")
#define PG8_SPTR(p) asm volatile("" : "+s"(p))
#define PG8_WAIT_VN(n) asm volatile("s_waitcnt vmcnt(%0)" :: "n"(n) : "memory")
#define PG8_WAIT_L(n) asm volatile("s_waitcnt lgkmcnt(" #n ")" ::: "memory")
#define PG8_BAR __builtin_amdgcn_s_barrier()
#define PG8_SCHED __builtin_amdgcn_sched_barrier(0)
    Unit cur, nxt; int ui = 0;
    if (!S.next(0, cur)) return;
    f32x4 acc[2][2][4][2];
#pragma unroll
    for (int a = 0; a < 2; ++a)
#pragma unroll
        for (int b = 0; b < 2; ++b)
#pragma unroll
            for (int m = 0; m < 4; ++m)
#pragma unroll
                for (int n = 0; n < 2; ++n) acc[a][b][m][n] = (f32x4){0.f, 0.f, 0.f, 0.f};
    bf16x8 At[4][2], B0[2][2], B1[2][2];
    const char* cA = (const char*)g.A + (size_t)cur.pm * tstep; const char* cB = (const char*)g.Bt + (size_t)cur.pn * tstep;
    S.a_ready(cur);
    if constexpr (RELAX) {
        PG8_STAGE(PG8_SB(0, 0), cB, voffB); PG8_STAGE(PG8_SB(0, 1), cB + hstep, voffB); PG8_STAGE(PG8_SA(0, 0), cA, voffA); PG8_STAGE(PG8_SA(0, 1), cA + hstep, voffA);
        { const char* pb = cB + kstep; const char* pa = cA + kstep; const char* pbh = cB + hstep + kstep; const char* pah = cA + hstep + kstep; PG8_SPTR(pb); PG8_SPTR(pa); PG8_SPTR(pbh); PG8_SPTR(pah);
          PG8_STAGE(PG8_SB(1, 0), pb, voffB); PG8_STAGE(PG8_SA(1, 0), pa, voffA); PG8_STAGE(PG8_SB(1, 1), pbh, voffB); PG8_STAGE(PG8_SA(1, 1), pah, voffA); }
        PG8_WAIT_V(0); PG8_BAR;
        if (wr == 1) PG8_BAR;
    } else
    if constexpr (SP2) {
        PG8_STAGE(PG8_SB(0, 0), cB, voffB); PG8_STAGE(PG8_SB(0, 1), cB + hstep, voffB); PG8_STAGE(PG8_SA(0, 0), cA, voffA); PG8_STAGE(PG8_SA(0, 1), cA + hstep, voffA);
        if (wr == 1) PG8_BAR;
        PG8_WAIT_V(2); PG8_BAR;
        PG8_STAGE(PG8_SB(1, 0), cB + kstep, voffB); PG8_STAGE(PG8_SA(1, 0), cA + kstep, voffA); PG8_STAGE(PG8_SB(1, 1), cB + hstep + kstep, voffB);
        PG8_WAIT_V(6); PG8_BAR;
    } else {
        PG8_STAGE(PG8_SB(0, 0), cB, voffB); PG8_STAGE(PG8_SA(0, 0), cA, voffA); PG8_STAGE(PG8_SB(0, 1), cB + hstep, voffB); PG8_STAGE(PG8_SA(0, 1), cA + hstep, voffA);
        if (wr == 1) PG8_BAR;
        PG8_WAIT_V(4); PG8_BAR;
        PG8_STAGE(PG8_SB(1, 0), cB + kstep, voffB); PG8_STAGE(PG8_SA(1, 0), cA + kstep, voffA); PG8_STAGE(PG8_SB(1, 1), cB + hstep + kstep, voffB);
        PG8_WAIT_V(6); PG8_BAR;
    }
    for (;;) {
        const bool has_next = S.next(ui + 1, nxt);
        const char* nA = has_next ? (const char*)g.A + (size_t)nxt.pm * tstep : cA; const char* nB = has_next ? (const char*)g.Bt + (size_t)nxt.pn * tstep : cB;
#define PG8_BODY_SP2(W1, W2, W3, STAGE1) \
            PG8_LDB(B0, 0, 0); PG8_LDB(B1, 0, 1); PG8_SCHED; PG8_LDA(At, 0, 0); if (STAGE1) PG8_STAGE(PG8_SA(1, 1), a1 + hstep, voffA); \
            PG8_WAIT_VN(W1); PG8_WAIT_L(0); PG8_BAR; PG8_MMA(0, 0, At, B0); PG8_MMA(0, 1, At, B1); PG8_BAR; PG8_SCHED; \
            PG8_LDA(At, 0, 1); PG8_STAGE(PG8_SB(0, 0), b2, voffB); PG8_STAGE(PG8_SB(0, 1), b2 + hstep, voffB); PG8_STAGE(PG8_SA(0, 0), a2, voffA); \
            PG8_WAIT_VN(W2); PG8_WAIT_L(0); PG8_BAR; PG8_MMA(1, 0, At, B0); PG8_MMA(1, 1, At, B1); PG8_BAR; PG8_SCHED; \
            PG8_LDB(B0, 1, 0); PG8_LDB(B1, 1, 1); PG8_SCHED; PG8_LDA(At, 1, 0); PG8_STAGE(PG8_SA(0, 1), a2 + hstep, voffA); \
            PG8_WAIT_VN(W3); PG8_WAIT_L(0); PG8_BAR; PG8_MMA(0, 0, At, B0); PG8_MMA(0, 1, At, B1); PG8_BAR; PG8_SCHED; \
            PG8_LDA(At, 1, 1); PG8_STAGE(PG8_SB(1, 0), b3, voffB); PG8_STAGE(PG8_SB(1, 1), b3 + hstep, voffB); PG8_STAGE(PG8_SA(1, 0), a3, voffA); \
            PG8_WAIT_VN(8); PG8_WAIT_L(0); PG8_BAR; PG8_MMA(1, 0, At, B0); PG8_MMA(1, 1, At, B1); PG8_BAR; PG8_SCHED;
        if constexpr (RELAX) {
            { const char* a1 = cA + kstep; const char* a2 = cA + 2 * kstep; const char* b2 = cB + 2 * kstep; const char* a3 = a2 + kstep; const char* b3 = b2 + kstep; (void)a1;
              PG8_SPTR(a2); PG8_SPTR(b2); PG8_SPTR(a3); PG8_SPTR(b3);
              PG8_BODY_SP2(8 + Epi::NST, 8 + Epi::NST, 8 + Epi::NST, false) }
            for (int t = 2; t < nt; t += 2) {
                const bool last = (t == nt - 2);
                const char* a1 = cA + (size_t)(t + 1) * kstep;
                const char* a2 = last ? nA : cA + (size_t)(t + 2) * kstep; const char* b2 = last ? nB : cB + (size_t)(t + 2) * kstep;
                const char* a3 = a2 + kstep; const char* b3 = b2 + kstep;
                if (last && has_next) S.a_ready(nxt);
                PG8_BODY_SP2(8, 8, 8, true)
            }
        } else
        for (int t = 0; t < nt; t += 2) {
            const bool last = (t == nt - 2);
            const char* a1 = cA + (size_t)(t + 1) * kstep;
            const char* a2 = last ? nA : cA + (size_t)(t + 2) * kstep; const char* b2 = last ? nB : cB + (size_t)(t + 2) * kstep;
            const char* a3 = a2 + kstep; const char* b3 = b2 + kstep;
            if (last && has_next) S.a_ready(nxt);
            if constexpr (SP2) {
            PG8_LDB(B0, 0, 0); PG8_LDB(B1, 0, 1); PG8_SCHED; PG8_LDA(At, 0, 0); PG8_STAGE(PG8_SA(1, 1), a1 + hstep, voffA);
            PG8_WAIT_V(8); PG8_WAIT_L(0); PG8_BAR; PG8_MMA(0, 0, At, B0); PG8_MMA(0, 1, At, B1); PG8_BAR; PG8_SCHED;
            PG8_LDA(At, 0, 1); PG8_STAGE(PG8_SB(0, 0), b2, voffB); PG8_STAGE(PG8_SB(0, 1), b2 + hstep, voffB); PG8_STAGE(PG8_SA(0, 0), a2, voffA);
            PG8_WAIT_V(8); PG8_WAIT_L(0); PG8_BAR; PG8_MMA(1, 0, At, B0); PG8_MMA(1, 1, At, B1); PG8_BAR; PG8_SCHED;
            PG8_LDB(B0, 1, 0); PG8_LDB(B1, 1, 1); PG8_SCHED; PG8_LDA(At, 1, 0); PG8_STAGE(PG8_SA(0, 1), a2 + hstep, voffA);
            PG8_WAIT_V(8); PG8_WAIT_L(0); PG8_BAR; PG8_MMA(0, 0, At, B0); PG8_MMA(0, 1, At, B1); PG8_BAR; PG8_SCHED;
            PG8_LDA(At, 1, 1); PG8_STAGE(PG8_SB(1, 0), b3, voffB); PG8_STAGE(PG8_SB(1, 1), b3 + hstep, voffB); PG8_STAGE(PG8_SA(1, 0), a3, voffA);
            PG8_WAIT_V(8); PG8_WAIT_L(0); PG8_BAR; PG8_MMA(1, 0, At, B0); PG8_MMA(1, 1, At, B1); PG8_BAR; PG8_SCHED;
            } else {
            PG8_LDB(B0, 0, 0); PG8_SCHED; PG8_LDA(At, 0, 0); PG8_STAGE(PG8_SA(1, 1), a1 + hstep, voffA);
            PG8_WAIT_L(8); PG8_BAR; PG8_WAIT_L(0); PG8_MMA(0, 0, At, B0); PG8_BAR; PG8_SCHED;
            PG8_LDB(B1, 0, 1); PG8_STAGE(PG8_SB(0, 0), b2, voffB);
            PG8_BAR; PG8_WAIT_L(0); PG8_MMA(0, 1, At, B1); PG8_BAR;
            PG8_LDA(At, 0, 1); PG8_STAGE(PG8_SA(0, 0), a2, voffA);
            PG8_BAR; PG8_WAIT_L(0); PG8_MMA(1, 0, At, B0); PG8_BAR; PG8_SCHED;
            PG8_STAGE(PG8_SB(0, 1), b2 + hstep, voffB);
            PG8_WAIT_V(6); PG8_BAR; PG8_MMA(1, 1, At, B1); PG8_BAR;
            PG8_LDB(B0, 1, 0); PG8_SCHED; PG8_LDA(At, 1, 0); PG8_STAGE(PG8_SA(0, 1), a2 + hstep, voffA);
            PG8_WAIT_L(8); PG8_BAR; PG8_WAIT_L(0); PG8_MMA(0, 0, At, B0); PG8_BAR; PG8_SCHED;
            PG8_LDB(B1, 1, 1); PG8_STAGE(PG8_SB(1, 0), b3, voffB);
            PG8_BAR; PG8_WAIT_L(0); PG8_MMA(0, 1, At, B1); PG8_BAR;
            PG8_LDA(At, 1, 1); PG8_STAGE(PG8_SA(1, 0), a3, voffA);
            PG8_BAR; PG8_WAIT_L(0); PG8_MMA(1, 0, At, B0); PG8_BAR; PG8_SCHED;
            PG8_STAGE(PG8_SB(1, 1), b3 + hstep, voffB);
            PG8_WAIT_V(6); PG8_BAR; PG8_MMA(1, 1, At, B1); PG8_BAR;
            }
        }
        if constexpr (ALIGN_EPI) { if (wr == 0) PG8_BAR; }
        if constexpr (RELAX) { if (has_next) { const char* ps = nA + kstep + hstep; PG8_SPTR(ps); PG8_STAGE(PG8_SA(1, 1), ps, voffA); } asm volatile("" ::: "memory"); }
        if constexpr (!Epi::AFTER_DRAIN) { int te = tid; asm volatile("" : "+v"(te)); E(acc, cur, wr, wc, te & 15, (te & 63) >> 4); S.done(cur); }
        if (!has_next) break;
#pragma unroll
        for (int a = 0; a < 2; ++a)
#pragma unroll
            for (int b = 0; b < 2; ++b)
#pragma unroll
                for (int m = 0; m < 4; ++m)
#pragma unroll
                    for (int n = 0; n < 2; ++n) acc[a][b][m][n] = (f32x4){0.f, 0.f, 0.f, 0.f};
        cur = nxt; cA = nA; cB = nB; ++ui;
        if constexpr (ALIGN_EPI) { if (wr == 1) PG8_BAR; }
    }
    PG8_WAIT_V(0);
    if constexpr (!ALIGN_EPI) { if (wr == 0) PG8_BAR; }
    PG8_BAR;
    if constexpr (Epi::AFTER_DRAIN) { E.fused(acc, cur, wr, wc, fr, fq, lds, wid, lane); S.done(cur); }
#undef PG8_SA
#undef PG8_SB
#undef PG8_STAGE
#undef PG8_LDA
#undef PG8_LDB
#undef PG8_MMA
#undef PG8_WAIT_V
#undef PG8_WAIT_L
#undef PG8_BAR
#undef PG8_SCHED
#undef PG8_BODY_SP2
#undef PG8_WAIT_VN
#undef PG8_SPTR
}
}

#define PG8_SP2 true
#ifndef REP_MODE
#define REP_MODE 1
#endif
#ifndef NSA_NAIVE
#define NSA_NAIVE 0
#endif
#ifndef REC_NAIVE
#define REC_NAIVE 0
#endif
#define PG8_ALIGN true

constexpr int NWAVES = 8, NT = NWAVES * 64;
constexpr int BATCH = 8, SEQ = 4096, D = 1024, DEPTH = 4, M = BATCH * SEQ;
constexpr int EVEN_IN = 3352, PE = 3584;
constexpr int PO = 4096;
constexpr int FF = 2816, FF2 = 2 * FF;
constexpr int C_RQ = 0, C_RK = 512, C_RV = 1024, C_RG = 1536, C_NQ = 2048, C_KC = 2560, C_VC = 2688, C_KS = 2816, C_VS = 2944, C_KW = 3072, C_VW = 3200, C_NG = 3328;
constexpr int C_HQ = 0, C_HF = 1024, C_HI = 2048, C_HG = 3072;
constexpr int NCMP = 255;
constexpr float RMS_EPS = 1e-6f;

constexpr size_t MiB = 1u << 20;
constexpr size_t WS_CTL = 0, CTL_ZERO_BYTES = 1 * MiB;
constexpr size_t WS_ROPE = 1 * MiB;
constexpr size_t WS_LB = 3 * MiB;
constexpr size_t WS_KCMP = 4 * MiB;
constexpr size_t WS_CBIAS = 3 * MiB + 16 * 1024;
constexpr size_t WS_W1T = 4 * MiB;
constexpr size_t WS_ROWSS = 5 * MiB;
constexpr size_t WS_SEL = 6 * MiB;
constexpr size_t WS_WEIN = 8 * MiB;
constexpr size_t WS_WEOUT = 22 * MiB;
constexpr size_t WS_WOIN = 26 * MiB;
constexpr size_t WS_WOOUT = 42 * MiB;
constexpr size_t WS_W13 = 46 * MiB;
constexpr size_t WS_W2 = 90 * MiB;
constexpr size_t WS_H = 112 * MiB;
constexpr size_t WS_PROJ = 176 * MiB;
constexpr size_t WS_MIXED = 432 * MiB;
constexpr size_t WS_KCB = 7 * MiB;
constexpr size_t WS_VCTB = 7 * MiB + 512 * 1024;
constexpr size_t WS_VT = 496 * MiB;
constexpr size_t WS_KT = 400 * MiB;
constexpr size_t WS_END = 512 * MiB;
constexpr int CW_BAR = 4096, CW_Q = 8192;

constexpr int RING_BYTES = 131072;
constexpr int LDSCTL_OFF = 146944, MISC_OFF = LDSCTL_OFF + 320;
constexpr int LDS_BYTES = 147456;

#define GAS __attribute__((address_space(1)))
#define LAS __attribute__((address_space(3)))
typedef unsigned short bf16;
typedef unsigned v4u __attribute__((ext_vector_type(4)));
typedef unsigned v2u __attribute__((ext_vector_type(2)));
typedef float f32x4 __attribute__((ext_vector_type(4)));
typedef float f32x2 __attribute__((ext_vector_type(2)));
typedef GAS unsigned gu32;
#define RLX_AGENT __ATOMIC_RELAXED, __HIP_MEMORY_SCOPE_AGENT
#define LDS_WAIT() asm volatile("s_waitcnt lgkmcnt(0)" ::: "memory")
#define VM_WAIT() asm volatile("s_waitcnt vmcnt(0)" ::: "memory")
__device__ __forceinline__ unsigned f2bf(float f) { unsigned u = __builtin_bit_cast(unsigned, f); return (u + 0x7fffu + ((u >> 16) & 1u)) >> 16; }
typedef float f32x2_t __attribute__((ext_vector_type(2)));
typedef __bf16 bf16x2_t __attribute__((ext_vector_type(2)));
__device__ __forceinline__ unsigned pk2(float lo, float hi) { f32x2_t v = {lo, hi}; bf16x2_t r = __builtin_convertvector(v, bf16x2_t); return __builtin_bit_cast(unsigned, r); }
__device__ __forceinline__ float bf2f(unsigned v) { return __builtin_bit_cast(float, v << 16); }
__device__ __forceinline__ float bflo(unsigned w) { return __builtin_bit_cast(float, w << 16); }
__device__ __forceinline__ float bfhi(unsigned w) { return __builtin_bit_cast(float, w & 0xffff0000u); }
__device__ __forceinline__ float sigmoidf_(float x) { return __builtin_amdgcn_rcpf(1.0f + __expf(-x)); }
__device__ __forceinline__ float siluf_(float x) { return x * __builtin_amdgcn_rcpf(1.0f + __expf(-x)); }

#define XB_TMO      128
#define XB_XCNT(j)  (256  + 64 * (j))
#define XB_XSUB(j)  (1280 + 64 * (j))
#define XB_XGEN(j)  (2304 + 64 * (j))
#define XB_TOP      3328
#define XB_TOPGEN   3392
#define XCD_BAR_WORDS 3456
#define XB_SPIN_CAP (1u << 18)
__device__ __forceinline__ unsigned xb_ld(unsigned* p)              { return __hip_atomic_load(p, __ATOMIC_RELAXED, __HIP_MEMORY_SCOPE_AGENT); }
__device__ __forceinline__ unsigned xb_add(unsigned* p, unsigned v) { return __hip_atomic_fetch_add(p, v, __ATOMIC_RELAXED, __HIP_MEMORY_SCOPE_AGENT); }
__device__ __forceinline__ unsigned xb_xcc_id() { return (unsigned)__builtin_amdgcn_s_getreg((3 << 11) | 20) & 0xFu; }
#define XB_SPIN(cond, bar) do { unsigned _sp = 0; while (cond) { __builtin_amdgcn_s_sleep(1); \
    if ((++_sp & 255u) == 0u) { if (xb_ld(&(bar)[XB_TMO])) break; if (_sp > XB_SPIN_CAP) { atomicAdd(&(bar)[XB_TMO], 1u); break; } } } } while (0)
struct XcdBarrier { unsigned* bar; unsigned x; volatile LAS unsigned* st; };
__device__ __forceinline__ XcdBarrier xcd_barrier_post(unsigned* bar, volatile LAS unsigned* st) {
    XcdBarrier b; b.bar = bar; b.x = xb_xcc_id(); b.st = st;
    if (threadIdx.x == 0) (void)xb_add(&bar[XB_XCNT(b.x)], 1u);
    return b;
}
__device__ __forceinline__ void xcd_barrier_complete(unsigned* bar, unsigned x, unsigned& nloc, unsigned& nx) {
    const unsigned G = gridDim.x * gridDim.y * gridDim.z;
    unsigned sum, cnt, mine, sp = 0u;
    for (;;) {
        sum = 0u; cnt = 0u; mine = 0u;
        size_t xz = 0; asm volatile("" : "+v"(xz)); unsigned* xc = &bar[XB_XCNT(0)] + xz;
#pragma unroll
        for (unsigned j = 0; j < 16; ++j) { const unsigned c = xb_ld(&xc[64 * j]); sum += c; cnt += (c > 0u) ? 1u : 0u; mine = (j == x) ? c : mine; }
        if (sum == G) break;
        __builtin_amdgcn_s_sleep(1);
        if ((++sp & 255u) == 0u) { if (xb_ld(&bar[XB_TMO])) break; if (sp > XB_SPIN_CAP) { atomicAdd(&bar[XB_TMO], 1u); break; } }
    }
    nloc = mine > 0u ? mine : 1u; nx = cnt > 0u ? cnt : 1u;
}
__device__ __forceinline__ void xcd_barrier(const XcdBarrier& b) {
    asm volatile("s_waitcnt vmcnt(0)" ::: "memory");
    __syncthreads();
    if (threadIdx.x == 0) {
        unsigned* bar = b.bar;
        __builtin_amdgcn_s_waitcnt(0);
        unsigned nloc = b.st[0], nx = b.st[1];
        if (nloc == 0u) { xcd_barrier_complete(bar, b.x, nloc, nx); b.st[0] = nloc; b.st[1] = nx; }
        const unsigned old = xb_add(&bar[XB_XSUB(b.x)], 1u);
        const unsigned gen = old / nloc;
        if (old + 1u == (gen + 1u) * nloc) {
            __builtin_amdgcn_fence(__ATOMIC_RELEASE, "agent");
            asm volatile("s_waitcnt vmcnt(0)" ::: "memory");
            const unsigned og = xb_add(&bar[XB_TOP], 1u);
            const unsigned tg = og / nx;
            if (og + 1u == (tg + 1u) * nx) xb_add(&bar[XB_TOPGEN], 1u);
            else XB_SPIN(xb_ld(&bar[XB_TOPGEN]) == tg, bar);
            __builtin_amdgcn_fence(__ATOMIC_ACQUIRE, "agent");
            xb_add(&bar[XB_XGEN(b.x)], 1u);
            asm volatile("s_waitcnt vmcnt(0)" ::: "memory");
        } else {
            XB_SPIN(xb_ld(&bar[XB_XGEN(b.x)]) == gen, bar);
            __builtin_amdgcn_fence(__ATOMIC_ACQUIRE, "agent");
            asm volatile("s_waitcnt vmcnt(0)" ::: "memory");
        }
    }
    __syncthreads();
}

__device__ __forceinline__ float wave_sum(float v) {
#pragma unroll
    for (int o = 1; o < 64; o <<= 1) v += __shfl_xor(v, o);
    return v;
}
__device__ __forceinline__ float wave_max(float v) {
#pragma unroll
    for (int o = 1; o < 64; o <<= 1) v = fmaxf(v, __shfl_xor(v, o));
    return v;
}

__device__ __forceinline__ int inproj_row(int rmode, int cs) {
    if (rmode == 1 && cs < 1024) { const int isk = cs >> 9, hd = (cs & 511) >> 7, ch = cs & 127, half = ch >> 6, i = ch & 63; return 256 * hd + 128 * isk + 32 * (i >> 4) + 8 * ((i >> 2) & 3) + 4 * half + (i & 3); }
    if (rmode == 2 && cs < 2048) { const int isf = cs >> 10, hd = (cs & 1023) >> 7, ch = cs & 127; return 256 * hd + 128 * isf + ch; }
    return cs;
}
__device__ __forceinline__ void tr_item64(const float* W, int K, int N, bf16* WT, int k0, int n0, int drow0, LAS unsigned* scr, int lane, const float* gain = nullptr, int rmode = 0) {
    const int q = lane >> 4, nl4 = 4 * (lane & 15); const bool ok = n0 + nl4 < N;
    const GAS float* src = (const GAS float*)W + (size_t)(k0 + 2 * q) * N + n0 + nl4;
    f32x4 v[16]; f32x2 g[8];
#pragma unroll
    for (int j = 0; j < 16; ++j) { const int kr = 8 * (j >> 1) + (j & 1); v[j] = ok ? *(const GAS f32x4*)(src + (size_t)kr * N) : (f32x4){0.f, 0.f, 0.f, 0.f}; }
#pragma unroll
    for (int i = 0; i < 8; ++i) g[i] = gain ? *(const GAS f32x2*)((const GAS float*)gain + k0 + 2 * q + 8 * i) : (f32x2){1.0f, 1.0f};
    __builtin_amdgcn_sched_barrier(0);
#pragma unroll
    for (int i = 0; i < 8; ++i) { const f32x4 a = v[2 * i] * g[i].x, b = v[2 * i + 1] * g[i].y; LAS unsigned* d = scr + (4 * i + q) * 66 + nl4;
        v2u w0; w0.x = pk2(a.x, b.x); w0.y = pk2(a.y, b.y); v2u w1; w1.x = pk2(a.z, b.z); w1.y = pk2(a.w, b.w);
        *(LAS v2u*)d = w0; *(LAS v2u*)(d + 2) = w1; }
    LDS_WAIT(); asm volatile("" ::: "memory");
    const int c = lane & 7;
#pragma unroll
    for (int jj = 0; jj < 8; ++jj) { const int n = (lane >> 3) + 8 * jj; const LAS unsigned* sp = scr + (4 * c) * 66 + n;
        v4u o; o.x = sp[0]; o.y = sp[66]; o.z = sp[132]; o.w = sp[198];
        *(GAS v4u*)(WT + (size_t)(rmode ? inproj_row(rmode, n0 + n) : drow0 + n) * K + k0 + 8 * c) = o; }
    LDS_WAIT(); asm volatile("" ::: "memory");
}
__device__ __forceinline__ void rms_row_to_bf16(const float* xrow, const float* g, bf16* orow, int lane) {
    const GAS f32x4* xr = (const GAS f32x4*)xrow + lane; const GAS f32x4* gr = (const GAS f32x4*)g + lane;
    f32x4 v[4]; float s = 0.f;
#pragma unroll
    for (int j = 0; j < 4; ++j) { v[j] = xr[64 * j]; s += (v[j].x * v[j].x + v[j].y * v[j].y) + (v[j].z * v[j].z + v[j].w * v[j].w); }
    const float r = 1.0f / sqrtf(wave_sum(s) * (1.f / D) + RMS_EPS);
    GAS v2u* o8 = (GAS v2u*)orow + lane;
#pragma unroll
    for (int j = 0; j < 4; ++j) { const f32x4 gg = gr[64 * j]; v2u w; w.x = pk2(v[j].x * r * gg.x, v[j].y * r * gg.y); w.y = pk2(v[j].z * r * gg.z, v[j].w * r * gg.w); o8[64 * j] = w; }
}
__device__ __forceinline__ void row_to_bf16_ss(const float* xrow, bf16* orow, float* rowss, int m, int lane) {
    const GAS f32x4* xr = (const GAS f32x4*)xrow + lane;
    f32x4 v[4]; float s = 0.f;
#pragma unroll
    for (int j = 0; j < 4; ++j) { v[j] = xr[64 * j]; s += (v[j].x * v[j].x + v[j].y * v[j].y) + (v[j].z * v[j].z + v[j].w * v[j].w); }
    s = wave_sum(s);
    GAS v2u* o8 = (GAS v2u*)orow + lane;
#pragma unroll
    for (int j = 0; j < 4; ++j) { v2u w; w.x = pk2(v[j].x, v[j].y); w.y = pk2(v[j].z, v[j].w); o8[64 * j] = w; }
    if (lane < 16) rowss[(size_t)lane * M + m] = lane == 0 ? s : 0.f;
}
__device__ __forceinline__ void rows2_to_bf16_ss(const float* xa, const float* xb, bf16* oa, bf16* ob, float* rowss, int ma, int mb, int lane) {
    const GAS f32x4* xr0 = (const GAS f32x4*)xa + lane; const GAS f32x4* xr1 = (const GAS f32x4*)xb + lane;
    f32x4 v[2][4]; float s0 = 0.f, s1 = 0.f;
#pragma unroll
    for (int j = 0; j < 4; ++j) { v[0][j] = xr0[64 * j]; v[1][j] = xr1[64 * j]; }
#pragma unroll
    for (int j = 0; j < 4; ++j) { s0 += (v[0][j].x * v[0][j].x + v[0][j].y * v[0][j].y) + (v[0][j].z * v[0][j].z + v[0][j].w * v[0][j].w); s1 += (v[1][j].x * v[1][j].x + v[1][j].y * v[1][j].y) + (v[1][j].z * v[1][j].z + v[1][j].w * v[1][j].w); }
#pragma unroll
    for (int o = 1; o < 64; o <<= 1) { s0 += __shfl_xor(s0, o); s1 += __shfl_xor(s1, o); }
    GAS v2u* o0 = (GAS v2u*)oa + lane; GAS v2u* o1 = (GAS v2u*)ob + lane;
#pragma unroll
    for (int j = 0; j < 4; ++j) { v2u w; w.x = pk2(v[0][j].x, v[0][j].y); w.y = pk2(v[0][j].z, v[0][j].w); o0[64 * j] = w; v2u w2; w2.x = pk2(v[1][j].x, v[1][j].y); w2.y = pk2(v[1][j].z, v[1][j].w); o1[64 * j] = w2; }
    if (lane < 16) { rowss[(size_t)lane * M + ma] = lane == 0 ? s0 : 0.f; rowss[(size_t)lane * M + mb] = lane == 0 ? s1 : 0.f; }
}
__device__ __forceinline__ void rms_row_bf16_to_f32(const bf16* xrow, const float* g, float* orow, int lane) {
    const GAS v4u* xr = (const GAS v4u*)xrow + lane; const GAS f32x4* gr = (const GAS f32x4*)g + 2 * lane;
    v4u w[2]; float v[2][8]; float s = 0.f;
#pragma unroll
    for (int j = 0; j < 2; ++j) { w[j] = xr[64 * j]; const unsigned ww[4] = {w[j].x, w[j].y, w[j].z, w[j].w};
#pragma unroll
        for (int k = 0; k < 4; ++k) { v[j][2 * k] = bflo(ww[k]); v[j][2 * k + 1] = bfhi(ww[k]); s += v[j][2 * k] * v[j][2 * k] + v[j][2 * k + 1] * v[j][2 * k + 1]; } }
    const float r = __builtin_amdgcn_rsqf(wave_sum(s) * (1.f / D) + RMS_EPS);
    GAS f32x4* o = (GAS f32x4*)orow + 2 * lane;
#pragma unroll
    for (int j = 0; j < 2; ++j) { const f32x4 g0 = gr[128 * j], g1 = gr[128 * j + 1];
        o[128 * j] = (f32x4){v[j][0] * r * g0.x, v[j][1] * r * g0.y, v[j][2] * r * g0.z, v[j][3] * r * g0.w}; o[128 * j + 1] = (f32x4){v[j][4] * r * g1.x, v[j][5] * r * g1.y, v[j][6] * r * g1.z, v[j][7] * r * g1.w}; }
}
__device__ __forceinline__ void rms_row_to_f32(float* xrow, const float* g, int lane) {
    GAS f32x4* xr = (GAS f32x4*)xrow + lane; const GAS f32x4* gr = (const GAS f32x4*)g + lane;
    f32x4 v[4]; float s = 0.f;
#pragma unroll
    for (int j = 0; j < 4; ++j) { v[j] = xr[64 * j]; s += (v[j].x * v[j].x + v[j].y * v[j].y) + (v[j].z * v[j].z + v[j].w * v[j].w); }
    const float r = 1.0f / sqrtf(wave_sum(s) * (1.f / D) + RMS_EPS);
#pragma unroll
    for (int j = 0; j < 4; ++j) { const f32x4 gg = gr[64 * j]; xr[64 * j] = (f32x4){v[j].x * r * gg.x, v[j].y * r * gg.y, v[j].z * r * gg.z, v[j].w * r * gg.w}; }
}

__device__ __forceinline__ void convert_weights(const float* const* in, unsigned char* ws, int half, LAS unsigned* scr, int w0, int nw, int lane) {
    constexpr int I_EIN = 16 * 56, I_SQ = 16 * 16, I_OIN = 16 * 64, I_W1 = 16 * 44, I_W2 = 44 * 16;
    constexpr int NITEMS = I_EIN + I_SQ + I_OIN + I_SQ + 2 * I_W1 + 2 * I_W1 + 2 * I_W2;
    const int j = half;
    for (int it = w0; it < NITEMS; it += nw) {
        int r = it;
        if (r < I_EIN) { tr_item64(in[4] + (size_t)j * D * EVEN_IN, D, EVEN_IN, (bf16*)(ws + WS_WEIN) + (size_t)j * PE * D, (r / 56) * 64, (r % 56) * 64, (r % 56) * 64, scr, lane, in[1] + (size_t)(2 * j) * D, 1); continue; } r -= I_EIN;
        if (r < I_SQ) { tr_item64(in[5] + (size_t)j * D * D, D, D, (bf16*)(ws + WS_WEOUT) + (size_t)j * D * D, (r / 16) * 64, (r % 16) * 64, (r % 16) * 64, scr, lane); continue; } r -= I_SQ;
        if (r < I_OIN) { tr_item64(in[12] + (size_t)j * D * PO, D, PO, (bf16*)(ws + WS_WOIN) + (size_t)j * PO * D, (r / 64) * 64, (r % 64) * 64, (r % 64) * 64, scr, lane, in[1] + (size_t)(2 * j + 1) * D, 2); continue; } r -= I_OIN;
        if (r < I_SQ) { tr_item64(in[13] + (size_t)j * D * D, D, D, (bf16*)(ws + WS_WOOUT) + (size_t)j * D * D, (r / 16) * 64, (r % 16) * 64, (r % 16) * 64, scr, lane); continue; } r -= I_SQ;
        if (r < 4 * I_W1) { const int which = r / (2 * I_W1); r %= 2 * I_W1; const int l = 2 * half + r / I_W1; r %= I_W1; const int n0 = (r % 44) * 64;
            tr_item64(in[which ? 17 : 16] + (size_t)l * D * FF, D, FF, (bf16*)(ws + WS_W13) + (size_t)l * FF2 * D, (r / 44) * 64, n0, 256 * (n0 / 128) + (n0 % 128) + 128 * which, scr, lane, in[2] + (size_t)l * D); continue; } r -= 4 * I_W1;
        { const int l = 2 * half + r / I_W2; r %= I_W2; tr_item64(in[18] + (size_t)l * FF * D, FF, D, (bf16*)(ws + WS_W2) + (size_t)l * D * FF, (r / 16) * 64, (r % 16) * 64, (r % 16) * 64, scr, lane); }
    }
}

constexpr int RS_TBL_OFF = RING_BYTES, RS_TAB_OFF = RING_BYTES + 1024;
template <class Sched>
__device__ __forceinline__ void build_rstd_table(LAS unsigned char* lds, const Sched& S, const float* rowss, int tid) {
    LAS int* tbl = (LAS int*)(lds + RS_TBL_OFF); LAS float* rsl = (LAS float*)(lds + RS_TAB_OFF); LAS int* spm = tbl + 128;
    if (tid < 16) { pg8::Unit u; const bool ok = tid < 14 && S.next(tid, u); spm[tid] = ok ? u.pm : -1; if (ok) tbl[u.pm] = tid; }
    __syncthreads();
#pragma unroll 1
    for (int sl = tid >> 8; sl < 14; sl += 2) { const int pm = spm[sl]; if (pm < 0) break;
        const int row = pm * 256 + (tid & 255); float p[16];
#pragma unroll
        for (int pl = 0; pl < 16; ++pl) p[pl] = rowss[(size_t)pl * M + row];
        float q = 0.f;
#pragma unroll
        for (int pl = 0; pl < 16; ++pl) q += p[pl];
        rsl[sl * 256 + (tid & 255)] = __builtin_amdgcn_rsqf(q * (1.0f / 1024.0f) + RMS_EPS); }
    __syncthreads();
}

template <int MODE>
__device__ __forceinline__ void recur_unit(LAS unsigned char* lds, int b, int hd, const bf16* proj, int ldp, const float2* rope, const float* lb, const float* ng, bf16* mixed, int tid, int lane, int wave) {
    LAS float* sq = (LAS float*)lds;
    LAS float* sk = sq + 2048;
    LAS float* sv = sk + 2048;
    LAS float* so = sv + 2048;
    LAS float* sf = so + 2048;
    const int e = tid >> 2, ds = tid & 3;
    float S[32];
#pragma unroll
    for (int i = 0; i < 32; ++i) S[i] = 0.f;
    const float gamma = 1.0f - exp2f(-5.0f - (float)hd);
    for (int blk = 0; blk < SEQ / 16; ++blk) {
        {
            const int tt = tid >> 5, ii = tid & 31; const int pos = blk * 16 + tt; const size_t row = (size_t)(b * SEQ + pos) * ldp;
            if (MODE == 0) {
#pragma unroll
                for (int h2 = 0; h2 < 2; ++h2) { const int i = ii + 32 * h2; const float2 cs = rope[pos * 64 + i];
                    const float q1 = bf2f(proj[row + C_RQ + hd * 128 + i]), q2 = bf2f(proj[row + C_RQ + hd * 128 + i + 64]);
                    const float k1 = bf2f(proj[row + C_RK + hd * 128 + i]), k2 = bf2f(proj[row + C_RK + hd * 128 + i + 64]);
                    sq[tt * 128 + i] = q1 * cs.x - q2 * cs.y; sq[tt * 128 + i + 64] = q1 * cs.y + q2 * cs.x;
                    sk[tt * 128 + i] = (k1 * cs.x - k2 * cs.y) * 0.08838834764831845f; sk[tt * 128 + i + 64] = (k1 * cs.y + k2 * cs.x) * 0.08838834764831845f; }
#pragma unroll
                for (int h4 = 0; h4 < 4; ++h4) sv[tt * 128 + ii + 32 * h4] = bf2f(proj[row + C_RV + hd * 128 + ii + 32 * h4]);
            } else {
#pragma unroll
                for (int h4 = 0; h4 < 4; ++h4) { const int d = ii + 32 * h4; const float qp = bf2f(proj[row + C_HQ + hd * 128 + d]), fp = bf2f(proj[row + C_HF + hd * 128 + d]);
                    const float l = lb[hd * 128 + d]; const float sg = sigmoidf_(fp);
                    sq[tt * 128 + d] = siluf_(qp) * 0.08838834764831845f; sf[tt * 128 + d] = l + (1.0f - l) * sg; sk[tt * 128 + d] = (1.0f - l) * (1.0f - sg);
                    sv[tt * 128 + d] = bf2f(proj[row + C_HI + hd * 128 + d]); }
            }
        }
        __syncthreads();
#pragma unroll 1
        for (int tt = 0; tt < 16; ++tt) {
            const float ve = sv[tt * 128 + e]; float po = 0.f;
#pragma unroll
            for (int i4 = 0; i4 < 8; ++i4) {
                const f32x4 q4 = *(const LAS f32x4*)(sq + tt * 128 + ds * 32 + i4 * 4), k4 = *(const LAS f32x4*)(sk + tt * 128 + ds * 32 + i4 * 4);
                f32x4 f4; if (MODE == 1) f4 = *(const LAS f32x4*)(sf + tt * 128 + ds * 32 + i4 * 4); else f4 = (f32x4){gamma, gamma, gamma, gamma};
                S[i4 * 4 + 0] = f4.x * S[i4 * 4 + 0] + k4.x * ve; po += q4.x * S[i4 * 4 + 0];
                S[i4 * 4 + 1] = f4.y * S[i4 * 4 + 1] + k4.y * ve; po += q4.y * S[i4 * 4 + 1];
                S[i4 * 4 + 2] = f4.z * S[i4 * 4 + 2] + k4.z * ve; po += q4.z * S[i4 * 4 + 2];
                S[i4 * 4 + 3] = f4.w * S[i4 * 4 + 3] + k4.w * ve; po += q4.w * S[i4 * 4 + 3];
            }
            po += __shfl_xor(po, 1); po += __shfl_xor(po, 2);
            if (ds == 0) so[tt * 128 + e] = po;
        }
        __syncthreads();
        {
#pragma unroll
            for (int r = 0; r < 2; ++r) { const int tt = wave * 2 + r; const int pos = blk * 16 + tt; const size_t trow = (size_t)(b * SEQ + pos);
                const float o0 = so[tt * 128 + lane], o1 = so[tt * 128 + lane + 64];
                float y0, y1;
                if (MODE == 0) {
                    const float mu = wave_sum(o0 + o1) * (1.f / 128.f); const float d0 = o0 - mu, d1 = o1 - mu;
                    const float var = wave_sum(d0 * d0 + d1 * d1) * (1.f / 128.f); const float rs = 1.0f / sqrtf(var + 1e-5f);
                    y0 = d0 * rs * siluf_(bf2f(proj[trow * ldp + C_RG + hd * 128 + lane])); y1 = d1 * rs * siluf_(bf2f(proj[trow * ldp + C_RG + hd * 128 + lane + 64]));
                } else {
                    const float ms = wave_sum(o0 * o0 + o1 * o1) * (1.f / 128.f); const float rs = 1.0f / sqrtf(ms + RMS_EPS);
                    y0 = o0 * rs * ng[lane] * sigmoidf_(bf2f(proj[trow * ldp + C_HG + hd * 128 + lane])); y1 = o1 * rs * ng[lane + 64] * sigmoidf_(bf2f(proj[trow * ldp + C_HG + hd * 128 + lane + 64]));
                }
                mixed[trow * D + hd * 128 + lane] = (bf16)f2bf(y0); mixed[trow * D + hd * 128 + lane + 64] = (bf16)f2bf(y1); }
        }
    }
    __syncthreads();
}

__device__ __forceinline__ float gelu_tanh(float x) { const float u = 0.7978845608028654f * (x + 0.044715f * x * x * x); const float t = 1.0f - 2.0f / (__expf(2.0f * u) + 1.0f); return 0.5f * x * (1.0f + t); }

__device__ __forceinline__ void compress_task(LAS float* xs  , int task, const bf16* proj, const float* pos_k, const float* w1_k, const float* w2_k, const float* pos_v, const float* w1_v, const float* w2_v, float* kcmp, bf16* kcb, bf16* vctb, int lane) {
    const int kv = task / (16 * NCMP); const int rem = task % (16 * NCMP); const int bg = rem / NCMP, i = rem % NCMP; const int b = bg >> 1, g = bg & 1;
    const float* pos = kv ? pos_v : pos_k; const float* w1 = kv ? w1_v : w1_k; const float* w2 = kv ? w2_v : w2_k;
    const int col = (kv ? C_VC : C_KC) + 64 * g + lane;
#pragma unroll 4
    for (int l = 0; l < 32; ++l) xs[l * 64 + lane] = bf2f(proj[(size_t)(b * SEQ + 16 * i + l) * PE + col]) + pos[l * 64 + lane];
    LDS_WAIT(); asm volatile("" ::: "memory");
    float pre = 0.f;
#pragma unroll 4
    for (int k = 0; k < 2048; k += 4) { const f32x4 a = *(const LAS f32x4*)(xs + k);
        pre += a.x * w1[(k + 0) * 64 + lane]; pre += a.y * w1[(k + 1) * 64 + lane]; pre += a.z * w1[(k + 2) * 64 + lane]; pre += a.w * w1[(k + 3) * 64 + lane]; }
    xs[2048 + lane] = gelu_tanh(pre);
    LDS_WAIT(); asm volatile("" ::: "memory");
    float o = 0.f;
#pragma unroll 4
    for (int c = 0; c < 64; c += 4) { const f32x4 a = *(const LAS f32x4*)(xs + 2048 + c);
        o += a.x * w2[(c + 0) * 64 + lane]; o += a.y * w2[(c + 1) * 64 + lane]; o += a.z * w2[(c + 2) * 64 + lane]; o += a.w * w2[(c + 3) * 64 + lane]; }
    kcmp[((size_t)(kv * 16 + bg) * 256 + i) * 64 + lane] = o;
    (kv == 0 ? kcb : vctb)[((size_t)bg * 256 + i) * 64 + lane] = (bf16)f2bf(o);
    LDS_WAIT(); asm volatile("" ::: "memory");
}

__device__ __forceinline__ void cmp_attn_task(LAS float* wl  , int task, const bf16* proj, const float* kcmp, float* accn, unsigned long long* sel, int lane) {
    LAS float* q4 = wl; LAS float* pl = wl + 256; LAS float* cs = wl + 512;
    const int bg = task >> 12, t = task & 4095; const int b = bg >> 1, g = bg & 1; const size_t trow = (size_t)(b * SEQ + t);
    const float* kc = kcmp + (size_t)bg * 256 * 64; const float* vc = kcmp + (size_t)(16 + bg) * 256 * 64;
#pragma unroll
    for (int hh = 0; hh < 4; ++hh) q4[hh * 64 + lane] = bf2f(proj[trow * PE + C_NQ + (g * 4 + hh) * 64 + lane]) * 0.125f;
    const int nvalid = t >= 31 ? (((t - 31) >> 4) + 1 > NCMP ? NCMP : ((t - 31) >> 4) + 1) : 0;
    float c4[4] = {0.f, 0.f, 0.f, 0.f};
    LDS_WAIT(); asm volatile("" ::: "memory");
#pragma unroll 1
    for (int hh = 0; hh < 4; ++hh) {
        float s4[4]; float mx = -INFINITY;
#pragma unroll
        for (int r = 0; r < 4; ++r) { const int n = lane + 64 * r; float s = -INFINITY;
            if (64 * r < nvalid) { if (n < nvalid) { float a = 0.f; const GAS f32x4* kr = (const GAS f32x4*)(kc + (size_t)n * 64);
#pragma unroll 4
                    for (int c = 0; c < 16; ++c) { const f32x4 kk = kr[c]; const f32x4 qq = *(const LAS f32x4*)(q4 + hh * 64 + c * 4); a += kk.x * qq.x + kk.y * qq.y + kk.z * qq.z + kk.w * qq.w; }
                    s = a; } }
            s4[r] = s; mx = fmaxf(mx, s); }
        mx = wave_max(mx); if (!(mx > -INFINITY)) mx = 0.f;
        float sum = 0.f;
#pragma unroll
        for (int r = 0; r < 4; ++r) { s4[r] = (s4[r] > -INFINITY) ? __expf(s4[r] - mx) : 0.f; sum += s4[r]; }
        sum = wave_sum(sum); const float inv = 1.0f / fmaxf(sum, 1e-30f);
#pragma unroll
        for (int r = 0; r < 4; ++r) { s4[r] *= inv; c4[r] += s4[r]; pl[lane + 64 * r] = s4[r]; }
        LDS_WAIT(); asm volatile("" ::: "memory");
        float o = 0.f;
        for (int n = 0; n < nvalid; ++n) o += pl[n] * vc[(size_t)n * 64 + lane];
        const float gate = sigmoidf_(bf2f(proj[trow * PE + C_NG + 0 * 8 + g * 4 + hh]));
        accn[trow * 512 + (g * 4 + hh) * 64 + lane] = gate * o;
        LDS_WAIT(); asm volatile("" ::: "memory");
    }
#pragma unroll
    for (int r = 0; r < 4; ++r) cs[lane + 64 * r] = c4[r];
    LDS_WAIT(); asm volatile("" ::: "memory");
    float imp = 0.f;
#pragma unroll
    for (int dn = -1; dn <= 3; ++dn) { const int n = 4 * lane + dn; if (n >= 0 && n < NCMP) imp += cs[n]; }
    const int bt = t >> 6; const bool valid = lane <= bt; const bool forced = (lane == 0) || (bt - lane >= 0 && bt - lane < 2);
    float score = valid ? imp + (forced ? 1.0e4f : 0.f) : -1e30f;
    unsigned long long mask = 0ull;
#pragma unroll 1
    for (int k = 0; k < 8; ++k) { const float mv = wave_max(score); const unsigned long long bal = __ballot(score == mv); const int j = __ffsll((long long)bal) - 1; mask |= 1ull << j; if (lane == j) score = -INFINITY; }
    if (lane == 0) sel[(size_t)bg * SEQ + t] = mask;
    LDS_WAIT(); asm volatile("" ::: "memory");
}

template <int MODE>
__device__ __forceinline__ void blk_attn_task(LAS float* wl  , int task, const bf16* proj, const unsigned long long* sel, float* accn, bf16* mixed, int lane) {
    LAS float* q4 = wl; LAS float* p4 = wl + 256;
    const int bg = task >> 12, t = task & 4095; const int b = bg >> 1, g = bg & 1; const size_t trow = (size_t)(b * SEQ + t);
    const int kcol = (MODE == 0 ? C_KS : C_KW) + 64 * g, vcol = (MODE == 0 ? C_VS : C_VW) + 64 * g;
#pragma unroll
    for (int hh = 0; hh < 4; ++hh) q4[hh * 64 + lane] = bf2f(proj[trow * PE + C_NQ + (g * 4 + hh) * 64 + lane]) * 0.125f;
    LDS_WAIT(); asm volatile("" ::: "memory");
    const int bt = t >> 6;
    unsigned long long todo;
    if (MODE == 0) { todo = sel[(size_t)bg * SEQ + t]; todo &= (bt >= 63) ? ~0ull : ((1ull << (bt + 1)) - 1ull); }
    else { const int lo = (t - 511) > 0 ? ((t - 511) >> 6) : 0; todo = ((bt >= 63) ? ~0ull : ((1ull << (bt + 1)) - 1ull)) & ~((1ull << lo) - 1ull); }
    float m4[4] = {-INFINITY, -INFINITY, -INFINITY, -INFINITY}, l4[4] = {0.f, 0.f, 0.f, 0.f}, o4[4] = {0.f, 0.f, 0.f, 0.f};
    while (todo) {
        const int j = __ffsll((long long)todo) - 1; todo &= todo - 1ull;
        const int pos = 64 * j + lane; const bool valid = (pos <= t) && (MODE == 0 || (t - pos) < 512);
        const GAS v4u* kr = (const GAS v4u*)(proj + (size_t)(b * SEQ + pos) * PE + kcol);
        v4u kk[8];
#pragma unroll
        for (int c = 0; c < 8; ++c) kk[c] = kr[c];
#pragma unroll
        for (int hh = 0; hh < 4; ++hh) { float a = 0.f;
#pragma unroll
            for (int c = 0; c < 8; ++c) { const f32x4 qa = *(const LAS f32x4*)(q4 + hh * 64 + c * 8), qb = *(const LAS f32x4*)(q4 + hh * 64 + c * 8 + 4);
                a += bflo(kk[c].x) * qa.x + bfhi(kk[c].x) * qa.y + bflo(kk[c].y) * qa.z + bfhi(kk[c].y) * qa.w + bflo(kk[c].z) * qb.x + bfhi(kk[c].z) * qb.y + bflo(kk[c].w) * qb.z + bfhi(kk[c].w) * qb.w; }
            const float s = valid ? a : -INFINITY;
            const float mn = fmaxf(m4[hh], wave_max(s));
            const float sc = __expf(m4[hh] - mn); const float p = valid ? __expf(s - mn) : 0.f;
            l4[hh] = l4[hh] * sc + wave_sum(p); o4[hh] *= sc; m4[hh] = mn; p4[hh * 64 + lane] = p; }
        LDS_WAIT(); asm volatile("" ::: "memory");
        const bf16* vr = proj + (size_t)(b * SEQ + 64 * j) * PE + vcol + lane;
#pragma unroll 4
        for (int k4 = 0; k4 < 64; k4 += 4) {
            const float v0 = bf2f(vr[(size_t)(k4 + 0) * PE]), v1 = bf2f(vr[(size_t)(k4 + 1) * PE]), v2 = bf2f(vr[(size_t)(k4 + 2) * PE]), v3 = bf2f(vr[(size_t)(k4 + 3) * PE]);
#pragma unroll
            for (int hh = 0; hh < 4; ++hh) { const f32x4 pp = *(const LAS f32x4*)(p4 + hh * 64 + k4); o4[hh] += pp.x * v0 + pp.y * v1 + pp.z * v2 + pp.w * v3; }
        }
        LDS_WAIT(); asm volatile("" ::: "memory");
    }
#pragma unroll
    for (int hh = 0; hh < 4; ++hh) { const float gate = sigmoidf_(bf2f(proj[trow * PE + C_NG + (MODE == 0 ? 1 : 2) * 8 + g * 4 + hh])); const float o = gate * o4[hh] / l4[hh];
        const size_t idx = trow * 512 + (g * 4 + hh) * 64 + lane;
        if (MODE == 0) accn[idx] += o; else mixed[trow * D + 512 + (g * 4 + hh) * 64 + lane] = (bf16)f2bf(accn[idx] + o); }
}


typedef float f32x16 __attribute__((ext_vector_type(16)));
typedef short s16x8 __attribute__((ext_vector_type(8)));
typedef short s16x4 __attribute__((ext_vector_type(4)));
constexpr int A_KC = 0;
constexpr int A_VCT = 36864;
constexpr int A_K0 = 71168;
constexpr int A_V0 = 89600;
constexpr int A_OT = 107008;
constexpr int A_KSTRIDE = 9216, A_VSTRIDE = 8704;
#define EXP2(x) __builtin_amdgcn_exp2f(x)
constexpr float SM_C = 0.125f * 1.4426950408889634f;
constexpr float LAZY_TAU = 5.0f;

__device__ __forceinline__ unsigned cvtpk(float lo, float hi) { f32x2_t v = {lo, hi}; bf16x2_t b = __builtin_convertvector(v, bf16x2_t); return __builtin_bit_cast(unsigned, b); }
__device__ __forceinline__ s16x8 pack8(const f32x16& p, int o) {
    v4u w; w.x = cvtpk(p[o + 0], p[o + 1]); w.y = cvtpk(p[o + 2], p[o + 3]); w.z = cvtpk(p[o + 4], p[o + 5]); w.w = cvtpk(p[o + 6], p[o + 7]);
    return __builtin_bit_cast(s16x8, w);
}
__device__ __forceinline__ s16x8 lds_a128(const LAS unsigned char* p) { return *(const LAS s16x8*)p; }
__device__ __forceinline__ s16x8 lds_a64x2(const LAS unsigned char* p) {
    const v2u lo = *(const LAS v2u*)p, hi = *(const LAS v2u*)(p + 16); v4u w; w.x = lo.x; w.y = lo.y; w.z = hi.x; w.w = hi.y; return __builtin_bit_cast(s16x8, w);
}
#define MFMA32(a, b, c) __builtin_amdgcn_mfma_f32_32x32x16_bf16((a), (b), (c), 0, 0, 0)
constexpr int rowc(int r) { return (r & 3) + 8 * (r >> 2); }

template <int MASKED>
__device__ __forceinline__ void attn_block_rf(const s16x8 (&kf)[4][2], const s16x8 (&vf)[2][4], const s16x8 (&qf)[4], int h, int key0, int klo, int khi, bool en, float& m, float& l, f32x16 (&O)[2]) {
    f32x16 s0, s1;
#pragma unroll
    for (int i = 0; i < 16; ++i) { s0[i] = 0.f; s1[i] = 0.f; }
#pragma unroll
    for (int ks = 0; ks < 4; ++ks) { s0 = MFMA32(kf[ks][0], qf[ks], s0); s1 = MFMA32(kf[ks][1], qf[ks], s1); }
    if (MASKED == 1) {
        const int lo0 = klo - key0 - 4 * h, hi0 = khi - key0 - 4 * h;
#pragma unroll
        for (int i = 0; i < 16; ++i) { const int c = rowc(i);
            s0[i] = (en && c >= lo0 && c <= hi0) ? s0[i] : -INFINITY; s1[i] = (en && c + 32 >= lo0 && c + 32 <= hi0) ? s1[i] : -INFINITY; }
    }
    float mx = -INFINITY;
#pragma unroll
    for (int i = 0; i < 16; ++i) { mx = __builtin_elementwise_max(mx, s0[i]); mx = __builtin_elementwise_max(mx, s1[i]); }
    if (MASKED == 2) mx = en ? mx : -INFINITY;
    mx = __builtin_elementwise_max(mx, __shfl_xor(mx, 32));
    if (__builtin_amdgcn_ballot_w64((mx - m) * SM_C > LAZY_TAU) != 0ull) {
        const float mn = __builtin_elementwise_max(m, mx);
        const float alpha = EXP2((m - mn) * SM_C); m = mn; l *= alpha;
#pragma unroll
        for (int i = 0; i < 16; ++i) { O[0][i] *= alpha; O[1][i] *= alpha; }
    }
    const float mc = (MASKED == 2 && !en) ? INFINITY : m * SM_C;
    float ls = 0.f;
#pragma unroll
    for (int i = 0; i < 16; ++i) { s0[i] = EXP2(fmaf(s0[i], SM_C, -mc)); s1[i] = EXP2(fmaf(s1[i], SM_C, -mc)); ls += s0[i] + s1[i]; }
    l += ls;
    const s16x8 p00 = pack8(s0, 0), p01 = pack8(s0, 8), p10 = pack8(s1, 0), p11 = pack8(s1, 8);
#pragma unroll
    for (int dt = 0; dt < 2; ++dt) { O[dt] = MFMA32(vf[dt][0], p00, O[dt]); O[dt] = MFMA32(vf[dt][1], p01, O[dt]); O[dt] = MFMA32(vf[dt][2], p10, O[dt]); O[dt] = MFMA32(vf[dt][3], p11, O[dt]); }
}
__device__ __forceinline__ void nsa_load_k(const bf16* Kt, int bgx, int j, int lane, s16x8 (&kf)[4][2]) {
    const GAS v4u* p = (const GAS v4u*)(Kt + ((size_t)bgx * 64 + j) * 4096) + lane;
#pragma unroll
    for (int ks = 0; ks < 4; ++ks) { kf[ks][0] = __builtin_bit_cast(s16x8, p[(ks * 2 + 0) * 64]); kf[ks][1] = __builtin_bit_cast(s16x8, p[(ks * 2 + 1) * 64]); }
}
__device__ __forceinline__ void nsa_load_v(const bf16* Vt, int bgx, int j, int lane, s16x8 (&vf)[2][4]) {
    const GAS v4u* p = (const GAS v4u*)(Vt + ((size_t)bgx * 64 + j) * 4096) + lane;
#pragma unroll
    for (int dt = 0; dt < 2; ++dt)
#pragma unroll
        for (int kk = 0; kk < 4; ++kk) vf[dt][kk] = __builtin_bit_cast(s16x8, p[(dt * 4 + kk) * 64]);
}

__device__ __forceinline__ void nsa_subunit(LAS unsigned char* lds, int bg, int qt, const bf16* proj, const bf16* kcb, const bf16* vctb, const bf16* Kt, const bf16* Vt, bf16* mixed, int tid_in, int wave) {
    int tid = tid_in; asm volatile("" : "+v"(tid)); const int lane = tid & 63;
    const int b = bg >> 1, g = bg & 1; const int t0 = qt * 64, bt = qt;
    const int r32 = lane & 31, h = lane >> 5, head = r32 >> 3, ql = lane & 7;
    const int t = t0 + 8 * wave + ql; const size_t trow = (size_t)(b * SEQ + t);
    {
        const bf16* ksrc = kcb + (size_t)bg * 256 * 64; const bf16* vsrc = vctb + (size_t)bg * 256 * 64;
#pragma unroll
        for (int i = 0; i < 4; ++i) { const int p = tid + i * NT;
            { const int row = p >> 3, c = p & 7; const v4u v = *(const GAS v4u*)(ksrc + row * 64 + 8 * c); *(LAS v4u*)(lds + A_KC + row * 144 + 16 * c) = v; }
            { const int n = p >> 3, c = p & 7; const v4u v = *(const GAS v4u*)(vsrc + n * 64 + 8 * c); LAS unsigned short* d = (LAS unsigned short*)(lds + A_VCT + (8 * c) * 536 + n * 2);
              d[0 * 268] = (unsigned short)(v.x & 0xffffu); d[1 * 268] = (unsigned short)(v.x >> 16); d[2 * 268] = (unsigned short)(v.y & 0xffffu); d[3 * 268] = (unsigned short)(v.y >> 16);
              d[4 * 268] = (unsigned short)(v.z & 0xffffu); d[5 * 268] = (unsigned short)(v.z >> 16); d[6 * 268] = (unsigned short)(v.w & 0xffffu); d[7 * 268] = (unsigned short)(v.w >> 16); } }
    }
    s16x8 qf[4];
    { const bf16* qp = proj + trow * PE + C_NQ + (g * 4 + head) * 64 + 8 * h;
#pragma unroll
      for (int ks = 0; ks < 4; ++ks) qf[ks] = __builtin_bit_cast(s16x8, *(const GAS v4u*)(qp + 16 * ks)); }
    __syncthreads();
    f32x16 OT[2];
#pragma unroll
    for (int i = 0; i < 16; ++i) { OT[0][i] = 0.f; OT[1][i] = 0.f; }
    unsigned long long selmask;
    {
        const int nmax = t >= 31 ? ((t - 31) >> 4) : -1;
        const int ntile = ((t0 + 63 - 31) >= 0) ? ((((t0 + 63 - 31) >> 4) + 1 + 31) >> 5) : 0;
        float m = -3.0e38f, l = 0.f;
#pragma unroll
        for (int T = 0; T < 8; ++T) if (T < ntile) {
            f32x16 s;
#pragma unroll
            for (int i = 0; i < 16; ++i) s[i] = 0.f;
#pragma unroll
            for (int ks = 0; ks < 4; ++ks) s = MFMA32(lds_a128(lds + A_KC + (32 * T + r32) * 144 + (16 * ks + 8 * h) * 2), qf[ks], s);
            const int lim = nmax - 32 * T - 4 * h; float mx = -INFINITY;
#pragma unroll
            for (int i = 0; i < 16; ++i) { s[i] = (rowc(i) <= lim) ? s[i] : -INFINITY; mx = __builtin_elementwise_max(mx, s[i]); }
            mx = __builtin_elementwise_max(mx, __shfl_xor(mx, 32));
            const float mn = __builtin_elementwise_max(m, mx); const float alpha = EXP2((m - mn) * SM_C); const float mc = mn * SM_C; m = mn; float ls = 0.f;
#pragma unroll
            for (int i = 0; i < 16; ++i) ls += EXP2(fmaf(s[i], SM_C, -mc));
            l = l * alpha + ls;
        }
        l += __shfl_xor(l, 32);
        const float invl = l > 0.f ? 1.0f / l : 0.f; const float mc = m * SM_C;
        float imp[32];
#pragma unroll
        for (int k = 0; k < 32; ++k) imp[k] = 0.f;
        const float gate_c = sigmoidf_(bf2f(proj[trow * PE + C_NG + 0 * 8 + g * 4 + head]));
        float carry = 0.f;
#pragma unroll
        for (int T = 0; T < 8; ++T) if (T < ntile) {
            f32x16 s;
#pragma unroll
            for (int i = 0; i < 16; ++i) s[i] = 0.f;
#pragma unroll
            for (int ks = 0; ks < 4; ++ks) s = MFMA32(lds_a128(lds + A_KC + (32 * T + r32) * 144 + (16 * ks + 8 * h) * 2), qf[ks], s);
            const int lim = nmax - 32 * T - 4 * h;
#pragma unroll
            for (int i = 0; i < 16; ++i) s[i] = (rowc(i) <= lim) ? EXP2(fmaf(s[i], SM_C, -mc)) * invl : 0.f;
            float Gs[4], Es[4], Xs[4];
#pragma unroll
            for (int rg = 0; rg < 4; ++rg) { Gs[rg] = (s[4 * rg] + s[4 * rg + 1]) + (s[4 * rg + 2] + s[4 * rg + 3]); Es[rg] = s[4 * rg + 3];
                Gs[rg] += __shfl_xor(Gs[rg], 8); Gs[rg] += __shfl_xor(Gs[rg], 16); Es[rg] += __shfl_xor(Es[rg], 8); Es[rg] += __shfl_xor(Es[rg], 16); Xs[rg] = __shfl_xor(Es[rg], 32); }
#pragma unroll
            for (int rg = 0; rg < 4; ++rg) imp[4 * T + rg] = Gs[rg] + (h ? Xs[rg] : (rg ? Xs[rg > 0 ? rg - 1 : 0] : carry));
            carry = Xs[3];
#pragma unroll
            for (int i = 0; i < 16; ++i) s[i] *= gate_c;
            const s16x8 p0 = pack8(s, 0), p1 = pack8(s, 8);
#pragma unroll
            for (int dt = 0; dt < 2; ++dt) { const LAS unsigned char* vr = lds + A_VCT + (32 * dt + r32) * 536 + (32 * T + 4 * h) * 2;
                OT[dt] = MFMA32(lds_a64x2(vr), p0, OT[dt]); OT[dt] = MFMA32(lds_a64x2(vr + 32), p1, OT[dt]); }
        }
#pragma unroll
        for (int k = 0; k < 32; ++k) { const int j = 2 * k + h; const bool ok = (j <= bt) && (j != 0) && (j != bt) && (j != bt - 1); imp[k] = ok ? imp[k] : -1.0f; }
        selmask = 1ull | (1ull << bt) | (bt >= 1 ? (1ull << (bt - 1)) : 0ull);
        const int rounds = 8 - (bt == 0 ? 1 : (bt == 1 ? 2 : 3));
#pragma unroll 1
        for (int rd = 0; rd < rounds; ++rd) {
            float mx = imp[0];
#pragma unroll
            for (int k = 1; k < 32; ++k) mx = __builtin_elementwise_max(mx, imp[k]);
            const float gm = __builtin_elementwise_max(mx, __shfl_xor(mx, 32));
            int jb = 64;
#pragma unroll
            for (int k = 31; k >= 0; --k) jb = (imp[k] == gm) ? (2 * k + h) : jb;
            const int jo = __shfl_xor(jb, 32); jb = jb < jo ? jb : jo;
            selmask |= 1ull << jb;
#pragma unroll
            for (int k = 0; k < 32; ++k) imp[k] = (2 * k + h == jb) ? -INFINITY : imp[k];
        }
    }
    const int wlo = bt >= 8 ? bt - 8 : 0;
    {
        LAS v4u* otp = (LAS v4u*)(lds + A_OT + (wave * 64 + lane) * 64);
#pragma unroll
        for (int dt = 0; dt < 2; ++dt)
#pragma unroll
            for (int q = 0; q < 2; ++q) { v4u w; w.x = cvtpk(OT[dt][8 * q], OT[dt][8 * q + 1]); w.y = cvtpk(OT[dt][8 * q + 2], OT[dt][8 * q + 3]); w.z = cvtpk(OT[dt][8 * q + 4], OT[dt][8 * q + 5]); w.w = cvtpk(OT[dt][8 * q + 6], OT[dt][8 * q + 7]); otp[2 * dt + q] = w; }
    }
    const float gate_s = sigmoidf_(bf2f(proj[trow * PE + C_NG + 1 * 8 + g * 4 + head])), gate_w = sigmoidf_(bf2f(proj[trow * PE + C_NG + 2 * 8 + g * 4 + head]));
    unsigned long long wact = 0ull;
#pragma unroll 1
    for (int j = 0; j <= bt; ++j) if (__ballot((selmask >> j) & 1ull) != 0ull) wact |= 1ull << j;
    float m = -3.0e38f, l = 0.f;
    f32x16 O[2];
#pragma unroll
    for (int i = 0; i < 16; ++i) { O[0][i] = 0.f; O[1][i] = 0.f; }
    int cj = __ffsll((long long)wact) - 1; wact &= wact - 1ull; bool cwin = false; int wj = wlo;
    s16x8 kf[4][2], kn[4][2], vf[2][4];
    nsa_load_k(Kt, bg * 2 + 0, cj, lane, kf);
#pragma unroll 1
    for (;;) {
        int nj; bool nwin, nvalid = true;
        if (!cwin && wact != 0ull) { nj = __ffsll((long long)wact) - 1; wact &= wact - 1ull; nwin = false; }
        else if (wj <= bt) { nj = wj++; nwin = true; }
        else { nj = 0; nwin = true; nvalid = false; }
        nsa_load_v(Vt, bg * 2 + (cwin ? 1 : 0), cj, lane, vf);
        if (nvalid) nsa_load_k(Kt, bg * 2 + (nwin ? 1 : 0), nj, lane, kn);
        if (!cwin) {
            const bool en = (selmask >> cj) & 1ull;
            if (cj == bt) attn_block_rf<1>(kf, vf, qf, h, 64 * cj, 0, t, en, m, l, O);
            else attn_block_rf<2>(kf, vf, qf, h, 64 * cj, 0, t, en, m, l, O);
        } else {
            if (cj == bt || (bt >= 8 && cj == wlo)) attn_block_rf<1>(kf, vf, qf, h, 64 * cj, t - 511, t, true, m, l, O);
            else attn_block_rf<0>(kf, vf, qf, h, 64 * cj, 0, t, true, m, l, O);
        }
        if ((!cwin && nwin) || !nvalid) {
            const float lt = l + __shfl_xor(l, 32);
            const float gate = (cwin ? gate_w : gate_s) * __builtin_amdgcn_rcpf(lt);
            LAS v4u* otp = (LAS v4u*)(lds + A_OT + (wave * 64 + lane) * 64);
#pragma unroll
            for (int dt = 0; dt < 2; ++dt)
#pragma unroll
                for (int q = 0; q < 2; ++q) { const v4u w = otp[2 * dt + q];
                    const unsigned ww[4] = {w.x, w.y, w.z, w.w};
#pragma unroll
                    for (int k = 0; k < 4; ++k) { O[dt][8 * q + 2 * k] = bflo(ww[k]) + gate * O[dt][8 * q + 2 * k]; O[dt][8 * q + 2 * k + 1] = bfhi(ww[k]) + gate * O[dt][8 * q + 2 * k + 1]; } }
            if (!nvalid) break;
#pragma unroll
            for (int dt = 0; dt < 2; ++dt)
#pragma unroll
                for (int q = 0; q < 2; ++q) { v4u w; w.x = cvtpk(O[dt][8 * q], O[dt][8 * q + 1]); w.y = cvtpk(O[dt][8 * q + 2], O[dt][8 * q + 3]); w.z = cvtpk(O[dt][8 * q + 4], O[dt][8 * q + 5]); w.w = cvtpk(O[dt][8 * q + 6], O[dt][8 * q + 7]); otp[2 * dt + q] = w; }
#pragma unroll
            for (int i = 0; i < 16; ++i) { O[0][i] = 0.f; O[1][i] = 0.f; }
            m = -3.0e38f; l = 0.f;
        }
        cj = nj; cwin = nwin;
#pragma unroll
        for (int ks = 0; ks < 4; ++ks) { kf[ks][0] = kn[ks][0]; kf[ks][1] = kn[ks][1]; }
    }
    {
        bf16* op = mixed + trow * D + 512 + (g * 4 + head) * 64 + 4 * h;
#pragma unroll
        for (int dt = 0; dt < 2; ++dt)
#pragma unroll
            for (int rg = 0; rg < 4; ++rg) { v2u w; w.x = cvtpk(O[dt][4 * rg], O[dt][4 * rg + 1]); w.y = cvtpk(O[dt][4 * rg + 2], O[dt][4 * rg + 3]); *(GAS v2u*)(op + 32 * dt + 8 * rg) = w; }
    }
    __syncthreads();
}

__device__ __forceinline__ void kv_tile_item(LAS unsigned short* scr  , int item, const bf16* proj, bf16* Kt, bf16* Vt, int lane) {
    const int bgx = item >> 6, kb = item & 63; const int bg = bgx >> 1, x = bgx & 1; const int b = bg >> 1, g = bg & 1; const int r = lane & 31, h = lane >> 5;
    const bf16* ksrc = proj + (size_t)(b * SEQ + 64 * kb) * PE + (x ? C_KW : C_KS) + 64 * g;
    GAS v4u* kd = (GAS v4u*)(Kt + (size_t)item * 4096) + lane;
#pragma unroll
    for (int ks = 0; ks < 4; ++ks)
#pragma unroll
        for (int kt = 0; kt < 2; ++kt) kd[(ks * 2 + kt) * 64] = *(const GAS v4u*)(ksrc + (size_t)(32 * kt + r) * PE + 16 * ks + 8 * h);
    const bf16* vsrc = proj + (size_t)(b * SEQ + 64 * kb + lane) * PE + (x ? C_VW : C_VS) + 64 * g;
#pragma unroll
    for (int c = 0; c < 8; ++c) { const v4u v = *(const GAS v4u*)(vsrc + 8 * c); LAS unsigned* d = (LAS unsigned*)(scr + lane * 66 + 8 * c); d[0] = v.x; d[1] = v.y; d[2] = v.z; d[3] = v.w; }
    LDS_WAIT(); asm volatile("" ::: "memory");
    GAS v4u* vd = (GAS v4u*)(Vt + (size_t)item * 4096) + lane;
#pragma unroll
    for (int dt = 0; dt < 2; ++dt)
#pragma unroll
        for (int kk = 0; kk < 4; ++kk) { const int dim = 32 * dt + r, k0 = 16 * kk + 4 * h; v4u o;
            o.x = (unsigned)scr[(k0 + 0) * 66 + dim] | ((unsigned)scr[(k0 + 1) * 66 + dim] << 16); o.y = (unsigned)scr[(k0 + 2) * 66 + dim] | ((unsigned)scr[(k0 + 3) * 66 + dim] << 16);
            o.z = (unsigned)scr[(k0 + 8) * 66 + dim] | ((unsigned)scr[(k0 + 9) * 66 + dim] << 16); o.w = (unsigned)scr[(k0 + 10) * 66 + dim] | ((unsigned)scr[(k0 + 11) * 66 + dim] << 16);
            vd[(dt * 4 + kk) * 64] = o; }
    LDS_WAIT(); asm volatile("" ::: "memory");
}

__device__ __forceinline__ float gelu_tanh_f(float x) { const float u = 0.7978845608028654f * (x + 0.044715f * x * x * x); const float t = 1.0f - 2.0f * __builtin_amdgcn_rcpf(__expf(2.0f * u) + 1.0f); return 0.5f * x * (1.0f + t); }
__device__ __forceinline__ void compress_unit(LAS unsigned char* lds, int unit, const bf16* proj, const bf16* W1T  , const float* cbias  , const float* w2k, const float* w2v,
                                              bf16* kcb, bf16* vcb, int tid_in, int wave) {
    int tid = tid_in; asm volatile("" : "+v"(tid)); const int lane = tid & 63;
    const int kv = unit >> 7, bg = (unit >> 3) & 15, tile = unit & 7; const int b = bg >> 1, g = bg & 1;
    const int r32 = lane & 31, h = lane >> 5; const int i = 32 * tile + r32;
    const bf16* w1 = W1T + (size_t)kv * 64 * 2048; const int col = (kv ? C_VC : C_KC) + 64 * g;
    f32x16 acc0, acc1;
#pragma unroll
    for (int q = 0; q < 16; ++q) { acc0[q] = 0.f; acc1[q] = 0.f; }
#pragma unroll
    for (int ks = 0; ks < 16; ++ks) {
        int tok = 16 * i + 4 * wave + (ks >> 2); tok = tok > SEQ - 1 ? SEQ - 1 : tok;
        const s16x8 av = __builtin_bit_cast(s16x8, *(const GAS v4u*)(proj + (size_t)(b * SEQ + tok) * PE + col + 16 * (ks & 3) + 8 * h));
        const int k0 = 256 * wave + 16 * ks + 8 * h;
        const s16x8 b0 = __builtin_bit_cast(s16x8, *(const GAS v4u*)(w1 + (size_t)r32 * 2048 + k0)), b1 = __builtin_bit_cast(s16x8, *(const GAS v4u*)(w1 + (size_t)(32 + r32) * 2048 + k0));
        acc0 = MFMA32(av, b0, acc0); acc1 = MFMA32(av, b1, acc1);
    }
    LAS float* part = (LAS float*)lds;
    LAS float* hidl = (LAS float*)(lds + 65536);
#pragma unroll
    for (int q = 0; q < 16; ++q) { const int row = (q & 3) + 8 * (q >> 2) + 4 * h; part[(wave * 32 + row) * 64 + r32] = acc0[q]; part[(wave * 32 + row) * 64 + 32 + r32] = acc1[q]; }
    __syncthreads();
    const int il = tid >> 4, c4 = (tid & 15) * 4;
    {
        f32x4 s = (f32x4){0.f, 0.f, 0.f, 0.f};
#pragma unroll 8
        for (int ksg = 0; ksg < 32; ++ksg) s = s + *(const GAS f32x4*)(cbias + (kv * 32 + ksg) * 64 + c4);
#pragma unroll
        for (int w = 0; w < 8; ++w) s = s + *(const LAS f32x4*)(part + (w * 32 + il) * 64 + c4);
        *(LAS f32x4*)(hidl + il * 64 + c4) = (f32x4){gelu_tanh_f(s.x), gelu_tanh_f(s.y), gelu_tanh_f(s.z), gelu_tanh_f(s.w)};
    }
    __syncthreads();
    {
        const float* w2 = kv ? w2v : w2k; f32x4 o = (f32x4){0.f, 0.f, 0.f, 0.f};
#pragma unroll 8
        for (int c = 0; c < 64; ++c) { const float hv = hidl[il * 64 + c]; o = o + *(const GAS f32x4*)(w2 + c * 64 + c4) * hv; }
        const int irow = 32 * tile + il; if (irow == 255) o = (f32x4){0.f, 0.f, 0.f, 0.f};
        v2u w; w.x = cvtpk(o.x, o.y); w.y = cvtpk(o.z, o.w);
        *(GAS v2u*)((kv ? vcb : kcb) + ((size_t)bg * 256 + irow) * 64 + c4) = w;
    }
    __syncthreads();
}


typedef float f32x4v __attribute__((ext_vector_type(4)));
#define MFMA16(a, b, c) __builtin_amdgcn_mfma_f32_16x16x32_bf16((a), (b), (c), 0, 0, 0)
constexpr int R_QT = 0, R_KT = 8704, R_KTT = 17920, R_VTT = 30208, R_E = 42496, R_BUF = 43008;
constexpr int S_QT = 0, S_KT = 24576, S_V = 49152, S_E = 65536, S_PF = 66560, S_OB = 71680, S_END = 105472;
__device__ __forceinline__ unsigned off_b(unsigned row, unsigned ch) { return 256u * row + 16u * (ch ^ (((row & 3u) << 2) | ((row >> 2) & 3u))); }
__device__ __forceinline__ unsigned tr_addr(unsigned lane, unsigned c, unsigned ks, unsigned t) { const unsigned h = lane >> 5, blk = (lane >> 4) & 1u, q = (lane & 15u) >> 2, pp = lane & 3u; return off_b(16u * ks + 8u * h + 4u * t + q, 4u * c + 2u * blk + (pp >> 1)) + 8u * (pp & 1u); }
typedef short v4i16_t __attribute__((ext_vector_type(4)));
__device__ __forceinline__ s16x8 tr_frag(const LAS unsigned char* tile, unsigned lane, unsigned c, unsigned ks) {
    const v4i16_t a = __builtin_amdgcn_ds_read_tr16_b64_v4i16((LAS v4i16_t*)(tile + tr_addr(lane, c, ks, 0))), b = __builtin_amdgcn_ds_read_tr16_b64_v4i16((LAS v4i16_t*)(tile + tr_addr(lane, c, ks, 1)));
    s16x8 r; r[0] = a[0]; r[1] = a[1]; r[2] = a[2]; r[3] = a[3]; r[4] = b[0]; r[5] = b[1]; r[6] = b[2]; r[7] = b[3]; return r; }
constexpr float REC_SCALE = 0.08838834764831845f;

__device__ __forceinline__ s16x8 lds_2x64(const LAS unsigned char* p, const LAS unsigned char* q) { const v2u lo = *(const LAS v2u*)p, hi = *(const LAS v2u*)q; v4u w; w.x = lo.x; w.y = lo.y; w.z = hi.x; w.w = hi.y; return __builtin_bit_cast(s16x8, w); }

template <int MODE>
__device__ __forceinline__ void rec_prep_task(int task, bf16* proj, const float2* rope, const float* lb, float* Eg, int lane) {
    constexpr int NH = MODE ? 8 : 4, LDP = MODE ? PO : PE, CQ = MODE ? C_HQ : C_RQ, CK = MODE ? C_HF : C_RK, CV = MODE ? C_HI : C_RV;
    const int chunk = task & 127, bh = task >> 7; const int b = bh / NH, hd = bh % NH;
    const size_t row0 = (size_t)(b * SEQ + 32 * chunk);
    if (MODE == 1) {
        const float l0 = lb[hd * 128 + 2 * lane], l1 = lb[hd * 128 + 2 * lane + 1];
        float B0 = 0.f, B1 = 0.f;
        bf16* rp0 = proj + row0 * LDP + hd * 128 + 2 * lane;
        unsigned qw[32], fw[32];
#pragma unroll
        for (int t = 0; t < 32; ++t) { qw[t] = *(const GAS unsigned*)(rp0 + (size_t)t * LDP + CQ); fw[t] = *(const GAS unsigned*)(rp0 + (size_t)t * LDP + CK); }
        __builtin_amdgcn_sched_barrier(0);
#pragma unroll
        for (int t = 0; t < 32; ++t) {
            bf16* rp = rp0 + (size_t)t * LDP;
            const float f0 = bflo(fw[t]), f1 = bfhi(fw[t]), q0 = bflo(qw[t]), q1 = bfhi(qw[t]);
            const float s0 = sigmoidf_(f0), s1 = sigmoidf_(f1);
            B0 += __logf(l0 + (1.0f - l0) * s0); B1 += __logf(l1 + (1.0f - l1) * s1);
            const float e0 = __expf(B0), e1 = __expf(B1);
            const float qt0 = siluf_(q0) * REC_SCALE * e0, qt1 = siluf_(q1) * REC_SCALE * e1;
            const float kt0 = (1.0f - l0) * (1.0f - s0) * __builtin_amdgcn_rcpf(e0), kt1 = (1.0f - l1) * (1.0f - s1) * __builtin_amdgcn_rcpf(e1);
            *(GAS unsigned*)(rp + CQ) = pk2(qt0, qt1);
            const unsigned kw = pk2(kt0, kt1);
            *(GAS unsigned*)(rp + CK) = kw;
            if (t == 31) { *(GAS f32x2*)(Eg + ((size_t)bh * 128 + chunk) * 128 + 2 * lane) = (f32x2){e0, e1}; }
        }
    } else {
        const float gamma = 1.0f - exp2f(-5.0f - (float)hd); const float ginv = 1.0f / gamma;
        float gp = 1.0f, gi = 1.0f;
        bf16* rp0 = proj + row0 * LDP + hd * 128 + lane;
#pragma unroll
        for (int half = 0; half < 2; ++half) {
            unsigned short q1h[16], q2h[16], k1h[16], k2h[16]; float2 csh[16];
#pragma unroll
            for (int i = 0; i < 16; ++i) { const int t = 16 * half + i; const bf16* rp = rp0 + (size_t)t * LDP;
                q1h[i] = rp[CQ]; q2h[i] = rp[CQ + 64]; k1h[i] = rp[CK]; k2h[i] = rp[CK + 64]; csh[i] = rope[(32 * chunk + t) * 64 + lane]; }
            __builtin_amdgcn_sched_barrier(0);
#pragma unroll
            for (int i = 0; i < 16; ++i) { const int t = 16 * half + i; bf16* rp = rp0 + (size_t)t * LDP;
                gp *= gamma; gi *= ginv;
                const float2 cs = csh[i];
                const float q1 = bf2f(q1h[i]), q2 = bf2f(q2h[i]), k1 = bf2f(k1h[i]), k2 = bf2f(k2h[i]);
                const unsigned qa = f2bf((q1 * cs.x - q2 * cs.y) * gp), qb = f2bf((q1 * cs.y + q2 * cs.x) * gp);
                const unsigned ka = f2bf((k1 * cs.x - k2 * cs.y) * (REC_SCALE * gi)), kb = f2bf((k1 * cs.y + k2 * cs.x) * (REC_SCALE * gi));
                rp[CQ] = (bf16)qa; rp[CQ + 64] = (bf16)qb; rp[CK] = (bf16)ka; rp[CK + 64] = (bf16)kb;
            }
        }
    }
}


struct RecSet { v4u q[2], k[2], v[2]; f32x4v e; v4u g[2]; f32x4v ec[2]; };

template <int MODE, int SEGS>
__device__ __forceinline__ void rec_issue(RecSet& R, int c, int bh, int hd, size_t rowbase, const bf16* proj, const float* Eg, int hid) {
    constexpr int NCH = SEQ / 32 / SEGS, LDP = MODE ? PO : PE, CQ = MODE ? C_HQ : C_RQ, CK = MODE ? C_HF : C_RK, CV = MODE ? C_HI : C_RV, CG = MODE ? C_HG : C_RG;
    if (c + 2 < NCH) { const size_t r2 = rowbase + 32 * (c + 2);
#pragma unroll
        for (int i = 0; i < 2; ++i) { const int p = hid + 256 * i, tq = p >> 4, cq = p & 15;
            R.q[i] = *(const GAS v4u*)(proj + (r2 + tq) * LDP + CQ + hd * 128 + 8 * cq); R.k[i] = *(const GAS v4u*)(proj + (r2 + tq) * LDP + CK + hd * 128 + 8 * cq); } }
    if (c + 1 < NCH) { const size_t r1 = rowbase + 32 * (c + 1);
#pragma unroll
        for (int i = 0; i < 2; ++i) { const int p = hid + 256 * i, tq = p >> 4, cq = p & 15; R.v[i] = *(const GAS v4u*)(proj + (r1 + tq) * LDP + CV + hd * 128 + 8 * cq); }
        if (MODE == 1 && hid < 32) R.e = *(const GAS f32x4v*)(Eg + ((size_t)bh * 128 + c + 1) * 128 + 4 * hid);
        if (SEGS > 1) { const GAS f32x4v* ep = (const GAS f32x4v*)(Eg + ((size_t)bh * 128 + c + 1) * 128 + 8 * (hid & 15)); R.ec[0] = ep[0]; R.ec[1] = ep[1]; } }
    if (SEGS == 1 && c >= 1) { const GAS v4u* gp = (const GAS v4u*)(proj + (rowbase + 32 * (c - 1) + (hid >> 3)) * LDP + CG + hd * 128 + 16 * (hid & 7)); R.g[0] = gp[0]; R.g[1] = gp[1]; }
}
__device__ __forceinline__ v4u scale8(v4u q, const float (&f)[8]) {
    v4u o; o.x = pk2(bflo(q.x) * f[0], bfhi(q.x) * f[1]); o.y = pk2(bflo(q.y) * f[2], bfhi(q.y) * f[3]); o.z = pk2(bflo(q.z) * f[4], bfhi(q.z) * f[5]); o.w = pk2(bflo(q.w) * f[6], bfhi(q.w) * f[7]); return o; }
template <int MODE, int SEGS>
__device__ __forceinline__ void rec_stage(const RecSet& R, LAS unsigned char* lds, int c, int hid, float (&ecum)[8], bool fix, bf16* projw, int hd, size_t rowbase) {
    constexpr int NCH = SEQ / 32 / SEGS, LDP = MODE ? PO : PE, CQ = MODE ? C_HQ : C_RQ;
    if (SEGS > 1 && c + 1 < NCH) {
        ecum[0] *= R.ec[0][0]; ecum[1] *= R.ec[0][1]; ecum[2] *= R.ec[0][2]; ecum[3] *= R.ec[0][3]; ecum[4] *= R.ec[1][0]; ecum[5] *= R.ec[1][1]; ecum[6] *= R.ec[1][2]; ecum[7] *= R.ec[1][3]; }
    if (c + 2 < NCH) {
#pragma unroll
        for (int i = 0; i < 2; ++i) { const int p = hid + 256 * i; const unsigned o = off_b(p >> 4, p & 15);
            *(LAS v4u*)(lds + S_QT + ((c + 2) % 3) * 8192 + o) = R.q[i]; *(LAS v4u*)(lds + S_KT + ((c + 2) % 3) * 8192 + o) = R.k[i];
            if (SEGS > 1 && fix) *(GAS v4u*)(projw + (rowbase + 32 * (c + 2) + (p >> 4)) * LDP + CQ + hd * 128 + 8 * (p & 15)) = scale8(R.q[i], ecum); } }
    if (c + 1 < NCH) {
#pragma unroll
        for (int i = 0; i < 2; ++i) { const int p = hid + 256 * i; *(LAS v4u*)(lds + S_V + ((c + 1) & 1) * 8192 + off_b(p >> 4, p & 15)) = R.v[i]; }
        if (MODE == 1 && hid < 32) *(LAS f32x4v*)(lds + S_E + ((c + 1) & 1) * 512 + 16 * hid) = R.e; }
}
__device__ __forceinline__ void rec_store_raw(const LAS unsigned char* lds, int cp, int hd, size_t rowbase, bf16* mixed, int hid) {
    const int t = hid >> 3, seg = hid & 7;
    const LAS f32x4v* ob = (const LAS f32x4v*)(lds + S_OB + (cp & 1) * 16896 + t * 528 + seg * 64);
    const f32x4v o0 = ob[0], o1 = ob[1], o2 = ob[2], o3 = ob[3];
    GAS v4u* dst = (GAS v4u*)(mixed + (rowbase + 32 * cp + t) * D + hd * 128 + 16 * seg);
    dst[0] = (v4u){pk2(o0[0], o0[1]), pk2(o0[2], o0[3]), pk2(o1[0], o1[1]), pk2(o1[2], o1[3])}; dst[1] = (v4u){pk2(o2[0], o2[1]), pk2(o2[2], o2[3]), pk2(o3[0], o3[1]), pk2(o3[2], o3[3])};
}
__device__ __forceinline__ void rec_ptile3(LAS unsigned char* lds, int cn, int hw, int lane) {
    const int c16 = lane & 15, q4 = lane >> 4; const int si = hw == 2 ? 1 : 0, ti = hw == 0 ? 0 : 1;
    const LAS unsigned char* kb = lds + S_KT + (cn % 3) * 8192; const LAS unsigned char* qb = lds + S_QT + (cn % 3) * 8192;
    s16x8 ka[4], qa[4];
#pragma unroll
    for (int ks = 0; ks < 4; ++ks) { ka[ks] = lds_a128(kb + off_b(16 * si + c16, 4 * ks + q4)); qa[ks] = lds_a128(qb + off_b(16 * ti + c16, 4 * ks + q4)); }
    __builtin_amdgcn_sched_barrier(0);
    f32x4v p = (f32x4v){0.f, 0.f, 0.f, 0.f};
#pragma unroll
    for (int ks = 0; ks < 4; ++ks) p = MFMA16(ka[ks], qa[ks], p);
    if (hw != 1) {
#pragma unroll
        for (int r = 0; r < 4; ++r) p[r] = ((4 * q4 + r) <= c16) ? p[r] : 0.f;
    }
    v2u w; w.x = cvtpk(p[0], p[1]); w.y = cvtpk(p[2], p[3]);
    *(LAS v2u*)(lds + S_PF + (cn & 1) * 2560 + (16 * ti + c16) * 80 + (16 * si + 4 * q4) * 2) = w;
}
template <int MODE>
__device__ __forceinline__ void rec_finish(const LAS unsigned char* lds, int cp, const v4u (&g)[2], const float (&ngl)[16], int hd, size_t rowbase, bf16* mixed, int hid) {
    const int t = hid >> 3, seg = hid & 7;
    const LAS f32x4v* ob = (const LAS f32x4v*)(lds + S_OB + (cp & 1) * 16896 + t * 528 + seg * 64);
    f32x4v o[4];
#pragma unroll
    for (int i = 0; i < 4; ++i) o[i] = ob[i];
    float s1 = 0.f, s2 = 0.f;
#pragma unroll
    for (int i = 0; i < 4; ++i) { s1 += (o[i][0] + o[i][1]) + (o[i][2] + o[i][3]); s2 += (o[i][0] * o[i][0] + o[i][1] * o[i][1]) + (o[i][2] * o[i][2] + o[i][3] * o[i][3]); }
    s1 += __shfl_xor(s1, 1); s2 += __shfl_xor(s2, 1); s1 += __shfl_xor(s1, 2); s2 += __shfl_xor(s2, 2); s1 += __shfl_xor(s1, 4); s2 += __shfl_xor(s2, 4);
    float mu = 0.f, rs;
    if (MODE == 0) { mu = s1 * (1.f / 128.f); rs = __builtin_amdgcn_rsqf(fmaxf(s2 * (1.f / 128.f) - mu * mu, 0.f) + 1e-5f); }
    else rs = __builtin_amdgcn_rsqf(s2 * (1.f / 128.f) + RMS_EPS);
    v4u out[2];
#pragma unroll
    for (int hv = 0; hv < 2; ++hv) { unsigned w[4];
#pragma unroll
        for (int k = 0; k < 4; ++k) { const int e0 = 8 * hv + 2 * k; const unsigned gw = k == 0 ? g[hv].x : (k == 1 ? g[hv].y : (k == 2 ? g[hv].z : g[hv].w));
            const float a = o[e0 >> 2][e0 & 3], bq = o[(e0 + 1) >> 2][(e0 + 1) & 3]; float y0, y1;
            if (MODE == 0) { y0 = (a - mu) * rs * siluf_(bflo(gw)); y1 = (bq - mu) * rs * siluf_(bfhi(gw)); }
            else { y0 = a * rs * ngl[e0] * sigmoidf_(bflo(gw)); y1 = bq * rs * ngl[e0 + 1] * sigmoidf_(bfhi(gw)); }
            w[k] = pk2(y0, y1); }
        out[hv] = (v4u){w[0], w[1], w[2], w[3]}; }
    GAS v4u* dst = (GAS v4u*)(mixed + (rowbase + 32 * cp + t) * D + hd * 128 + 16 * seg);
    dst[0] = out[0]; dst[1] = out[1];
}

template <int MODE>
__device__ __forceinline__ void rec_compute(LAS unsigned char* lds, int c, f32x16 (&Sacc)[4], float egam, int w, int lane) {
    const int r32 = lane & 31, h = lane >> 5;
    const LAS unsigned char* qt = lds + S_QT + (c % 3) * 8192; const LAS unsigned char* ktl = lds + S_KT + (c % 3) * 8192; const LAS unsigned char* vtl = lds + S_V + (c & 1) * 8192;
    const LAS unsigned char* pf = lds + S_PF + (c & 1) * 2560 + r32 * 80 + 16 * h;
    const s16x8 pf0 = lds_a128(pf), pf1 = lds_a128(pf + 32);
    const s16x8 vf0 = tr_frag(vtl, lane, w, 0), vf1 = tr_frag(vtl, lane, w, 1);
    s16x8 qp[4][2];
#pragma unroll
    for (int dt = 0; dt < 4; ++dt)
#pragma unroll
        for (int sp = 0; sp < 2; ++sp) qp[dt][sp] = lds_2x64(qt + off_b(r32, 4 * dt + 2 * sp) + 8 * h, qt + off_b(r32, 4 * dt + 2 * sp + 1) + 8 * h);
    __builtin_amdgcn_sched_barrier(0);
    f32x16 o;
#pragma unroll
    for (int i = 0; i < 16; ++i) o[i] = 0.f;
    o = MFMA32(vf0, pf0, o); o = MFMA32(vf1, pf1, o);
#pragma unroll
    for (int dt = 0; dt < 4; ++dt)
#pragma unroll
        for (int sp = 0; sp < 2; ++sp) o = MFMA32(pack8(Sacc[dt], 8 * sp), qp[dt][sp], o);
    __builtin_amdgcn_sched_barrier(0);
    s16x8 kf[4][2];
#pragma unroll
    for (int dt = 0; dt < 4; ++dt) { kf[dt][0] = tr_frag(ktl, lane, dt, 0); kf[dt][1] = tr_frag(ktl, lane, dt, 1); }
    __builtin_amdgcn_sched_barrier(0);
#pragma unroll
    for (int dt = 0; dt < 4; ++dt) { Sacc[dt] = MFMA32(kf[dt][0], vf0, Sacc[dt]); Sacc[dt] = MFMA32(kf[dt][1], vf1, Sacc[dt]); }
    {
        LAS unsigned char* ob = lds + S_OB + (c & 1) * 16896 + r32 * 528 + (32 * w + 4 * h) * 4;
#pragma unroll
        for (int g = 0; g < 4; ++g) *(LAS f32x4v*)(ob + 32 * g) = (f32x4v){o[4 * g], o[4 * g + 1], o[4 * g + 2], o[4 * g + 3]};
    }
    if (MODE == 1) { const LAS unsigned char* eb = lds + S_E + (c & 1) * 512 + 16 * h;
#pragma unroll
        for (int dt = 0; dt < 4; ++dt)
#pragma unroll
            for (int g = 0; g < 4; ++g) { const f32x4v e4 = *(const LAS f32x4v*)(eb + (32 * dt + 8 * g) * 4);
                Sacc[dt][4 * g] *= e4[0]; Sacc[dt][4 * g + 1] *= e4[1]; Sacc[dt][4 * g + 2] *= e4[2]; Sacc[dt][4 * g + 3] *= e4[3]; }
    } else {
#pragma unroll
        for (int dt = 0; dt < 4; ++dt)
#pragma unroll
            for (int i = 0; i < 16; ++i) Sacc[dt][i] *= egam;
    }
}

#define REC_BAR() do { asm volatile("s_waitcnt lgkmcnt(0)" ::: "memory"); __builtin_amdgcn_s_barrier(); asm volatile("" ::: "memory"); } while (0)

template <int MODE, int SEGS>
__device__ __forceinline__ void rec_serial_unit(LAS unsigned char* lds, int unit, bf16* proj, const float* Eg0, const float* ng, bf16* mixed, float* Send, float* Dseg, int tid_in, int wave) {
    constexpr int NH = MODE ? 8 : 4, NCH = SEQ / 32 / SEGS, LDP = MODE ? PO : PE, CQ = MODE ? C_HQ : C_RQ, CK = MODE ? C_HF : C_RK, CV = MODE ? C_HI : C_RV;
    int tid = tid_in; asm volatile("" : "+v"(tid)); const int lane = tid & 63;
    const int bh = unit / SEGS, sg = unit % SEGS;
    const int b = bh / NH, hd = bh % NH; const size_t rowbase = (size_t)b * SEQ + (size_t)sg * NCH * 32;
    const float* Eg = Eg0 + (size_t)sg * NCH * 128;
    const bool fix = SEGS > 1 && sg > 0;
    float ecum[8] = {1.f, 1.f, 1.f, 1.f, 1.f, 1.f, 1.f, 1.f};
    {
        const int tq = tid >> 4, cq = tid & 15; const unsigned o = off_b(tq, cq);
        if (SEGS > 1) { const GAS f32x4v* ep = (const GAS f32x4v*)(Eg + ((size_t)bh * 128) * 128 + 8 * cq); const f32x4v e0 = ep[0], e1 = ep[1];
            ecum[0] = e0[0]; ecum[1] = e0[1]; ecum[2] = e0[2]; ecum[3] = e0[3]; ecum[4] = e1[0]; ecum[5] = e1[1]; ecum[6] = e1[2]; ecum[7] = e1[3]; }
#pragma unroll
        for (int cc = 0; cc < 2; ++cc) { const size_t r = rowbase + 32 * cc + tq;
            const v4u qv = *(const GAS v4u*)(proj + r * LDP + CQ + hd * 128 + 8 * cq);
            *(LAS v4u*)(lds + S_QT + cc * 8192 + o) = qv;
            if (SEGS > 1 && fix && cc == 1) *(GAS v4u*)(proj + r * LDP + CQ + hd * 128 + 8 * cq) = scale8(qv, ecum);
            *(LAS v4u*)(lds + S_KT + cc * 8192 + o) = *(const GAS v4u*)(proj + r * LDP + CK + hd * 128 + 8 * cq); }
        *(LAS v4u*)(lds + S_V + o) = *(const GAS v4u*)(proj + (rowbase + tq) * LDP + CV + hd * 128 + 8 * cq);
        if (MODE == 1 && tid < 32) *(LAS f32x4v*)(lds + S_E + 16 * tid) = *(const GAS f32x4v*)(Eg + ((size_t)bh * 128) * 128 + 4 * tid);
        if (tid < 128) { const int par = tid >> 6, t16 = (tid >> 2) & 15, q = tid & 3; unsigned z = 0u; asm volatile("" : "+v"(z)); *(LAS v2u*)(lds + S_PF + par * 2560 + t16 * 80 + 32 + 8 * q) = (v2u){z, z}; }
    }
    __syncthreads();
    if (wave >= 4 && wave < 7) rec_ptile3(lds, 0, wave - 4, lane);
    __syncthreads();
    if (wave < 4) {
        f32x16 Sacc[4];
#pragma unroll
        for (int dt = 0; dt < 4; ++dt)
#pragma unroll
            for (int i = 0; i < 16; ++i) Sacc[dt][i] = 0.f;
        const float egam = MODE ? 1.f : exp2f(32.0f * log2f(1.0f - exp2f(-5.0f - (float)hd)));
#pragma unroll 1
        for (int c = 0; c <= NCH; ++c) { if (c < NCH) rec_compute<MODE>(lds, c, Sacc, egam, wave, lane); REC_BAR(); }
        if (SEGS > 1 && sg + 1 < SEGS) {
            const int r32 = lane & 31, h = lane >> 5; float* sp = Send + ((size_t)(bh * (SEGS - 1) + sg) * 128) * 128 + 32 * wave + r32;
#pragma unroll
            for (int dt = 0; dt < 4; ++dt)
#pragma unroll
                for (int i = 0; i < 16; ++i) sp[(size_t)(32 * dt + (i & 3) + 8 * (i >> 2) + 4 * h) * 128] = Sacc[dt][i];
        }
    } else {
        const int hid = tid - 256, hw = wave - 4;
        RecSet RA, RB;
        float ngl[16];
#pragma unroll
        for (int i = 0; i < 16; ++i) ngl[i] = (MODE && SEGS == 1) ? ng[16 * (hid & 7) + i] : 1.f;
        rec_issue<MODE, SEGS>(RA, 0, bh, hd, rowbase, proj, Eg, hid); rec_issue<MODE, SEGS>(RB, 1, bh, hd, rowbase, proj, Eg, hid);
#pragma unroll 1
        for (int c = 0; c <= NCH; c += 2) {
            if (c >= 1) { if (SEGS == 1) rec_finish<MODE>(lds, c - 1, RA.g, ngl, hd, rowbase, mixed, hid); else rec_store_raw(lds, c - 1, hd, rowbase, mixed, hid); }
            if (hw < 3 && c + 1 < NCH) rec_ptile3(lds, c + 1, hw, lane);
            rec_stage<MODE, SEGS>(RA, lds, c, hid, ecum, fix, proj, hd, rowbase);
            if (c + 2 <= NCH) rec_issue<MODE, SEGS>(RA, c + 2, bh, hd, rowbase, proj, Eg, hid);
            REC_BAR();
            if (c + 1 <= NCH) {
                if (SEGS == 1) rec_finish<MODE>(lds, c, RB.g, ngl, hd, rowbase, mixed, hid); else rec_store_raw(lds, c, hd, rowbase, mixed, hid);
                if (hw < 3 && c + 2 < NCH) rec_ptile3(lds, c + 2, hw, lane);
                rec_stage<MODE, SEGS>(RB, lds, c + 1, hid, ecum, fix, proj, hd, rowbase);
                if (c + 3 <= NCH) rec_issue<MODE, SEGS>(RB, c + 3, bh, hd, rowbase, proj, Eg, hid);
                REC_BAR();
            }
        }
        if (SEGS > 1 && hid < 16) { float* dp = Dseg + (size_t)(bh * SEGS + sg) * 128 + 8 * hid;
            *(GAS f32x4v*)dp = (f32x4v){ecum[0], ecum[1], ecum[2], ecum[3]}; *(GAS f32x4v*)(dp + 4) = (f32x4v){ecum[4], ecum[5], ecum[6], ecum[7]}; }
    }
    __syncthreads();
}

__device__ __forceinline__ void rec_fix_unit(LAS unsigned char* lds, int unit, const bf16* proj, const float* Send, const float* Dseg, const float* ng, bf16* mixed, int tid_in, int wave) {
    int tid = tid_in; asm volatile("" : "+v"(tid)); const int lane = tid & 63;
    const int sg = unit & 3, bh = unit >> 2; const int b = bh >> 3, hd = bh & 7;
    const int r32 = lane & 31, h = lane >> 5;
    LAS unsigned char* ST = lds;
    if (sg > 0) {
        const int e = tid & 127, d0 = 32 * (tid >> 7); float sv[32], t1[32];
        const float* s0p = Send + ((size_t)(bh * 3 + 0) * 128 + d0) * 128 + e;
#pragma unroll
        for (int dd = 0; dd < 32; ++dd) sv[dd] = s0p[(size_t)dd * 128];
        __builtin_amdgcn_sched_barrier(0);
        if (sg >= 2) { const float* s1p = Send + ((size_t)(bh * 3 + 1) * 128 + d0) * 128 + e; const float* dp = Dseg + (size_t)(bh * 4 + 1) * 128 + d0;
#pragma unroll
            for (int dd = 0; dd < 32; ++dd) t1[dd] = s1p[(size_t)dd * 128];
            __builtin_amdgcn_sched_barrier(0);
#pragma unroll
            for (int dd = 0; dd < 32; ++dd) sv[dd] = dp[dd] * sv[dd] + t1[dd]; }
        if (sg >= 3) { const float* s2p = Send + ((size_t)(bh * 3 + 2) * 128 + d0) * 128 + e; const float* dp = Dseg + (size_t)(bh * 4 + 2) * 128 + d0;
#pragma unroll
            for (int dd = 0; dd < 32; ++dd) t1[dd] = s2p[(size_t)dd * 128];
            __builtin_amdgcn_sched_barrier(0);
#pragma unroll
            for (int dd = 0; dd < 32; ++dd) sv[dd] = dp[dd] * sv[dd] + t1[dd]; }
#pragma unroll
        for (int q = 0; q < 4; ++q) *(LAS v4u*)(ST + e * 272 + d0 * 2 + 16 * q) = (v4u){pk2(sv[8 * q], sv[8 * q + 1]), pk2(sv[8 * q + 2], sv[8 * q + 3]), pk2(sv[8 * q + 4], sv[8 * q + 5]), pk2(sv[8 * q + 6], sv[8 * q + 7])};
    }
    __syncthreads();
#pragma unroll 1
    for (int blk = 0; blk < 4; ++blk) {
        f32x16 O[4];
#pragma unroll
        for (int et = 0; et < 4; ++et)
#pragma unroll
            for (int i = 0; i < 16; ++i) O[et][i] = 0.f;
        const size_t trow = (size_t)b * SEQ + 1024 * sg + 256 * blk + 32 * wave + r32;
        if (sg > 0) {
            s16x8 qf[8];
            { const bf16* qp = proj + trow * PO + C_HQ + hd * 128 + 8 * h;
#pragma unroll
              for (int ks = 0; ks < 8; ++ks) qf[ks] = __builtin_bit_cast(s16x8, *(const GAS v4u*)(qp + 16 * ks)); }
#pragma unroll
            for (int et = 0; et < 4; ++et)
#pragma unroll
                for (int ks = 0; ks < 8; ++ks) O[et] = MFMA32(lds_a128(ST + (32 * et + r32) * 272 + (16 * ks + 8 * h) * 2), qf[ks], O[et]);
        }
        bf16* mp = mixed + trow * D + hd * 128 + 4 * h; const bf16* gp = proj + trow * PO + C_HG + hd * 128 + 4 * h;
        v2u ol[4][4], gl[4][4];
#pragma unroll
        for (int et = 0; et < 4; ++et)
#pragma unroll
            for (int g = 0; g < 4; ++g) { ol[et][g] = *(const GAS v2u*)(mp + 32 * et + 8 * g); gl[et][g] = *(const GAS v2u*)(gp + 32 * et + 8 * g); }
        __builtin_amdgcn_sched_barrier(0);
        float s2 = 0.f;
#pragma unroll
        for (int et = 0; et < 4; ++et)
#pragma unroll
            for (int g = 0; g < 4; ++g) { const v2u w = ol[et][g];
                O[et][4 * g] += bflo(w.x); O[et][4 * g + 1] += bfhi(w.x); O[et][4 * g + 2] += bflo(w.y); O[et][4 * g + 3] += bfhi(w.y);
                s2 += (O[et][4 * g] * O[et][4 * g] + O[et][4 * g + 1] * O[et][4 * g + 1]) + (O[et][4 * g + 2] * O[et][4 * g + 2] + O[et][4 * g + 3] * O[et][4 * g + 3]); }
        s2 += __shfl_xor(s2, 32);
        const float rs = __builtin_amdgcn_rsqf(s2 * (1.f / 128.f) + RMS_EPS);
#pragma unroll
        for (int et = 0; et < 4; ++et)
#pragma unroll
            for (int g = 0; g < 4; ++g) { const v2u gw = gl[et][g]; const f32x4v nv = *(const GAS f32x4v*)(ng + 32 * et + 8 * g + 4 * h);
                v2u w; w.x = pk2(O[et][4 * g] * rs * nv[0] * sigmoidf_(bflo(gw.x)), O[et][4 * g + 1] * rs * nv[1] * sigmoidf_(bfhi(gw.x)));
                w.y = pk2(O[et][4 * g + 2] * rs * nv[2] * sigmoidf_(bflo(gw.y)), O[et][4 * g + 3] * rs * nv[3] * sigmoidf_(bfhi(gw.y)));
                *(GAS v2u*)(mp + 32 * et + 8 * g) = w; }
    }
    __syncthreads();
}
struct Args { const float* in[19]; float* out; unsigned char* ws; int ph_lo, ph_hi, rep, pad; };
constexpr int NPH_LAYER = 11, NPHASES = 1 + DEPTH * NPH_LAYER;

__global__ void __launch_bounds__(NT, 2) trunk_fwd(Args args) {
    extern __shared__ __attribute__((aligned(16))) unsigned char lds_raw[];
    LAS unsigned char* lds = (LAS unsigned char*)lds_raw;
    volatile LAS unsigned* MISC = (volatile LAS unsigned*)(lds + MISC_OFF);
    const int tid0 = threadIdx.x; const int wave0 = __builtin_amdgcn_readfirstlane(tid0 >> 6); const int wave = wave0;
#define PHASE_TID() int tid; asm volatile("v_mbcnt_lo_u32_b32 %0, -1, 0\n\tv_mbcnt_hi_u32_b32 %0, -1, %0" : "=v"(tid)); tid |= wave0 << 6;     \
    const int lane = tid & 63; (void)lane; int wave = wave0; asm volatile("" : "+s"(wave)); (void)wave; \
    size_t wso = 0; asm volatile("" : "+s"(wso)); unsigned char* ws = args.ws + wso; gu32* ctl = (gu32*)(ws + WS_CTL); float2* rope = (float2*)(ws + WS_ROPE); float* lbv = (float*)(ws + WS_LB); \
    bf16* Hb = (bf16*)(ws + WS_H); bf16* proj = (bf16*)(ws + WS_PROJ); bf16* hid = (bf16*)(ws + WS_PROJ); bf16* mixed = (bf16*)(ws + WS_MIXED); float* rowss = (float*)(ws + WS_ROWSS); \
    bf16* kcb = (bf16*)(ws + WS_KCB); bf16* vctb = (bf16*)(ws + WS_VCTB); bf16* VTb = (bf16*)(ws + WS_VT); bf16* KTb = (bf16*)(ws + WS_KT); \
    (void)ctl; (void)rope; (void)lbv; (void)Hb; (void)proj; (void)hid; (void)mixed; (void)rowss; (void)kcb; (void)vctb; (void)VTb; (void)KTb
    const int G = gridDim.x; const int bx = blockIdx.x; const int vcu = (G % 8 == 0) ? (bx % 8) * (G / 8) + bx / 8 : bx;
    const int gw = vcu * NWAVES + wave, NGW = G * NWAVES;
    unsigned char* ws = args.ws;
    gu32* ctl = (gu32*)(ws + WS_CTL);
    for (int u = tid0; u < (LDS_BYTES - LDSCTL_OFF) / 4; u += NT) ((LAS unsigned*)(lds + LDSCTL_OFF))[u] = 0u;
    __syncthreads();
    XcdBarrier bar; bar.bar = (unsigned*)(ctl + CW_BAR); bar.x = 0; bar.st = nullptr;
#if ONE_LAUNCH
    bar = xcd_barrier_post((unsigned*)(ctl + CW_BAR), MISC + 8);
#define GRID_BAR() xcd_barrier(bar)
#else
#define GRID_BAR() do {} while (0)
#endif
    const int lo = args.ph_lo, hi = args.ph_hi;
#define IN(k) (lo <= (k) && (k) < hi)
    const float* x_in = args.in[0]; float* xres = args.out;
    float2* rope = (float2*)(ws + WS_ROPE); float* lbv = (float*)(ws + WS_LB); float* kcmp = (float*)(ws + WS_KCMP); unsigned long long* sel = (unsigned long long*)(ws + WS_SEL);
    bf16* Hb = (bf16*)(ws + WS_H); float* accn = (float*)(ws + WS_H); bf16* proj = (bf16*)(ws + WS_PROJ); bf16* hid = (bf16*)(ws + WS_PROJ); bf16* mixed = (bf16*)(ws + WS_MIXED);
    float* rowss = (float*)(ws + WS_ROWSS); bf16* kcb = (bf16*)(ws + WS_KCB); bf16* vctb = (bf16*)(ws + WS_VCTB); bf16* VTb = (bf16*)(ws + WS_VT); bf16* KTb = (bf16*)(ws + WS_KT);

    if (IN(0)) { PHASE_TID();
        LAS unsigned* scr = (LAS unsigned*)(lds + wave * 16384);
#if PROBE_ML
        const int pr = args.rep;
#else
        const int pr = 0;
#endif
        if (pr == 0 || pr == 1 || pr == 2) { convert_weights(args.in, ws, 0, scr, gw, NGW, lane); convert_weights(args.in, ws, 1, scr, gw, NGW, lane); }
        if (pr == 0 || pr == 1 || pr == 4) {
        for (int it = gw; it < 4 * 32; it += NGW) { const int m = it >> 5, r = it & 31; const int jj = m >> 1, kv = m & 1;
            tr_item64(args.in[kv ? 10 : 7] + (size_t)jj * 2048 * 64, 2048, 64, (bf16*)(ws + WS_W1T) + (size_t)m * 64 * 2048, r * 64, 0, 0, scr, lane); }
        for (int mt = gw; mt < 4 * 32; mt += NGW) { const int m = mt >> 5, ksg = mt & 31; const int jj = m >> 1, kv = m & 1;
            const float* pos = args.in[kv ? 9 : 6] + (size_t)jj * 2048 + 64 * ksg; const float* w1 = args.in[kv ? 10 : 7] + (size_t)jj * 2048 * 64 + (size_t)64 * ksg * 64;
            float acc = 0.f;
#pragma unroll 16
            for (int k = 0; k < 64; ++k) acc += pos[k] * w1[k * 64 + lane];
            ((float*)(ws + WS_CBIAS))[(m * 32 + ksg) * 64 + lane] = acc; }
        for (int idx = vcu * NT + tid; idx < SEQ * 64; idx += G * NT) { const int s = idx >> 6, i = idx & 63;
            const float inv = exp2f(-(float)i * (13.287712379549449f / 64.0f));
            double tt = (double)s * (double)inv * 0.15915494309189535; tt -= floor(tt); const float tf = (float)tt;
            rope[idx] = make_float2(__builtin_amdgcn_cosf(tf), __builtin_amdgcn_sinf(tf)); }
        for (int c = vcu * NT + tid; c < 1024; c += G * NT) { const float l0 = args.in[15][c], l1 = args.in[15][1024 + c]; lbv[c] = 0.f; lbv[1024 + c] = 1.0f / (1.0f + expf(l0 - l1)); }
        }
        if (pr == 0 || pr == 1 || pr == 3) {
        if (M % (G * 2 * NWAVES) == 0) { const int per = M / G; for (int m = vcu * per + wave; m < (vcu + 1) * per; m += 2 * NWAVES) rows2_to_bf16_ss(x_in + (size_t)m * D, x_in + (size_t)(m + NWAVES) * D, Hb + (size_t)m * D, Hb + (size_t)(m + NWAVES) * D, rowss, m, m + NWAVES, lane); }
        else if (M % G == 0) { const int per = M / G; for (int m = vcu * per + wave; m < (vcu + 1) * per; m += NWAVES) row_to_bf16_ss(x_in + (size_t)m * D, Hb + (size_t)m * D, rowss, m, lane); }
        else for (int m = gw; m < M; m += NGW) row_to_bf16_ss(x_in + (size_t)m * D, Hb + (size_t)m * D, rowss, m, lane);
        }
        __syncthreads();
        GRID_BAR();
    }

#pragma unroll 1
    for (int L = 0; L < DEPTH; ++L) {
        const int pb = 1 + L * NPH_LAYER; const int j = L >> 1; const bool even = (L & 1) == 0;
        if (IN(pb + 0)) { PHASE_TID();
            const int N = even ? PE : PO; const bf16* Wt = even ? (const bf16*)(ws + WS_WEIN) + (size_t)j * PE * D : (const bf16*)(ws + WS_WOIN) + (size_t)j * PO * D;
            pg8::Gemm g{Hb, Wt, M, N, D}; pg8::StaticOrder S; S.init(M, N, G, bx);
            build_rstd_table(lds, S, rowss, tid);
            pg8::EpiInProj E{proj, N, (const LAS int*)(lds + RS_TBL_OFF), (const LAS float*)(lds + RS_TAB_OFF), even ? 0 : 1, (const float*)rope, lbv + (size_t)j * 1024, (float*)(ws + WS_VT), PROBE_ML ? args.rep : 0};
#if PROBE_ML
            if (args.rep == 7 && (bx % 8) >= 4) S.nwg = 0;
            if (args.rep == 8 && (bx % 8) != 0) S.nwg = 0;
            if (args.rep == 10 || args.rep == 11) { const int ns = (bx % 8) * (args.rep == 10 ? 1 : 2); for (int i = 0; i < ns; ++i) __builtin_amdgcn_s_sleep(82); }
#endif
            pg8::gemm_phase<pg8::EpiInProj, pg8::StaticOrder, PG8_ALIGN, PG8_SP2>(lds, g, S, E, tid);
            GRID_BAR();
        }
        if (even && IN(pb + 1)) { PHASE_TID();
#if REC_NAIVE
            const int nret = (G > 64) ? 32 : 0;
            if (nret == 0 || vcu < nret) for (int u = vcu; u < 32; u += (nret ? nret : G)) recur_unit<0>(lds, u >> 2, u & 3, proj, PE, rope, nullptr, nullptr, mixed, tid, lane, wave);
            if (nret == 0 || vcu >= nret)
#else
            const int nret = 0;
#endif
            {
                LAS float* xs = (LAS float*)(lds + wave * 16384);
                const int w0 = nret ? (vcu - nret) * NWAVES + wave : gw, nw = nret ? (G - nret) * NWAVES : NGW;
                for (int item = w0; item < 16 * 2 * 64; item += nw) kv_tile_item((LAS unsigned short*)xs, item, proj, KTb, VTb, lane);
                __syncthreads();
                for (int u = vcu; u < 256; u += G) compress_unit(lds, u, proj, (const bf16*)(ws + WS_W1T) + (size_t)j * 2 * 64 * 2048, (const float*)(ws + WS_CBIAS) + j * 2 * 32 * 64, args.in[8] + (size_t)j * 4096, args.in[11] + (size_t)j * 4096, kcb, vctb, tid, wave);
            }
            __syncthreads();
            GRID_BAR();
        }
#if NSA_NAIVE
        if (even && IN(pb + 2)) { PHASE_TID();
            LAS float* wl = (LAS float*)(lds + wave * 4096);
            for (int task = gw; task < 16 * SEQ; task += NGW) cmp_attn_task(wl, task, proj, kcmp, accn, sel, lane);
            __syncthreads();
            GRID_BAR();
        }
        if (even && IN(pb + 3)) { PHASE_TID();
            LAS float* wl = (LAS float*)(lds + wave * 4096);
            for (int task = gw; task < 16 * SEQ; task += NGW) blk_attn_task<0>(wl, task, proj, sel, accn, mixed, lane);
            __syncthreads();
            GRID_BAR();
        }
        if (even && IN(pb + 4)) { PHASE_TID();
            LAS float* wl = (LAS float*)(lds + wave * 4096);
            for (int task = gw; task < 16 * SEQ; task += NGW) blk_attn_task<1>(wl, task, proj, sel, accn, mixed, lane);
            __syncthreads();
            GRID_BAR();
        }
#else
        if (even && IN(pb + 2)) { PHASE_TID();
            const int per = (G % 8 == 0 && G >= 64) ? G / 8 : 0;
            { const int ru0 = per ? (((vcu % per) % 8 == 0 && (vcu % per) / 8 < 4) ? (vcu / per) * 4 + (vcu % per) / 8 : BATCH * 4) : vcu, rstep = per ? BATCH * 4 : G;
              for (int u = ru0; u < BATCH * 4; u += rstep) rec_serial_unit<0, 1>(lds, u, proj, nullptr, nullptr, mixed, nullptr, nullptr, tid, wave); }
            const int xq = per ? vcu / per : 0; const unsigned nitem = per ? 128u : 1024u;
            for (;;) {
                if (tid == 0) MISC[0] = __hip_atomic_fetch_add((unsigned*)(ctl + CW_Q + 64 * (j * 8 + xq + 16 * args.rep)), 1u, __ATOMIC_RELAXED, __HIP_MEMORY_SCOPE_AGENT);
                __syncthreads();
                const unsigned it = MISC[0];
                __syncthreads();
                if (it >= nitem) break;
                nsa_subunit(lds, per ? 2 * xq + (int)(it & 1u) : (int)(it & 15u), 63 - (int)(per ? it >> 1 : it >> 4), proj, kcb, vctb, KTb, VTb, mixed, tid, wave);
            }
            __syncthreads();
            GRID_BAR();
        }
#endif
#if REC_NAIVE
        if (!even && IN(pb + 5)) { PHASE_TID();
            for (int u = vcu; u < 64; u += G) recur_unit<1>(lds, u >> 3, u & 7, proj, PO, nullptr, lbv + (size_t)j * 1024, args.in[14] + (size_t)j * 128, mixed, tid, lane, wave);
            __syncthreads();
            GRID_BAR();
        }
#else
        if (!even && IN(pb + 3)) { PHASE_TID();
            for (int u = vcu; u < BATCH * 8 * 4; u += G) rec_serial_unit<1, 4>(lds, u, proj, (const float*)(ws + WS_VT), nullptr, mixed, (float*)(ws + WS_VT + 4 * MiB), (float*)(ws + WS_KCB), tid, wave);
            __syncthreads();
            GRID_BAR();
        }
        if (!even && IN(pb + 5)) { PHASE_TID();
            for (int u = vcu; u < BATCH * 8 * 4; u += G) rec_fix_unit(lds, u, proj, (const float*)(ws + WS_VT + 4 * MiB), (const float*)(ws + WS_KCB), args.in[14] + (size_t)j * 128, mixed, tid, wave);
            __syncthreads();
            GRID_BAR();
        }
#endif
        if (IN(pb + 6)) { PHASE_TID();
            const bf16* Wt = even ? (const bf16*)(ws + WS_WEOUT) + (size_t)j * D * D : (const bf16*)(ws + WS_WOOUT) + (size_t)j * D * D;
            pg8::Gemm g{mixed, Wt, M, D, D}; pg8::StaticOrder S; S.init(M, D, G, bx);
            pg8::EpiResF32 E{Hb, D, (PROBE_ML && args.rep) ? 0.f : 1.f, rowss, M, PROBE_ML ? args.rep : 0};
            pg8::gemm_phase<pg8::EpiResF32, pg8::StaticOrder, PG8_ALIGN, PG8_SP2>(lds, g, S, E, tid);
            GRID_BAR();
        }
        if (IN(pb + 8)) { PHASE_TID();
            pg8::Gemm g{Hb, (const bf16*)(ws + WS_W13) + (size_t)L * FF2 * D, M, FF2, D}; pg8::StaticOrder S; S.init(M, FF2, G, bx);
            build_rstd_table(lds, S, rowss, tid);
            pg8::EpiSwiGLU E{hid, FF, (const LAS int*)(lds + RS_TBL_OFF), (const LAS float*)(lds + RS_TAB_OFF), PROBE_ML ? args.rep : 0};
            pg8::gemm_phase<pg8::EpiSwiGLU, pg8::StaticOrder, PG8_ALIGN, PG8_SP2>(lds, g, S, E, tid);
            GRID_BAR();
        }
        if (IN(pb + 9)) { PHASE_TID();
            pg8::Gemm g{hid, (const bf16*)(ws + WS_W2) + (size_t)L * D * FF, M, D, FF}; pg8::StaticOrder S; S.init(M, D, G, bx);
            pg8::EpiResF32 E{Hb, D, (PROBE_ML && args.rep) ? 0.f : 1.f, rowss, M, PROBE_ML ? args.rep : 0};
            pg8::gemm_phase<pg8::EpiResF32, pg8::StaticOrder, PG8_ALIGN, PG8_SP2>(lds, g, S, E, tid);
            GRID_BAR();
        }
        if (L + 1 == DEPTH && IN(pb + 10)) { PHASE_TID();
#if PROBE_ML
            if (args.rep == 5 || (args.rep == 9 && (bx % 8) == 0)) {
                typedef short bf16x8_ __attribute__((ext_vector_type(8)));
                bf16x8_ af[4], bfm[4];
                for (int i = 0; i < 4; ++i) { af[i] = *(const bf16x8_*)(Hb + (size_t)(gw * 64 + lane) * D + i * 8); bfm[i] = *(const bf16x8_*)(Hb + (size_t)(gw * 64 + lane) * D + 512 + i * 8); }
                f32x4 c[4][4];
                for (int i = 0; i < 4; ++i) for (int k = 0; k < 4; ++k) c[i][k] = (f32x4){0.f, 0.f, 0.f, 0.f};
#pragma unroll 1
                for (int it = 0; it < 4096; ++it) {
#pragma unroll
                    for (int i = 0; i < 4; ++i)
#pragma unroll
                        for (int k = 0; k < 4; ++k) c[i][k] = __builtin_amdgcn_mfma_f32_16x16x32_bf16(af[i], bfm[k], c[i][k], 0, 0, 0);
                }
                f32x4 sacc = (f32x4){0.f, 0.f, 0.f, 0.f};
                for (int i = 0; i < 4; ++i) for (int k = 0; k < 4; ++k) sacc += c[i][k];
                ((f32x4*)(ws + WS_CTL + 512 * 1024))[gw * 64 + lane] = sacc;
            } else if (args.rep == 9) {
            } else if (args.rep == 6) {
                float a = bf2f(Hb[(size_t)(gw * 64 + lane) * D]), b = 1.0000001f, c0 = 1e-9f;
#pragma unroll 1
                for (int it = 0; it < 131072 / 16; ++it) {
#pragma unroll
                    for (int k = 0; k < 16; ++k) asm volatile("v_fma_f32 %0, %0, %1, %2" : "+v"(a) : "v"(b), "v"(c0));
                }
                ((float*)(ws + WS_CTL + 512 * 1024))[gw * 64 + lane] = a;
            } else
#endif
            for (int m = gw; m < M; m += NGW) rms_row_bf16_to_f32(Hb + (size_t)m * D, args.in[3], xres + (size_t)m * D, lane);
        }
    }
#undef IN
}

extern "C" void kernel_launch(void* const* d_in, const int* in_sizes, int n_in, void* d_out, int out_size, void* d_ws, size_t ws_size, hipStream_t stream) {
    static int grid = 0;
    if (grid == 0) {
        if (n_in != 19 || in_sizes[0] != M * D || out_size != M * D || ws_size < WS_END) { fprintf(stderr, "kernel_launch: unexpected shapes/workspace (n_in %d, in0 %d, out %d, ws %zu); nothing launched\n", n_in, n_in > 0 ? in_sizes[0] : -1, out_size, ws_size); grid = -1; return; }
        int dev = 0, cus = 0;
        if (hipGetDevice(&dev) != hipSuccess || hipDeviceGetAttribute(&cus, hipDeviceAttributeMultiprocessorCount, dev) != hipSuccess) { grid = -1; return; }
        if (hipFuncSetAttribute((const void*)trunk_fwd, hipFuncAttributeMaxDynamicSharedMemorySize, LDS_BYTES) != hipSuccess) { fprintf(stderr, "kernel_launch: hipFuncSetAttribute failed\n"); grid = -1; return; }
        int per_cu = 0;
        if (hipOccupancyMaxActiveBlocksPerMultiprocessor(&per_cu, (const void*)trunk_fwd, NT, LDS_BYTES) != hipSuccess || per_cu < 1) fprintf(stderr, "kernel_launch: occupancy query reports %d\n", per_cu);
        (void)hipGetLastError();
        grid = cus;
    }
    if (grid < 0) return;
    (void)hipMemsetAsync((char*)d_ws + WS_CTL, 0, CTL_ZERO_BYTES, stream);
    Args a{};
    for (int i = 0; i < 19; ++i) a.in[i] = (const float*)d_in[i];
    a.out = (float*)d_out; a.ws = (unsigned char*)d_ws;
#if ONE_LAUNCH && !PROBE_ML
    a.ph_lo = 0; a.ph_hi = NPHASES;
    hipLaunchKernelGGL(trunk_fwd, dim3(grid), dim3(NT), LDS_BYTES, stream, a);
#else
#if ONE_LAUNCH
#define PROBE_RESET() (void)hipMemsetAsync((char*)d_ws + WS_CTL + CW_BAR * 4, 0, (CW_Q - CW_BAR) * 4, stream)
#else
#define PROBE_RESET() do {} while (0)
#endif
    for (int p = 0; p < NPHASES; ++p) {
        if (p > 0) { const int L = (p - 1) / NPH_LAYER, k = (p - 1) % NPH_LAYER; const bool even = (L & 1) == 0; if (even && (k == 5 || ((k == 3 || k == 4) && !NSA_NAIVE))) continue; if (!even && (k == 1 || k == 2 || k == 4)) continue; if (k == 7 || (k == 10 && L + 1 < DEPTH)) continue; }
        a.ph_lo = p; a.ph_hi = p + 1; a.rep = 0;
        PROBE_RESET();
        hipLaunchKernelGGL(trunk_fwd, dim3(grid), dim3(NT), LDS_BYTES, stream, a);
#ifdef REP_K
        if ((p == 0 && REP_K == -2) || (p > 0 && (p - 1) % NPH_LAYER == REP_K)) { a.rep = REP_MODE; PROBE_RESET(); hipLaunchKernelGGL(trunk_fwd, dim3(grid), dim3(NT), LDS_BYTES, stream, a); }
#endif
    }
#endif
}
```

```cpp
#include <hip/hip_runtime.h>
#include <cstdio>
#include <cstdint>

#ifndef ONE_LAUNCH
#define ONE_LAUNCH 1
#define PROBE_ML 0
#endif

namespace pg8 {
#define PG8_LAS __attribute__((address_space(3)))
typedef unsigned short bf16_t;
typedef short bf16x8 __attribute__((ext_vector_type(8)));
typedef float f32x4 __attribute__((ext_vector_type(4)));
typedef unsigned u32x4 __attribute__((ext_vector_type(4)));
constexpr int BM = 256, BK = 64, HALF = 128, HTB = HALF * BK * 2  , STAGE_BYTES = 8 * HTB, NXCD = 8, WGM = 8;

__host__ __device__ __forceinline__ int lds_byte(int r, int c) { const int st = (r >> 4) * 2 + (c >> 5), rr = r & 15, cc = c & 31, ob = rr * 64 + cc * 2; return st * 1024 + (ob ^ (((ob >> 9) & 1) << 5)); }
__host__ __device__ __forceinline__ void stage_rc(int b, int& R, int& C) { const int st = b / 1024, sb = b % 1024, swz = sb ^ (((sb >> 9) & 1) << 5); R = (st >> 1) * 16 + swz / 64; C = (st & 1) * 32 + (swz % 64) / 2; }
__host__ __device__ __forceinline__ int perm32(int rho) { const int n = rho >> 4, i = rho & 15; return 8 * (i >> 2) + 4 * n + (i & 3); }

struct Unit { int pm, pn; };
struct Gemm { const bf16_t* A; const bf16_t* Bt; int M, N, K; };

struct StaticOrder {
    int nM, nN, nwg, G, c;
    __host__ __device__ void init(int M, int N, int G_, int c_) { nM = M / BM; nN = N / BM; nwg = nM * nN; G = G_; c = c_; }
    __host__ __device__ bool next(int i, Unit& u) const {
        const long L = (long)i * G + c; if (L >= nwg) return false;
        int wgid = (int)L; { const int q = nwg / NXCD, r = nwg % NXCD, xcd = wgid % NXCD, off = wgid / NXCD; wgid = (xcd < r ? xcd * (q + 1) : r * (q + 1) + (xcd - r) * q) + off; }
        const int nig = WGM * nN, gid = wgid / nig, fm = gid * WGM, gsz = (nM - fm) < WGM ? (nM - fm) : WGM;
        u.pm = fm + ((wgid % nig) % gsz); u.pn = (wgid % nig) / gsz; return true;
    }
    __device__ __forceinline__ void a_ready(const Unit&) const {}
    __device__ __forceinline__ void done(const Unit&) const {}
};

#ifndef NST_INPROJ
#define NST_INPROJ (PROBE_ML ? 0 : 16)
#endif
__device__ __forceinline__ unsigned cvt_pk_bf16(float lo, float hi) { unsigned r; asm volatile("v_cvt_pk_bf16_f32 %0, %1, %2" : "=v"(r) : "v"(lo), "v"(hi)); return r; }
__device__ __forceinline__ float fast_silu(float x) { return x * __builtin_amdgcn_rcpf(1.0f + __expf(-x)); }

__device__ __forceinline__ void row_rstd8(const PG8_LAS int* tbl, const PG8_LAS float* rsl, const Unit& u, int rl0, float (&rs)[2][4]) {
    const PG8_LAS float* p = rsl + tbl[u.pm] * 256 + rl0;
#pragma unroll
    for (int ai = 0; ai < 2; ++ai)
#pragma unroll
        for (int m = 0; m < 4; ++m) rs[ai][m] = p[ai * HALF + m * 16];
}
struct EpiBf16Plain {
    static constexpr bool PERM = true, AFTER_DRAIN = false; static constexpr int NST = PROBE_ML ? 0 : 16;
    bf16_t* O; int ldc; const PG8_LAS int* tbl; const PG8_LAS float* rsl;
    __device__ __forceinline__ void operator()(const f32x4 (&acc)[2][2][4][2], const Unit& u, int wr, int wc, int fr, int fq) const {
        const int row0 = u.pm * BM + wr * 64 + fr, col0 = u.pn * BM + wc * 32 + 8 * fq;
        float rs[2][4]; row_rstd8(tbl, rsl, u, wr * 64 + fr, rs);
#pragma unroll
        for (int ai = 0; ai < 2; ++ai)
#pragma unroll
            for (int m = 0; m < 4; ++m) { bf16_t* rowp = O + (size_t)(row0 + ai * HALF + m * 16) * ldc + col0; const float r = rs[ai][m];
#pragma unroll
                for (int bj = 0; bj < 2; ++bj) { const f32x4 v0 = acc[ai][bj][m][0] * r, v1 = acc[ai][bj][m][1] * r;
                    u32x4 w; w.x = cvt_pk_bf16(v0[0], v0[1]); w.y = cvt_pk_bf16(v0[2], v0[3]); w.z = cvt_pk_bf16(v1[0], v1[1]); w.w = cvt_pk_bf16(v1[2], v1[3]);
                    *(u32x4*)(rowp + bj * HALF) = w; } }
    }
};

__device__ __forceinline__ float dpp_scan16(float x) {
    x += __builtin_bit_cast(float, __builtin_amdgcn_update_dpp(0, __builtin_bit_cast(int, x), 0x111, 0xf, 0xf, true));
    x += __builtin_bit_cast(float, __builtin_amdgcn_update_dpp(0, __builtin_bit_cast(int, x), 0x112, 0xf, 0xf, true));
    x += __builtin_bit_cast(float, __builtin_amdgcn_update_dpp(0, __builtin_bit_cast(int, x), 0x114, 0xf, 0xf, true));
    x += __builtin_bit_cast(float, __builtin_amdgcn_update_dpp(0, __builtin_bit_cast(int, x), 0x118, 0xf, 0xf, true));
    return x;
}
struct EpiInProj {
    static constexpr bool PERM = true, AFTER_DRAIN = false; static constexpr int NST = NST_INPROJ;
    bf16_t* O; int ldc; const PG8_LAS int* tbl; const PG8_LAS float* rsl;
    int mode; const float* rope; const float* lb; float* Eg; int dbg;
    __device__ __forceinline__ void operator()(const f32x4 (&acc)[2][2][4][2], const Unit& u, int wr, int wc, int fr, int fq) const {
        if (dbg == 3) return;
        const int row0 = u.pm * BM + wr * 64 + fr;
        float rs[2][4]; row_rstd8(tbl, rsl, u, wr * 64 + fr, rs);
        const int lane = (fq << 4) | fr;
        if (mode == 0 && u.pn < 4) {
            const int hd = u.pn; const int i0 = 16 * wc + 4 * fq;
            const float lg = __builtin_amdgcn_logf(1.0f - __builtin_amdgcn_exp2f(-5.0f - (float)hd));
            const int pos0 = row0 & 4095;
            const f32x4* cs = (const f32x4*)(rope + ((size_t)pos0 * 64 + i0) * 2); const f32x4* c16p = (const f32x4*)(rope + ((size_t)16 * 64 + i0) * 2); const f32x4* c128p = (const f32x4*)(rope + ((size_t)128 * 64 + i0) * 2);
            const f32x4 b01 = cs[0], b23 = cs[1], s01 = c16p[0], s23 = c16p[1], t01 = c128p[0], t23 = c128p[1];
            float cb[4] = {b01[0], b01[2], b23[0], b23[2]}, sb[4] = {b01[1], b01[3], b23[1], b23[3]};
            const float c16[4] = {s01[0], s01[2], s23[0], s23[2]}, s16[4] = {s01[1], s01[3], s23[1], s23[3]}, c128[4] = {t01[0], t01[2], t23[0], t23[2]}, s128[4] = {t01[1], t01[3], t23[1], t23[3]};
            float gpv[2], giv[2]; float k884 = 0.08838834764831845f; asm volatile("" : "+v"(k884));
#pragma unroll
            for (int par = 0; par < 2; ++par) { const float tl1 = (float)(fr + 16 * par + 1); gpv[par] = __builtin_amdgcn_exp2f(tl1 * lg); giv[par] = k884 * __builtin_amdgcn_exp2f(-tl1 * lg); }
            typedef unsigned u32x2 __attribute__((ext_vector_type(2)));
#pragma unroll
            for (int ai = 0; ai < 2; ++ai) {
                float c[4], sn[4];
#pragma unroll
                for (int k = 0; k < 4; ++k) { c[k] = cb[k]; sn[k] = sb[k]; }
#pragma unroll
                for (int m = 0; m < 4; ++m) { const int row = row0 + ai * HALF + m * 16; const float r = rs[ai][m];
#pragma unroll
                    for (int bj = 0; bj < 2; ++bj) { const f32x4 x1 = acc[ai][bj][m][0] * r, x2 = acc[ai][bj][m][1] * r; const float sc = bj ? giv[m & 1] : gpv[m & 1];
                        float a[4], b[4];
#pragma unroll
                        for (int k = 0; k < 4; ++k) { a[k] = (x1[k] * c[k] - x2[k] * sn[k]) * sc; b[k] = (x1[k] * sn[k] + x2[k] * c[k]) * sc; }
                        bf16_t* dst = O + (size_t)row * ldc + (bj ? 512 : 0) + hd * 128 + i0;
                        u32x2 w0; w0.x = cvt_pk_bf16(a[0], a[1]); w0.y = cvt_pk_bf16(a[2], a[3]); *(u32x2*)dst = w0;
                        u32x2 w1; w1.x = cvt_pk_bf16(b[0], b[1]); w1.y = cvt_pk_bf16(b[2], b[3]); *(u32x2*)(dst + 64) = w1; }
                    if (m < 3) {
#pragma unroll
                        for (int k = 0; k < 4; ++k) { const float cn = c[k] * c16[k] - sn[k] * s16[k]; sn[k] = sn[k] * c16[k] + c[k] * s16[k]; c[k] = cn; } }
                }
                if (ai == 0) {
#pragma unroll
                    for (int k = 0; k < 4; ++k) { const float cn = cb[k] * c128[k] - sb[k] * s128[k]; sb[k] = sb[k] * c128[k] + cb[k] * s128[k]; cb[k] = cn; } }
            }
        } else if (mode == 1 && u.pn < 8) {
            const int hd = u.pn; const int ch0 = 32 * wc + 8 * fq;
            const f32x4 lb0 = *(const f32x4*)(lb + hd * 128 + ch0), lb1 = *(const f32x4*)(lb + hd * 128 + ch0 + 4);
            float lw[8], oml[8];
#pragma unroll
            for (int k = 0; k < 8; ++k) { lw[k] = k < 4 ? lb0[k & 3] : lb1[k & 3]; oml[k] = 1.0f - lw[k]; }
            const int src15 = ((lane & 48) | 15) << 2;
#pragma unroll
            for (int ai = 0; ai < 2; ++ai)
#pragma unroll
                for (int mp = 0; mp < 2; ++mp) {
                    float carry[8];
#pragma unroll
                    for (int mm = 0; mm < 2; ++mm) { const int m = 2 * mp + mm; const int row = row0 + ai * HALF + m * 16; const float r = rs[ai][m];
                        const float rn = -1.4426950408889634f * r, rc = 0.08838834764831845f * r;
                        float B[8], sg[8], Ef[8];
#pragma unroll
                        for (int k = 0; k < 8; ++k) { Ef[k] = __builtin_amdgcn_exp2f(acc[ai][1][m][k >> 2][k & 3] * rn);
                            sg[k] = __builtin_amdgcn_rcpf(1.0f + Ef[k]); B[k] = __builtin_amdgcn_logf(fmaf(oml[k], sg[k], lw[k])); }
#pragma unroll
                        for (int k = 0; k < 8; ++k) B[k] += __builtin_bit_cast(float, __builtin_amdgcn_update_dpp(0, __builtin_bit_cast(int, B[k]), 0x111, 0xf, 0xf, true));
#pragma unroll
                        for (int k = 0; k < 8; ++k) B[k] += __builtin_bit_cast(float, __builtin_amdgcn_update_dpp(0, __builtin_bit_cast(int, B[k]), 0x112, 0xf, 0xf, true));
#pragma unroll
                        for (int k = 0; k < 8; ++k) B[k] += __builtin_bit_cast(float, __builtin_amdgcn_update_dpp(0, __builtin_bit_cast(int, B[k]), 0x114, 0xf, 0xf, true));
#pragma unroll
                        for (int k = 0; k < 8; ++k) B[k] += __builtin_bit_cast(float, __builtin_amdgcn_update_dpp(0, __builtin_bit_cast(int, B[k]), 0x118, 0xf, 0xf, true));
                        if (mm == 1) {
#pragma unroll
                            for (int k = 0; k < 8; ++k) B[k] += carry[k]; }
                        if (mm == 0) {
#pragma unroll
                            for (int k = 0; k < 8; ++k) carry[k] = __builtin_bit_cast(float, __builtin_amdgcn_ds_bpermute(src15, __builtin_bit_cast(int, B[k]))); }
                        float qt[8], kt[8], ev[8];
#pragma unroll
                        for (int k = 0; k < 8; ++k) { const float aq = acc[ai][0][m][k >> 2][k & 3];
                            const float e = __builtin_amdgcn_exp2f(B[k]), ei = __builtin_amdgcn_exp2f(-B[k]);
                            const float iq = __builtin_amdgcn_rcpf(1.0f + __builtin_amdgcn_exp2f(aq * rn));
                            qt[k] = (aq * rc) * (iq * e);
                            kt[k] = (oml[k] * Ef[k]) * (sg[k] * ei); ev[k] = e; }
                        bf16_t* dst = O + (size_t)row * ldc + hd * 128 + ch0;
                        u32x4 wq; wq.x = cvt_pk_bf16(qt[0], qt[1]); wq.y = cvt_pk_bf16(qt[2], qt[3]); wq.z = cvt_pk_bf16(qt[4], qt[5]); wq.w = cvt_pk_bf16(qt[6], qt[7]); *(u32x4*)dst = wq;
                        u32x4 wk; wk.x = cvt_pk_bf16(kt[0], kt[1]); wk.y = cvt_pk_bf16(kt[2], kt[3]); wk.z = cvt_pk_bf16(kt[4], kt[5]); wk.w = cvt_pk_bf16(kt[6], kt[7]); *(u32x4*)(dst + 1024) = wk;
                        if (mm == 1 && fr == 15) { float* ep = Eg + ((size_t)((row >> 12) * 8 + hd) * 128 + ((row & 4095) >> 5)) * 128 + ch0;
                            *(f32x4*)ep = (f32x4){ev[0], ev[1], ev[2], ev[3]}; *(f32x4*)(ep + 4) = (f32x4){ev[4], ev[5], ev[6], ev[7]}; } }
                }
        } else {
            const int col0 = u.pn * BM + wc * 32 + 8 * fq;
#pragma unroll
            for (int ai = 0; ai < 2; ++ai)
#pragma unroll
                for (int m = 0; m < 4; ++m) { bf16_t* rowp = O + (size_t)(row0 + ai * HALF + m * 16) * ldc + col0; const float r = rs[ai][m];
#pragma unroll
                    for (int bj = 0; bj < 2; ++bj) { const f32x4 v0 = acc[ai][bj][m][0] * r, v1 = acc[ai][bj][m][1] * r;
                        u32x4 w; w.x = cvt_pk_bf16(v0[0], v0[1]); w.y = cvt_pk_bf16(v0[2], v0[3]); w.z = cvt_pk_bf16(v1[0], v1[1]); w.w = cvt_pk_bf16(v1[2], v1[3]);
                        *(u32x4*)(rowp + bj * HALF) = w; } }
        }
    }
};
struct EpiResF32 {
    static constexpr bool PERM = true, AFTER_DRAIN = false; static constexpr int NST = PROBE_ML ? 0 : 16;
    bf16_t* xb; int ldc; float scale; float* rowss; int M_; int dbg;
    __device__ __forceinline__ void operator()(const f32x4 (&acc)[2][2][4][2], const Unit& u, int wr, int wc, int fr, int fq) const {
        if (dbg == 3) return;
        const int row0 = u.pm * BM + wr * 64 + fr, col0 = u.pn * BM + wc * 32 + 8 * fq;
        u32x4 r[2][4][2];
#pragma unroll
        for (int ai = 0; ai < 2; ++ai)
#pragma unroll
            for (int m = 0; m < 4; ++m) { const size_t ro = (size_t)(row0 + ai * HALF + m * 16) * ldc + col0;
#pragma unroll
                for (int bj = 0; bj < 2; ++bj) r[ai][m][bj] = *(const u32x4*)(xb + ro + bj * HALF); }
        __builtin_amdgcn_sched_barrier(0);
#pragma unroll
        for (int ai = 0; ai < 2; ++ai) {
#pragma unroll
            for (int m = 0; m < 4; ++m) { const size_t ro = (size_t)(row0 + ai * HALF + m * 16) * ldc + col0; float q = 0.f;
#pragma unroll
                for (int bj = 0; bj < 2; ++bj) { const u32x4 rw = r[ai][m][bj]; const unsigned rr[4] = {rw.x, rw.y, rw.z, rw.w}; unsigned ow[4];
#pragma unroll
                    for (int k = 0; k < 4; ++k) { const f32x4 a = acc[ai][bj][m][k >> 1];
                        const float lo = __builtin_bit_cast(float, rr[k] << 16) + a[2 * (k & 1)] * scale, hi = __builtin_bit_cast(float, rr[k] & 0xffff0000u) + a[2 * (k & 1) + 1] * scale;
                        const unsigned w = cvt_pk_bf16(lo, hi); ow[k] = w;
                        const float l2 = __builtin_bit_cast(float, w << 16), h2 = __builtin_bit_cast(float, w & 0xffff0000u); q += l2 * l2 + h2 * h2; }
                    u32x4 o; o.x = ow[0]; o.y = ow[1]; o.z = ow[2]; o.w = ow[3]; *(u32x4*)(xb + ro + bj * HALF) = o; }
                q += __shfl_xor(q, 16); q += __shfl_xor(q, 32);
                if (fq == 0) rowss[(size_t)(u.pn * 4 + wc) * M_ + row0 + ai * HALF + m * 16] = q; }
            __builtin_amdgcn_sched_barrier(0);
        }
    }
};
struct EpiSwiGLU {
    static constexpr bool PERM = true, AFTER_DRAIN = false; static constexpr int NST = PROBE_ML ? 0 : 8;
    bf16_t* O; int ldc; const PG8_LAS int* tbl; const PG8_LAS float* rsl; int dbg;
    __device__ __forceinline__ void operator()(const f32x4 (&acc)[2][2][4][2], const Unit& u, int wr, int wc, int fr, int fq) const {
        if (dbg == 3) return;
        const int row0 = u.pm * BM + wr * 64 + fr, col0 = u.pn * HALF + wc * 32 + 8 * fq;
        float rs[2][4]; row_rstd8(tbl, rsl, u, wr * 64 + fr, rs);
#pragma unroll
        for (int ai = 0; ai < 2; ++ai)
#pragma unroll
            for (int m = 0; m < 4; ++m) { bf16_t* rowp = O + (size_t)(row0 + ai * HALF + m * 16) * ldc + col0; const float r = rs[ai][m];
                const f32x4 g0 = acc[ai][0][m][0] * r, g1 = acc[ai][0][m][1] * r, u0 = acc[ai][1][m][0] * r, u1 = acc[ai][1][m][1] * r;
                u32x4 w; w.x = cvt_pk_bf16(fast_silu(g0[0]) * u0[0], fast_silu(g0[1]) * u0[1]); w.y = cvt_pk_bf16(fast_silu(g0[2]) * u0[2], fast_silu(g0[3]) * u0[3]);
                w.z = cvt_pk_bf16(fast_silu(g1[0]) * u1[0], fast_silu(g1[1]) * u1[1]); w.w = cvt_pk_bf16(fast_silu(g1[2]) * u1[2], fast_silu(g1[3]) * u1[3]);
                if (dbg != 2 || w.x == 0x12345u) *(u32x4*)rowp = w; }
    }
};

template <class Epi, class Sched, bool ALIGN_EPI = false, bool SP2 = false>
__device__ __forceinline__ void gemm_phase(PG8_LAS unsigned char* lds, const Gemm g, const Sched& S, const Epi& E, const int tid_in) {
    const int tid = tid_in, wid = __builtin_amdgcn_readfirstlane(tid >> 6), lane = tid & 63, wr = wid >> 2, wc = wid & 3, fr = lane & 15, fq = lane >> 4;
    const int K = g.K, nt = K / BK;
    constexpr bool RELAX = SP2 && ALIGN_EPI && (Epi::NST > 0);
    unsigned voffA[2], voffB[2];
#pragma unroll
    for (int i = 0; i < 2; ++i) { int R, C; stage_rc(tid * 16 + i * 8192, R, C); const int Rb = Epi::PERM ? ((R & ~31) + perm32(R & 31)) : R;
        voffA[i] = (unsigned)(R * K + C) * 2u; voffB[i] = (unsigned)(Rb * K + C) * 2u; }
    const size_t kstep = (size_t)(BK * 2);
    const size_t hstep = (size_t)HALF * K * 2;
    const size_t tstep = 2 * hstep;
    const unsigned ldsw = (unsigned)wid * 1024u;
    const int aoff = lds_byte(wr * 64 + fr, fq * 8), boff = lds_byte(wc * 32 + fr, fq * 8);
#define PG8_SA(b, h) (((b) * 2 + (h)) * HTB)
#define PG8_SB(b, h) ((4 + (b) * 2 + (h)) * HTB)
#define PG8_STAGE(bufoff, gbase, voff) do { _Pragma("unroll") for (int _i = 0; _i < 2; ++_i) \
        __builtin_amdgcn_global_load_lds((const unsigned*)((const char*)(gbase) + (voff)[_i]), (PG8_LAS unsigned*)(lds + (bufoff) + ldsw + _i * 8192), 16, 0, 0); } while (0)
#define PG8_LDA(dst, b, h) do { _Pragma("unroll") for (int m = 0; m < 4; ++m) _Pragma("unroll") for (int k = 0; k < 2; ++k) dst[m][k] = *(const PG8_LAS bf16x8*)(lds + PG8_SA(b, h) + aoff + m * 2048 + k * 1024); } while (0)
#define PG8_LDB(dst, b, h) do { _Pragma("unroll") for (int n = 0; n < 2; ++n) _Pragma("unroll") for (int k = 0; k < 2; ++k) dst[n][k] = *(const PG8_LAS bf16x8*)(lds + PG8_SB(b, h) + boff + n * 2048 + k * 1024); } while (0)
#define PG8_MMA(ai, bj, At, Bt) do { __builtin_amdgcn_s_setprio(1); _Pragma("unroll") for (int m = 0; m < 4; ++m) _Pragma("unroll") for (int n = 0; n < 2; ++n) _Pragma("unroll") for (int k = 0; k < 2; ++k) \
        acc[ai][bj][m][n] = __builtin_amdgcn_mfma_f32_16x16x32_bf16(Bt[n][k], At[m][k], acc[ai][bj][m][n], 0, 0, 0); __builtin_amdgcn_s_setprio(0); } while (0)
#define PG8_WAIT_V(n) asm volatile("s_waitcnt vmcnt(" #n ")" ::: "memory")
#define PG8_SPTR(p) asm volatile("" : "+s"(p))
#define PG8_WAIT_VN(n) asm volatile("s_waitcnt vmcnt(%0)" :: "n"(n) : "memory")
#define PG8_WAIT_L(n) asm volatile("s_waitcnt lgkmcnt(" #n ")" ::: "memory")
#define PG8_BAR __builtin_amdgcn_s_barrier()
#define PG8_SCHED __builtin_amdgcn_sched_barrier(0)
    Unit cur, nxt; int ui = 0;
    if (!S.next(0, cur)) return;
    f32x4 acc[2][2][4][2];
#pragma unroll
    for (int a = 0; a < 2; ++a)
#pragma unroll
        for (int b = 0; b < 2; ++b)
#pragma unroll
            for (int m = 0; m < 4; ++m)
#pragma unroll
                for (int n = 0; n < 2; ++n) acc[a][b][m][n] = (f32x4){0.f, 0.f, 0.f, 0.f};
    bf16x8 At[4][2], B0[2][2], B1[2][2];
    const char* cA = (const char*)g.A + (size_t)cur.pm * tstep; const char* cB = (const char*)g.Bt + (size_t)cur.pn * tstep;
    S.a_ready(cur);
    if constexpr (RELAX) {
        PG8_STAGE(PG8_SB(0, 0), cB, voffB); PG8_STAGE(PG8_SB(0, 1), cB + hstep, voffB); PG8_STAGE(PG8_SA(0, 0), cA, voffA); PG8_STAGE(PG8_SA(0, 1), cA + hstep, voffA);
        { const char* pb = cB + kstep; const char* pa = cA + kstep; const char* pbh = cB + hstep + kstep; const char* pah = cA + hstep + kstep; PG8_SPTR(pb); PG8_SPTR(pa); PG8_SPTR(pbh); PG8_SPTR(pah);
          PG8_STAGE(PG8_SB(1, 0), pb, voffB); PG8_STAGE(PG8_SA(1, 0), pa, voffA); PG8_STAGE(PG8_SB(1, 1), pbh, voffB); PG8_STAGE(PG8_SA(1, 1), pah, voffA); }
        PG8_WAIT_V(0); PG8_BAR;
        if (wr == 1) PG8_BAR;
    } else
    if constexpr (SP2) {
        PG8_STAGE(PG8_SB(0, 0), cB, voffB); PG8_STAGE(PG8_SB(0, 1), cB + hstep, voffB); PG8_STAGE(PG8_SA(0, 0), cA, voffA); PG8_STAGE(PG8_SA(0, 1), cA + hstep, voffA);
        if (wr == 1) PG8_BAR;
        PG8_WAIT_V(2); PG8_BAR;
        PG8_STAGE(PG8_SB(1, 0), cB + kstep, voffB); PG8_STAGE(PG8_SA(1, 0), cA + kstep, voffA); PG8_STAGE(PG8_SB(1, 1), cB + hstep + kstep, voffB);
        PG8_WAIT_V(6); PG8_BAR;
    } else {
        PG8_STAGE(PG8_SB(0, 0), cB, voffB); PG8_STAGE(PG8_SA(0, 0), cA, voffA); PG8_STAGE(PG8_SB(0, 1), cB + hstep, voffB); PG8_STAGE(PG8_SA(0, 1), cA + hstep, voffA);
        if (wr == 1) PG8_BAR;
        PG8_WAIT_V(4); PG8_BAR;
        PG8_STAGE(PG8_SB(1, 0), cB + kstep, voffB); PG8_STAGE(PG8_SA(1, 0), cA + kstep, voffA); PG8_STAGE(PG8_SB(1, 1), cB + hstep + kstep, voffB);
        PG8_WAIT_V(6); PG8_BAR;
    }
    for (;;) {
        const bool has_next = S.next(ui + 1, nxt);
        const char* nA = has_next ? (const char*)g.A + (size_t)nxt.pm * tstep : cA; const char* nB = has_next ? (const char*)g.Bt + (size_t)nxt.pn * tstep : cB;
#define PG8_BODY_SP2(W1, W2, W3, STAGE1) \
            PG8_LDB(B0, 0, 0); PG8_LDB(B1, 0, 1); PG8_SCHED; PG8_LDA(At, 0, 0); if (STAGE1) PG8_STAGE(PG8_SA(1, 1), a1 + hstep, voffA); \
            PG8_WAIT_VN(W1); PG8_WAIT_L(0); PG8_BAR; PG8_MMA(0, 0, At, B0); PG8_MMA(0, 1, At, B1); PG8_BAR; PG8_SCHED; \
            PG8_LDA(At, 0, 1); PG8_STAGE(PG8_SB(0, 0), b2, voffB); PG8_STAGE(PG8_SB(0, 1), b2 + hstep, voffB); PG8_STAGE(PG8_SA(0, 0), a2, voffA); \
            PG8_WAIT_VN(W2); PG8_WAIT_L(0); PG8_BAR; PG8_MMA(1, 0, At, B0); PG8_MMA(1, 1, At, B1); PG8_BAR; PG8_SCHED; \
            PG8_LDB(B0, 1, 0); PG8_LDB(B1, 1, 1); PG8_SCHED; PG8_LDA(At, 1, 0); PG8_STAGE(PG8_SA(0, 1), a2 + hstep, voffA); \
            PG8_WAIT_VN(W3); PG8_WAIT_L(0); PG8_BAR; PG8_MMA(0, 0, At, B0); PG8_MMA(0, 1, At, B1); PG8_BAR; PG8_SCHED; \
            PG8_LDA(At, 1, 1); PG8_STAGE(PG8_SB(1, 0), b3, voffB); PG8_STAGE(PG8_SB(1, 1), b3 + hstep, voffB); PG8_STAGE(PG8_SA(1, 0), a3, voffA); \
            PG8_WAIT_VN(8); PG8_WAIT_L(0); PG8_BAR; PG8_MMA(1, 0, At, B0); PG8_MMA(1, 1, At, B1); PG8_BAR; PG8_SCHED;
        if constexpr (RELAX) {
            { const char* a1 = cA + kstep; const char* a2 = cA + 2 * kstep; const char* b2 = cB + 2 * kstep; const char* a3 = a2 + kstep; const char* b3 = b2 + kstep; (void)a1;
              PG8_SPTR(a2); PG8_SPTR(b2); PG8_SPTR(a3); PG8_SPTR(b3);
              PG8_BODY_SP2(8 + Epi::NST, 8 + Epi::NST, 8 + Epi::NST, false) }
            for (int t = 2; t < nt; t += 2) {
                const bool last = (t == nt - 2);
                const char* a1 = cA + (size_t)(t + 1) * kstep;
                const char* a2 = last ? nA : cA + (size_t)(t + 2) * kstep; const char* b2 = last ? nB : cB + (size_t)(t + 2) * kstep;
                const char* a3 = a2 + kstep; const char* b3 = b2 + kstep;
                if (last && has_next) S.a_ready(nxt);
                PG8_BODY_SP2(8, 8, 8, true)
            }
        } else
        for (int t = 0; t < nt; t += 2) {
            const bool last = (t == nt - 2);
            const char* a1 = cA + (size_t)(t + 1) * kstep;
            const char* a2 = last ? nA : cA + (size_t)(t + 2) * kstep; const char* b2 = last ? nB : cB + (size_t)(t + 2) * kstep;
            const char* a3 = a2 + kstep; const char* b3 = b2 + kstep;
            if (last && has_next) S.a_ready(nxt);
            if constexpr (SP2) {
            PG8_LDB(B0, 0, 0); PG8_LDB(B1, 0, 1); PG8_SCHED; PG8_LDA(At, 0, 0); PG8_STAGE(PG8_SA(1, 1), a1 + hstep, voffA);
            PG8_WAIT_V(8); PG8_WAIT_L(0); PG8_BAR; PG8_MMA(0, 0, At, B0); PG8_MMA(0, 1, At, B1); PG8_BAR; PG8_SCHED;
            PG8_LDA(At, 0, 1); PG8_STAGE(PG8_SB(0, 0), b2, voffB); PG8_STAGE(PG8_SB(0, 1), b2 + hstep, voffB); PG8_STAGE(PG8_SA(0, 0), a2, voffA);
            PG8_WAIT_V(8); PG8_WAIT_L(0); PG8_BAR; PG8_MMA(1, 0, At, B0); PG8_MMA(1, 1, At, B1); PG8_BAR; PG8_SCHED;
            PG8_LDB(B0, 1, 0); PG8_LDB(B1, 1, 1); PG8_SCHED; PG8_LDA(At, 1, 0); PG8_STAGE(PG8_SA(0, 1), a2 + hstep, voffA);
            PG8_WAIT_V(8); PG8_WAIT_L(0); PG8_BAR; PG8_MMA(0, 0, At, B0); PG8_MMA(0, 1, At, B1); PG8_BAR; PG8_SCHED;
            PG8_LDA(At, 1, 1); PG8_STAGE(PG8_SB(1, 0), b3, voffB); PG8_STAGE(PG8_SB(1, 1), b3 + hstep, voffB); PG8_STAGE(PG8_SA(1, 0), a3, voffA);
            PG8_WAIT_V(8); PG8_WAIT_L(0); PG8_BAR; PG8_MMA(1, 0, At, B0); PG8_MMA(1, 1, At, B1); PG8_BAR; PG8_SCHED;
            } else {
            PG8_LDB(B0, 0, 0); PG8_SCHED; PG8_LDA(At, 0, 0); PG8_STAGE(PG8_SA(1, 1), a1 + hstep, voffA);
            PG8_WAIT_L(8); PG8_BAR; PG8_WAIT_L(0); PG8_MMA(0, 0, At, B0); PG8_BAR; PG8_SCHED;
            PG8_LDB(B1, 0, 1); PG8_STAGE(PG8_SB(0, 0), b2, voffB);
            PG8_BAR; PG8_WAIT_L(0); PG8_MMA(0, 1, At, B1); PG8_BAR;
            PG8_LDA(At, 0, 1); PG8_STAGE(PG8_SA(0, 0), a2, voffA);
            PG8_BAR; PG8_WAIT_L(0); PG8_MMA(1, 0, At, B0); PG8_BAR; PG8_SCHED;
            PG8_STAGE(PG8_SB(0, 1), b2 + hstep, voffB);
            PG8_WAIT_V(6); PG8_BAR; PG8_MMA(1, 1, At, B1); PG8_BAR;
            PG8_LDB(B0, 1, 0); PG8_SCHED; PG8_LDA(At, 1, 0); PG8_STAGE(PG8_SA(0, 1), a2 + hstep, voffA);
            PG8_WAIT_L(8); PG8_BAR; PG8_WAIT_L(0); PG8_MMA(0, 0, At, B0); PG8_BAR; PG8_SCHED;
            PG8_LDB(B1, 1, 1); PG8_STAGE(PG8_SB(1, 0), b3, voffB);
            PG8_BAR; PG8_WAIT_L(0); PG8_MMA(0, 1, At, B1); PG8_BAR;
            PG8_LDA(At, 1, 1); PG8_STAGE(PG8_SA(1, 0), a3, voffA);
            PG8_BAR; PG8_WAIT_L(0); PG8_MMA(1, 0, At, B0); PG8_BAR; PG8_SCHED;
            PG8_STAGE(PG8_SB(1, 1), b3 + hstep, voffB);
            PG8_WAIT_V(6); PG8_BAR; PG8_MMA(1, 1, At, B1); PG8_BAR;
            }
        }
        if constexpr (ALIGN_EPI) { if (wr == 0) PG8_BAR; }
        if constexpr (RELAX) { if (has_next) { const char* ps = nA + kstep + hstep; PG8_SPTR(ps); PG8_STAGE(PG8_SA(1, 1), ps, voffA); } asm volatile("" ::: "memory"); }
        if constexpr (!Epi::AFTER_DRAIN) { int te = tid; asm volatile("" : "+v"(te)); E(acc, cur, wr, wc, te & 15, (te & 63) >> 4); S.done(cur); }
        if (!has_next) break;
#pragma unroll
        for (int a = 0; a < 2; ++a)
#pragma unroll
            for (int b = 0; b < 2; ++b)
#pragma unroll
                for (int m = 0; m < 4; ++m)
#pragma unroll
                    for (int n = 0; n < 2; ++n) acc[a][b][m][n] = (f32x4){0.f, 0.f, 0.f, 0.f};
        cur = nxt; cA = nA; cB = nB; ++ui;
        if constexpr (ALIGN_EPI) { if (wr == 1) PG8_BAR; }
    }
    PG8_WAIT_V(0);
    if constexpr (!ALIGN_EPI) { if (wr == 0) PG8_BAR; }
    PG8_BAR;
    if constexpr (Epi::AFTER_DRAIN) { E.fused(acc, cur, wr, wc, fr, fq, lds, wid, lane); S.done(cur); }
#undef PG8_SA
#undef PG8_SB
#undef PG8_STAGE
#undef PG8_LDA
#undef PG8_LDB
#undef PG8_MMA
#undef PG8_WAIT_V
#undef PG8_WAIT_L
#undef PG8_BAR
#undef PG8_SCHED
#undef PG8_BODY_SP2
#undef PG8_WAIT_VN
#undef PG8_SPTR
}
}

#define PG8_SP2 true
#ifndef REP_MODE
#define REP_MODE 1
#endif
#ifndef NSA_NAIVE
#define NSA_NAIVE 0
#endif
#ifndef REC_NAIVE
#define REC_NAIVE 0
#endif
#define PG8_ALIGN true

constexpr int NWAVES = 8, NT = NWAVES * 64;
constexpr int BATCH = 8, SEQ = 4096, D = 1024, DEPTH = 4, M = BATCH * SEQ;
constexpr int EVEN_IN = 3352, PE = 3584;
constexpr int PO = 4096;
constexpr int FF = 2816, FF2 = 2 * FF;
constexpr int C_RQ = 0, C_RK = 512, C_RV = 1024, C_RG = 1536, C_NQ = 2048, C_KC = 2560, C_VC = 2688, C_KS = 2816, C_VS = 2944, C_KW = 3072, C_VW = 3200, C_NG = 3328;
constexpr int C_HQ = 0, C_HF = 1024, C_HI = 2048, C_HG = 3072;
constexpr int NCMP = 255;
constexpr float RMS_EPS = 1e-6f;

constexpr size_t MiB = 1u << 20;
constexpr size_t WS_CTL = 0, CTL_ZERO_BYTES = 1 * MiB;
constexpr size_t WS_ROPE = 1 * MiB;
constexpr size_t WS_LB = 3 * MiB;
constexpr size_t WS_KCMP = 4 * MiB;
constexpr size_t WS_CBIAS = 3 * MiB + 16 * 1024;
constexpr size_t WS_W1T = 4 * MiB;
constexpr size_t WS_ROWSS = 5 * MiB;
constexpr size_t WS_SEL = 6 * MiB;
constexpr size_t WS_WEIN = 8 * MiB;
constexpr size_t WS_WEOUT = 22 * MiB;
constexpr size_t WS_WOIN = 26 * MiB;
constexpr size_t WS_WOOUT = 42 * MiB;
constexpr size_t WS_W13 = 46 * MiB;
constexpr size_t WS_W2 = 90 * MiB;
constexpr size_t WS_H = 112 * MiB;
constexpr size_t WS_PROJ = 176 * MiB;
constexpr size_t WS_MIXED = 432 * MiB;
constexpr size_t WS_KCB = 7 * MiB;
constexpr size_t WS_VCTB = 7 * MiB + 512 * 1024;
constexpr size_t WS_VT = 496 * MiB;
constexpr size_t WS_KT = 400 * MiB;
constexpr size_t WS_END = 512 * MiB;
constexpr int CW_BAR = 4096, CW_Q = 8192;

constexpr int RING_BYTES = 131072;
constexpr int LDSCTL_OFF = 146944, MISC_OFF = LDSCTL_OFF + 320;
constexpr int LDS_BYTES = 147456;

#define GAS __attribute__((address_space(1)))
#define LAS __attribute__((address_space(3)))
typedef unsigned short bf16;
typedef unsigned v4u __attribute__((ext_vector_type(4)));
typedef unsigned v2u __attribute__((ext_vector_type(2)));
typedef float f32x4 __attribute__((ext_vector_type(4)));
typedef float f32x2 __attribute__((ext_vector_type(2)));
typedef GAS unsigned gu32;
#define RLX_AGENT __ATOMIC_RELAXED, __HIP_MEMORY_SCOPE_AGENT
#define LDS_WAIT() asm volatile("s_waitcnt lgkmcnt(0)" ::: "memory")
#define VM_WAIT() asm volatile("s_waitcnt vmcnt(0)" ::: "memory")
__device__ __forceinline__ unsigned f2bf(float f) { unsigned u = __builtin_bit_cast(unsigned, f); return (u + 0x7fffu + ((u >> 16) & 1u)) >> 16; }
typedef float f32x2_t __attribute__((ext_vector_type(2)));
typedef __bf16 bf16x2_t __attribute__((ext_vector_type(2)));
__device__ __forceinline__ unsigned pk2(float lo, float hi) { f32x2_t v = {lo, hi}; bf16x2_t r = __builtin_convertvector(v, bf16x2_t); return __builtin_bit_cast(unsigned, r); }
__device__ __forceinline__ float bf2f(unsigned v) { return __builtin_bit_cast(float, v << 16); }
__device__ __forceinline__ float bflo(unsigned w) { return __builtin_bit_cast(float, w << 16); }
__device__ __forceinline__ float bfhi(unsigned w) { return __builtin_bit_cast(float, w & 0xffff0000u); }
__device__ __forceinline__ float sigmoidf_(float x) { return __builtin_amdgcn_rcpf(1.0f + __expf(-x)); }
__device__ __forceinline__ float siluf_(float x) { return x * __builtin_amdgcn_rcpf(1.0f + __expf(-x)); }

#define XB_TMO      128
#define XB_XCNT(j)  (256  + 64 * (j))
#define XB_XSUB(j)  (1280 + 64 * (j))
#define XB_XGEN(j)  (2304 + 64 * (j))
#define XB_TOP      3328
#define XB_TOPGEN   3392
#define XCD_BAR_WORDS 3456
#define XB_SPIN_CAP (1u << 18)
__device__ __forceinline__ unsigned xb_ld(unsigned* p)              { return __hip_atomic_load(p, __ATOMIC_RELAXED, __HIP_MEMORY_SCOPE_AGENT); }
__device__ __forceinline__ unsigned xb_add(unsigned* p, unsigned v) { return __hip_atomic_fetch_add(p, v, __ATOMIC_RELAXED, __HIP_MEMORY_SCOPE_AGENT); }
__device__ __forceinline__ unsigned xb_xcc_id() { return (unsigned)__builtin_amdgcn_s_getreg((3 << 11) | 20) & 0xFu; }
#define XB_SPIN(cond, bar) do { unsigned _sp = 0; while (cond) { __builtin_amdgcn_s_sleep(1); \
    if ((++_sp & 255u) == 0u) { if (xb_ld(&(bar)[XB_TMO])) break; if (_sp > XB_SPIN_CAP) { atomicAdd(&(bar)[XB_TMO], 1u); break; } } } } while (0)
struct XcdBarrier { unsigned* bar; unsigned x; volatile LAS unsigned* st; };
__device__ __forceinline__ XcdBarrier xcd_barrier_post(unsigned* bar, volatile LAS unsigned* st) {
    XcdBarrier b; b.bar = bar; b.x = xb_xcc_id(); b.st = st;
    if (threadIdx.x == 0) (void)xb_add(&bar[XB_XCNT(b.x)], 1u);
    return b;
}
__device__ __forceinline__ void xcd_barrier_complete(unsigned* bar, unsigned x, unsigned& nloc, unsigned& nx) {
    const unsigned G = gridDim.x * gridDim.y * gridDim.z;
    unsigned sum, cnt, mine, sp = 0u;
    for (;;) {
        sum = 0u; cnt = 0u; mine = 0u;
        size_t xz = 0; asm volatile("" : "+v"(xz)); unsigned* xc = &bar[XB_XCNT(0)] + xz;
#pragma unroll
        for (unsigned j = 0; j < 16; ++j) { const unsigned c = xb_ld(&xc[64 * j]); sum += c; cnt += (c > 0u) ? 1u : 0u; mine = (j == x) ? c : mine; }
        if (sum == G) break;
        __builtin_amdgcn_s_sleep(1);
        if ((++sp & 255u) == 0u) { if (xb_ld(&bar[XB_TMO])) break; if (sp > XB_SPIN_CAP) { atomicAdd(&bar[XB_TMO], 1u); break; } }
    }
    nloc = mine > 0u ? mine : 1u; nx = cnt > 0u ? cnt : 1u;
}
__device__ __forceinline__ void xcd_barrier(const XcdBarrier& b) {
    asm volatile("s_waitcnt vmcnt(0)" ::: "memory");
    __syncthreads();
    if (threadIdx.x == 0) {
        unsigned* bar = b.bar;
        __builtin_amdgcn_s_waitcnt(0);
        unsigned nloc = b.st[0], nx = b.st[1];
        if (nloc == 0u) { xcd_barrier_complete(bar, b.x, nloc, nx); b.st[0] = nloc; b.st[1] = nx; }
        const unsigned old = xb_add(&bar[XB_XSUB(b.x)], 1u);
        const unsigned gen = old / nloc;
        if (old + 1u == (gen + 1u) * nloc) {
            __builtin_amdgcn_fence(__ATOMIC_RELEASE, "agent");
            asm volatile("s_waitcnt vmcnt(0)" ::: "memory");
            const unsigned og = xb_add(&bar[XB_TOP], 1u);
            const unsigned tg = og / nx;
            if (og + 1u == (tg + 1u) * nx) xb_add(&bar[XB_TOPGEN], 1u);
            else XB_SPIN(xb_ld(&bar[XB_TOPGEN]) == tg, bar);
            __builtin_amdgcn_fence(__ATOMIC_ACQUIRE, "agent");
            xb_add(&bar[XB_XGEN(b.x)], 1u);
            asm volatile("s_waitcnt vmcnt(0)" ::: "memory");
        } else {
            XB_SPIN(xb_ld(&bar[XB_XGEN(b.x)]) == gen, bar);
            __builtin_amdgcn_fence(__ATOMIC_ACQUIRE, "agent");
            asm volatile("s_waitcnt vmcnt(0)" ::: "memory");
        }
    }
    __syncthreads();
}

__device__ __forceinline__ float wave_sum(float v) {
#pragma unroll
    for (int o = 1; o < 64; o <<= 1) v += __shfl_xor(v, o);
    return v;
}
__device__ __forceinline__ float wave_max(float v) {
#pragma unroll
    for (int o = 1; o < 64; o <<= 1) v = fmaxf(v, __shfl_xor(v, o));
    return v;
}

__device__ __forceinline__ int inproj_row(int rmode, int cs) {
    if (rmode == 1 && cs < 1024) { const int isk = cs >> 9, hd = (cs & 511) >> 7, ch = cs & 127, half = ch >> 6, i = ch & 63; return 256 * hd + 128 * isk + 32 * (i >> 4) + 8 * ((i >> 2) & 3) + 4 * half + (i & 3); }
    if (rmode == 2 && cs < 2048) { const int isf = cs >> 10, hd = (cs & 1023) >> 7, ch = cs & 127; return 256 * hd + 128 * isf + ch; }
    return cs;
}
__device__ __forceinline__ void tr_item64(const float* W, int K, int N, bf16* WT, int k0, int n0, int drow0, LAS unsigned* scr, int lane, const float* gain = nullptr, int rmode = 0) {
    const int q = lane >> 4, nl4 = 4 * (lane & 15); const bool ok = n0 + nl4 < N;
    const GAS float* src = (const GAS float*)W + (size_t)(k0 + 2 * q) * N + n0 + nl4;
    f32x4 v[16]; f32x2 g[8];
#pragma unroll
    for (int j = 0; j < 16; ++j) { const int kr = 8 * (j >> 1) + (j & 1); v[j] = ok ? *(const GAS f32x4*)(src + (size_t)kr * N) : (f32x4){0.f, 0.f, 0.f, 0.f}; }
#pragma unroll
    for (int i = 0; i < 8; ++i) g[i] = gain ? *(const GAS f32x2*)((const GAS float*)gain + k0 + 2 * q + 8 * i) : (f32x2){1.0f, 1.0f};
    __builtin_amdgcn_sched_barrier(0);
#pragma unroll
    for (int i = 0; i < 8; ++i) { const f32x4 a = v[2 * i] * g[i].x, b = v[2 * i + 1] * g[i].y; LAS unsigned* d = scr + (4 * i + q) * 66 + nl4;
        v2u w0; w0.x = pk2(a.x, b.x); w0.y = pk2(a.y, b.y); v2u w1; w1.x = pk2(a.z, b.z); w1.y = pk2(a.w, b.w);
        *(LAS v2u*)d = w0; *(LAS v2u*)(d + 2) = w1; }
    LDS_WAIT(); asm volatile("" ::: "memory");
    const int c = lane & 7;
#pragma unroll
    for (int jj = 0; jj < 8; ++jj) { const int n = (lane >> 3) + 8 * jj; const LAS unsigned* sp = scr + (4 * c) * 66 + n;
        v4u o; o.x = sp[0]; o.y = sp[66]; o.z = sp[132]; o.w = sp[198];
        *(GAS v4u*)(WT + (size_t)(rmode ? inproj_row(rmode, n0 + n) : drow0 + n) * K + k0 + 8 * c) = o; }
    LDS_WAIT(); asm volatile("" ::: "memory");
}
__device__ __forceinline__ void rms_row_to_bf16(const float* xrow, const float* g, bf16* orow, int lane) {
    const GAS f32x4* xr = (const GAS f32x4*)xrow + lane; const GAS f32x4* gr = (const GAS f32x4*)g + lane;
    f32x4 v[4]; float s = 0.f;
#pragma unroll
    for (int j = 0; j < 4; ++j) { v[j] = xr[64 * j]; s += (v[j].x * v[j].x + v[j].y * v[j].y) + (v[j].z * v[j].z + v[j].w * v[j].w); }
    const float r = 1.0f / sqrtf(wave_sum(s) * (1.f / D) + RMS_EPS);
    GAS v2u* o8 = (GAS v2u*)orow + lane;
#pragma unroll
    for (int j = 0; j < 4; ++j) { const f32x4 gg = gr[64 * j]; v2u w; w.x = pk2(v[j].x * r * gg.x, v[j].y * r * gg.y); w.y = pk2(v[j].z * r * gg.z, v[j].w * r * gg.w); o8[64 * j] = w; }
}
__device__ __forceinline__ void row_to_bf16_ss(const float* xrow, bf16* orow, float* rowss, int m, int lane) {
    const GAS f32x4* xr = (const GAS f32x4*)xrow + lane;
    f32x4 v[4]; float s = 0.f;
#pragma unroll
    for (int j = 0; j < 4; ++j) { v[j] = xr[64 * j]; s += (v[j].x * v[j].x + v[j].y * v[j].y) + (v[j].z * v[j].z + v[j].w * v[j].w); }
    s = wave_sum(s);
    GAS v2u* o8 = (GAS v2u*)orow + lane;
#pragma unroll
    for (int j = 0; j < 4; ++j) { v2u w; w.x = pk2(v[j].x, v[j].y); w.y = pk2(v[j].z, v[j].w); o8[64 * j] = w; }
    if (lane < 16) rowss[(size_t)lane * M + m] = lane == 0 ? s : 0.f;
}
__device__ __forceinline__ void rows2_to_bf16_ss(const float* xa, const float* xb, bf16* oa, bf16* ob, float* rowss, int ma, int mb, int lane) {
    const GAS f32x4* xr0 = (const GAS f32x4*)xa + lane; const GAS f32x4* xr1 = (const GAS f32x4*)xb + lane;
    f32x4 v[2][4]; float s0 = 0.f, s1 = 0.f;
#pragma unroll
    for (int j = 0; j < 4; ++j) { v[0][j] = xr0[64 * j]; v[1][j] = xr1[64 * j]; }
#pragma unroll
    for (int j = 0; j < 4; ++j) { s0 += (v[0][j].x * v[0][j].x + v[0][j].y * v[0][j].y) + (v[0][j].z * v[0][j].z + v[0][j].w * v[0][j].w); s1 += (v[1][j].x * v[1][j].x + v[1][j].y * v[1][j].y) + (v[1][j].z * v[1][j].z + v[1][j].w * v[1][j].w); }
#pragma unroll
    for (int o = 1; o < 64; o <<= 1) { s0 += __shfl_xor(s0, o); s1 += __shfl_xor(s1, o); }
    GAS v2u* o0 = (GAS v2u*)oa + lane; GAS v2u* o1 = (GAS v2u*)ob + lane;
#pragma unroll
    for (int j = 0; j < 4; ++j) { v2u w; w.x = pk2(v[0][j].x, v[0][j].y); w.y = pk2(v[0][j].z, v[0][j].w); o0[64 * j] = w; v2u w2; w2.x = pk2(v[1][j].x, v[1][j].y); w2.y = pk2(v[1][j].z, v[1][j].w); o1[64 * j] = w2; }
    if (lane < 16) { rowss[(size_t)lane * M + ma] = lane == 0 ? s0 : 0.f; rowss[(size_t)lane * M + mb] = lane == 0 ? s1 : 0.f; }
}
__device__ __forceinline__ void rms_row_bf16_to_f32(const bf16* xrow, const float* g, float* orow, int lane) {
    const GAS v4u* xr = (const GAS v4u*)xrow + lane; const GAS f32x4* gr = (const GAS f32x4*)g + 2 * lane;
    v4u w[2]; float v[2][8]; float s = 0.f;
#pragma unroll
    for (int j = 0; j < 2; ++j) { w[j] = xr[64 * j]; const unsigned ww[4] = {w[j].x, w[j].y, w[j].z, w[j].w};
#pragma unroll
        for (int k = 0; k < 4; ++k) { v[j][2 * k] = bflo(ww[k]); v[j][2 * k + 1] = bfhi(ww[k]); s += v[j][2 * k] * v[j][2 * k] + v[j][2 * k + 1] * v[j][2 * k + 1]; } }
    const float r = __builtin_amdgcn_rsqf(wave_sum(s) * (1.f / D) + RMS_EPS);
    GAS f32x4* o = (GAS f32x4*)orow + 2 * lane;
#pragma unroll
    for (int j = 0; j < 2; ++j) { const f32x4 g0 = gr[128 * j], g1 = gr[128 * j + 1];
        o[128 * j] = (f32x4){v[j][0] * r * g0.x, v[j][1] * r * g0.y, v[j][2] * r * g0.z, v[j][3] * r * g0.w}; o[128 * j + 1] = (f32x4){v[j][4] * r * g1.x, v[j][5] * r * g1.y, v[j][6] * r * g1.z, v[j][7] * r * g1.w}; }
}
__device__ __forceinline__ void rms_row_to_f32(float* xrow, const float* g, int lane) {
    GAS f32x4* xr = (GAS f32x4*)xrow + lane; const GAS f32x4* gr = (const GAS f32x4*)g + lane;
    f32x4 v[4]; float s = 0.f;
#pragma unroll
    for (int j = 0; j < 4; ++j) { v[j] = xr[64 * j]; s += (v[j].x * v[j].x + v[j].y * v[j].y) + (v[j].z * v[j].z + v[j].w * v[j].w); }
    const float r = 1.0f / sqrtf(wave_sum(s) * (1.f / D) + RMS_EPS);
#pragma unroll
    for (int j = 0; j < 4; ++j) { const f32x4 gg = gr[64 * j]; xr[64 * j] = (f32x4){v[j].x * r * gg.x, v[j].y * r * gg.y, v[j].z * r * gg.z, v[j].w * r * gg.w}; }
}

__device__ __forceinline__ void convert_weights(const float* const* in, unsigned char* ws, int half, LAS unsigned* scr, int w0, int nw, int lane) {
    constexpr int I_EIN = 16 * 56, I_SQ = 16 * 16, I_OIN = 16 * 64, I_W1 = 16 * 44, I_W2 = 44 * 16;
    constexpr int NITEMS = I_EIN + I_SQ + I_OIN + I_SQ + 2 * I_W1 + 2 * I_W1 + 2 * I_W2;
    const int j = half;
    for (int it = w0; it < NITEMS; it += nw) {
        int r = it;
        if (r < I_EIN) { tr_item64(in[4] + (size_t)j * D * EVEN_IN, D, EVEN_IN, (bf16*)(ws + WS_WEIN) + (size_t)j * PE * D, (r / 56) * 64, (r % 56) * 64, (r % 56) * 64, scr, lane, in[1] + (size_t)(2 * j) * D, 1); continue; } r -= I_EIN;
        if (r < I_SQ) { tr_item64(in[5] + (size_t)j * D * D, D, D, (bf16*)(ws + WS_WEOUT) + (size_t)j * D * D, (r / 16) * 64, (r % 16) * 64, (r % 16) * 64, scr, lane); continue; } r -= I_SQ;
        if (r < I_OIN) { tr_item64(in[12] + (size_t)j * D * PO, D, PO, (bf16*)(ws + WS_WOIN) + (size_t)j * PO * D, (r / 64) * 64, (r % 64) * 64, (r % 64) * 64, scr, lane, in[1] + (size_t)(2 * j + 1) * D, 2); continue; } r -= I_OIN;
        if (r < I_SQ) { tr_item64(in[13] + (size_t)j * D * D, D, D, (bf16*)(ws + WS_WOOUT) + (size_t)j * D * D, (r / 16) * 64, (r % 16) * 64, (r % 16) * 64, scr, lane); continue; } r -= I_SQ;
        if (r < 4 * I_W1) { const int which = r / (2 * I_W1); r %= 2 * I_W1; const int l = 2 * half + r / I_W1; r %= I_W1; const int n0 = (r % 44) * 64;
            tr_item64(in[which ? 17 : 16] + (size_t)l * D * FF, D, FF, (bf16*)(ws + WS_W13) + (size_t)l * FF2 * D, (r / 44) * 64, n0, 256 * (n0 / 128) + (n0 % 128) + 128 * which, scr, lane, in[2] + (size_t)l * D); continue; } r -= 4 * I_W1;
        { const int l = 2 * half + r / I_W2; r %= I_W2; tr_item64(in[18] + (size_t)l * FF * D, FF, D, (bf16*)(ws + WS_W2) + (size_t)l * D * FF, (r / 16) * 64, (r % 16) * 64, (r % 16) * 64, scr, lane); }
    }
}

constexpr int RS_TBL_OFF = RING_BYTES, RS_TAB_OFF = RING_BYTES + 1024;
template <class Sched>
__device__ __forceinline__ void build_rstd_table(LAS unsigned char* lds, const Sched& S, const float* rowss, int tid) {
    LAS int* tbl = (LAS int*)(lds + RS_TBL_OFF); LAS float* rsl = (LAS float*)(lds + RS_TAB_OFF); LAS int* spm = tbl + 128;
    if (tid < 16) { pg8::Unit u; const bool ok = tid < 14 && S.next(tid, u); spm[tid] = ok ? u.pm : -1; if (ok) tbl[u.pm] = tid; }
    __syncthreads();
#pragma unroll 1
    for (int sl = tid >> 8; sl < 14; sl += 2) { const int pm = spm[sl]; if (pm < 0) break;
        const int row = pm * 256 + (tid & 255); float p[16];
#pragma unroll
        for (int pl = 0; pl < 16; ++pl) p[pl] = rowss[(size_t)pl * M + row];
        float q = 0.f;
#pragma unroll
        for (int pl = 0; pl < 16; ++pl) q += p[pl];
        rsl[sl * 256 + (tid & 255)] = __builtin_amdgcn_rsqf(q * (1.0f / 1024.0f) + RMS_EPS); }
    __syncthreads();
}

template <int MODE>
__device__ __forceinline__ void recur_unit(LAS unsigned char* lds, int b, int hd, const bf16* proj, int ldp, const float2* rope, const float* lb, const float* ng, bf16* mixed, int tid, int lane, int wave) {
    LAS float* sq = (LAS float*)lds;
    LAS float* sk = sq + 2048;
    LAS float* sv = sk + 2048;
    LAS float* so = sv + 2048;
    LAS float* sf = so + 2048;
    const int e = tid >> 2, ds = tid & 3;
    float S[32];
#pragma unroll
    for (int i = 0; i < 32; ++i) S[i] = 0.f;
    const float gamma = 1.0f - exp2f(-5.0f - (float)hd);
    for (int blk = 0; blk < SEQ / 16; ++blk) {
        {
            const int tt = tid >> 5, ii = tid & 31; const int pos = blk * 16 + tt; const size_t row = (size_t)(b * SEQ + pos) * ldp;
            if (MODE == 0) {
#pragma unroll
                for (int h2 = 0; h2 < 2; ++h2) { const int i = ii + 32 * h2; const float2 cs = rope[pos * 64 + i];
                    const float q1 = bf2f(proj[row + C_RQ + hd * 128 + i]), q2 = bf2f(proj[row + C_RQ + hd * 128 + i + 64]);
                    const float k1 = bf2f(proj[row + C_RK + hd * 128 + i]), k2 = bf2f(proj[row + C_RK + hd * 128 + i + 64]);
                    sq[tt * 128 + i] = q1 * cs.x - q2 * cs.y; sq[tt * 128 + i + 64] = q1 * cs.y + q2 * cs.x;
                    sk[tt * 128 + i] = (k1 * cs.x - k2 * cs.y) * 0.08838834764831845f; sk[tt * 128 + i + 64] = (k1 * cs.y + k2 * cs.x) * 0.08838834764831845f; }
#pragma unroll
                for (int h4 = 0; h4 < 4; ++h4) sv[tt * 128 + ii + 32 * h4] = bf2f(proj[row + C_RV + hd * 128 + ii + 32 * h4]);
            } else {
#pragma unroll
                for (int h4 = 0; h4 < 4; ++h4) { const int d = ii + 32 * h4; const float qp = bf2f(proj[row + C_HQ + hd * 128 + d]), fp = bf2f(proj[row + C_HF + hd * 128 + d]);
                    const float l = lb[hd * 128 + d]; const float sg = sigmoidf_(fp);
                    sq[tt * 128 + d] = siluf_(qp) * 0.08838834764831845f; sf[tt * 128 + d] = l + (1.0f - l) * sg; sk[tt * 128 + d] = (1.0f - l) * (1.0f - sg);
                    sv[tt * 128 + d] = bf2f(proj[row + C_HI + hd * 128 + d]); }
            }
        }
        __syncthreads();
#pragma unroll 1
        for (int tt = 0; tt < 16; ++tt) {
            const float ve = sv[tt * 128 + e]; float po = 0.f;
#pragma unroll
            for (int i4 = 0; i4 < 8; ++i4) {
                const f32x4 q4 = *(const LAS f32x4*)(sq + tt * 128 + ds * 32 + i4 * 4), k4 = *(const LAS f32x4*)(sk + tt * 128 + ds * 32 + i4 * 4);
                f32x4 f4; if (MODE == 1) f4 = *(const LAS f32x4*)(sf + tt * 128 + ds * 32 + i4 * 4); else f4 = (f32x4){gamma, gamma, gamma, gamma};
                S[i4 * 4 + 0] = f4.x * S[i4 * 4 + 0] + k4.x * ve; po += q4.x * S[i4 * 4 + 0];
                S[i4 * 4 + 1] = f4.y * S[i4 * 4 + 1] + k4.y * ve; po += q4.y * S[i4 * 4 + 1];
                S[i4 * 4 + 2] = f4.z * S[i4 * 4 + 2] + k4.z * ve; po += q4.z * S[i4 * 4 + 2];
                S[i4 * 4 + 3] = f4.w * S[i4 * 4 + 3] + k4.w * ve; po += q4.w * S[i4 * 4 + 3];
            }
            po += __shfl_xor(po, 1); po += __shfl_xor(po, 2);
            if (ds == 0) so[tt * 128 + e] = po;
        }
        __syncthreads();
        {
#pragma unroll
            for (int r = 0; r < 2; ++r) { const int tt = wave * 2 + r; const int pos = blk * 16 + tt; const size_t trow = (size_t)(b * SEQ + pos);
                const float o0 = so[tt * 128 + lane], o1 = so[tt * 128 + lane + 64];
                float y0, y1;
                if (MODE == 0) {
                    const float mu = wave_sum(o0 + o1) * (1.f / 128.f); const float d0 = o0 - mu, d1 = o1 - mu;
                    const float var = wave_sum(d0 * d0 + d1 * d1) * (1.f / 128.f); const float rs = 1.0f / sqrtf(var + 1e-5f);
                    y0 = d0 * rs * siluf_(bf2f(proj[trow * ldp + C_RG + hd * 128 + lane])); y1 = d1 * rs * siluf_(bf2f(proj[trow * ldp + C_RG + hd * 128 + lane + 64]));
                } else {
                    const float ms = wave_sum(o0 * o0 + o1 * o1) * (1.f / 128.f); const float rs = 1.0f / sqrtf(ms + RMS_EPS);
                    y0 = o0 * rs * ng[lane] * sigmoidf_(bf2f(proj[trow * ldp + C_HG + hd * 128 + lane])); y1 = o1 * rs * ng[lane + 64] * sigmoidf_(bf2f(proj[trow * ldp + C_HG + hd * 128 + lane + 64]));
                }
                mixed[trow * D + hd * 128 + lane] = (bf16)f2bf(y0); mixed[trow * D + hd * 128 + lane + 64] = (bf16)f2bf(y1); }
        }
    }
    __syncthreads();
}

__device__ __forceinline__ float gelu_tanh(float x) { const float u = 0.7978845608028654f * (x + 0.044715f * x * x * x); const float t = 1.0f - 2.0f / (__expf(2.0f * u) + 1.0f); return 0.5f * x * (1.0f + t); }

__device__ __forceinline__ void compress_task(LAS float* xs  , int task, const bf16* proj, const float* pos_k, const float* w1_k, const float* w2_k, const float* pos_v, const float* w1_v, const float* w2_v, float* kcmp, bf16* kcb, bf16* vctb, int lane) {
    const int kv = task / (16 * NCMP); const int rem = task % (16 * NCMP); const int bg = rem / NCMP, i = rem % NCMP; const int b = bg >> 1, g = bg & 1;
    const float* pos = kv ? pos_v : pos_k; const float* w1 = kv ? w1_v : w1_k; const float* w2 = kv ? w2_v : w2_k;
    const int col = (kv ? C_VC : C_KC) + 64 * g + lane;
#pragma unroll 4
    for (int l = 0; l < 32; ++l) xs[l * 64 + lane] = bf2f(proj[(size_t)(b * SEQ + 16 * i + l) * PE + col]) + pos[l * 64 + lane];
    LDS_WAIT(); asm volatile("" ::: "memory");
    float pre = 0.f;
#pragma unroll 4
    for (int k = 0; k < 2048; k += 4) { const f32x4 a = *(const LAS f32x4*)(xs + k);
        pre += a.x * w1[(k + 0) * 64 + lane]; pre += a.y * w1[(k + 1) * 64 + lane]; pre += a.z * w1[(k + 2) * 64 + lane]; pre += a.w * w1[(k + 3) * 64 + lane]; }
    xs[2048 + lane] = gelu_tanh(pre);
    LDS_WAIT(); asm volatile("" ::: "memory");
    float o = 0.f;
#pragma unroll 4
    for (int c = 0; c < 64; c += 4) { const f32x4 a = *(const LAS f32x4*)(xs + 2048 + c);
        o += a.x * w2[(c + 0) * 64 + lane]; o += a.y * w2[(c + 1) * 64 + lane]; o += a.z * w2[(c + 2) * 64 + lane]; o += a.w * w2[(c + 3) * 64 + lane]; }
    kcmp[((size_t)(kv * 16 + bg) * 256 + i) * 64 + lane] = o;
    (kv == 0 ? kcb : vctb)[((size_t)bg * 256 + i) * 64 + lane] = (bf16)f2bf(o);
    LDS_WAIT(); asm volatile("" ::: "memory");
}

__device__ __forceinline__ void cmp_attn_task(LAS float* wl  , int task, const bf16* proj, const float* kcmp, float* accn, unsigned long long* sel, int lane) {
    LAS float* q4 = wl; LAS float* pl = wl + 256; LAS float* cs = wl + 512;
    const int bg = task >> 12, t = task & 4095; const int b = bg >> 1, g = bg & 1; const size_t trow = (size_t)(b * SEQ + t);
    const float* kc = kcmp + (size_t)bg * 256 * 64; const float* vc = kcmp + (size_t)(16 + bg) * 256 * 64;
#pragma unroll
    for (int hh = 0; hh < 4; ++hh) q4[hh * 64 + lane] = bf2f(proj[trow * PE + C_NQ + (g * 4 + hh) * 64 + lane]) * 0.125f;
    const int nvalid = t >= 31 ? (((t - 31) >> 4) + 1 > NCMP ? NCMP : ((t - 31) >> 4) + 1) : 0;
    float c4[4] = {0.f, 0.f, 0.f, 0.f};
    LDS_WAIT(); asm volatile("" ::: "memory");
#pragma unroll 1
    for (int hh = 0; hh < 4; ++hh) {
        float s4[4]; float mx = -INFINITY;
#pragma unroll
        for (int r = 0; r < 4; ++r) { const int n = lane + 64 * r; float s = -INFINITY;
            if (64 * r < nvalid) { if (n < nvalid) { float a = 0.f; const GAS f32x4* kr = (const GAS f32x4*)(kc + (size_t)n * 64);
#pragma unroll 4
                    for (int c = 0; c < 16; ++c) { const f32x4 kk = kr[c]; const f32x4 qq = *(const LAS f32x4*)(q4 + hh * 64 + c * 4); a += kk.x * qq.x + kk.y * qq.y + kk.z * qq.z + kk.w * qq.w; }
                    s = a; } }
            s4[r] = s; mx = fmaxf(mx, s); }
        mx = wave_max(mx); if (!(mx > -INFINITY)) mx = 0.f;
        float sum = 0.f;
#pragma unroll
        for (int r = 0; r < 4; ++r) { s4[r] = (s4[r] > -INFINITY) ? __expf(s4[r] - mx) : 0.f; sum += s4[r]; }
        sum = wave_sum(sum); const float inv = 1.0f / fmaxf(sum, 1e-30f);
#pragma unroll
        for (int r = 0; r < 4; ++r) { s4[r] *= inv; c4[r] += s4[r]; pl[lane + 64 * r] = s4[r]; }
        LDS_WAIT(); asm volatile("" ::: "memory");
        float o = 0.f;
        for (int n = 0; n < nvalid; ++n) o += pl[n] * vc[(size_t)n * 64 + lane];
        const float gate = sigmoidf_(bf2f(proj[trow * PE + C_NG + 0 * 8 + g * 4 + hh]));
        accn[trow * 512 + (g * 4 + hh) * 64 + lane] = gate * o;
        LDS_WAIT(); asm volatile("" ::: "memory");
    }
#pragma unroll
    for (int r = 0; r < 4; ++r) cs[lane + 64 * r] = c4[r];
    LDS_WAIT(); asm volatile("" ::: "memory");
    float imp = 0.f;
#pragma unroll
    for (int dn = -1; dn <= 3; ++dn) { const int n = 4 * lane + dn; if (n >= 0 && n < NCMP) imp += cs[n]; }
    const int bt = t >> 6; const bool valid = lane <= bt; const bool forced = (lane == 0) || (bt - lane >= 0 && bt - lane < 2);
    float score = valid ? imp + (forced ? 1.0e4f : 0.f) : -1e30f;
    unsigned long long mask = 0ull;
#pragma unroll 1
    for (int k = 0; k < 8; ++k) { const float mv = wave_max(score); const unsigned long long bal = __ballot(score == mv); const int j = __ffsll((long long)bal) - 1; mask |= 1ull << j; if (lane == j) score = -INFINITY; }
    if (lane == 0) sel[(size_t)bg * SEQ + t] = mask;
    LDS_WAIT(); asm volatile("" ::: "memory");
}

template <int MODE>
__device__ __forceinline__ void blk_attn_task(LAS float* wl  , int task, const bf16* proj, const unsigned long long* sel, float* accn, bf16* mixed, int lane) {
    LAS float* q4 = wl; LAS float* p4 = wl + 256;
    const int bg = task >> 12, t = task & 4095; const int b = bg >> 1, g = bg & 1; const size_t trow = (size_t)(b * SEQ + t);
    const int kcol = (MODE == 0 ? C_KS : C_KW) + 64 * g, vcol = (MODE == 0 ? C_VS : C_VW) + 64 * g;
#pragma unroll
    for (int hh = 0; hh < 4; ++hh) q4[hh * 64 + lane] = bf2f(proj[trow * PE + C_NQ + (g * 4 + hh) * 64 + lane]) * 0.125f;
    LDS_WAIT(); asm volatile("" ::: "memory");
    const int bt = t >> 6;
    unsigned long long todo;
    if (MODE == 0) { todo = sel[(size_t)bg * SEQ + t]; todo &= (bt >= 63) ? ~0ull : ((1ull << (bt + 1)) - 1ull); }
    else { const int lo = (t - 511) > 0 ? ((t - 511) >> 6) : 0; todo = ((bt >= 63) ? ~0ull : ((1ull << (bt + 1)) - 1ull)) & ~((1ull << lo) - 1ull); }
    float m4[4] = {-INFINITY, -INFINITY, -INFINITY, -INFINITY}, l4[4] = {0.f, 0.f, 0.f, 0.f}, o4[4] = {0.f, 0.f, 0.f, 0.f};
    while (todo) {
        const int j = __ffsll((long long)todo) - 1; todo &= todo - 1ull;
        const int pos = 64 * j + lane; const bool valid = (pos <= t) && (MODE == 0 || (t - pos) < 512);
        const GAS v4u* kr = (const GAS v4u*)(proj + (size_t)(b * SEQ + pos) * PE + kcol);
        v4u kk[8];
#pragma unroll
        for (int c = 0; c < 8; ++c) kk[c] = kr[c];
#pragma unroll
        for (int hh = 0; hh < 4; ++hh) { float a = 0.f;
#pragma unroll
            for (int c = 0; c < 8; ++c) { const f32x4 qa = *(const LAS f32x4*)(q4 + hh * 64 + c * 8), qb = *(const LAS f32x4*)(q4 + hh * 64 + c * 8 + 4);
                a += bflo(kk[c].x) * qa.x + bfhi(kk[c].x) * qa.y + bflo(kk[c].y) * qa.z + bfhi(kk[c].y) * qa.w + bflo(kk[c].z) * qb.x + bfhi(kk[c].z) * qb.y + bflo(kk[c].w) * qb.z + bfhi(kk[c].w) * qb.w; }
            const float s = valid ? a : -INFINITY;
            const float mn = fmaxf(m4[hh], wave_max(s));
            const float sc = __expf(m4[hh] - mn); const float p = valid ? __expf(s - mn) : 0.f;
            l4[hh] = l4[hh] * sc + wave_sum(p); o4[hh] *= sc; m4[hh] = mn; p4[hh * 64 + lane] = p; }
        LDS_WAIT(); asm volatile("" ::: "memory");
        const bf16* vr = proj + (size_t)(b * SEQ + 64 * j) * PE + vcol + lane;
#pragma unroll 4
        for (int k4 = 0; k4 < 64; k4 += 4) {
            const float v0 = bf2f(vr[(size_t)(k4 + 0) * PE]), v1 = bf2f(vr[(size_t)(k4 + 1) * PE]), v2 = bf2f(vr[(size_t)(k4 + 2) * PE]), v3 = bf2f(vr[(size_t)(k4 + 3) * PE]);
#pragma unroll
            for (int hh = 0; hh < 4; ++hh) { const f32x4 pp = *(const LAS f32x4*)(p4 + hh * 64 + k4); o4[hh] += pp.x * v0 + pp.y * v1 + pp.z * v2 + pp.w * v3; }
        }
        LDS_WAIT(); asm volatile("" ::: "memory");
    }
#pragma unroll
    for (int hh = 0; hh < 4; ++hh) { const float gate = sigmoidf_(bf2f(proj[trow * PE + C_NG + (MODE == 0 ? 1 : 2) * 8 + g * 4 + hh])); const float o = gate * o4[hh] / l4[hh];
        const size_t idx = trow * 512 + (g * 4 + hh) * 64 + lane;
        if (MODE == 0) accn[idx] += o; else mixed[trow * D + 512 + (g * 4 + hh) * 64 + lane] = (bf16)f2bf(accn[idx] + o); }
}


typedef float f32x16 __attribute__((ext_vector_type(16)));
typedef short s16x8 __attribute__((ext_vector_type(8)));
typedef short s16x4 __attribute__((ext_vector_type(4)));
constexpr int A_KC = 0;
constexpr int A_VCT = 36864;
constexpr int A_K0 = 71168;
constexpr int A_V0 = 89600;
constexpr int A_OT = 107008;
constexpr int A_KSTRIDE = 9216, A_VSTRIDE = 8704;
#define EXP2(x) __builtin_amdgcn_exp2f(x)
constexpr float SM_C = 0.125f * 1.4426950408889634f;
constexpr float LAZY_TAU = 5.0f;

__device__ __forceinline__ unsigned cvtpk(float lo, float hi) { f32x2_t v = {lo, hi}; bf16x2_t b = __builtin_convertvector(v, bf16x2_t); return __builtin_bit_cast(unsigned, b); }
__device__ __forceinline__ s16x8 pack8(const f32x16& p, int o) {
    v4u w; w.x = cvtpk(p[o + 0], p[o + 1]); w.y = cvtpk(p[o + 2], p[o + 3]); w.z = cvtpk(p[o + 4], p[o + 5]); w.w = cvtpk(p[o + 6], p[o + 7]);
    return __builtin_bit_cast(s16x8, w);
}
__device__ __forceinline__ s16x8 lds_a128(const LAS unsigned char* p) { return *(const LAS s16x8*)p; }
__device__ __forceinline__ s16x8 lds_a64x2(const LAS unsigned char* p) {
    const v2u lo = *(const LAS v2u*)p, hi = *(const LAS v2u*)(p + 16); v4u w; w.x = lo.x; w.y = lo.y; w.z = hi.x; w.w = hi.y; return __builtin_bit_cast(s16x8, w);
}
#define MFMA32(a, b, c) __builtin_amdgcn_mfma_f32_32x32x16_bf16((a), (b), (c), 0, 0, 0)
constexpr int rowc(int r) { return (r & 3) + 8 * (r >> 2); }

template <int MASKED>
__device__ __forceinline__ void attn_block_rf(const s16x8 (&kf)[4][2], const s16x8 (&vf)[2][4], const s16x8 (&qf)[4], int h, int key0, int klo, int khi, bool en, float& m, float& l, f32x16 (&O)[2]) {
    f32x16 s0, s1;
#pragma unroll
    for (int i = 0; i < 16; ++i) { s0[i] = 0.f; s1[i] = 0.f; }
#pragma unroll
    for (int ks = 0; ks < 4; ++ks) { s0 = MFMA32(kf[ks][0], qf[ks], s0); s1 = MFMA32(kf[ks][1], qf[ks], s1); }
    if (MASKED == 1) {
        const int lo0 = klo - key0 - 4 * h, hi0 = khi - key0 - 4 * h;
#pragma unroll
        for (int i = 0; i < 16; ++i) { const int c = rowc(i);
            s0[i] = (en && c >= lo0 && c <= hi0) ? s0[i] : -INFINITY; s1[i] = (en && c + 32 >= lo0 && c + 32 <= hi0) ? s1[i] : -INFINITY; }
    }
    float mx = -INFINITY;
#pragma unroll
    for (int i = 0; i < 16; ++i) { mx = __builtin_elementwise_max(mx, s0[i]); mx = __builtin_elementwise_max(mx, s1[i]); }
    if (MASKED == 2) mx = en ? mx : -INFINITY;
    mx = __builtin_elementwise_max(mx, __shfl_xor(mx, 32));
    if (__builtin_amdgcn_ballot_w64((mx - m) * SM_C > LAZY_TAU) != 0ull) {
        const float mn = __builtin_elementwise_max(m, mx);
        const float alpha = EXP2((m - mn) * SM_C); m = mn; l *= alpha;
#pragma unroll
        for (int i = 0; i < 16; ++i) { O[0][i] *= alpha; O[1][i] *= alpha; }
    }
    const float mc = (MASKED == 2 && !en) ? INFINITY : m * SM_C;
    float ls = 0.f;
#pragma unroll
    for (int i = 0; i < 16; ++i) { s0[i] = EXP2(fmaf(s0[i], SM_C, -mc)); s1[i] = EXP2(fmaf(s1[i], SM_C, -mc)); ls += s0[i] + s1[i]; }
    l += ls;
    const s16x8 p00 = pack8(s0, 0), p01 = pack8(s0, 8), p10 = pack8(s1, 0), p11 = pack8(s1, 8);
#pragma unroll
    for (int dt = 0; dt < 2; ++dt) { O[dt] = MFMA32(vf[dt][0], p00, O[dt]); O[dt] = MFMA32(vf[dt][1], p01, O[dt]); O[dt] = MFMA32(vf[dt][2], p10, O[dt]); O[dt] = MFMA32(vf[dt][3], p11, O[dt]); }
}
__device__ __forceinline__ void nsa_load_k(const bf16* Kt, int bgx, int j, int lane, s16x8 (&kf)[4][2]) {
    const GAS v4u* p = (const GAS v4u*)(Kt + ((size_t)bgx * 64 + j) * 4096) + lane;
#pragma unroll
    for (int ks = 0; ks < 4; ++ks) { kf[ks][0] = __builtin_bit_cast(s16x8, p[(ks * 2 + 0) * 64]); kf[ks][1] = __builtin_bit_cast(s16x8, p[(ks * 2 + 1) * 64]); }
}
__device__ __forceinline__ void nsa_load_v(const bf16* Vt, int bgx, int j, int lane, s16x8 (&vf)[2][4]) {
    const GAS v4u* p = (const GAS v4u*)(Vt + ((size_t)bgx * 64 + j) * 4096) + lane;
#pragma unroll
    for (int dt = 0; dt < 2; ++dt)
#pragma unroll
        for (int kk = 0; kk < 4; ++kk) vf[dt][kk] = __builtin_bit_cast(s16x8, p[(dt * 4 + kk) * 64]);
}

__device__ __forceinline__ void nsa_subunit(LAS unsigned char* lds, int bg, int qt, const bf16* proj, const bf16* kcb, const bf16* vctb, const bf16* Kt, const bf16* Vt, bf16* mixed, int tid_in, int wave) {
    int tid = tid_in; asm volatile("" : "+v"(tid)); const int lane = tid & 63;
    const int b = bg >> 1, g = bg & 1; const int t0 = qt * 64, bt = qt;
    const int r32 = lane & 31, h = lane >> 5, head = r32 >> 3, ql = lane & 7;
    const int t = t0 + 8 * wave + ql; const size_t trow = (size_t)(b * SEQ + t);
    {
        const bf16* ksrc = kcb + (size_t)bg * 256 * 64; const bf16* vsrc = vctb + (size_t)bg * 256 * 64;
#pragma unroll
        for (int i = 0; i < 4; ++i) { const int p = tid + i * NT;
            { const int row = p >> 3, c = p & 7; const v4u v = *(const GAS v4u*)(ksrc + row * 64 + 8 * c); *(LAS v4u*)(lds + A_KC + row * 144 + 16 * c) = v; }
            { const int n = p >> 3, c = p & 7; const v4u v = *(const GAS v4u*)(vsrc + n * 64 + 8 * c); LAS unsigned short* d = (LAS unsigned short*)(lds + A_VCT + (8 * c) * 536 + n * 2);
              d[0 * 268] = (unsigned short)(v.x & 0xffffu); d[1 * 268] = (unsigned short)(v.x >> 16); d[2 * 268] = (unsigned short)(v.y & 0xffffu); d[3 * 268] = (unsigned short)(v.y >> 16);
              d[4 * 268] = (unsigned short)(v.z & 0xffffu); d[5 * 268] = (unsigned short)(v.z >> 16); d[6 * 268] = (unsigned short)(v.w & 0xffffu); d[7 * 268] = (unsigned short)(v.w >> 16); } }
    }
    s16x8 qf[4];
    { const bf16* qp = proj + trow * PE + C_NQ + (g * 4 + head) * 64 + 8 * h;
#pragma unroll
      for (int ks = 0; ks < 4; ++ks) qf[ks] = __builtin_bit_cast(s16x8, *(const GAS v4u*)(qp + 16 * ks)); }
    __syncthreads();
    f32x16 OT[2];
#pragma unroll
    for (int i = 0; i < 16; ++i) { OT[0][i] = 0.f; OT[1][i] = 0.f; }
    unsigned long long selmask;
    {
        const int nmax = t >= 31 ? ((t - 31) >> 4) : -1;
        const int ntile = ((t0 + 63 - 31) >= 0) ? ((((t0 + 63 - 31) >> 4) + 1 + 31) >> 5) : 0;
        float m = -3.0e38f, l = 0.f;
        float imp[32];
#pragma unroll
        for (int k = 0; k < 32; ++k) imp[k] = 0.f;
        float carry = 0.f;
#pragma unroll
        for (int T = 0; T < 8; ++T) if (T < ntile) {
            f32x16 s;
#pragma unroll
            for (int i = 0; i < 16; ++i) s[i] = 0.f;
#pragma unroll
            for (int ks = 0; ks < 4; ++ks) s = MFMA32(lds_a128(lds + A_KC + (32 * T + r32) * 144 + (16 * ks + 8 * h) * 2), qf[ks], s);
            const int lim = nmax - 32 * T - 4 * h; float mx = -INFINITY;
#pragma unroll
            for (int i = 0; i < 16; ++i) { s[i] = (rowc(i) <= lim) ? s[i] : -INFINITY; mx = __builtin_elementwise_max(mx, s[i]); }
            mx = __builtin_elementwise_max(mx, __shfl_xor(mx, 32));
            if (__builtin_amdgcn_ballot_w64((mx - m) * SM_C > LAZY_TAU) != 0ull) {
                const float mn = __builtin_elementwise_max(m, mx); const float alpha = EXP2((m - mn) * SM_C); m = mn; l *= alpha; carry *= alpha;
#pragma unroll
                for (int k = 0; k < 4 * T; ++k) imp[k] *= alpha;
#pragma unroll
                for (int i = 0; i < 16; ++i) { OT[0][i] *= alpha; OT[1][i] *= alpha; }
            }
            const float mc = m * SM_C; float ls = 0.f;
#pragma unroll
            for (int i = 0; i < 16; ++i) { s[i] = EXP2(fmaf(s[i], SM_C, -mc)); ls += s[i]; }
            l += ls;
            float Gs[4], Xs[4];
#pragma unroll
            for (int rg = 0; rg < 4; ++rg) { Gs[rg] = (s[4 * rg] + s[4 * rg + 1]) + (s[4 * rg + 2] + s[4 * rg + 3]); Xs[rg] = __shfl_xor(s[4 * rg + 3], 32); }
#pragma unroll
            for (int rg = 0; rg < 4; ++rg) imp[4 * T + rg] = Gs[rg] + (h ? Xs[rg] : (rg ? Xs[rg > 0 ? rg - 1 : 0] : carry));
            carry = Xs[3];
            const s16x8 p0 = pack8(s, 0), p1 = pack8(s, 8);
#pragma unroll
            for (int dt = 0; dt < 2; ++dt) { const LAS unsigned char* vr = lds + A_VCT + (32 * dt + r32) * 536 + (32 * T + 4 * h) * 2;
                OT[dt] = MFMA32(lds_a64x2(vr), p0, OT[dt]); OT[dt] = MFMA32(lds_a64x2(vr + 32), p1, OT[dt]); }
        }
        l += __shfl_xor(l, 32);
        const float invl = l > 0.f ? __builtin_amdgcn_rcpf(l) : 0.f;
        {
            const float og = invl * sigmoidf_(bf2f(proj[trow * PE + C_NG + 0 * 8 + g * 4 + head]));
#pragma unroll
            for (int i = 0; i < 16; ++i) { OT[0][i] *= og; OT[1][i] *= og; }
        }
#pragma unroll
        for (int k = 0; k < 32; ++k) { float v = imp[k] * invl; v += __shfl_xor(v, 8); v += __shfl_xor(v, 16); imp[k] = v; }
#pragma unroll
        for (int k = 0; k < 32; ++k) { const int j = 2 * k + h; const bool ok = (j <= bt) && (j != 0) && (j != bt) && (j != bt - 1); imp[k] = ok ? imp[k] : -1.0f; }
        selmask = 1ull | (1ull << bt) | (bt >= 1 ? (1ull << (bt - 1)) : 0ull);
        const int rounds = 8 - (bt == 0 ? 1 : (bt == 1 ? 2 : 3));
#pragma unroll 1
        for (int rd = 0; rd < rounds; ++rd) {
            float mx = imp[0];
#pragma unroll
            for (int k = 1; k < 32; ++k) mx = __builtin_elementwise_max(mx, imp[k]);
            const float gm = __builtin_elementwise_max(mx, __shfl_xor(mx, 32));
            int jb = 64;
#pragma unroll
            for (int k = 31; k >= 0; --k) jb = (imp[k] == gm) ? (2 * k + h) : jb;
            const int jo = __shfl_xor(jb, 32); jb = jb < jo ? jb : jo;
            selmask |= 1ull << jb;
#pragma unroll
            for (int k = 0; k < 32; ++k) imp[k] = (2 * k + h == jb) ? -INFINITY : imp[k];
        }
    }
    const int wlo = bt >= 8 ? bt - 8 : 0;
    {
        LAS v4u* otp = (LAS v4u*)(lds + A_OT + (wave * 64 + lane) * 64);
#pragma unroll
        for (int dt = 0; dt < 2; ++dt)
#pragma unroll
            for (int q = 0; q < 2; ++q) { v4u w; w.x = cvtpk(OT[dt][8 * q], OT[dt][8 * q + 1]); w.y = cvtpk(OT[dt][8 * q + 2], OT[dt][8 * q + 3]); w.z = cvtpk(OT[dt][8 * q + 4], OT[dt][8 * q + 5]); w.w = cvtpk(OT[dt][8 * q + 6], OT[dt][8 * q + 7]); otp[2 * dt + q] = w; }
    }
    const float gate_s = sigmoidf_(bf2f(proj[trow * PE + C_NG + 1 * 8 + g * 4 + head])), gate_w = sigmoidf_(bf2f(proj[trow * PE + C_NG + 2 * 8 + g * 4 + head]));
    unsigned long long wact = 0ull;
#pragma unroll 1
    for (int j = 0; j <= bt; ++j) if (__ballot((selmask >> j) & 1ull) != 0ull) wact |= 1ull << j;
    float m = -3.0e38f, l = 0.f;
    f32x16 O[2];
#pragma unroll
    for (int i = 0; i < 16; ++i) { O[0][i] = 0.f; O[1][i] = 0.f; }
    int cj = __ffsll((long long)wact) - 1; wact &= wact - 1ull; bool cwin = false; int wj = wlo;
    s16x8 kf[4][2], kn[4][2], vf[2][4];
    nsa_load_k(Kt, bg * 2 + 0, cj, lane, kf);
#pragma unroll 1
    for (;;) {
        int nj; bool nwin, nvalid = true;
        if (!cwin && wact != 0ull) { nj = __ffsll((long long)wact) - 1; wact &= wact - 1ull; nwin = false; }
        else if (wj <= bt) { nj = wj++; nwin = true; }
        else { nj = 0; nwin = true; nvalid = false; }
        nsa_load_v(Vt, bg * 2 + (cwin ? 1 : 0), cj, lane, vf);
        if (nvalid) nsa_load_k(Kt, bg * 2 + (nwin ? 1 : 0), nj, lane, kn);
        if (!cwin) {
            const bool en = (selmask >> cj) & 1ull;
            if (cj == bt) attn_block_rf<1>(kf, vf, qf, h, 64 * cj, 0, t, en, m, l, O);
            else attn_block_rf<2>(kf, vf, qf, h, 64 * cj, 0, t, en, m, l, O);
        } else {
            if (cj == bt || (bt >= 8 && cj == wlo)) attn_block_rf<1>(kf, vf, qf, h, 64 * cj, t - 511, t, true, m, l, O);
            else attn_block_rf<0>(kf, vf, qf, h, 64 * cj, 0, t, true, m, l, O);
        }
        if ((!cwin && nwin) || !nvalid) {
            const float lt = l + __shfl_xor(l, 32);
            const float gate = (cwin ? gate_w : gate_s) * __builtin_amdgcn_rcpf(lt);
            LAS v4u* otp = (LAS v4u*)(lds + A_OT + (wave * 64 + lane) * 64);
#pragma unroll
            for (int dt = 0; dt < 2; ++dt)
#pragma unroll
                for (int q = 0; q < 2; ++q) { const v4u w = otp[2 * dt + q];
                    const unsigned ww[4] = {w.x, w.y, w.z, w.w};
#pragma unroll
                    for (int k = 0; k < 4; ++k) { O[dt][8 * q + 2 * k] = bflo(ww[k]) + gate * O[dt][8 * q + 2 * k]; O[dt][8 * q + 2 * k + 1] = bfhi(ww[k]) + gate * O[dt][8 * q + 2 * k + 1]; } }
            if (!nvalid) break;
#pragma unroll
            for (int dt = 0; dt < 2; ++dt)
#pragma unroll
                for (int q = 0; q < 2; ++q) { v4u w; w.x = cvtpk(O[dt][8 * q], O[dt][8 * q + 1]); w.y = cvtpk(O[dt][8 * q + 2], O[dt][8 * q + 3]); w.z = cvtpk(O[dt][8 * q + 4], O[dt][8 * q + 5]); w.w = cvtpk(O[dt][8 * q + 6], O[dt][8 * q + 7]); otp[2 * dt + q] = w; }
#pragma unroll
            for (int i = 0; i < 16; ++i) { O[0][i] = 0.f; O[1][i] = 0.f; }
            m = -3.0e38f; l = 0.f;
        }
        cj = nj; cwin = nwin;
#pragma unroll
        for (int ks = 0; ks < 4; ++ks) { kf[ks][0] = kn[ks][0]; kf[ks][1] = kn[ks][1]; }
    }
    {
        bf16* op = mixed + trow * D + 512 + (g * 4 + head) * 64 + 4 * h;
#pragma unroll
        for (int dt = 0; dt < 2; ++dt)
#pragma unroll
            for (int rg = 0; rg < 4; ++rg) { v2u w; w.x = cvtpk(O[dt][4 * rg], O[dt][4 * rg + 1]); w.y = cvtpk(O[dt][4 * rg + 2], O[dt][4 * rg + 3]); *(GAS v2u*)(op + 32 * dt + 8 * rg) = w; }
    }
    __syncthreads();
}

__device__ __forceinline__ void kv_tile_item(LAS unsigned short* scr  , int item, const bf16* proj, bf16* Kt, bf16* Vt, int lane) {
    const int bgx = item >> 6, kb = item & 63; const int bg = bgx >> 1, x = bgx & 1; const int b = bg >> 1, g = bg & 1; const int r = lane & 31, h = lane >> 5;
    const bf16* ksrc = proj + (size_t)(b * SEQ + 64 * kb) * PE + (x ? C_KW : C_KS) + 64 * g;
    GAS v4u* kd = (GAS v4u*)(Kt + (size_t)item * 4096) + lane;
#pragma unroll
    for (int ks = 0; ks < 4; ++ks)
#pragma unroll
        for (int kt = 0; kt < 2; ++kt) kd[(ks * 2 + kt) * 64] = *(const GAS v4u*)(ksrc + (size_t)(32 * kt + r) * PE + 16 * ks + 8 * h);
    const bf16* vsrc = proj + (size_t)(b * SEQ + 64 * kb + lane) * PE + (x ? C_VW : C_VS) + 64 * g;
#pragma unroll
    for (int c = 0; c < 8; ++c) { const v4u v = *(const GAS v4u*)(vsrc + 8 * c); LAS unsigned* d = (LAS unsigned*)(scr + lane * 66 + 8 * c); d[0] = v.x; d[1] = v.y; d[2] = v.z; d[3] = v.w; }
    LDS_WAIT(); asm volatile("" ::: "memory");
    GAS v4u* vd = (GAS v4u*)(Vt + (size_t)item * 4096) + lane;
#pragma unroll
    for (int dt = 0; dt < 2; ++dt)
#pragma unroll
        for (int kk = 0; kk < 4; ++kk) { const int dim = 32 * dt + r, k0 = 16 * kk + 4 * h; v4u o;
            o.x = (unsigned)scr[(k0 + 0) * 66 + dim] | ((unsigned)scr[(k0 + 1) * 66 + dim] << 16); o.y = (unsigned)scr[(k0 + 2) * 66 + dim] | ((unsigned)scr[(k0 + 3) * 66 + dim] << 16);
            o.z = (unsigned)scr[(k0 + 8) * 66 + dim] | ((unsigned)scr[(k0 + 9) * 66 + dim] << 16); o.w = (unsigned)scr[(k0 + 10) * 66 + dim] | ((unsigned)scr[(k0 + 11) * 66 + dim] << 16);
            vd[(dt * 4 + kk) * 64] = o; }
    LDS_WAIT(); asm volatile("" ::: "memory");
}

__device__ __forceinline__ float gelu_tanh_f(float x) { const float u = 0.7978845608028654f * (x + 0.044715f * x * x * x); const float t = 1.0f - 2.0f * __builtin_amdgcn_rcpf(__expf(2.0f * u) + 1.0f); return 0.5f * x * (1.0f + t); }
__device__ __forceinline__ void compress_unit(LAS unsigned char* lds, int unit, const bf16* proj, const bf16* W1T  , const float* cbias  , const float* w2k, const float* w2v,
                                              bf16* kcb, bf16* vcb, int tid_in, int wave) {
    int tid = tid_in; asm volatile("" : "+v"(tid)); const int lane = tid & 63;
    const int kv = unit >> 7, bg = (unit >> 3) & 15, tile = unit & 7; const int b = bg >> 1, g = bg & 1;
    const int r32 = lane & 31, h = lane >> 5; const int i = 32 * tile + r32;
    const bf16* w1 = W1T + (size_t)kv * 64 * 2048; const int col = (kv ? C_VC : C_KC) + 64 * g;
    f32x16 acc0, acc1;
#pragma unroll
    for (int q = 0; q < 16; ++q) { acc0[q] = 0.f; acc1[q] = 0.f; }
#pragma unroll
    for (int ks = 0; ks < 16; ++ks) {
        int tok = 16 * i + 4 * wave + (ks >> 2); tok = tok > SEQ - 1 ? SEQ - 1 : tok;
        const s16x8 av = __builtin_bit_cast(s16x8, *(const GAS v4u*)(proj + (size_t)(b * SEQ + tok) * PE + col + 16 * (ks & 3) + 8 * h));
        const int k0 = 256 * wave + 16 * ks + 8 * h;
        const s16x8 b0 = __builtin_bit_cast(s16x8, *(const GAS v4u*)(w1 + (size_t)r32 * 2048 + k0)), b1 = __builtin_bit_cast(s16x8, *(const GAS v4u*)(w1 + (size_t)(32 + r32) * 2048 + k0));
        acc0 = MFMA32(av, b0, acc0); acc1 = MFMA32(av, b1, acc1);
    }
    LAS float* part = (LAS float*)lds;
    LAS float* hidl = (LAS float*)(lds + 65536);
#pragma unroll
    for (int q = 0; q < 16; ++q) { const int row = (q & 3) + 8 * (q >> 2) + 4 * h; part[(wave * 32 + row) * 64 + r32] = acc0[q]; part[(wave * 32 + row) * 64 + 32 + r32] = acc1[q]; }
    __syncthreads();
    const int il = tid >> 4, c4 = (tid & 15) * 4;
    {
        f32x4 s = (f32x4){0.f, 0.f, 0.f, 0.f};
#pragma unroll 8
        for (int ksg = 0; ksg < 32; ++ksg) s = s + *(const GAS f32x4*)(cbias + (kv * 32 + ksg) * 64 + c4);
#pragma unroll
        for (int w = 0; w < 8; ++w) s = s + *(const LAS f32x4*)(part + (w * 32 + il) * 64 + c4);
        *(LAS f32x4*)(hidl + il * 64 + c4) = (f32x4){gelu_tanh_f(s.x), gelu_tanh_f(s.y), gelu_tanh_f(s.z), gelu_tanh_f(s.w)};
    }
    __syncthreads();
    {
        const float* w2 = kv ? w2v : w2k; f32x4 o = (f32x4){0.f, 0.f, 0.f, 0.f};
#pragma unroll 8
        for (int c = 0; c < 64; ++c) { const float hv = hidl[il * 64 + c]; o = o + *(const GAS f32x4*)(w2 + c * 64 + c4) * hv; }
        const int irow = 32 * tile + il; if (irow == 255) o = (f32x4){0.f, 0.f, 0.f, 0.f};
        v2u w; w.x = cvtpk(o.x, o.y); w.y = cvtpk(o.z, o.w);
        *(GAS v2u*)((kv ? vcb : kcb) + ((size_t)bg * 256 + irow) * 64 + c4) = w;
    }
    __syncthreads();
}


typedef float f32x4v __attribute__((ext_vector_type(4)));
#define MFMA16(a, b, c) __builtin_amdgcn_mfma_f32_16x16x32_bf16((a), (b), (c), 0, 0, 0)
constexpr int R_QT = 0, R_KT = 8704, R_KTT = 17920, R_VTT = 30208, R_E = 42496, R_BUF = 43008;
constexpr int S_QT = 0, S_KT = 24576, S_V = 49152, S_E = 65536, S_PF = 66560, S_OB = 71680, S_END = 105472;
__device__ __forceinline__ unsigned off_b(unsigned row, unsigned ch) { return 256u * row + 16u * (ch ^ (((row & 3u) << 2) | ((row >> 2) & 3u))); }
__device__ __forceinline__ unsigned tr_addr(unsigned lane, unsigned c, unsigned ks, unsigned t) { const unsigned h = lane >> 5, blk = (lane >> 4) & 1u, q = (lane & 15u) >> 2, pp = lane & 3u; return off_b(16u * ks + 8u * h + 4u * t + q, 4u * c + 2u * blk + (pp >> 1)) + 8u * (pp & 1u); }
typedef short v4i16_t __attribute__((ext_vector_type(4)));
__device__ __forceinline__ s16x8 tr_frag(const LAS unsigned char* tile, unsigned lane, unsigned c, unsigned ks) {
    const v4i16_t a = __builtin_amdgcn_ds_read_tr16_b64_v4i16((LAS v4i16_t*)(tile + tr_addr(lane, c, ks, 0))), b = __builtin_amdgcn_ds_read_tr16_b64_v4i16((LAS v4i16_t*)(tile + tr_addr(lane, c, ks, 1)));
    s16x8 r; r[0] = a[0]; r[1] = a[1]; r[2] = a[2]; r[3] = a[3]; r[4] = b[0]; r[5] = b[1]; r[6] = b[2]; r[7] = b[3]; return r; }
constexpr float REC_SCALE = 0.08838834764831845f;

__device__ __forceinline__ s16x8 lds_2x64(const LAS unsigned char* p, const LAS unsigned char* q) { const v2u lo = *(const LAS v2u*)p, hi = *(const LAS v2u*)q; v4u w; w.x = lo.x; w.y = lo.y; w.z = hi.x; w.w = hi.y; return __builtin_bit_cast(s16x8, w); }

template <int MODE>
__device__ __forceinline__ void rec_prep_task(int task, bf16* proj, const float2* rope, const float* lb, float* Eg, int lane) {
    constexpr int NH = MODE ? 8 : 4, LDP = MODE ? PO : PE, CQ = MODE ? C_HQ : C_RQ, CK = MODE ? C_HF : C_RK, CV = MODE ? C_HI : C_RV;
    const int chunk = task & 127, bh = task >> 7; const int b = bh / NH, hd = bh % NH;
    const size_t row0 = (size_t)(b * SEQ + 32 * chunk);
    if (MODE == 1) {
        const float l0 = lb[hd * 128 + 2 * lane], l1 = lb[hd * 128 + 2 * lane + 1];
        float B0 = 0.f, B1 = 0.f;
        bf16* rp0 = proj + row0 * LDP + hd * 128 + 2 * lane;
        unsigned qw[32], fw[32];
#pragma unroll
        for (int t = 0; t < 32; ++t) { qw[t] = *(const GAS unsigned*)(rp0 + (size_t)t * LDP + CQ); fw[t] = *(const GAS unsigned*)(rp0 + (size_t)t * LDP + CK); }
        __builtin_amdgcn_sched_barrier(0);
#pragma unroll
        for (int t = 0; t < 32; ++t) {
            bf16* rp = rp0 + (size_t)t * LDP;
            const float f0 = bflo(fw[t]), f1 = bfhi(fw[t]), q0 = bflo(qw[t]), q1 = bfhi(qw[t]);
            const float s0 = sigmoidf_(f0), s1 = sigmoidf_(f1);
            B0 += __logf(l0 + (1.0f - l0) * s0); B1 += __logf(l1 + (1.0f - l1) * s1);
            const float e0 = __expf(B0), e1 = __expf(B1);
            const float qt0 = siluf_(q0) * REC_SCALE * e0, qt1 = siluf_(q1) * REC_SCALE * e1;
            const float kt0 = (1.0f - l0) * (1.0f - s0) * __builtin_amdgcn_rcpf(e0), kt1 = (1.0f - l1) * (1.0f - s1) * __builtin_amdgcn_rcpf(e1);
            *(GAS unsigned*)(rp + CQ) = pk2(qt0, qt1);
            const unsigned kw = pk2(kt0, kt1);
            *(GAS unsigned*)(rp + CK) = kw;
            if (t == 31) { *(GAS f32x2*)(Eg + ((size_t)bh * 128 + chunk) * 128 + 2 * lane) = (f32x2){e0, e1}; }
        }
    } else {
        const float gamma = 1.0f - exp2f(-5.0f - (float)hd); const float ginv = 1.0f / gamma;
        float gp = 1.0f, gi = 1.0f;
        bf16* rp0 = proj + row0 * LDP + hd * 128 + lane;
#pragma unroll
        for (int half = 0; half < 2; ++half) {
            unsigned short q1h[16], q2h[16], k1h[16], k2h[16]; float2 csh[16];
#pragma unroll
            for (int i = 0; i < 16; ++i) { const int t = 16 * half + i; const bf16* rp = rp0 + (size_t)t * LDP;
                q1h[i] = rp[CQ]; q2h[i] = rp[CQ + 64]; k1h[i] = rp[CK]; k2h[i] = rp[CK + 64]; csh[i] = rope[(32 * chunk + t) * 64 + lane]; }
            __builtin_amdgcn_sched_barrier(0);
#pragma unroll
            for (int i = 0; i < 16; ++i) { const int t = 16 * half + i; bf16* rp = rp0 + (size_t)t * LDP;
                gp *= gamma; gi *= ginv;
                const float2 cs = csh[i];
                const float q1 = bf2f(q1h[i]), q2 = bf2f(q2h[i]), k1 = bf2f(k1h[i]), k2 = bf2f(k2h[i]);
                const unsigned qa = f2bf((q1 * cs.x - q2 * cs.y) * gp), qb = f2bf((q1 * cs.y + q2 * cs.x) * gp);
                const unsigned ka = f2bf((k1 * cs.x - k2 * cs.y) * (REC_SCALE * gi)), kb = f2bf((k1 * cs.y + k2 * cs.x) * (REC_SCALE * gi));
                rp[CQ] = (bf16)qa; rp[CQ + 64] = (bf16)qb; rp[CK] = (bf16)ka; rp[CK + 64] = (bf16)kb;
            }
        }
    }
}


struct RecSet { v4u q[2], k[2], v[2]; f32x4v e; v4u g[2]; f32x4v ec[2]; };

template <int MODE, int SEGS>
__device__ __forceinline__ void rec_issue(RecSet& R, int c, int bh, int hd, size_t rowbase, const bf16* proj, const float* Eg, int hid) {
    constexpr int NCH = SEQ / 32 / SEGS, LDP = MODE ? PO : PE, CQ = MODE ? C_HQ : C_RQ, CK = MODE ? C_HF : C_RK, CV = MODE ? C_HI : C_RV, CG = MODE ? C_HG : C_RG;
    if (c + 2 < NCH) { const size_t r2 = rowbase + 32 * (c + 2);
#pragma unroll
        for (int i = 0; i < 2; ++i) { const int p = hid + 256 * i, tq = p >> 4, cq = p & 15;
            R.q[i] = *(const GAS v4u*)(proj + (r2 + tq) * LDP + CQ + hd * 128 + 8 * cq); R.k[i] = *(const GAS v4u*)(proj + (r2 + tq) * LDP + CK + hd * 128 + 8 * cq); } }
    if (c + 1 < NCH) { const size_t r1 = rowbase + 32 * (c + 1);
#pragma unroll
        for (int i = 0; i < 2; ++i) { const int p = hid + 256 * i, tq = p >> 4, cq = p & 15; R.v[i] = *(const GAS v4u*)(proj + (r1 + tq) * LDP + CV + hd * 128 + 8 * cq); }
        if (MODE == 1 && hid < 32) R.e = *(const GAS f32x4v*)(Eg + ((size_t)bh * 128 + c + 1) * 128 + 4 * hid);
        if (SEGS > 1) { const GAS f32x4v* ep = (const GAS f32x4v*)(Eg + ((size_t)bh * 128 + c + 1) * 128 + 8 * (hid & 15)); R.ec[0] = ep[0]; R.ec[1] = ep[1]; } }
    if (SEGS == 1 && c >= 1) { const GAS v4u* gp = (const GAS v4u*)(proj + (rowbase + 32 * (c - 1) + (hid >> 3)) * LDP + CG + hd * 128 + 16 * (hid & 7)); R.g[0] = gp[0]; R.g[1] = gp[1]; }
}
__device__ __forceinline__ v4u scale8(v4u q, const float (&f)[8]) {
    v4u o; o.x = pk2(bflo(q.x) * f[0], bfhi(q.x) * f[1]); o.y = pk2(bflo(q.y) * f[2], bfhi(q.y) * f[3]); o.z = pk2(bflo(q.z) * f[4], bfhi(q.z) * f[5]); o.w = pk2(bflo(q.w) * f[6], bfhi(q.w) * f[7]); return o; }
template <int MODE, int SEGS>
__device__ __forceinline__ void rec_stage(const RecSet& R, LAS unsigned char* lds, int c, int hid, float (&ecum)[8], bool fix, bf16* projw, int hd, size_t rowbase) {
    constexpr int NCH = SEQ / 32 / SEGS, LDP = MODE ? PO : PE, CQ = MODE ? C_HQ : C_RQ;
    if (SEGS > 1 && c + 1 < NCH) {
        ecum[0] *= R.ec[0][0]; ecum[1] *= R.ec[0][1]; ecum[2] *= R.ec[0][2]; ecum[3] *= R.ec[0][3]; ecum[4] *= R.ec[1][0]; ecum[5] *= R.ec[1][1]; ecum[6] *= R.ec[1][2]; ecum[7] *= R.ec[1][3]; }
    if (c + 2 < NCH) {
#pragma unroll
        for (int i = 0; i < 2; ++i) { const int p = hid + 256 * i; const unsigned o = off_b(p >> 4, p & 15);
            *(LAS v4u*)(lds + S_QT + ((c + 2) % 3) * 8192 + o) = R.q[i]; *(LAS v4u*)(lds + S_KT + ((c + 2) % 3) * 8192 + o) = R.k[i];
            if (SEGS > 1 && fix) *(GAS v4u*)(projw + (rowbase + 32 * (c + 2) + (p >> 4)) * LDP + CQ + hd * 128 + 8 * (p & 15)) = scale8(R.q[i], ecum); } }
    if (c + 1 < NCH) {
#pragma unroll
        for (int i = 0; i < 2; ++i) { const int p = hid + 256 * i; *(LAS v4u*)(lds + S_V + ((c + 1) & 1) * 8192 + off_b(p >> 4, p & 15)) = R.v[i]; }
        if (MODE == 1 && hid < 32) *(LAS f32x4v*)(lds + S_E + ((c + 1) & 1) * 512 + 16 * hid) = R.e; }
}
__device__ __forceinline__ void rec_store_raw(const LAS unsigned char* lds, int cp, int hd, size_t rowbase, bf16* mixed, int hid) {
    const int t = hid >> 3, seg = hid & 7;
    const LAS f32x4v* ob = (const LAS f32x4v*)(lds + S_OB + (cp & 1) * 16896 + t * 528 + seg * 64);
    const f32x4v o0 = ob[0], o1 = ob[1], o2 = ob[2], o3 = ob[3];
    GAS v4u* dst = (GAS v4u*)(mixed + (rowbase + 32 * cp + t) * D + hd * 128 + 16 * seg);
    dst[0] = (v4u){pk2(o0[0], o0[1]), pk2(o0[2], o0[3]), pk2(o1[0], o1[1]), pk2(o1[2], o1[3])}; dst[1] = (v4u){pk2(o2[0], o2[1]), pk2(o2[2], o2[3]), pk2(o3[0], o3[1]), pk2(o3[2], o3[3])};
}
__device__ __forceinline__ void rec_ptile3(LAS unsigned char* lds, int cn, int hw, int lane) {
    const int c16 = lane & 15, q4 = lane >> 4; const int si = hw == 2 ? 1 : 0, ti = hw == 0 ? 0 : 1;
    const LAS unsigned char* kb = lds + S_KT + (cn % 3) * 8192; const LAS unsigned char* qb = lds + S_QT + (cn % 3) * 8192;
    s16x8 ka[4], qa[4];
#pragma unroll
    for (int ks = 0; ks < 4; ++ks) { ka[ks] = lds_a128(kb + off_b(16 * si + c16, 4 * ks + q4)); qa[ks] = lds_a128(qb + off_b(16 * ti + c16, 4 * ks + q4)); }
    __builtin_amdgcn_sched_barrier(0);
    f32x4v p = (f32x4v){0.f, 0.f, 0.f, 0.f};
#pragma unroll
    for (int ks = 0; ks < 4; ++ks) p = MFMA16(ka[ks], qa[ks], p);
    if (hw != 1) {
#pragma unroll
        for (int r = 0; r < 4; ++r) p[r] = ((4 * q4 + r) <= c16) ? p[r] : 0.f;
    }
    v2u w; w.x = cvtpk(p[0], p[1]); w.y = cvtpk(p[2], p[3]);
    *(LAS v2u*)(lds + S_PF + (cn & 1) * 2560 + (16 * ti + c16) * 80 + (16 * si + 4 * q4) * 2) = w;
}
template <int MODE>
__device__ __forceinline__ void rec_finish(const LAS unsigned char* lds, int cp, const v4u (&g)[2], const float (&ngl)[16], int hd, size_t rowbase, bf16* mixed, int hid) {
    const int t = hid >> 3, seg = hid & 7;
    const LAS f32x4v* ob = (const LAS f32x4v*)(lds + S_OB + (cp & 1) * 16896 + t * 528 + seg * 64);
    f32x4v o[4];
#pragma unroll
    for (int i = 0; i < 4; ++i) o[i] = ob[i];
    float s1 = 0.f, s2 = 0.f;
#pragma unroll
    for (int i = 0; i < 4; ++i) { s1 += (o[i][0] + o[i][1]) + (o[i][2] + o[i][3]); s2 += (o[i][0] * o[i][0] + o[i][1] * o[i][1]) + (o[i][2] * o[i][2] + o[i][3] * o[i][3]); }
    s1 += __shfl_xor(s1, 1); s2 += __shfl_xor(s2, 1); s1 += __shfl_xor(s1, 2); s2 += __shfl_xor(s2, 2); s1 += __shfl_xor(s1, 4); s2 += __shfl_xor(s2, 4);
    float mu = 0.f, rs;
    if (MODE == 0) { mu = s1 * (1.f / 128.f); rs = __builtin_amdgcn_rsqf(fmaxf(s2 * (1.f / 128.f) - mu * mu, 0.f) + 1e-5f); }
    else rs = __builtin_amdgcn_rsqf(s2 * (1.f / 128.f) + RMS_EPS);
    v4u out[2];
#pragma unroll
    for (int hv = 0; hv < 2; ++hv) { unsigned w[4];
#pragma unroll
        for (int k = 0; k < 4; ++k) { const int e0 = 8 * hv + 2 * k; const unsigned gw = k == 0 ? g[hv].x : (k == 1 ? g[hv].y : (k == 2 ? g[hv].z : g[hv].w));
            const float a = o[e0 >> 2][e0 & 3], bq = o[(e0 + 1) >> 2][(e0 + 1) & 3]; float y0, y1;
            if (MODE == 0) { y0 = (a - mu) * rs * siluf_(bflo(gw)); y1 = (bq - mu) * rs * siluf_(bfhi(gw)); }
            else { y0 = a * rs * ngl[e0] * sigmoidf_(bflo(gw)); y1 = bq * rs * ngl[e0 + 1] * sigmoidf_(bfhi(gw)); }
            w[k] = pk2(y0, y1); }
        out[hv] = (v4u){w[0], w[1], w[2], w[3]}; }
    GAS v4u* dst = (GAS v4u*)(mixed + (rowbase + 32 * cp + t) * D + hd * 128 + 16 * seg);
    dst[0] = out[0]; dst[1] = out[1];
}

template <int MODE>
__device__ __forceinline__ void rec_compute(LAS unsigned char* lds, int c, f32x16 (&Sacc)[4], float egam, int w, int lane) {
    const int r32 = lane & 31, h = lane >> 5;
    const LAS unsigned char* qt = lds + S_QT + (c % 3) * 8192; const LAS unsigned char* ktl = lds + S_KT + (c % 3) * 8192; const LAS unsigned char* vtl = lds + S_V + (c & 1) * 8192;
    const LAS unsigned char* pf = lds + S_PF + (c & 1) * 2560 + r32 * 80 + 16 * h;
    const s16x8 pf0 = lds_a128(pf), pf1 = lds_a128(pf + 32);
    const s16x8 vf0 = tr_frag(vtl, lane, w, 0), vf1 = tr_frag(vtl, lane, w, 1);
    s16x8 qp[4][2];
#pragma unroll
    for (int dt = 0; dt < 4; ++dt)
#pragma unroll
        for (int sp = 0; sp < 2; ++sp) qp[dt][sp] = lds_2x64(qt + off_b(r32, 4 * dt + 2 * sp) + 8 * h, qt + off_b(r32, 4 * dt + 2 * sp + 1) + 8 * h);
    __builtin_amdgcn_sched_barrier(0);
    f32x16 o;
#pragma unroll
    for (int i = 0; i < 16; ++i) o[i] = 0.f;
    o = MFMA32(vf0, pf0, o); o = MFMA32(vf1, pf1, o);
#pragma unroll
    for (int dt = 0; dt < 4; ++dt)
#pragma unroll
        for (int sp = 0; sp < 2; ++sp) o = MFMA32(pack8(Sacc[dt], 8 * sp), qp[dt][sp], o);
    __builtin_amdgcn_sched_barrier(0);
    s16x8 kf[4][2];
#pragma unroll
    for (int dt = 0; dt < 4; ++dt) { kf[dt][0] = tr_frag(ktl, lane, dt, 0); kf[dt][1] = tr_frag(ktl, lane, dt, 1); }
    __builtin_amdgcn_sched_barrier(0);
#pragma unroll
    for (int dt = 0; dt < 4; ++dt) { Sacc[dt] = MFMA32(kf[dt][0], vf0, Sacc[dt]); Sacc[dt] = MFMA32(kf[dt][1], vf1, Sacc[dt]); }
    {
        LAS unsigned char* ob = lds + S_OB + (c & 1) * 16896 + r32 * 528 + (32 * w + 4 * h) * 4;
#pragma unroll
        for (int g = 0; g < 4; ++g) *(LAS f32x4v*)(ob + 32 * g) = (f32x4v){o[4 * g], o[4 * g + 1], o[4 * g + 2], o[4 * g + 3]};
    }
    if (MODE == 1) { const LAS unsigned char* eb = lds + S_E + (c & 1) * 512 + 16 * h;
#pragma unroll
        for (int dt = 0; dt < 4; ++dt)
#pragma unroll
            for (int g = 0; g < 4; ++g) { const f32x4v e4 = *(const LAS f32x4v*)(eb + (32 * dt + 8 * g) * 4);
                Sacc[dt][4 * g] *= e4[0]; Sacc[dt][4 * g + 1] *= e4[1]; Sacc[dt][4 * g + 2] *= e4[2]; Sacc[dt][4 * g + 3] *= e4[3]; }
    } else {
#pragma unroll
        for (int dt = 0; dt < 4; ++dt)
#pragma unroll
            for (int i = 0; i < 16; ++i) Sacc[dt][i] *= egam;
    }
}

#define REC_BAR() do { asm volatile("s_waitcnt lgkmcnt(0)" ::: "memory"); __builtin_amdgcn_s_barrier(); asm volatile("" ::: "memory"); } while (0)

template <int MODE, int SEGS>
__device__ __forceinline__ void rec_serial_unit(LAS unsigned char* lds, int unit, bf16* proj, const float* Eg0, const float* ng, bf16* mixed, float* Send, float* Dseg, int tid_in, int wave) {
    constexpr int NH = MODE ? 8 : 4, NCH = SEQ / 32 / SEGS, LDP = MODE ? PO : PE, CQ = MODE ? C_HQ : C_RQ, CK = MODE ? C_HF : C_RK, CV = MODE ? C_HI : C_RV;
    int tid = tid_in; asm volatile("" : "+v"(tid)); const int lane = tid & 63;
    const int bh = unit / SEGS, sg = unit % SEGS;
    const int b = bh / NH, hd = bh % NH; const size_t rowbase = (size_t)b * SEQ + (size_t)sg * NCH * 32;
    const float* Eg = Eg0 + (size_t)sg * NCH * 128;
    const bool fix = SEGS > 1 && sg > 0;
    float ecum[8] = {1.f, 1.f, 1.f, 1.f, 1.f, 1.f, 1.f, 1.f};
    {
        const int tq = tid >> 4, cq = tid & 15; const unsigned o = off_b(tq, cq);
        if (SEGS > 1) { const GAS f32x4v* ep = (const GAS f32x4v*)(Eg + ((size_t)bh * 128) * 128 + 8 * cq); const f32x4v e0 = ep[0], e1 = ep[1];
            ecum[0] = e0[0]; ecum[1] = e0[1]; ecum[2] = e0[2]; ecum[3] = e0[3]; ecum[4] = e1[0]; ecum[5] = e1[1]; ecum[6] = e1[2]; ecum[7] = e1[3]; }
#pragma unroll
        for (int cc = 0; cc < 2; ++cc) { const size_t r = rowbase + 32 * cc + tq;
            const v4u qv = *(const GAS v4u*)(proj + r * LDP + CQ + hd * 128 + 8 * cq);
            *(LAS v4u*)(lds + S_QT + cc * 8192 + o) = qv;
            if (SEGS > 1 && fix && cc == 1) *(GAS v4u*)(proj + r * LDP + CQ + hd * 128 + 8 * cq) = scale8(qv, ecum);
            *(LAS v4u*)(lds + S_KT + cc * 8192 + o) = *(const GAS v4u*)(proj + r * LDP + CK + hd * 128 + 8 * cq); }
        *(LAS v4u*)(lds + S_V + o) = *(const GAS v4u*)(proj + (rowbase + tq) * LDP + CV + hd * 128 + 8 * cq);
        if (MODE == 1 && tid < 32) *(LAS f32x4v*)(lds + S_E + 16 * tid) = *(const GAS f32x4v*)(Eg + ((size_t)bh * 128) * 128 + 4 * tid);
        if (tid < 128) { const int par = tid >> 6, t16 = (tid >> 2) & 15, q = tid & 3; unsigned z = 0u; asm volatile("" : "+v"(z)); *(LAS v2u*)(lds + S_PF + par * 2560 + t16 * 80 + 32 + 8 * q) = (v2u){z, z}; }
    }
    __syncthreads();
    if (wave >= 4 && wave < 7) rec_ptile3(lds, 0, wave - 4, lane);
    __syncthreads();
    if (wave < 4) {
        f32x16 Sacc[4];
#pragma unroll
        for (int dt = 0; dt < 4; ++dt)
#pragma unroll
            for (int i = 0; i < 16; ++i) Sacc[dt][i] = 0.f;
        const float egam = MODE ? 1.f : exp2f(32.0f * log2f(1.0f - exp2f(-5.0f - (float)hd)));
#pragma unroll 1
        for (int c = 0; c <= NCH; ++c) { if (c < NCH) rec_compute<MODE>(lds, c, Sacc, egam, wave, lane); REC_BAR(); }
        if (SEGS > 1 && sg + 1 < SEGS) {
            const int r32 = lane & 31, h = lane >> 5; float* sp = Send + ((size_t)(bh * (SEGS - 1) + sg) * 128) * 128 + 32 * wave + r32;
#pragma unroll
            for (int dt = 0; dt < 4; ++dt)
#pragma unroll
                for (int i = 0; i < 16; ++i) sp[(size_t)(32 * dt + (i & 3) + 8 * (i >> 2) + 4 * h) * 128] = Sacc[dt][i];
        }
    } else {
        const int hid = tid - 256, hw = wave - 4;
        RecSet RA, RB;
        float ngl[16];
#pragma unroll
        for (int i = 0; i < 16; ++i) ngl[i] = (MODE && SEGS == 1) ? ng[16 * (hid & 7) + i] : 1.f;
        rec_issue<MODE, SEGS>(RA, 0, bh, hd, rowbase, proj, Eg, hid); rec_issue<MODE, SEGS>(RB, 1, bh, hd, rowbase, proj, Eg, hid);
#pragma unroll 1
        for (int c = 0; c <= NCH; c += 2) {
            if (c >= 1) { if (SEGS == 1) rec_finish<MODE>(lds, c - 1, RA.g, ngl, hd, rowbase, mixed, hid); else rec_store_raw(lds, c - 1, hd, rowbase, mixed, hid); }
            if (hw < 3 && c + 1 < NCH) rec_ptile3(lds, c + 1, hw, lane);
            rec_stage<MODE, SEGS>(RA, lds, c, hid, ecum, fix, proj, hd, rowbase);
            if (c + 2 <= NCH) rec_issue<MODE, SEGS>(RA, c + 2, bh, hd, rowbase, proj, Eg, hid);
            REC_BAR();
            if (c + 1 <= NCH) {
                if (SEGS == 1) rec_finish<MODE>(lds, c, RB.g, ngl, hd, rowbase, mixed, hid); else rec_store_raw(lds, c, hd, rowbase, mixed, hid);
                if (hw < 3 && c + 2 < NCH) rec_ptile3(lds, c + 2, hw, lane);
                rec_stage<MODE, SEGS>(RB, lds, c + 1, hid, ecum, fix, proj, hd, rowbase);
                if (c + 3 <= NCH) rec_issue<MODE, SEGS>(RB, c + 3, bh, hd, rowbase, proj, Eg, hid);
                REC_BAR();
            }
        }
        if (SEGS > 1 && hid < 16) { float* dp = Dseg + (size_t)(bh * SEGS + sg) * 128 + 8 * hid;
            *(GAS f32x4v*)dp = (f32x4v){ecum[0], ecum[1], ecum[2], ecum[3]}; *(GAS f32x4v*)(dp + 4) = (f32x4v){ecum[4], ecum[5], ecum[6], ecum[7]}; }
    }
    __syncthreads();
}

__device__ __forceinline__ void rec_fix_unit(LAS unsigned char* lds, int unit, const bf16* proj, const float* Send, const float* Dseg, const float* ng, bf16* mixed, int tid_in, int wave) {
    int tid = tid_in; asm volatile("" : "+v"(tid)); const int lane = tid & 63;
    const int sg = unit & 3, bh = unit >> 2; const int b = bh >> 3, hd = bh & 7;
    const int r32 = lane & 31, h = lane >> 5;
    LAS unsigned char* ST = lds;
    if (sg > 0) {
        const int e = tid & 127, d0 = 32 * (tid >> 7); float sv[32], t1[32];
        const float* s0p = Send + ((size_t)(bh * 3 + 0) * 128 + d0) * 128 + e;
#pragma unroll
        for (int dd = 0; dd < 32; ++dd) sv[dd] = s0p[(size_t)dd * 128];
        __builtin_amdgcn_sched_barrier(0);
        if (sg >= 2) { const float* s1p = Send + ((size_t)(bh * 3 + 1) * 128 + d0) * 128 + e; const float* dp = Dseg + (size_t)(bh * 4 + 1) * 128 + d0;
#pragma unroll
            for (int dd = 0; dd < 32; ++dd) t1[dd] = s1p[(size_t)dd * 128];
            __builtin_amdgcn_sched_barrier(0);
#pragma unroll
            for (int dd = 0; dd < 32; ++dd) sv[dd] = dp[dd] * sv[dd] + t1[dd]; }
        if (sg >= 3) { const float* s2p = Send + ((size_t)(bh * 3 + 2) * 128 + d0) * 128 + e; const float* dp = Dseg + (size_t)(bh * 4 + 2) * 128 + d0;
#pragma unroll
            for (int dd = 0; dd < 32; ++dd) t1[dd] = s2p[(size_t)dd * 128];
            __builtin_amdgcn_sched_barrier(0);
#pragma unroll
            for (int dd = 0; dd < 32; ++dd) sv[dd] = dp[dd] * sv[dd] + t1[dd]; }
#pragma unroll
        for (int q = 0; q < 4; ++q) *(LAS v4u*)(ST + e * 272 + d0 * 2 + 16 * q) = (v4u){pk2(sv[8 * q], sv[8 * q + 1]), pk2(sv[8 * q + 2], sv[8 * q + 3]), pk2(sv[8 * q + 4], sv[8 * q + 5]), pk2(sv[8 * q + 6], sv[8 * q + 7])};
    }
    __syncthreads();
#pragma unroll 1
    for (int blk = 0; blk < 4; ++blk) {
        f32x16 O[4];
#pragma unroll
        for (int et = 0; et < 4; ++et)
#pragma unroll
            for (int i = 0; i < 16; ++i) O[et][i] = 0.f;
        const size_t trow = (size_t)b * SEQ + 1024 * sg + 256 * blk + 32 * wave + r32;
        if (sg > 0) {
            s16x8 qf[8];
            { const bf16* qp = proj + trow * PO + C_HQ + hd * 128 + 8 * h;
#pragma unroll
              for (int ks = 0; ks < 8; ++ks) qf[ks] = __builtin_bit_cast(s16x8, *(const GAS v4u*)(qp + 16 * ks)); }
#pragma unroll
            for (int et = 0; et < 4; ++et)
#pragma unroll
                for (int ks = 0; ks < 8; ++ks) O[et] = MFMA32(lds_a128(ST + (32 * et + r32) * 272 + (16 * ks + 8 * h) * 2), qf[ks], O[et]);
        }
        bf16* mp = mixed + trow * D + hd * 128 + 4 * h; const bf16* gp = proj + trow * PO + C_HG + hd * 128 + 4 * h;
        v2u ol[4][4], gl[4][4];
#pragma unroll
        for (int et = 0; et < 4; ++et)
#pragma unroll
            for (int g = 0; g < 4; ++g) { ol[et][g] = *(const GAS v2u*)(mp + 32 * et + 8 * g); gl[et][g] = *(const GAS v2u*)(gp + 32 * et + 8 * g); }
        __builtin_amdgcn_sched_barrier(0);
        float s2 = 0.f;
#pragma unroll
        for (int et = 0; et < 4; ++et)
#pragma unroll
            for (int g = 0; g < 4; ++g) { const v2u w = ol[et][g];
                O[et][4 * g] += bflo(w.x); O[et][4 * g + 1] += bfhi(w.x); O[et][4 * g + 2] += bflo(w.y); O[et][4 * g + 3] += bfhi(w.y);
                s2 += (O[et][4 * g] * O[et][4 * g] + O[et][4 * g + 1] * O[et][4 * g + 1]) + (O[et][4 * g + 2] * O[et][4 * g + 2] + O[et][4 * g + 3] * O[et][4 * g + 3]); }
        s2 += __shfl_xor(s2, 32);
        const float rs = __builtin_amdgcn_rsqf(s2 * (1.f / 128.f) + RMS_EPS);
#pragma unroll
        for (int et = 0; et < 4; ++et)
#pragma unroll
            for (int g = 0; g < 4; ++g) { const v2u gw = gl[et][g]; const f32x4v nv = *(const GAS f32x4v*)(ng + 32 * et + 8 * g + 4 * h);
                v2u w; w.x = pk2(O[et][4 * g] * rs * nv[0] * sigmoidf_(bflo(gw.x)), O[et][4 * g + 1] * rs * nv[1] * sigmoidf_(bfhi(gw.x)));
                w.y = pk2(O[et][4 * g + 2] * rs * nv[2] * sigmoidf_(bflo(gw.y)), O[et][4 * g + 3] * rs * nv[3] * sigmoidf_(bfhi(gw.y)));
                *(GAS v2u*)(mp + 32 * et + 8 * g) = w; }
    }
    __syncthreads();
}
struct Args { const float* in[19]; float* out; unsigned char* ws; int ph_lo, ph_hi, rep, pad; };
constexpr int NPH_LAYER = 11, NPHASES = 1 + DEPTH * NPH_LAYER;

__global__ void __launch_bounds__(NT, 2) trunk_fwd(Args args) {
    extern __shared__ __attribute__((aligned(16))) unsigned char lds_raw[];
    LAS unsigned char* lds = (LAS unsigned char*)lds_raw;
    volatile LAS unsigned* MISC = (volatile LAS unsigned*)(lds + MISC_OFF);
    const int tid0 = threadIdx.x; const int wave0 = __builtin_amdgcn_readfirstlane(tid0 >> 6); const int wave = wave0;
#define PHASE_TID() int tid; asm volatile("v_mbcnt_lo_u32_b32 %0, -1, 0\n\tv_mbcnt_hi_u32_b32 %0, -1, %0" : "=v"(tid)); tid |= wave0 << 6;     \
    const int lane = tid & 63; (void)lane; int wave = wave0; asm volatile("" : "+s"(wave)); (void)wave; \
    size_t wso = 0; asm volatile("" : "+s"(wso)); unsigned char* ws = args.ws + wso; gu32* ctl = (gu32*)(ws + WS_CTL); float2* rope = (float2*)(ws + WS_ROPE); float* lbv = (float*)(ws + WS_LB); \
    bf16* Hb = (bf16*)(ws + WS_H); bf16* proj = (bf16*)(ws + WS_PROJ); bf16* hid = (bf16*)(ws + WS_PROJ); bf16* mixed = (bf16*)(ws + WS_MIXED); float* rowss = (float*)(ws + WS_ROWSS); \
    bf16* kcb = (bf16*)(ws + WS_KCB); bf16* vctb = (bf16*)(ws + WS_VCTB); bf16* VTb = (bf16*)(ws + WS_VT); bf16* KTb = (bf16*)(ws + WS_KT); \
    (void)ctl; (void)rope; (void)lbv; (void)Hb; (void)proj; (void)hid; (void)mixed; (void)rowss; (void)kcb; (void)vctb; (void)VTb; (void)KTb
    const int G = gridDim.x; const int bx = blockIdx.x; const int vcu = (G % 8 == 0) ? (bx % 8) * (G / 8) + bx / 8 : bx;
    const int gw = vcu * NWAVES + wave, NGW = G * NWAVES;
    unsigned char* ws = args.ws;
    gu32* ctl = (gu32*)(ws + WS_CTL);
    for (int u = tid0; u < (LDS_BYTES - LDSCTL_OFF) / 4; u += NT) ((LAS unsigned*)(lds + LDSCTL_OFF))[u] = 0u;
    __syncthreads();
    XcdBarrier bar; bar.bar = (unsigned*)(ctl + CW_BAR); bar.x = 0; bar.st = nullptr;
#if ONE_LAUNCH
    bar = xcd_barrier_post((unsigned*)(ctl + CW_BAR), MISC + 8);
#define GRID_BAR() xcd_barrier(bar)
#else
#define GRID_BAR() do {} while (0)
#endif
    const int lo = args.ph_lo, hi = args.ph_hi;
#define IN(k) (lo <= (k) && (k) < hi)
    const float* x_in = args.in[0]; float* xres = args.out;
    float2* rope = (float2*)(ws + WS_ROPE); float* lbv = (float*)(ws + WS_LB); float* kcmp = (float*)(ws + WS_KCMP); unsigned long long* sel = (unsigned long long*)(ws + WS_SEL);
    bf16* Hb = (bf16*)(ws + WS_H); float* accn = (float*)(ws + WS_H); bf16* proj = (bf16*)(ws + WS_PROJ); bf16* hid = (bf16*)(ws + WS_PROJ); bf16* mixed = (bf16*)(ws + WS_MIXED);
    float* rowss = (float*)(ws + WS_ROWSS); bf16* kcb = (bf16*)(ws + WS_KCB); bf16* vctb = (bf16*)(ws + WS_VCTB); bf16* VTb = (bf16*)(ws + WS_VT); bf16* KTb = (bf16*)(ws + WS_KT);

    if (IN(0)) { PHASE_TID();
        LAS unsigned* scr = (LAS unsigned*)(lds + wave * 16384);
#if PROBE_ML
        const int pr = args.rep;
#else
        const int pr = 0;
#endif
        if (pr == 0 || pr == 1 || pr == 2) { convert_weights(args.in, ws, 0, scr, gw, NGW, lane); convert_weights(args.in, ws, 1, scr, gw, NGW, lane); }
        if (pr == 0 || pr == 1 || pr == 4) {
        for (int it = gw; it < 4 * 32; it += NGW) { const int m = it >> 5, r = it & 31; const int jj = m >> 1, kv = m & 1;
            tr_item64(args.in[kv ? 10 : 7] + (size_t)jj * 2048 * 64, 2048, 64, (bf16*)(ws + WS_W1T) + (size_t)m * 64 * 2048, r * 64, 0, 0, scr, lane); }
        for (int mt = gw; mt < 4 * 32; mt += NGW) { const int m = mt >> 5, ksg = mt & 31; const int jj = m >> 1, kv = m & 1;
            const float* pos = args.in[kv ? 9 : 6] + (size_t)jj * 2048 + 64 * ksg; const float* w1 = args.in[kv ? 10 : 7] + (size_t)jj * 2048 * 64 + (size_t)64 * ksg * 64;
            float acc = 0.f;
#pragma unroll 16
            for (int k = 0; k < 64; ++k) acc += pos[k] * w1[k * 64 + lane];
            ((float*)(ws + WS_CBIAS))[(m * 32 + ksg) * 64 + lane] = acc; }
        for (int idx = vcu * NT + tid; idx < SEQ * 64; idx += G * NT) { const int s = idx >> 6, i = idx & 63;
            const float inv = exp2f(-(float)i * (13.287712379549449f / 64.0f));
            double tt = (double)s * (double)inv * 0.15915494309189535; tt -= floor(tt); const float tf = (float)tt;
            rope[idx] = make_float2(__builtin_amdgcn_cosf(tf), __builtin_amdgcn_sinf(tf)); }
        for (int c = vcu * NT + tid; c < 1024; c += G * NT) { const float l0 = args.in[15][c], l1 = args.in[15][1024 + c]; lbv[c] = 0.f; lbv[1024 + c] = 1.0f / (1.0f + expf(l0 - l1)); }
        }
        if (pr == 0 || pr == 1 || pr == 3) {
        if (M % (G * 2 * NWAVES) == 0) { const int per = M / G; for (int m = vcu * per + wave; m < (vcu + 1) * per; m += 2 * NWAVES) rows2_to_bf16_ss(x_in + (size_t)m * D, x_in + (size_t)(m + NWAVES) * D, Hb + (size_t)m * D, Hb + (size_t)(m + NWAVES) * D, rowss, m, m + NWAVES, lane); }
        else if (M % G == 0) { const int per = M / G; for (int m = vcu * per + wave; m < (vcu + 1) * per; m += NWAVES) row_to_bf16_ss(x_in + (size_t)m * D, Hb + (size_t)m * D, rowss, m, lane); }
        else for (int m = gw; m < M; m += NGW) row_to_bf16_ss(x_in + (size_t)m * D, Hb + (size_t)m * D, rowss, m, lane);
        }
        __syncthreads();
        GRID_BAR();
    }

#pragma unroll 1
    for (int L = 0; L < DEPTH; ++L) {
        const int pb = 1 + L * NPH_LAYER; const int j = L >> 1; const bool even = (L & 1) == 0;
        if (IN(pb + 0)) { PHASE_TID();
            const int N = even ? PE : PO; const bf16* Wt = even ? (const bf16*)(ws + WS_WEIN) + (size_t)j * PE * D : (const bf16*)(ws + WS_WOIN) + (size_t)j * PO * D;
            pg8::Gemm g{Hb, Wt, M, N, D}; pg8::StaticOrder S; S.init(M, N, G, bx);
            build_rstd_table(lds, S, rowss, tid);
            pg8::EpiInProj E{proj, N, (const LAS int*)(lds + RS_TBL_OFF), (const LAS float*)(lds + RS_TAB_OFF), even ? 0 : 1, (const float*)rope, lbv + (size_t)j * 1024, (float*)(ws + WS_VT), PROBE_ML ? args.rep : 0};
#if PROBE_ML
            if (args.rep == 7 && (bx % 8) >= 4) S.nwg = 0;
            if (args.rep == 8 && (bx % 8) != 0) S.nwg = 0;
            if (args.rep == 10 || args.rep == 11) { const int ns = (bx % 8) * (args.rep == 10 ? 1 : 2); for (int i = 0; i < ns; ++i) __builtin_amdgcn_s_sleep(82); }
#endif
            pg8::gemm_phase<pg8::EpiInProj, pg8::StaticOrder, PG8_ALIGN, PG8_SP2>(lds, g, S, E, tid);
            GRID_BAR();
        }
        if (even && IN(pb + 1)) { PHASE_TID();
#if REC_NAIVE
            const int nret = (G > 64) ? 32 : 0;
            if (nret == 0 || vcu < nret) for (int u = vcu; u < 32; u += (nret ? nret : G)) recur_unit<0>(lds, u >> 2, u & 3, proj, PE, rope, nullptr, nullptr, mixed, tid, lane, wave);
            if (nret == 0 || vcu >= nret)
#else
            const int nret = 0;
#endif
            {
                LAS float* xs = (LAS float*)(lds + wave * 16384);
                const int w0 = nret ? (vcu - nret) * NWAVES + wave : gw, nw = nret ? (G - nret) * NWAVES : NGW;
                for (int item = w0; item < 16 * 2 * 64; item += nw) kv_tile_item((LAS unsigned short*)xs, item, proj, KTb, VTb, lane);
                __syncthreads();
                for (int u = vcu; u < 256; u += G) compress_unit(lds, u, proj, (const bf16*)(ws + WS_W1T) + (size_t)j * 2 * 64 * 2048, (const float*)(ws + WS_CBIAS) + j * 2 * 32 * 64, args.in[8] + (size_t)j * 4096, args.in[11] + (size_t)j * 4096, kcb, vctb, tid, wave);
            }
            __syncthreads();
            GRID_BAR();
        }
#if NSA_NAIVE
        if (even && IN(pb + 2)) { PHASE_TID();
            LAS float* wl = (LAS float*)(lds + wave * 4096);
            for (int task = gw; task < 16 * SEQ; task += NGW) cmp_attn_task(wl, task, proj, kcmp, accn, sel, lane);
            __syncthreads();
            GRID_BAR();
        }
        if (even && IN(pb + 3)) { PHASE_TID();
            LAS float* wl = (LAS float*)(lds + wave * 4096);
            for (int task = gw; task < 16 * SEQ; task += NGW) blk_attn_task<0>(wl, task, proj, sel, accn, mixed, lane);
            __syncthreads();
            GRID_BAR();
        }
        if (even && IN(pb + 4)) { PHASE_TID();
            LAS float* wl = (LAS float*)(lds + wave * 4096);
            for (int task = gw; task < 16 * SEQ; task += NGW) blk_attn_task<1>(wl, task, proj, sel, accn, mixed, lane);
            __syncthreads();
            GRID_BAR();
        }
#else
        if (even && IN(pb + 2)) { PHASE_TID();
            const int per = (G % 8 == 0 && G >= 64) ? G / 8 : 0;
            { const int ru0 = per ? (((vcu % per) % 8 == 0 && (vcu % per) / 8 < 4) ? (vcu / per) * 4 + (vcu % per) / 8 : BATCH * 4) : vcu, rstep = per ? BATCH * 4 : G;
              for (int u = ru0; u < BATCH * 4; u += rstep) rec_serial_unit<0, 1>(lds, u, proj, nullptr, nullptr, mixed, nullptr, nullptr, tid, wave); }
            const int xq = per ? vcu / per : 0; const unsigned nitem = per ? 128u : 1024u;
            for (;;) {
                if (tid == 0) MISC[0] = __hip_atomic_fetch_add((unsigned*)(ctl + CW_Q + 64 * (j * 8 + xq + 16 * args.rep)), 1u, __ATOMIC_RELAXED, __HIP_MEMORY_SCOPE_AGENT);
                __syncthreads();
                const unsigned it = MISC[0];
                __syncthreads();
                if (it >= nitem) break;
                nsa_subunit(lds, per ? 2 * xq + (int)(it & 1u) : (int)(it & 15u), 63 - (int)(per ? it >> 1 : it >> 4), proj, kcb, vctb, KTb, VTb, mixed, tid, wave);
            }
            __syncthreads();
            GRID_BAR();
        }
#endif
#if REC_NAIVE
        if (!even && IN(pb + 5)) { PHASE_TID();
            for (int u = vcu; u < 64; u += G) recur_unit<1>(lds, u >> 3, u & 7, proj, PO, nullptr, lbv + (size_t)j * 1024, args.in[14] + (size_t)j * 128, mixed, tid, lane, wave);
            __syncthreads();
            GRID_BAR();
        }
#else
        if (!even && IN(pb + 3)) { PHASE_TID();
            for (int u = vcu; u < BATCH * 8 * 4; u += G) rec_serial_unit<1, 4>(lds, u, proj, (const float*)(ws + WS_VT), nullptr, mixed, (float*)(ws + WS_VT + 4 * MiB), (float*)(ws + WS_KCB), tid, wave);
            __syncthreads();
            GRID_BAR();
        }
        if (!even && IN(pb + 5)) { PHASE_TID();
            for (int u = vcu; u < BATCH * 8 * 4; u += G) rec_fix_unit(lds, u, proj, (const float*)(ws + WS_VT + 4 * MiB), (const float*)(ws + WS_KCB), args.in[14] + (size_t)j * 128, mixed, tid, wave);
            __syncthreads();
            GRID_BAR();
        }
#endif
        if (IN(pb + 6)) { PHASE_TID();
            const bf16* Wt = even ? (const bf16*)(ws + WS_WEOUT) + (size_t)j * D * D : (const bf16*)(ws + WS_WOOUT) + (size_t)j * D * D;
            pg8::Gemm g{mixed, Wt, M, D, D}; pg8::StaticOrder S; S.init(M, D, G, bx);
            pg8::EpiResF32 E{Hb, D, (PROBE_ML && args.rep) ? 0.f : 1.f, rowss, M, PROBE_ML ? args.rep : 0};
            pg8::gemm_phase<pg8::EpiResF32, pg8::StaticOrder, PG8_ALIGN, PG8_SP2>(lds, g, S, E, tid);
            GRID_BAR();
        }
        if (IN(pb + 8)) { PHASE_TID();
            pg8::Gemm g{Hb, (const bf16*)(ws + WS_W13) + (size_t)L * FF2 * D, M, FF2, D}; pg8::StaticOrder S; S.init(M, FF2, G, bx);
            build_rstd_table(lds, S, rowss, tid);
            pg8::EpiSwiGLU E{hid, FF, (const LAS int*)(lds + RS_TBL_OFF), (const LAS float*)(lds + RS_TAB_OFF), PROBE_ML ? args.rep : 0};
            pg8::gemm_phase<pg8::EpiSwiGLU, pg8::StaticOrder, PG8_ALIGN, PG8_SP2>(lds, g, S, E, tid);
            GRID_BAR();
        }
        if (IN(pb + 9)) { PHASE_TID();
            pg8::Gemm g{hid, (const bf16*)(ws + WS_W2) + (size_t)L * D * FF, M, D, FF}; pg8::StaticOrder S; S.init(M, D, G, bx);
            pg8::EpiResF32 E{Hb, D, (PROBE_ML && args.rep) ? 0.f : 1.f, rowss, M, PROBE_ML ? args.rep : 0};
            pg8::gemm_phase<pg8::EpiResF32, pg8::StaticOrder, PG8_ALIGN, PG8_SP2>(lds, g, S, E, tid);
            GRID_BAR();
        }
        if (L + 1 == DEPTH && IN(pb + 10)) { PHASE_TID();
#if PROBE_ML
            if (args.rep == 5 || (args.rep == 9 && (bx % 8) == 0)) {
                typedef short bf16x8_ __attribute__((ext_vector_type(8)));
                bf16x8_ af[4], bfm[4];
                for (int i = 0; i < 4; ++i) { af[i] = *(const bf16x8_*)(Hb + (size_t)(gw * 64 + lane) * D + i * 8); bfm[i] = *(const bf16x8_*)(Hb + (size_t)(gw * 64 + lane) * D + 512 + i * 8); }
                f32x4 c[4][4];
                for (int i = 0; i < 4; ++i) for (int k = 0; k < 4; ++k) c[i][k] = (f32x4){0.f, 0.f, 0.f, 0.f};
#pragma unroll 1
                for (int it = 0; it < 4096; ++it) {
#pragma unroll
                    for (int i = 0; i < 4; ++i)
#pragma unroll
                        for (int k = 0; k < 4; ++k) c[i][k] = __builtin_amdgcn_mfma_f32_16x16x32_bf16(af[i], bfm[k], c[i][k], 0, 0, 0);
                }
                f32x4 sacc = (f32x4){0.f, 0.f, 0.f, 0.f};
                for (int i = 0; i < 4; ++i) for (int k = 0; k < 4; ++k) sacc += c[i][k];
                ((f32x4*)(ws + WS_CTL + 512 * 1024))[gw * 64 + lane] = sacc;
            } else if (args.rep == 9) {
            } else if (args.rep == 6) {
                float a = bf2f(Hb[(size_t)(gw * 64 + lane) * D]), b = 1.0000001f, c0 = 1e-9f;
#pragma unroll 1
                for (int it = 0; it < 131072 / 16; ++it) {
#pragma unroll
                    for (int k = 0; k < 16; ++k) asm volatile("v_fma_f32 %0, %0, %1, %2" : "+v"(a) : "v"(b), "v"(c0));
                }
                ((float*)(ws + WS_CTL + 512 * 1024))[gw * 64 + lane] = a;
            } else
#endif
            for (int m = gw; m < M; m += NGW) rms_row_bf16_to_f32(Hb + (size_t)m * D, args.in[3], xres + (size_t)m * D, lane);
        }
    }
#undef IN
}

extern "C" void kernel_launch(void* const* d_in, const int* in_sizes, int n_in, void* d_out, int out_size, void* d_ws, size_t ws_size, hipStream_t stream) {
    static int grid = 0;
    if (grid == 0) {
        if (n_in != 19 || in_sizes[0] != M * D || out_size != M * D || ws_size < WS_END) { fprintf(stderr, "kernel_launch: unexpected shapes/workspace (n_in %d, in0 %d, out %d, ws %zu); nothing launched\n", n_in, n_in > 0 ? in_sizes[0] : -1, out_size, ws_size); grid = -1; return; }
        int dev = 0, cus = 0;
        if (hipGetDevice(&dev) != hipSuccess || hipDeviceGetAttribute(&cus, hipDeviceAttributeMultiprocessorCount, dev) != hipSuccess) { grid = -1; return; }
        if (hipFuncSetAttribute((const void*)trunk_fwd, hipFuncAttributeMaxDynamicSharedMemorySize, LDS_BYTES) != hipSuccess) { fprintf(stderr, "kernel_launch: hipFuncSetAttribute failed\n"); grid = -1; return; }
        int per_cu = 0;
        if (hipOccupancyMaxActiveBlocksPerMultiprocessor(&per_cu, (const void*)trunk_fwd, NT, LDS_BYTES) != hipSuccess || per_cu < 1) fprintf(stderr, "kernel_launch: occupancy query reports %d\n", per_cu);
        (void)hipGetLastError();
        grid = cus;
    }
    if (grid < 0) return;
    (void)hipMemsetAsync((char*)d_ws + WS_CTL, 0, CTL_ZERO_BYTES, stream);
    Args a{};
    for (int i = 0; i < 19; ++i) a.in[i] = (const float*)d_in[i];
    a.out = (float*)d_out; a.ws = (unsigned char*)d_ws;
#if ONE_LAUNCH && !PROBE_ML
    a.ph_lo = 0; a.ph_hi = NPHASES;
    hipLaunchKernelGGL(trunk_fwd, dim3(grid), dim3(NT), LDS_BYTES, stream, a);
#else
#if ONE_LAUNCH
#define PROBE_RESET() (void)hipMemsetAsync((char*)d_ws + WS_CTL + CW_BAR * 4, 0, (CW_Q - CW_BAR) * 4, stream)
#else
#define PROBE_RESET() do {} while (0)
#endif
    for (int p = 0; p < NPHASES; ++p) {
        if (p > 0) { const int L = (p - 1) / NPH_LAYER, k = (p - 1) % NPH_LAYER; const bool even = (L & 1) == 0; if (even && (k == 5 || ((k == 3 || k == 4) && !NSA_NAIVE))) continue; if (!even && (k == 1 || k == 2 || k == 4)) continue; if (k == 7 || (k == 10 && L + 1 < DEPTH)) continue; }
        a.ph_lo = p; a.ph_hi = p + 1; a.rep = 0;
        PROBE_RESET();
        hipLaunchKernelGGL(trunk_fwd, dim3(grid), dim3(NT), LDS_BYTES, stream, a);
#ifdef REP_K
        if ((p == 0 && REP_K == -2) || (p > 0 && (p - 1) % NPH_LAYER == REP_K)) { a.rep = REP_MODE; PROBE_RESET(); hipLaunchKernelGGL(trunk_fwd, dim3(grid), dim3(NT), LDS_BYTES, stream, a); }
#endif
    }
#endif
}
```

```cpp
#include <hip/hip_runtime.h>
#include <cstdio>
#include <cstdint>

#ifndef ONE_LAUNCH
#define ONE_LAUNCH 1
#define PROBE_ML 0
#endif

namespace pg8 {
#define PG8_LAS __attribute__((address_space(3)))
typedef unsigned short bf16_t;
typedef short bf16x8 __attribute__((ext_vector_type(8)));
typedef float f32x4 __attribute__((ext_vector_type(4)));
typedef unsigned u32x4 __attribute__((ext_vector_type(4)));
constexpr int BM = 256, BK = 64, HALF = 128, HTB = HALF * BK * 2  , STAGE_BYTES = 8 * HTB, NXCD = 8, WGM = 8;

__host__ __device__ __forceinline__ int lds_byte(int r, int c) { const int st = (r >> 4) * 2 + (c >> 5), rr = r & 15, cc = c & 31, ob = rr * 64 + cc * 2; return st * 1024 + (ob ^ (((ob >> 9) & 1) << 5)); }
__host__ __device__ __forceinline__ void stage_rc(int b, int& R, int& C) { const int st = b / 1024, sb = b % 1024, swz = sb ^ (((sb >> 9) & 1) << 5); R = (st >> 1) * 16 + swz / 64; C = (st & 1) * 32 + (swz % 64) / 2; }
__host__ __device__ __forceinline__ int perm32(int rho) { const int n = rho >> 4, i = rho & 15; return 8 * (i >> 2) + 4 * n + (i & 3); }

struct Unit { int pm, pn; };
struct Gemm { const bf16_t* A; const bf16_t* Bt; int M, N, K; };

struct StaticOrder {
    int nM, nN, nwg, G, c;
    __host__ __device__ void init(int M, int N, int G_, int c_) { nM = M / BM; nN = N / BM; nwg = nM * nN; G = G_; c = c_; }
    __host__ __device__ bool next(int i, Unit& u) const {
        const long L = (long)i * G + c; if (L >= nwg) return false;
        int wgid = (int)L; { const int q = nwg / NXCD, r = nwg % NXCD, xcd = wgid % NXCD, off = wgid / NXCD; wgid = (xcd < r ? xcd * (q + 1) : r * (q + 1) + (xcd - r) * q) + off; }
        const int nig = WGM * nN, gid = wgid / nig, fm = gid * WGM, gsz = (nM - fm) < WGM ? (nM - fm) : WGM;
        u.pm = fm + ((wgid % nig) % gsz); u.pn = (wgid % nig) / gsz; return true;
    }
    __device__ __forceinline__ void a_ready(const Unit&) const {}
    __device__ __forceinline__ void done(const Unit&) const {}
};

#ifndef NST_INPROJ
#define NST_INPROJ (PROBE_ML ? 0 : 16)
#endif
__device__ __forceinline__ unsigned cvt_pk_bf16(float lo, float hi) { unsigned r; asm volatile("v_cvt_pk_bf16_f32 %0, %1, %2" : "=v"(r) : "v"(lo), "v"(hi)); return r; }
__device__ __forceinline__ float fast_silu(float x) { return x * __builtin_amdgcn_rcpf(1.0f + __expf(-x)); }

__device__ __forceinline__ void row_rstd8(const PG8_LAS int* tbl, const PG8_LAS float* rsl, const Unit& u, int rl0, float (&rs)[2][4]) {
    const PG8_LAS float* p = rsl + tbl[u.pm] * 256 + rl0;
#pragma unroll
    for (int ai = 0; ai < 2; ++ai)
#pragma unroll
        for (int m = 0; m < 4; ++m) rs[ai][m] = p[ai * HALF + m * 16];
}
struct EpiBf16Plain {
    static constexpr bool PERM = true, AFTER_DRAIN = false; static constexpr int NST = PROBE_ML ? 0 : 16;
    bf16_t* O; int ldc; const PG8_LAS int* tbl; const PG8_LAS float* rsl;
    __device__ __forceinline__ void operator()(const f32x4 (&acc)[2][2][4][2], const Unit& u, int wr, int wc, int fr, int fq) const {
        const int row0 = u.pm * BM + wr * 64 + fr, col0 = u.pn * BM + wc * 32 + 8 * fq;
        float rs[2][4]; row_rstd8(tbl, rsl, u, wr * 64 + fr, rs);
#pragma unroll
        for (int ai = 0; ai < 2; ++ai)
#pragma unroll
            for (int m = 0; m < 4; ++m) { bf16_t* rowp = O + (size_t)(row0 + ai * HALF + m * 16) * ldc + col0; const float r = rs[ai][m];
#pragma unroll
                for (int bj = 0; bj < 2; ++bj) { const f32x4 v0 = acc[ai][bj][m][0] * r, v1 = acc[ai][bj][m][1] * r;
                    u32x4 w; w.x = cvt_pk_bf16(v0[0], v0[1]); w.y = cvt_pk_bf16(v0[2], v0[3]); w.z = cvt_pk_bf16(v1[0], v1[1]); w.w = cvt_pk_bf16(v1[2], v1[3]);
                    *(u32x4*)(rowp + bj * HALF) = w; } }
    }
};

__device__ __forceinline__ float dpp_scan16(float x) {
    x += __builtin_bit_cast(float, __builtin_amdgcn_update_dpp(0, __builtin_bit_cast(int, x), 0x111, 0xf, 0xf, true));
    x += __builtin_bit_cast(float, __builtin_amdgcn_update_dpp(0, __builtin_bit_cast(int, x), 0x112, 0xf, 0xf, true));
    x += __builtin_bit_cast(float, __builtin_amdgcn_update_dpp(0, __builtin_bit_cast(int, x), 0x114, 0xf, 0xf, true));
    x += __builtin_bit_cast(float, __builtin_amdgcn_update_dpp(0, __builtin_bit_cast(int, x), 0x118, 0xf, 0xf, true));
    return x;
}
struct EpiInProj {
    static constexpr bool PERM = true, AFTER_DRAIN = false; static constexpr int NST = NST_INPROJ;
    bf16_t* O; int ldc; const PG8_LAS int* tbl; const PG8_LAS float* rsl;
    int mode; const float* rope; const float* lb; float* Eg; int dbg;
    __device__ __forceinline__ void operator()(const f32x4 (&acc)[2][2][4][2], const Unit& u, int wr, int wc, int fr, int fq) const {
        if (dbg == 3) return;
        const int row0 = u.pm * BM + wr * 64 + fr;
        float rs[2][4]; row_rstd8(tbl, rsl, u, wr * 64 + fr, rs);
        const int lane = (fq << 4) | fr;
        if (mode == 0 && u.pn < 4) {
            const int hd = u.pn; const int i0 = 16 * wc + 4 * fq;
            const float lg = __builtin_amdgcn_logf(1.0f - __builtin_amdgcn_exp2f(-5.0f - (float)hd));
            const int pos0 = row0 & 4095;
            const f32x4* cs = (const f32x4*)(rope + ((size_t)pos0 * 64 + i0) * 2); const f32x4* c16p = (const f32x4*)(rope + ((size_t)16 * 64 + i0) * 2); const f32x4* c128p = (const f32x4*)(rope + ((size_t)128 * 64 + i0) * 2);
            const f32x4 b01 = cs[0], b23 = cs[1], s01 = c16p[0], s23 = c16p[1], t01 = c128p[0], t23 = c128p[1];
            float cb[4] = {b01[0], b01[2], b23[0], b23[2]}, sb[4] = {b01[1], b01[3], b23[1], b23[3]};
            const float c16[4] = {s01[0], s01[2], s23[0], s23[2]}, s16[4] = {s01[1], s01[3], s23[1], s23[3]}, c128[4] = {t01[0], t01[2], t23[0], t23[2]}, s128[4] = {t01[1], t01[3], t23[1], t23[3]};
            float gpv[2], giv[2]; float k884 = 0.08838834764831845f; asm volatile("" : "+v"(k884));
#pragma unroll
            for (int par = 0; par < 2; ++par) { const float tl1 = (float)(fr + 16 * par + 1); gpv[par] = __builtin_amdgcn_exp2f(tl1 * lg); giv[par] = k884 * __builtin_amdgcn_exp2f(-tl1 * lg); }
            typedef unsigned u32x2 __attribute__((ext_vector_type(2)));
#pragma unroll
            for (int ai = 0; ai < 2; ++ai) {
                float c[4], sn[4];
#pragma unroll
                for (int k = 0; k < 4; ++k) { c[k] = cb[k]; sn[k] = sb[k]; }
#pragma unroll
                for (int m = 0; m < 4; ++m) { const int row = row0 + ai * HALF + m * 16; const float r = rs[ai][m];
#pragma unroll
                    for (int bj = 0; bj < 2; ++bj) { const f32x4 x1 = acc[ai][bj][m][0] * r, x2 = acc[ai][bj][m][1] * r; const float sc = bj ? giv[m & 1] : gpv[m & 1];
                        float a[4], b[4];
#pragma unroll
                        for (int k = 0; k < 4; ++k) { a[k] = (x1[k] * c[k] - x2[k] * sn[k]) * sc; b[k] = (x1[k] * sn[k] + x2[k] * c[k]) * sc; }
                        bf16_t* dst = O + (size_t)row * ldc + (bj ? 512 : 0) + hd * 128 + i0;
                        u32x2 w0; w0.x = cvt_pk_bf16(a[0], a[1]); w0.y = cvt_pk_bf16(a[2], a[3]); *(u32x2*)dst = w0;
                        u32x2 w1; w1.x = cvt_pk_bf16(b[0], b[1]); w1.y = cvt_pk_bf16(b[2], b[3]); *(u32x2*)(dst + 64) = w1; }
                    if (m < 3) {
#pragma unroll
                        for (int k = 0; k < 4; ++k) { const float cn = c[k] * c16[k] - sn[k] * s16[k]; sn[k] = sn[k] * c16[k] + c[k] * s16[k]; c[k] = cn; } }
                }
                if (ai == 0) {
#pragma unroll
                    for (int k = 0; k < 4; ++k) { const float cn = cb[k] * c128[k] - sb[k] * s128[k]; sb[k] = sb[k] * c128[k] + cb[k] * s128[k]; cb[k] = cn; } }
            }
        } else if (mode == 1 && u.pn < 8) {
            const int hd = u.pn; const int ch0 = 32 * wc + 8 * fq;
            const f32x4 lb0 = *(const f32x4*)(lb + hd * 128 + ch0), lb1 = *(const f32x4*)(lb + hd * 128 + ch0 + 4);
            float lw[8], oml[8];
#pragma unroll
            for (int k = 0; k < 8; ++k) { lw[k] = k < 4 ? lb0[k & 3] : lb1[k & 3]; oml[k] = 1.0f - lw[k]; }
            const int src15 = ((lane & 48) | 15) << 2;
#pragma unroll
            for (int ai = 0; ai < 2; ++ai)
#pragma unroll
                for (int mp = 0; mp < 2; ++mp) {
                    float carry[8];
#pragma unroll
                    for (int mm = 0; mm < 2; ++mm) { const int m = 2 * mp + mm; const int row = row0 + ai * HALF + m * 16; const float r = rs[ai][m];
                        const float rn = -1.4426950408889634f * r, rc = 0.08838834764831845f * r;
                        float B[8], sg[8], Ef[8];
#pragma unroll
                        for (int k = 0; k < 8; ++k) { Ef[k] = __builtin_amdgcn_exp2f(acc[ai][1][m][k >> 2][k & 3] * rn);
                            sg[k] = __builtin_amdgcn_rcpf(1.0f + Ef[k]); B[k] = __builtin_amdgcn_logf(fmaf(oml[k], sg[k], lw[k])); }
#pragma unroll
                        for (int k = 0; k < 8; ++k) B[k] += __builtin_bit_cast(float, __builtin_amdgcn_update_dpp(0, __builtin_bit_cast(int, B[k]), 0x111, 0xf, 0xf, true));
#pragma unroll
                        for (int k = 0; k < 8; ++k) B[k] += __builtin_bit_cast(float, __builtin_amdgcn_update_dpp(0, __builtin_bit_cast(int, B[k]), 0x112, 0xf, 0xf, true));
#pragma unroll
                        for (int k = 0; k < 8; ++k) B[k] += __builtin_bit_cast(float, __builtin_amdgcn_update_dpp(0, __builtin_bit_cast(int, B[k]), 0x114, 0xf, 0xf, true));
#pragma unroll
                        for (int k = 0; k < 8; ++k) B[k] += __builtin_bit_cast(float, __builtin_amdgcn_update_dpp(0, __builtin_bit_cast(int, B[k]), 0x118, 0xf, 0xf, true));
                        if (mm == 1) {
#pragma unroll
                            for (int k = 0; k < 8; ++k) B[k] += carry[k]; }
                        if (mm == 0) {
#pragma unroll
                            for (int k = 0; k < 8; ++k) carry[k] = __builtin_bit_cast(float, __builtin_amdgcn_ds_bpermute(src15, __builtin_bit_cast(int, B[k]))); }
                        float qt[8], kt[8], ev[8];
#pragma unroll
                        for (int k = 0; k < 8; ++k) { const float aq = acc[ai][0][m][k >> 2][k & 3];
                            const float e = __builtin_amdgcn_exp2f(B[k]), ei = __builtin_amdgcn_exp2f(-B[k]);
                            const float iq = __builtin_amdgcn_rcpf(1.0f + __builtin_amdgcn_exp2f(aq * rn));
                            qt[k] = (aq * rc) * (iq * e);
                            kt[k] = (oml[k] * Ef[k]) * (sg[k] * ei); ev[k] = e; }
                        bf16_t* dst = O + (size_t)row * ldc + hd * 128 + ch0;
                        u32x4 wq; wq.x = cvt_pk_bf16(qt[0], qt[1]); wq.y = cvt_pk_bf16(qt[2], qt[3]); wq.z = cvt_pk_bf16(qt[4], qt[5]); wq.w = cvt_pk_bf16(qt[6], qt[7]); *(u32x4*)dst = wq;
                        u32x4 wk; wk.x = cvt_pk_bf16(kt[0], kt[1]); wk.y = cvt_pk_bf16(kt[2], kt[3]); wk.z = cvt_pk_bf16(kt[4], kt[5]); wk.w = cvt_pk_bf16(kt[6], kt[7]); *(u32x4*)(dst + 1024) = wk;
                        if (mm == 1 && fr == 15) { float* ep = Eg + ((size_t)((row >> 12) * 8 + hd) * 128 + ((row & 4095) >> 5)) * 128 + ch0;
                            *(f32x4*)ep = (f32x4){ev[0], ev[1], ev[2], ev[3]}; *(f32x4*)(ep + 4) = (f32x4){ev[4], ev[5], ev[6], ev[7]}; } }
                }
        } else {
            const int col0 = u.pn * BM + wc * 32 + 8 * fq;
#pragma unroll
            for (int ai = 0; ai < 2; ++ai)
#pragma unroll
                for (int m = 0; m < 4; ++m) { bf16_t* rowp = O + (size_t)(row0 + ai * HALF + m * 16) * ldc + col0; const float r = rs[ai][m];
#pragma unroll
                    for (int bj = 0; bj < 2; ++bj) { const f32x4 v0 = acc[ai][bj][m][0] * r, v1 = acc[ai][bj][m][1] * r;
                        u32x4 w; w.x = cvt_pk_bf16(v0[0], v0[1]); w.y = cvt_pk_bf16(v0[2], v0[3]); w.z = cvt_pk_bf16(v1[0], v1[1]); w.w = cvt_pk_bf16(v1[2], v1[3]);
                        *(u32x4*)(rowp + bj * HALF) = w; } }
        }
    }
};
struct EpiResF32 {
    static constexpr bool PERM = true, AFTER_DRAIN = false; static constexpr int NST = PROBE_ML ? 0 : 16;
    bf16_t* xb; int ldc; float scale; float* rowss; int M_; int dbg;
    __device__ __forceinline__ void operator()(const f32x4 (&acc)[2][2][4][2], const Unit& u, int wr, int wc, int fr, int fq) const {
        if (dbg == 3) return;
        const int row0 = u.pm * BM + wr * 64 + fr, col0 = u.pn * BM + wc * 32 + 8 * fq;
        u32x4 r[2][4][2];
#pragma unroll
        for (int ai = 0; ai < 2; ++ai)
#pragma unroll
            for (int m = 0; m < 4; ++m) { const size_t ro = (size_t)(row0 + ai * HALF + m * 16) * ldc + col0;
#pragma unroll
                for (int bj = 0; bj < 2; ++bj) r[ai][m][bj] = *(const u32x4*)(xb + ro + bj * HALF); }
        __builtin_amdgcn_sched_barrier(0);
#pragma unroll
        for (int ai = 0; ai < 2; ++ai) {
#pragma unroll
            for (int m = 0; m < 4; ++m) { const size_t ro = (size_t)(row0 + ai * HALF + m * 16) * ldc + col0; float q = 0.f;
#pragma unroll
                for (int bj = 0; bj < 2; ++bj) { const u32x4 rw = r[ai][m][bj]; const unsigned rr[4] = {rw.x, rw.y, rw.z, rw.w}; unsigned ow[4];
#pragma unroll
                    for (int k = 0; k < 4; ++k) { const f32x4 a = acc[ai][bj][m][k >> 1];
                        const float lo = __builtin_bit_cast(float, rr[k] << 16) + a[2 * (k & 1)] * scale, hi = __builtin_bit_cast(float, rr[k] & 0xffff0000u) + a[2 * (k & 1) + 1] * scale;
                        const unsigned w = cvt_pk_bf16(lo, hi); ow[k] = w;
                        const float l2 = __builtin_bit_cast(float, w << 16), h2 = __builtin_bit_cast(float, w & 0xffff0000u); q += l2 * l2 + h2 * h2; }
                    u32x4 o; o.x = ow[0]; o.y = ow[1]; o.z = ow[2]; o.w = ow[3]; *(u32x4*)(xb + ro + bj * HALF) = o; }
                q += __shfl_xor(q, 16); q += __shfl_xor(q, 32);
                if (fq == 0) rowss[(size_t)(u.pn * 4 + wc) * M_ + row0 + ai * HALF + m * 16] = q; }
            __builtin_amdgcn_sched_barrier(0);
        }
    }
};
struct EpiSwiGLU {
    static constexpr bool PERM = true, AFTER_DRAIN = false; static constexpr int NST = PROBE_ML ? 0 : 8;
    bf16_t* O; int ldc; const PG8_LAS int* tbl; const PG8_LAS float* rsl; int dbg;
    __device__ __forceinline__ void operator()(const f32x4 (&acc)[2][2][4][2], const Unit& u, int wr, int wc, int fr, int fq) const {
        if (dbg == 3) return;
        const int row0 = u.pm * BM + wr * 64 + fr, col0 = u.pn * HALF + wc * 32 + 8 * fq;
        float rs[2][4]; row_rstd8(tbl, rsl, u, wr * 64 + fr, rs);
#pragma unroll
        for (int ai = 0; ai < 2; ++ai)
#pragma unroll
            for (int m = 0; m < 4; ++m) { bf16_t* rowp = O + (size_t)(row0 + ai * HALF + m * 16) * ldc + col0; const float r = rs[ai][m];
                const f32x4 g0 = acc[ai][0][m][0] * r, g1 = acc[ai][0][m][1] * r, u0 = acc[ai][1][m][0] * r, u1 = acc[ai][1][m][1] * r;
                u32x4 w; w.x = cvt_pk_bf16(fast_silu(g0[0]) * u0[0], fast_silu(g0[1]) * u0[1]); w.y = cvt_pk_bf16(fast_silu(g0[2]) * u0[2], fast_silu(g0[3]) * u0[3]);
                w.z = cvt_pk_bf16(fast_silu(g1[0]) * u1[0], fast_silu(g1[1]) * u1[1]); w.w = cvt_pk_bf16(fast_silu(g1[2]) * u1[2], fast_silu(g1[3]) * u1[3]);
                if (dbg != 2 || w.x == 0x12345u) *(u32x4*)rowp = w; }
    }
};

template <class Epi, class Sched, bool ALIGN_EPI = false, bool SP2 = false>
__device__ __forceinline__ void gemm_phase(PG8_LAS unsigned char* lds, const Gemm g, const Sched& S, const Epi& E, const int tid_in) {
    const int tid = tid_in, wid = __builtin_amdgcn_readfirstlane(tid >> 6), lane = tid & 63, wr = wid >> 2, wc = wid & 3, fr = lane & 15, fq = lane >> 4;
    const int K = g.K, nt = K / BK;
    constexpr bool RELAX = SP2 && ALIGN_EPI && (Epi::NST > 0);
    unsigned voffA[2], voffB[2];
#pragma unroll
    for (int i = 0; i < 2; ++i) { int R, C; stage_rc(tid * 16 + i * 8192, R, C); const int Rb = Epi::PERM ? ((R & ~31) + perm32(R & 31)) : R;
        voffA[i] = (unsigned)(R * K + C) * 2u; voffB[i] = (unsigned)(Rb * K + C) * 2u; }
    const size_t kstep = (size_t)(BK * 2);
    const size_t hstep = (size_t)HALF * K * 2;
    const size_t tstep = 2 * hstep;
    const unsigned ldsw = (unsigned)wid * 1024u;
    const int aoff = lds_byte(wr * 64 + fr, fq * 8), boff = lds_byte(wc * 32 + fr, fq * 8);
#define PG8_SA(b, h) (((b) * 2 + (h)) * HTB)
#define PG8_SB(b, h) ((4 + (b) * 2 + (h)) * HTB)
#define PG8_STAGE(bufoff, gbase, voff) do { _Pragma("unroll") for (int _i = 0; _i < 2; ++_i) \
        __builtin_amdgcn_global_load_lds((const unsigned*)((const char*)(gbase) + (voff)[_i]), (PG8_LAS unsigned*)(lds + (bufoff) + ldsw + _i * 8192), 16, 0, 0); } while (0)
#define PG8_LDA(dst, b, h) do { _Pragma("unroll") for (int m = 0; m < 4; ++m) _Pragma("unroll") for (int k = 0; k < 2; ++k) dst[m][k] = *(const PG8_LAS bf16x8*)(lds + PG8_SA(b, h) + aoff + m * 2048 + k * 1024); } while (0)
#define PG8_LDB(dst, b, h) do { _Pragma("unroll") for (int n = 0; n < 2; ++n) _Pragma("unroll") for (int k = 0; k < 2; ++k) dst[n][k] = *(const PG8_LAS bf16x8*)(lds + PG8_SB(b, h) + boff + n * 2048 + k * 1024); } while (0)
#define PG8_MMA(ai, bj, At, Bt) do { __builtin_amdgcn_s_setprio(1); _Pragma("unroll") for (int m = 0; m < 4; ++m) _Pragma("unroll") for (int n = 0; n < 2; ++n) _Pragma("unroll") for (int k = 0; k < 2; ++k) \
        acc[ai][bj][m][n] = __builtin_amdgcn_mfma_f32_16x16x32_bf16(Bt[n][k], At[m][k], acc[ai][bj][m][n], 0, 0, 0); __builtin_amdgcn_s_setprio(0); } while (0)
#define PG8_WAIT_V(n) asm volatile("s_waitcnt vmcnt(" #n ")" ::: "memory")
#define PG8_SPTR(p) asm volatile("" : "+s"(p))
#define PG8_WAIT_VN(n) asm volatile("s_waitcnt vmcnt(%0)" :: "n"(n) : "memory")
#define PG8_WAIT_L(n) asm volatile("s_waitcnt lgkmcnt(" #n ")" ::: "memory")
#define PG8_BAR __builtin_amdgcn_s_barrier()
#define PG8_SCHED __builtin_amdgcn_sched_barrier(0)
    Unit cur, nxt; int ui = 0;
    if (!S.next(0, cur)) return;
    f32x4 acc[2][2][4][2];
#pragma unroll
    for (int a = 0; a < 2; ++a)
#pragma unroll
        for (int b = 0; b < 2; ++b)
#pragma unroll
            for (int m = 0; m < 4; ++m)
#pragma unroll
                for (int n = 0; n < 2; ++n) acc[a][b][m][n] = (f32x4){0.f, 0.f, 0.f, 0.f};
    bf16x8 At[4][2], B0[2][2], B1[2][2];
    const char* cA = (const char*)g.A + (size_t)cur.pm * tstep; const char* cB = (const char*)g.Bt + (size_t)cur.pn * tstep;
    S.a_ready(cur);
    if constexpr (RELAX) {
        PG8_STAGE(PG8_SB(0, 0), cB, voffB); PG8_STAGE(PG8_SB(0, 1), cB + hstep, voffB); PG8_STAGE(PG8_SA(0, 0), cA, voffA); PG8_STAGE(PG8_SA(0, 1), cA + hstep, voffA);
        { const char* pb = cB + kstep; const char* pa = cA + kstep; const char* pbh = cB + hstep + kstep; const char* pah = cA + hstep + kstep; PG8_SPTR(pb); PG8_SPTR(pa); PG8_SPTR(pbh); PG8_SPTR(pah);
          PG8_STAGE(PG8_SB(1, 0), pb, voffB); PG8_STAGE(PG8_SA(1, 0), pa, voffA); PG8_STAGE(PG8_SB(1, 1), pbh, voffB); PG8_STAGE(PG8_SA(1, 1), pah, voffA); }
        PG8_WAIT_V(0); PG8_BAR;
        if (wr == 1) PG8_BAR;
    } else
    if constexpr (SP2) {
        PG8_STAGE(PG8_SB(0, 0), cB, voffB); PG8_STAGE(PG8_SB(0, 1), cB + hstep, voffB); PG8_STAGE(PG8_SA(0, 0), cA, voffA); PG8_STAGE(PG8_SA(0, 1), cA + hstep, voffA);
        if (wr == 1) PG8_BAR;
        PG8_WAIT_V(2); PG8_BAR;
        PG8_STAGE(PG8_SB(1, 0), cB + kstep, voffB); PG8_STAGE(PG8_SA(1, 0), cA + kstep, voffA); PG8_STAGE(PG8_SB(1, 1), cB + hstep + kstep, voffB);
        PG8_WAIT_V(6); PG8_BAR;
    } else {
        PG8_STAGE(PG8_SB(0, 0), cB, voffB); PG8_STAGE(PG8_SA(0, 0), cA, voffA); PG8_STAGE(PG8_SB(0, 1), cB + hstep, voffB); PG8_STAGE(PG8_SA(0, 1), cA + hstep, voffA);
        if (wr == 1) PG8_BAR;
        PG8_WAIT_V(4); PG8_BAR;
        PG8_STAGE(PG8_SB(1, 0), cB + kstep, voffB); PG8_STAGE(PG8_SA(1, 0), cA + kstep, voffA); PG8_STAGE(PG8_SB(1, 1), cB + hstep + kstep, voffB);
        PG8_WAIT_V(6); PG8_BAR;
    }
    for (;;) {
        const bool has_next = S.next(ui + 1, nxt);
        const char* nA = has_next ? (const char*)g.A + (size_t)nxt.pm * tstep : cA; const char* nB = has_next ? (const char*)g.Bt + (size_t)nxt.pn * tstep : cB;
#define PG8_BODY_SP2(W1, W2, W3, STAGE1) \
            PG8_LDB(B0, 0, 0); PG8_LDB(B1, 0, 1); PG8_SCHED; PG8_LDA(At, 0, 0); if (STAGE1) PG8_STAGE(PG8_SA(1, 1), a1 + hstep, voffA); \
            PG8_WAIT_VN(W1); PG8_WAIT_L(0); PG8_BAR; PG8_MMA(0, 0, At, B0); PG8_MMA(0, 1, At, B1); PG8_BAR; PG8_SCHED; \
            PG8_LDA(At, 0, 1); PG8_STAGE(PG8_SB(0, 0), b2, voffB); PG8_STAGE(PG8_SB(0, 1), b2 + hstep, voffB); PG8_STAGE(PG8_SA(0, 0), a2, voffA); \
            PG8_WAIT_VN(W2); PG8_WAIT_L(0); PG8_BAR; PG8_MMA(1, 0, At, B0); PG8_MMA(1, 1, At, B1); PG8_BAR; PG8_SCHED; \
            PG8_LDB(B0, 1, 0); PG8_LDB(B1, 1, 1); PG8_SCHED; PG8_LDA(At, 1, 0); PG8_STAGE(PG8_SA(0, 1), a2 + hstep, voffA); \
            PG8_WAIT_VN(W3); PG8_WAIT_L(0); PG8_BAR; PG8_MMA(0, 0, At, B0); PG8_MMA(0, 1, At, B1); PG8_BAR; PG8_SCHED; \
            PG8_LDA(At, 1, 1); PG8_STAGE(PG8_SB(1, 0), b3, voffB); PG8_STAGE(PG8_SB(1, 1), b3 + hstep, voffB); PG8_STAGE(PG8_SA(1, 0), a3, voffA); \
            PG8_WAIT_VN(8); PG8_WAIT_L(0); PG8_BAR; PG8_MMA(1, 0, At, B0); PG8_MMA(1, 1, At, B1); PG8_BAR; PG8_SCHED;
        if constexpr (RELAX) {
            { const char* a1 = cA + kstep; const char* a2 = cA + 2 * kstep; const char* b2 = cB + 2 * kstep; const char* a3 = a2 + kstep; const char* b3 = b2 + kstep; (void)a1;
              PG8_SPTR(a2); PG8_SPTR(b2); PG8_SPTR(a3); PG8_SPTR(b3);
              PG8_BODY_SP2(8 + Epi::NST, 8 + Epi::NST, 8 + Epi::NST, false) }
            for (int t = 2; t < nt; t += 2) {
                const bool last = (t == nt - 2);
                const char* a1 = cA + (size_t)(t + 1) * kstep;
                const char* a2 = last ? nA : cA + (size_t)(t + 2) * kstep; const char* b2 = last ? nB : cB + (size_t)(t + 2) * kstep;
                const char* a3 = a2 + kstep; const char* b3 = b2 + kstep;
                if (last && has_next) S.a_ready(nxt);
                PG8_BODY_SP2(8, 8, 8, true)
            }
        } else
        for (int t = 0; t < nt; t += 2) {
            const bool last = (t == nt - 2);
            const char* a1 = cA + (size_t)(t + 1) * kstep;
            const char* a2 = last ? nA : cA + (size_t)(t + 2) * kstep; const char* b2 = last ? nB : cB + (size_t)(t + 2) * kstep;
            const char* a3 = a2 + kstep; const char* b3 = b2 + kstep;
            if (last && has_next) S.a_ready(nxt);
            if constexpr (SP2) {
            PG8_LDB(B0, 0, 0); PG8_LDB(B1, 0, 1); PG8_SCHED; PG8_LDA(At, 0, 0); PG8_STAGE(PG8_SA(1, 1), a1 + hstep, voffA);
            PG8_WAIT_V(8); PG8_WAIT_L(0); PG8_BAR; PG8_MMA(0, 0, At, B0); PG8_MMA(0, 1, At, B1); PG8_BAR; PG8_SCHED;
            PG8_LDA(At, 0, 1); PG8_STAGE(PG8_SB(0, 0), b2, voffB); PG8_STAGE(PG8_SB(0, 1), b2 + hstep, voffB); PG8_STAGE(PG8_SA(0, 0), a2, voffA);
            PG8_WAIT_V(8); PG8_WAIT_L(0); PG8_BAR; PG8_MMA(1, 0, At, B0); PG8_MMA(1, 1, At, B1); PG8_BAR; PG8_SCHED;
            PG8_LDB(B0, 1, 0); PG8_LDB(B1, 1, 1); PG8_SCHED; PG8_LDA(At, 1, 0); PG8_STAGE(PG8_SA(0, 1), a2 + hstep, voffA);
            PG8_WAIT_V(8); PG8_WAIT_L(0); PG8_BAR; PG8_MMA(0, 0, At, B0); PG8_MMA(0, 1, At, B1); PG8_BAR; PG8_SCHED;
            PG8_LDA(At, 1, 1); PG8_STAGE(PG8_SB(1, 0), b3, voffB); PG8_STAGE(PG8_SB(1, 1), b3 + hstep, voffB); PG8_STAGE(PG8_SA(1, 0), a3, voffA);
            PG8_WAIT_V(8); PG8_WAIT_L(0); PG8_BAR; PG8_MMA(1, 0, At, B0); PG8_MMA(1, 1, At, B1); PG8_BAR; PG8_SCHED;
            } else {
            PG8_LDB(B0, 0, 0); PG8_SCHED; PG8_LDA(At, 0, 0); PG8_STAGE(PG8_SA(1, 1), a1 + hstep, voffA);
            PG8_WAIT_L(8); PG8_BAR; PG8_WAIT_L(0); PG8_MMA(0, 0, At, B0); PG8_BAR; PG8_SCHED;
            PG8_LDB(B1, 0, 1); PG8_STAGE(PG8_SB(0, 0), b2, voffB);
            PG8_BAR; PG8_WAIT_L(0); PG8_MMA(0, 1, At, B1); PG8_BAR;
            PG8_LDA(At, 0, 1); PG8_STAGE(PG8_SA(0, 0), a2, voffA);
            PG8_BAR; PG8_WAIT_L(0); PG8_MMA(1, 0, At, B0); PG8_BAR; PG8_SCHED;
            PG8_STAGE(PG8_SB(0, 1), b2 + hstep, voffB);
            PG8_WAIT_V(6); PG8_BAR; PG8_MMA(1, 1, At, B1); PG8_BAR;
            PG8_LDB(B0, 1, 0); PG8_SCHED; PG8_LDA(At, 1, 0); PG8_STAGE(PG8_SA(0, 1), a2 + hstep, voffA);
            PG8_WAIT_L(8); PG8_BAR; PG8_WAIT_L(0); PG8_MMA(0, 0, At, B0); PG8_BAR; PG8_SCHED;
            PG8_LDB(B1, 1, 1); PG8_STAGE(PG8_SB(1, 0), b3, voffB);
            PG8_BAR; PG8_WAIT_L(0); PG8_MMA(0, 1, At, B1); PG8_BAR;
            PG8_LDA(At, 1, 1); PG8_STAGE(PG8_SA(1, 0), a3, voffA);
            PG8_BAR; PG8_WAIT_L(0); PG8_MMA(1, 0, At, B0); PG8_BAR; PG8_SCHED;
            PG8_STAGE(PG8_SB(1, 1), b3 + hstep, voffB);
            PG8_WAIT_V(6); PG8_BAR; PG8_MMA(1, 1, At, B1); PG8_BAR;
            }
        }
        if constexpr (ALIGN_EPI) { if (wr == 0) PG8_BAR; }
        if constexpr (RELAX) { if (has_next) { const char* ps = nA + kstep + hstep; PG8_SPTR(ps); PG8_STAGE(PG8_SA(1, 1), ps, voffA); } asm volatile("" ::: "memory"); }
        if constexpr (!Epi::AFTER_DRAIN) { int te = tid; asm volatile("" : "+v"(te)); E(acc, cur, wr, wc, te & 15, (te & 63) >> 4); S.done(cur); }
        if (!has_next) break;
#pragma unroll
        for (int a = 0; a < 2; ++a)
#pragma unroll
            for (int b = 0; b < 2; ++b)
#pragma unroll
                for (int m = 0; m < 4; ++m)
#pragma unroll
                    for (int n = 0; n < 2; ++n) acc[a][b][m][n] = (f32x4){0.f, 0.f, 0.f, 0.f};
        cur = nxt; cA = nA; cB = nB; ++ui;
        if constexpr (ALIGN_EPI) { if (wr == 1) PG8_BAR; }
    }
    PG8_WAIT_V(0);
    if constexpr (!ALIGN_EPI) { if (wr == 0) PG8_BAR; }
    PG8_BAR;
    if constexpr (Epi::AFTER_DRAIN) { E.fused(acc, cur, wr, wc, fr, fq, lds, wid, lane); S.done(cur); }
#undef PG8_SA
#undef PG8_SB
#undef PG8_STAGE
#undef PG8_LDA
#undef PG8_LDB
#undef PG8_MMA
#undef PG8_WAIT_V
#undef PG8_WAIT_L
#undef PG8_BAR
#undef PG8_SCHED
#undef PG8_BODY_SP2
#undef PG8_WAIT_VN
#undef PG8_SPTR
}
}

#define PG8_SP2 true
#ifndef REP_MODE
#define REP_MODE 1
#endif
#ifndef NSA_NAIVE
#define NSA_NAIVE 0
#endif
#ifndef REC_NAIVE
#define REC_NAIVE 0
#endif
#define PG8_ALIGN true

constexpr int NWAVES = 8, NT = NWAVES * 64;
constexpr int BATCH = 8, SEQ = 4096, D = 1024, DEPTH = 4, M = BATCH * SEQ;
constexpr int EVEN_IN = 3352, PE = 3584;
constexpr int PO = 4096;
constexpr int FF = 2816, FF2 = 2 * FF;
constexpr int C_RQ = 0, C_RK = 512, C_RV = 1024, C_RG = 1536, C_NQ = 2048, C_KC = 2560, C_VC = 2688, C_KS = 2816, C_VS = 2944, C_KW = 3072, C_VW = 3200, C_NG = 3328;
constexpr int C_HQ = 0, C_HF = 1024, C_HI = 2048, C_HG = 3072;
constexpr int NCMP = 255;
constexpr float RMS_EPS = 1e-6f;

constexpr size_t MiB = 1u << 20;
constexpr size_t WS_CTL = 0, CTL_ZERO_BYTES = 1 * MiB;
constexpr size_t WS_ROPE = 1 * MiB;
constexpr size_t WS_LB = 3 * MiB;
constexpr size_t WS_KCMP = 4 * MiB;
constexpr size_t WS_CBIAS = 3 * MiB + 16 * 1024;
constexpr size_t WS_W1T = 4 * MiB;
constexpr size_t WS_ROWSS = 5 * MiB;
constexpr size_t WS_SEL = 6 * MiB;
constexpr size_t WS_WEIN = 8 * MiB;
constexpr size_t WS_WEOUT = 22 * MiB;
constexpr size_t WS_WOIN = 26 * MiB;
constexpr size_t WS_WOOUT = 42 * MiB;
constexpr size_t WS_W13 = 46 * MiB;
constexpr size_t WS_W2 = 90 * MiB;
constexpr size_t WS_H = 112 * MiB;
constexpr size_t WS_PROJ = 176 * MiB;
constexpr size_t WS_MIXED = 432 * MiB;
constexpr size_t WS_KCB = 7 * MiB;
constexpr size_t WS_VCTB = 7 * MiB + 512 * 1024;
constexpr size_t WS_VT = 496 * MiB;
constexpr size_t WS_KT = 400 * MiB;
constexpr size_t WS_END = 512 * MiB;
constexpr int CW_BAR = 4096, CW_Q = 8192;

constexpr int RING_BYTES = 131072;
constexpr int LDSCTL_OFF = 146944, MISC_OFF = LDSCTL_OFF + 320;
constexpr int LDS_BYTES = 147456;

#define GAS __attribute__((address_space(1)))
#define LAS __attribute__((address_space(3)))
typedef unsigned short bf16;
typedef unsigned v4u __attribute__((ext_vector_type(4)));
typedef unsigned v2u __attribute__((ext_vector_type(2)));
typedef float f32x4 __attribute__((ext_vector_type(4)));
typedef float f32x2 __attribute__((ext_vector_type(2)));
typedef GAS unsigned gu32;
#define RLX_AGENT __ATOMIC_RELAXED, __HIP_MEMORY_SCOPE_AGENT
#define LDS_WAIT() asm volatile("s_waitcnt lgkmcnt(0)" ::: "memory")
#define VM_WAIT() asm volatile("s_waitcnt vmcnt(0)" ::: "memory")
__device__ __forceinline__ unsigned f2bf(float f) { unsigned u = __builtin_bit_cast(unsigned, f); return (u + 0x7fffu + ((u >> 16) & 1u)) >> 16; }
typedef float f32x2_t __attribute__((ext_vector_type(2)));
typedef __bf16 bf16x2_t __attribute__((ext_vector_type(2)));
__device__ __forceinline__ unsigned pk2(float lo, float hi) { f32x2_t v = {lo, hi}; bf16x2_t r = __builtin_convertvector(v, bf16x2_t); return __builtin_bit_cast(unsigned, r); }
__device__ __forceinline__ float bf2f(unsigned v) { return __builtin_bit_cast(float, v << 16); }
__device__ __forceinline__ float bflo(unsigned w) { return __builtin_bit_cast(float, w << 16); }
__device__ __forceinline__ float bfhi(unsigned w) { return __builtin_bit_cast(float, w & 0xffff0000u); }
__device__ __forceinline__ float sigmoidf_(float x) { return __builtin_amdgcn_rcpf(1.0f + __expf(-x)); }
__device__ __forceinline__ float siluf_(float x) { return x * __builtin_amdgcn_rcpf(1.0f + __expf(-x)); }

#define XB_TMO      128
#define XB_XCNT(j)  (256  + 64 * (j))
#define XB_XSUB(j)  (1280 + 64 * (j))
#define XB_XGEN(j)  (2304 + 64 * (j))
#define XB_TOP      3328
#define XB_TOPGEN   3392
#define XCD_BAR_WORDS 3456
#define XB_SPIN_CAP (1u << 18)
__device__ __forceinline__ unsigned xb_ld(unsigned* p)              { return __hip_atomic_load(p, __ATOMIC_RELAXED, __HIP_MEMORY_SCOPE_AGENT); }
__device__ __forceinline__ unsigned xb_add(unsigned* p, unsigned v) { return __hip_atomic_fetch_add(p, v, __ATOMIC_RELAXED, __HIP_MEMORY_SCOPE_AGENT); }
__device__ __forceinline__ unsigned xb_xcc_id() { return (unsigned)__builtin_amdgcn_s_getreg((3 << 11) | 20) & 0xFu; }
#define XB_SPIN(cond, bar) do { unsigned _sp = 0; while (cond) { __builtin_amdgcn_s_sleep(1); \
    if ((++_sp & 255u) == 0u) { if (xb_ld(&(bar)[XB_TMO])) break; if (_sp > XB_SPIN_CAP) { atomicAdd(&(bar)[XB_TMO], 1u); break; } } } } while (0)
struct XcdBarrier { unsigned* bar; unsigned x; volatile LAS unsigned* st; };
__device__ __forceinline__ XcdBarrier xcd_barrier_post(unsigned* bar, volatile LAS unsigned* st) {
    XcdBarrier b; b.bar = bar; b.x = xb_xcc_id(); b.st = st;
    if (threadIdx.x == 0) (void)xb_add(&bar[XB_XCNT(b.x)], 1u);
    return b;
}
__device__ __forceinline__ void xcd_barrier_complete(unsigned* bar, unsigned x, unsigned& nloc, unsigned& nx) {
    const unsigned G = gridDim.x * gridDim.y * gridDim.z;
    unsigned sum, cnt, mine, sp = 0u;
    for (;;) {
        sum = 0u; cnt = 0u; mine = 0u;
        size_t xz = 0; asm volatile("" : "+v"(xz)); unsigned* xc = &bar[XB_XCNT(0)] + xz;
#pragma unroll
        for (unsigned j = 0; j < 16; ++j) { const unsigned c = xb_ld(&xc[64 * j]); sum += c; cnt += (c > 0u) ? 1u : 0u; mine = (j == x) ? c : mine; }
        if (sum == G) break;
        __builtin_amdgcn_s_sleep(1);
        if ((++sp & 255u) == 0u) { if (xb_ld(&bar[XB_TMO])) break; if (sp > XB_SPIN_CAP) { atomicAdd(&bar[XB_TMO], 1u); break; } }
    }
    nloc = mine > 0u ? mine : 1u; nx = cnt > 0u ? cnt : 1u;
}
__device__ __forceinline__ void xcd_barrier(const XcdBarrier& b) {
    asm volatile("s_waitcnt vmcnt(0)" ::: "memory");
    __syncthreads();
    if (threadIdx.x == 0) {
        unsigned* bar = b.bar;
        __builtin_amdgcn_s_waitcnt(0);
        unsigned nloc = b.st[0], nx = b.st[1];
        if (nloc == 0u) { xcd_barrier_complete(bar, b.x, nloc, nx); b.st[0] = nloc; b.st[1] = nx; }
        const unsigned old = xb_add(&bar[XB_XSUB(b.x)], 1u);
        const unsigned gen = old / nloc;
        if (old + 1u == (gen + 1u) * nloc) {
            __builtin_amdgcn_fence(__ATOMIC_RELEASE, "agent");
            asm volatile("s_waitcnt vmcnt(0)" ::: "memory");
            const unsigned og = xb_add(&bar[XB_TOP], 1u);
            const unsigned tg = og / nx;
            if (og + 1u == (tg + 1u) * nx) xb_add(&bar[XB_TOPGEN], 1u);
            else XB_SPIN(xb_ld(&bar[XB_TOPGEN]) == tg, bar);
            __builtin_amdgcn_fence(__ATOMIC_ACQUIRE, "agent");
            xb_add(&bar[XB_XGEN(b.x)], 1u);
            asm volatile("s_waitcnt vmcnt(0)" ::: "memory");
        } else {
            XB_SPIN(xb_ld(&bar[XB_XGEN(b.x)]) == gen, bar);
            __builtin_amdgcn_fence(__ATOMIC_ACQUIRE, "agent");
            asm volatile("s_waitcnt vmcnt(0)" ::: "memory");
        }
    }
    __syncthreads();
}

__device__ __forceinline__ float wave_sum(float v) {
#pragma unroll
    for (int o = 1; o < 64; o <<= 1) v += __shfl_xor(v, o);
    return v;
}
__device__ __forceinline__ float wave_max(float v) {
#pragma unroll
    for (int o = 1; o < 64; o <<= 1) v = fmaxf(v, __shfl_xor(v, o));
    return v;
}

__device__ __forceinline__ int inproj_row(int rmode, int cs) {
    if (rmode == 1 && cs < 1024) { const int isk = cs >> 9, hd = (cs & 511) >> 7, ch = cs & 127, half = ch >> 6, i = ch & 63; return 256 * hd + 128 * isk + 32 * (i >> 4) + 8 * ((i >> 2) & 3) + 4 * half + (i & 3); }
    if (rmode == 2 && cs < 2048) { const int isf = cs >> 10, hd = (cs & 1023) >> 7, ch = cs & 127; return 256 * hd + 128 * isf + ch; }
    return cs;
}
__device__ __forceinline__ void tr_item64(const float* W, int K, int N, bf16* WT, int k0, int n0, int drow0, LAS unsigned* scr, int lane, const float* gain = nullptr, int rmode = 0) {
    const int q = lane >> 4, nl4 = 4 * (lane & 15); const bool ok = n0 + nl4 < N;
    const GAS float* src = (const GAS float*)W + (size_t)(k0 + 2 * q) * N + n0 + nl4;
    f32x4 v[16]; f32x2 g[8];
#pragma unroll
    for (int j = 0; j < 16; ++j) { const int kr = 8 * (j >> 1) + (j & 1); v[j] = ok ? *(const GAS f32x4*)(src + (size_t)kr * N) : (f32x4){0.f, 0.f, 0.f, 0.f}; }
#pragma unroll
    for (int i = 0; i < 8; ++i) g[i] = gain ? *(const GAS f32x2*)((const GAS float*)gain + k0 + 2 * q + 8 * i) : (f32x2){1.0f, 1.0f};
    __builtin_amdgcn_sched_barrier(0);
#pragma unroll
    for (int i = 0; i < 8; ++i) { const f32x4 a = v[2 * i] * g[i].x, b = v[2 * i + 1] * g[i].y; LAS unsigned* d = scr + (4 * i + q) * 66 + nl4;
        v2u w0; w0.x = pk2(a.x, b.x); w0.y = pk2(a.y, b.y); v2u w1; w1.x = pk2(a.z, b.z); w1.y = pk2(a.w, b.w);
        *(LAS v2u*)d = w0; *(LAS v2u*)(d + 2) = w1; }
    LDS_WAIT(); asm volatile("" ::: "memory");
    const int c = lane & 7;
#pragma unroll
    for (int jj = 0; jj < 8; ++jj) { const int n = (lane >> 3) + 8 * jj; const LAS unsigned* sp = scr + (4 * c) * 66 + n;
        v4u o; o.x = sp[0]; o.y = sp[66]; o.z = sp[132]; o.w = sp[198];
        *(GAS v4u*)(WT + (size_t)(rmode ? inproj_row(rmode, n0 + n) : drow0 + n) * K + k0 + 8 * c) = o; }
    LDS_WAIT(); asm volatile("" ::: "memory");
}
__device__ __forceinline__ void rms_row_to_bf16(const float* xrow, const float* g, bf16* orow, int lane) {
    const GAS f32x4* xr = (const GAS f32x4*)xrow + lane; const GAS f32x4* gr = (const GAS f32x4*)g + lane;
    f32x4 v[4]; float s = 0.f;
#pragma unroll
    for (int j = 0; j < 4; ++j) { v[j] = xr[64 * j]; s += (v[j].x * v[j].x + v[j].y * v[j].y) + (v[j].z * v[j].z + v[j].w * v[j].w); }
    const float r = 1.0f / sqrtf(wave_sum(s) * (1.f / D) + RMS_EPS);
    GAS v2u* o8 = (GAS v2u*)orow + lane;
#pragma unroll
    for (int j = 0; j < 4; ++j) { const f32x4 gg = gr[64 * j]; v2u w; w.x = pk2(v[j].x * r * gg.x, v[j].y * r * gg.y); w.y = pk2(v[j].z * r * gg.z, v[j].w * r * gg.w); o8[64 * j] = w; }
}
__device__ __forceinline__ void row_to_bf16_ss(const float* xrow, bf16* orow, float* rowss, int m, int lane) {
    const GAS f32x4* xr = (const GAS f32x4*)xrow + lane;
    f32x4 v[4]; float s = 0.f;
#pragma unroll
    for (int j = 0; j < 4; ++j) { v[j] = xr[64 * j]; s += (v[j].x * v[j].x + v[j].y * v[j].y) + (v[j].z * v[j].z + v[j].w * v[j].w); }
    s = wave_sum(s);
    GAS v2u* o8 = (GAS v2u*)orow + lane;
#pragma unroll
    for (int j = 0; j < 4; ++j) { v2u w; w.x = pk2(v[j].x, v[j].y); w.y = pk2(v[j].z, v[j].w); o8[64 * j] = w; }
    if (lane < 16) rowss[(size_t)lane * M + m] = lane == 0 ? s : 0.f;
}
__device__ __forceinline__ void rows2_to_bf16_ss(const float* xa, const float* xb, bf16* oa, bf16* ob, float* rowss, int ma, int mb, int lane) {
    const GAS f32x4* xr0 = (const GAS f32x4*)xa + lane; const GAS f32x4* xr1 = (const GAS f32x4*)xb + lane;
    f32x4 v[2][4]; float s0 = 0.f, s1 = 0.f;
#pragma unroll
    for (int j = 0; j < 4; ++j) { v[0][j] = xr0[64 * j]; v[1][j] = xr1[64 * j]; }
#pragma unroll
    for (int j = 0; j < 4; ++j) { s0 += (v[0][j].x * v[0][j].x + v[0][j].y * v[0][j].y) + (v[0][j].z * v[0][j].z + v[0][j].w * v[0][j].w); s1 += (v[1][j].x * v[1][j].x + v[1][j].y * v[1][j].y) + (v[1][j].z * v[1][j].z + v[1][j].w * v[1][j].w); }
#pragma unroll
    for (int o = 1; o < 64; o <<= 1) { s0 += __shfl_xor(s0, o); s1 += __shfl_xor(s1, o); }
    GAS v2u* o0 = (GAS v2u*)oa + lane; GAS v2u* o1 = (GAS v2u*)ob + lane;
#pragma unroll
    for (int j = 0; j < 4; ++j) { v2u w; w.x = pk2(v[0][j].x, v[0][j].y); w.y = pk2(v[0][j].z, v[0][j].w); o0[64 * j] = w; v2u w2; w2.x = pk2(v[1][j].x, v[1][j].y); w2.y = pk2(v[1][j].z, v[1][j].w); o1[64 * j] = w2; }
    if (lane < 16) { rowss[(size_t)lane * M + ma] = lane == 0 ? s0 : 0.f; rowss[(size_t)lane * M + mb] = lane == 0 ? s1 : 0.f; }
}
__device__ __forceinline__ void rms_row_bf16_to_f32(const bf16* xrow, const float* g, float* orow, int lane) {
    const GAS v4u* xr = (const GAS v4u*)xrow + lane; const GAS f32x4* gr = (const GAS f32x4*)g + 2 * lane;
    v4u w[2]; float v[2][8]; float s = 0.f;
#pragma unroll
    for (int j = 0; j < 2; ++j) { w[j] = xr[64 * j]; const unsigned ww[4] = {w[j].x, w[j].y, w[j].z, w[j].w};
#pragma unroll
        for (int k = 0; k < 4; ++k) { v[j][2 * k] = bflo(ww[k]); v[j][2 * k + 1] = bfhi(ww[k]); s += v[j][2 * k] * v[j][2 * k] + v[j][2 * k + 1] * v[j][2 * k + 1]; } }
    const float r = __builtin_amdgcn_rsqf(wave_sum(s) * (1.f / D) + RMS_EPS);
    GAS f32x4* o = (GAS f32x4*)orow + 2 * lane;
#pragma unroll
    for (int j = 0; j < 2; ++j) { const f32x4 g0 = gr[128 * j], g1 = gr[128 * j + 1];
        o[128 * j] = (f32x4){v[j][0] * r * g0.x, v[j][1] * r * g0.y, v[j][2] * r * g0.z, v[j][3] * r * g0.w}; o[128 * j + 1] = (f32x4){v[j][4] * r * g1.x, v[j][5] * r * g1.y, v[j][6] * r * g1.z, v[j][7] * r * g1.w}; }
}
__device__ __forceinline__ void rms_row_to_f32(float* xrow, const float* g, int lane) {
    GAS f32x4* xr = (GAS f32x4*)xrow + lane; const GAS f32x4* gr = (const GAS f32x4*)g + lane;
    f32x4 v[4]; float s = 0.f;
#pragma unroll
    for (int j = 0; j < 4; ++j) { v[j] = xr[64 * j]; s += (v[j].x * v[j].x + v[j].y * v[j].y) + (v[j].z * v[j].z + v[j].w * v[j].w); }
    const float r = 1.0f / sqrtf(wave_sum(s) * (1.f / D) + RMS_EPS);
#pragma unroll
    for (int j = 0; j < 4; ++j) { const f32x4 gg = gr[64 * j]; xr[64 * j] = (f32x4){v[j].x * r * gg.x, v[j].y * r * gg.y, v[j].z * r * gg.z, v[j].w * r * gg.w}; }
}

__device__ __forceinline__ void convert_weights(const float* const* in, unsigned char* ws, int half, LAS unsigned* scr, int w0, int nw, int lane) {
    constexpr int I_EIN = 16 * 56, I_SQ = 16 * 16, I_OIN = 16 * 64, I_W1 = 16 * 44, I_W2 = 44 * 16;
    constexpr int NITEMS = I_EIN + I_SQ + I_OIN + I_SQ + 2 * I_W1 + 2 * I_W1 + 2 * I_W2;
    const int j = half;
    for (int it = w0; it < NITEMS; it += nw) {
        int r = it;
        if (r < I_EIN) { tr_item64(in[4] + (size_t)j * D * EVEN_IN, D, EVEN_IN, (bf16*)(ws + WS_WEIN) + (size_t)j * PE * D, (r / 56) * 64, (r % 56) * 64, (r % 56) * 64, scr, lane, in[1] + (size_t)(2 * j) * D, 1); continue; } r -= I_EIN;
        if (r < I_SQ) { tr_item64(in[5] + (size_t)j * D * D, D, D, (bf16*)(ws + WS_WEOUT) + (size_t)j * D * D, (r / 16) * 64, (r % 16) * 64, (r % 16) * 64, scr, lane); continue; } r -= I_SQ;
        if (r < I_OIN) { tr_item64(in[12] + (size_t)j * D * PO, D, PO, (bf16*)(ws + WS_WOIN) + (size_t)j * PO * D, (r / 64) * 64, (r % 64) * 64, (r % 64) * 64, scr, lane, in[1] + (size_t)(2 * j + 1) * D, 2); continue; } r -= I_OIN;
        if (r < I_SQ) { tr_item64(in[13] + (size_t)j * D * D, D, D, (bf16*)(ws + WS_WOOUT) + (size_t)j * D * D, (r / 16) * 64, (r % 16) * 64, (r % 16) * 64, scr, lane); continue; } r -= I_SQ;
        if (r < 4 * I_W1) { const int which = r / (2 * I_W1); r %= 2 * I_W1; const int l = 2 * half + r / I_W1; r %= I_W1; const int n0 = (r % 44) * 64;
            tr_item64(in[which ? 17 : 16] + (size_t)l * D * FF, D, FF, (bf16*)(ws + WS_W13) + (size_t)l * FF2 * D, (r / 44) * 64, n0, 256 * (n0 / 128) + (n0 % 128) + 128 * which, scr, lane, in[2] + (size_t)l * D); continue; } r -= 4 * I_W1;
        { const int l = 2 * half + r / I_W2; r %= I_W2; tr_item64(in[18] + (size_t)l * FF * D, FF, D, (bf16*)(ws + WS_W2) + (size_t)l * D * FF, (r / 16) * 64, (r % 16) * 64, (r % 16) * 64, scr, lane); }
    }
}

constexpr int RS_TBL_OFF = RING_BYTES, RS_TAB_OFF = RING_BYTES + 1024;
template <class Sched>
__device__ __forceinline__ void build_rstd_table(LAS unsigned char* lds, const Sched& S, const float* rowss, int tid) {
    LAS int* tbl = (LAS int*)(lds + RS_TBL_OFF); LAS float* rsl = (LAS float*)(lds + RS_TAB_OFF); LAS int* spm = tbl + 128;
    if (tid < 16) { pg8::Unit u; const bool ok = tid < 14 && S.next(tid, u); spm[tid] = ok ? u.pm : -1; if (ok) tbl[u.pm] = tid; }
    __syncthreads();
#pragma unroll 1
    for (int sl = tid >> 8; sl < 14; sl += 2) { const int pm = spm[sl]; if (pm < 0) break;
        const int row = pm * 256 + (tid & 255); float p[16];
#pragma unroll
        for (int pl = 0; pl < 16; ++pl) p[pl] = rowss[(size_t)pl * M + row];
        float q = 0.f;
#pragma unroll
        for (int pl = 0; pl < 16; ++pl) q += p[pl];
        rsl[sl * 256 + (tid & 255)] = __builtin_amdgcn_rsqf(q * (1.0f / 1024.0f) + RMS_EPS); }
    __syncthreads();
}

template <int MODE>
__device__ __forceinline__ void recur_unit(LAS unsigned char* lds, int b, int hd, const bf16* proj, int ldp, const float2* rope, const float* lb, const float* ng, bf16* mixed, int tid, int lane, int wave) {
    LAS float* sq = (LAS float*)lds;
    LAS float* sk = sq + 2048;
    LAS float* sv = sk + 2048;
    LAS float* so = sv + 2048;
    LAS float* sf = so + 2048;
    const int e = tid >> 2, ds = tid & 3;
    float S[32];
#pragma unroll
    for (int i = 0; i < 32; ++i) S[i] = 0.f;
    const float gamma = 1.0f - exp2f(-5.0f - (float)hd);
    for (int blk = 0; blk < SEQ / 16; ++blk) {
        {
            const int tt = tid >> 5, ii = tid & 31; const int pos = blk * 16 + tt; const size_t row = (size_t)(b * SEQ + pos) * ldp;
            if (MODE == 0) {
#pragma unroll
                for (int h2 = 0; h2 < 2; ++h2) { const int i = ii + 32 * h2; const float2 cs = rope[pos * 64 + i];
                    const float q1 = bf2f(proj[row + C_RQ + hd * 128 + i]), q2 = bf2f(proj[row + C_RQ + hd * 128 + i + 64]);
                    const float k1 = bf2f(proj[row + C_RK + hd * 128 + i]), k2 = bf2f(proj[row + C_RK + hd * 128 + i + 64]);
                    sq[tt * 128 + i] = q1 * cs.x - q2 * cs.y; sq[tt * 128 + i + 64] = q1 * cs.y + q2 * cs.x;
                    sk[tt * 128 + i] = (k1 * cs.x - k2 * cs.y) * 0.08838834764831845f; sk[tt * 128 + i + 64] = (k1 * cs.y + k2 * cs.x) * 0.08838834764831845f; }
#pragma unroll
                for (int h4 = 0; h4 < 4; ++h4) sv[tt * 128 + ii + 32 * h4] = bf2f(proj[row + C_RV + hd * 128 + ii + 32 * h4]);
            } else {
#pragma unroll
                for (int h4 = 0; h4 < 4; ++h4) { const int d = ii + 32 * h4; const float qp = bf2f(proj[row + C_HQ + hd * 128 + d]), fp = bf2f(proj[row + C_HF + hd * 128 + d]);
                    const float l = lb[hd * 128 + d]; const float sg = sigmoidf_(fp);
                    sq[tt * 128 + d] = siluf_(qp) * 0.08838834764831845f; sf[tt * 128 + d] = l + (1.0f - l) * sg; sk[tt * 128 + d] = (1.0f - l) * (1.0f - sg);
                    sv[tt * 128 + d] = bf2f(proj[row + C_HI + hd * 128 + d]); }
            }
        }
        __syncthreads();
#pragma unroll 1
        for (int tt = 0; tt < 16; ++tt) {
            const float ve = sv[tt * 128 + e]; float po = 0.f;
#pragma unroll
            for (int i4 = 0; i4 < 8; ++i4) {
                const f32x4 q4 = *(const LAS f32x4*)(sq + tt * 128 + ds * 32 + i4 * 4), k4 = *(const LAS f32x4*)(sk + tt * 128 + ds * 32 + i4 * 4);
                f32x4 f4; if (MODE == 1) f4 = *(const LAS f32x4*)(sf + tt * 128 + ds * 32 + i4 * 4); else f4 = (f32x4){gamma, gamma, gamma, gamma};
                S[i4 * 4 + 0] = f4.x * S[i4 * 4 + 0] + k4.x * ve; po += q4.x * S[i4 * 4 + 0];
                S[i4 * 4 + 1] = f4.y * S[i4 * 4 + 1] + k4.y * ve; po += q4.y * S[i4 * 4 + 1];
                S[i4 * 4 + 2] = f4.z * S[i4 * 4 + 2] + k4.z * ve; po += q4.z * S[i4 * 4 + 2];
                S[i4 * 4 + 3] = f4.w * S[i4 * 4 + 3] + k4.w * ve; po += q4.w * S[i4 * 4 + 3];
            }
            po += __shfl_xor(po, 1); po += __shfl_xor(po, 2);
            if (ds == 0) so[tt * 128 + e] = po;
        }
        __syncthreads();
        {
#pragma unroll
            for (int r = 0; r < 2; ++r) { const int tt = wave * 2 + r; const int pos = blk * 16 + tt; const size_t trow = (size_t)(b * SEQ + pos);
                const float o0 = so[tt * 128 + lane], o1 = so[tt * 128 + lane + 64];
                float y0, y1;
                if (MODE == 0) {
                    const float mu = wave_sum(o0 + o1) * (1.f / 128.f); const float d0 = o0 - mu, d1 = o1 - mu;
                    const float var = wave_sum(d0 * d0 + d1 * d1) * (1.f / 128.f); const float rs = 1.0f / sqrtf(var + 1e-5f);
                    y0 = d0 * rs * siluf_(bf2f(proj[trow * ldp + C_RG + hd * 128 + lane])); y1 = d1 * rs * siluf_(bf2f(proj[trow * ldp + C_RG + hd * 128 + lane + 64]));
                } else {
                    const float ms = wave_sum(o0 * o0 + o1 * o1) * (1.f / 128.f); const float rs = 1.0f / sqrtf(ms + RMS_EPS);
                    y0 = o0 * rs * ng[lane] * sigmoidf_(bf2f(proj[trow * ldp + C_HG + hd * 128 + lane])); y1 = o1 * rs * ng[lane + 64] * sigmoidf_(bf2f(proj[trow * ldp + C_HG + hd * 128 + lane + 64]));
                }
                mixed[trow * D + hd * 128 + lane] = (bf16)f2bf(y0); mixed[trow * D + hd * 128 + lane + 64] = (bf16)f2bf(y1); }
        }
    }
    __syncthreads();
}

__device__ __forceinline__ float gelu_tanh(float x) { const float u = 0.7978845608028654f * (x + 0.044715f * x * x * x); const float t = 1.0f - 2.0f / (__expf(2.0f * u) + 1.0f); return 0.5f * x * (1.0f + t); }

__device__ __forceinline__ void compress_task(LAS float* xs  , int task, const bf16* proj, const float* pos_k, const float* w1_k, const float* w2_k, const float* pos_v, const float* w1_v, const float* w2_v, float* kcmp, bf16* kcb, bf16* vctb, int lane) {
    const int kv = task / (16 * NCMP); const int rem = task % (16 * NCMP); const int bg = rem / NCMP, i = rem % NCMP; const int b = bg >> 1, g = bg & 1;
    const float* pos = kv ? pos_v : pos_k; const float* w1 = kv ? w1_v : w1_k; const float* w2 = kv ? w2_v : w2_k;
    const int col = (kv ? C_VC : C_KC) + 64 * g + lane;
#pragma unroll 4
    for (int l = 0; l < 32; ++l) xs[l * 64 + lane] = bf2f(proj[(size_t)(b * SEQ + 16 * i + l) * PE + col]) + pos[l * 64 + lane];
    LDS_WAIT(); asm volatile("" ::: "memory");
    float pre = 0.f;
#pragma unroll 4
    for (int k = 0; k < 2048; k += 4) { const f32x4 a = *(const LAS f32x4*)(xs + k);
        pre += a.x * w1[(k + 0) * 64 + lane]; pre += a.y * w1[(k + 1) * 64 + lane]; pre += a.z * w1[(k + 2) * 64 + lane]; pre += a.w * w1[(k + 3) * 64 + lane]; }
    xs[2048 + lane] = gelu_tanh(pre);
    LDS_WAIT(); asm volatile("" ::: "memory");
    float o = 0.f;
#pragma unroll 4
    for (int c = 0; c < 64; c += 4) { const f32x4 a = *(const LAS f32x4*)(xs + 2048 + c);
        o += a.x * w2[(c + 0) * 64 + lane]; o += a.y * w2[(c + 1) * 64 + lane]; o += a.z * w2[(c + 2) * 64 + lane]; o += a.w * w2[(c + 3) * 64 + lane]; }
    kcmp[((size_t)(kv * 16 + bg) * 256 + i) * 64 + lane] = o;
    (kv == 0 ? kcb : vctb)[((size_t)bg * 256 + i) * 64 + lane] = (bf16)f2bf(o);
    LDS_WAIT(); asm volatile("" ::: "memory");
}

__device__ __forceinline__ void cmp_attn_task(LAS float* wl  , int task, const bf16* proj, const float* kcmp, float* accn, unsigned long long* sel, int lane) {
    LAS float* q4 = wl; LAS float* pl = wl + 256; LAS float* cs = wl + 512;
    const int bg = task >> 12, t = task & 4095; const int b = bg >> 1, g = bg & 1; const size_t trow = (size_t)(b * SEQ + t);
    const float* kc = kcmp + (size_t)bg * 256 * 64; const float* vc = kcmp + (size_t)(16 + bg) * 256 * 64;
#pragma unroll
    for (int hh = 0; hh < 4; ++hh) q4[hh * 64 + lane] = bf2f(proj[trow * PE + C_NQ + (g * 4 + hh) * 64 + lane]) * 0.125f;
    const int nvalid = t >= 31 ? (((t - 31) >> 4) + 1 > NCMP ? NCMP : ((t - 31) >> 4) + 1) : 0;
    float c4[4] = {0.f, 0.f, 0.f, 0.f};
    LDS_WAIT(); asm volatile("" ::: "memory");
#pragma unroll 1
    for (int hh = 0; hh < 4; ++hh) {
        float s4[4]; float mx = -INFINITY;
#pragma unroll
        for (int r = 0; r < 4; ++r) { const int n = lane + 64 * r; float s = -INFINITY;
            if (64 * r < nvalid) { if (n < nvalid) { float a = 0.f; const GAS f32x4* kr = (const GAS f32x4*)(kc + (size_t)n * 64);
#pragma unroll 4
                    for (int c = 0; c < 16; ++c) { const f32x4 kk = kr[c]; const f32x4 qq = *(const LAS f32x4*)(q4 + hh * 64 + c * 4); a += kk.x * qq.x + kk.y * qq.y + kk.z * qq.z + kk.w * qq.w; }
                    s = a; } }
            s4[r] = s; mx = fmaxf(mx, s); }
        mx = wave_max(mx); if (!(mx > -INFINITY)) mx = 0.f;
        float sum = 0.f;
#pragma unroll
        for (int r = 0; r < 4; ++r) { s4[r] = (s4[r] > -INFINITY) ? __expf(s4[r] - mx) : 0.f; sum += s4[r]; }
        sum = wave_sum(sum); const float inv = 1.0f / fmaxf(sum, 1e-30f);
#pragma unroll
        for (int r = 0; r < 4; ++r) { s4[r] *= inv; c4[r] += s4[r]; pl[lane + 64 * r] = s4[r]; }
        LDS_WAIT(); asm volatile("" ::: "memory");
        float o = 0.f;
        for (int n = 0; n < nvalid; ++n) o += pl[n] * vc[(size_t)n * 64 + lane];
        const float gate = sigmoidf_(bf2f(proj[trow * PE + C_NG + 0 * 8 + g * 4 + hh]));
        accn[trow * 512 + (g * 4 + hh) * 64 + lane] = gate * o;
        LDS_WAIT(); asm volatile("" ::: "memory");
    }
#pragma unroll
    for (int r = 0; r < 4; ++r) cs[lane + 64 * r] = c4[r];
    LDS_WAIT(); asm volatile("" ::: "memory");
    float imp = 0.f;
#pragma unroll
    for (int dn = -1; dn <= 3; ++dn) { const int n = 4 * lane + dn; if (n >= 0 && n < NCMP) imp += cs[n]; }
    const int bt = t >> 6; const bool valid = lane <= bt; const bool forced = (lane == 0) || (bt - lane >= 0 && bt - lane < 2);
    float score = valid ? imp + (forced ? 1.0e4f : 0.f) : -1e30f;
    unsigned long long mask = 0ull;
#pragma unroll 1
    for (int k = 0; k < 8; ++k) { const float mv = wave_max(score); const unsigned long long bal = __ballot(score == mv); const int j = __ffsll((long long)bal) - 1; mask |= 1ull << j; if (lane == j) score = -INFINITY; }
    if (lane == 0) sel[(size_t)bg * SEQ + t] = mask;
    LDS_WAIT(); asm volatile("" ::: "memory");
}

template <int MODE>
__device__ __forceinline__ void blk_attn_task(LAS float* wl  , int task, const bf16* proj, const unsigned long long* sel, float* accn, bf16* mixed, int lane) {
    LAS float* q4 = wl; LAS float* p4 = wl + 256;
    const int bg = task >> 12, t = task & 4095; const int b = bg >> 1, g = bg & 1; const size_t trow = (size_t)(b * SEQ + t);
    const int kcol = (MODE == 0 ? C_KS : C_KW) + 64 * g, vcol = (MODE == 0 ? C_VS : C_VW) + 64 * g;
#pragma unroll
    for (int hh = 0; hh < 4; ++hh) q4[hh * 64 + lane] = bf2f(proj[trow * PE + C_NQ + (g * 4 + hh) * 64 + lane]) * 0.125f;
    LDS_WAIT(); asm volatile("" ::: "memory");
    const int bt = t >> 6;
    unsigned long long todo;
    if (MODE == 0) { todo = sel[(size_t)bg * SEQ + t]; todo &= (bt >= 63) ? ~0ull : ((1ull << (bt + 1)) - 1ull); }
    else { const int lo = (t - 511) > 0 ? ((t - 511) >> 6) : 0; todo = ((bt >= 63) ? ~0ull : ((1ull << (bt + 1)) - 1ull)) & ~((1ull << lo) - 1ull); }
    float m4[4] = {-INFINITY, -INFINITY, -INFINITY, -INFINITY}, l4[4] = {0.f, 0.f, 0.f, 0.f}, o4[4] = {0.f, 0.f, 0.f, 0.f};
    while (todo) {
        const int j = __ffsll((long long)todo) - 1; todo &= todo - 1ull;
        const int pos = 64 * j + lane; const bool valid = (pos <= t) && (MODE == 0 || (t - pos) < 512);
        const GAS v4u* kr = (const GAS v4u*)(proj + (size_t)(b * SEQ + pos) * PE + kcol);
        v4u kk[8];
#pragma unroll
        for (int c = 0; c < 8; ++c) kk[c] = kr[c];
#pragma unroll
        for (int hh = 0; hh < 4; ++hh) { float a = 0.f;
#pragma unroll
            for (int c = 0; c < 8; ++c) { const f32x4 qa = *(const LAS f32x4*)(q4 + hh * 64 + c * 8), qb = *(const LAS f32x4*)(q4 + hh * 64 + c * 8 + 4);
                a += bflo(kk[c].x) * qa.x + bfhi(kk[c].x) * qa.y + bflo(kk[c].y) * qa.z + bfhi(kk[c].y) * qa.w + bflo(kk[c].z) * qb.x + bfhi(kk[c].z) * qb.y + bflo(kk[c].w) * qb.z + bfhi(kk[c].w) * qb.w; }
            const float s = valid ? a : -INFINITY;
            const float mn = fmaxf(m4[hh], wave_max(s));
            const float sc = __expf(m4[hh] - mn); const float p = valid ? __expf(s - mn) : 0.f;
            l4[hh] = l4[hh] * sc + wave_sum(p); o4[hh] *= sc; m4[hh] = mn; p4[hh * 64 + lane] = p; }
        LDS_WAIT(); asm volatile("" ::: "memory");
        const bf16* vr = proj + (size_t)(b * SEQ + 64 * j) * PE + vcol + lane;
#pragma unroll 4
        for (int k4 = 0; k4 < 64; k4 += 4) {
            const float v0 = bf2f(vr[(size_t)(k4 + 0) * PE]), v1 = bf2f(vr[(size_t)(k4 + 1) * PE]), v2 = bf2f(vr[(size_t)(k4 + 2) * PE]), v3 = bf2f(vr[(size_t)(k4 + 3) * PE]);
#pragma unroll
            for (int hh = 0; hh < 4; ++hh) { const f32x4 pp = *(const LAS f32x4*)(p4 + hh * 64 + k4); o4[hh] += pp.x * v0 + pp.y * v1 + pp.z * v2 + pp.w * v3; }
        }
        LDS_WAIT(); asm volatile("" ::: "memory");
    }
#pragma unroll
    for (int hh = 0; hh < 4; ++hh) { const float gate = sigmoidf_(bf2f(proj[trow * PE + C_NG + (MODE == 0 ? 1 : 2) * 8 + g * 4 + hh])); const float o = gate * o4[hh] / l4[hh];
        const size_t idx = trow * 512 + (g * 4 + hh) * 64 + lane;
        if (MODE == 0) accn[idx] += o; else mixed[trow * D + 512 + (g * 4 + hh) * 64 + lane] = (bf16)f2bf(accn[idx] + o); }
}


typedef float f32x16 __attribute__((ext_vector_type(16)));
typedef short s16x8 __attribute__((ext_vector_type(8)));
typedef short s16x4 __attribute__((ext_vector_type(4)));
constexpr int A_KC = 0;
constexpr int A_VCT = 36864;
constexpr int A_K0 = 71168;
constexpr int A_V0 = 89600;
constexpr int A_OT = 107008;
constexpr int A_KSTRIDE = 9216, A_VSTRIDE = 8704;
#define EXP2(x) __builtin_amdgcn_exp2f(x)
constexpr float SM_C = 0.125f * 1.4426950408889634f;
constexpr float LAZY_TAU = 5.0f;

__device__ __forceinline__ unsigned cvtpk(float lo, float hi) { f32x2_t v = {lo, hi}; bf16x2_t b = __builtin_convertvector(v, bf16x2_t); return __builtin_bit_cast(unsigned, b); }
__device__ __forceinline__ s16x8 pack8(const f32x16& p, int o) {
    v4u w; w.x = cvtpk(p[o + 0], p[o + 1]); w.y = cvtpk(p[o + 2], p[o + 3]); w.z = cvtpk(p[o + 4], p[o + 5]); w.w = cvtpk(p[o + 6], p[o + 7]);
    return __builtin_bit_cast(s16x8, w);
}
__device__ __forceinline__ s16x8 lds_a128(const LAS unsigned char* p) { return *(const LAS s16x8*)p; }
__device__ __forceinline__ s16x8 lds_a64x2(const LAS unsigned char* p) {
    const v2u lo = *(const LAS v2u*)p, hi = *(const LAS v2u*)(p + 16); v4u w; w.x = lo.x; w.y = lo.y; w.z = hi.x; w.w = hi.y; return __builtin_bit_cast(s16x8, w);
}
#define MFMA32(a, b, c) __builtin_amdgcn_mfma_f32_32x32x16_bf16((a), (b), (c), 0, 0, 0)
constexpr int rowc(int r) { return (r & 3) + 8 * (r >> 2); }

template <int MASKED>
__device__ __forceinline__ void attn_block_rf(const s16x8 (&kf)[4][2], const s16x8 (&vf)[2][4], const s16x8 (&qf)[4], int h, int key0, int klo, int khi, bool en, float& m, float& l, f32x16 (&O)[2]) {
    f32x16 s0, s1;
#pragma unroll
    for (int i = 0; i < 16; ++i) { s0[i] = 0.f; s1[i] = 0.f; }
#pragma unroll
    for (int ks = 0; ks < 4; ++ks) { s0 = MFMA32(kf[ks][0], qf[ks], s0); s1 = MFMA32(kf[ks][1], qf[ks], s1); }
    if (MASKED == 1) {
        const int lo0 = klo - key0 - 4 * h, hi0 = khi - key0 - 4 * h;
#pragma unroll
        for (int i = 0; i < 16; ++i) { const int c = rowc(i);
            s0[i] = (en && c >= lo0 && c <= hi0) ? s0[i] : -INFINITY; s1[i] = (en && c + 32 >= lo0 && c + 32 <= hi0) ? s1[i] : -INFINITY; }
    }
    float mx = -INFINITY;
#pragma unroll
    for (int i = 0; i < 16; ++i) { mx = __builtin_elementwise_max(mx, s0[i]); mx = __builtin_elementwise_max(mx, s1[i]); }
    if (MASKED == 2) mx = en ? mx : -INFINITY;
    mx = __builtin_elementwise_max(mx, __shfl_xor(mx, 32));
    if (__builtin_amdgcn_ballot_w64((mx - m) * SM_C > LAZY_TAU) != 0ull) {
        const float mn = __builtin_elementwise_max(m, mx);
        const float alpha = EXP2((m - mn) * SM_C); m = mn; l *= alpha;
#pragma unroll
        for (int i = 0; i < 16; ++i) { O[0][i] *= alpha; O[1][i] *= alpha; }
    }
    const float mc = (MASKED == 2 && !en) ? INFINITY : m * SM_C;
    float ls = 0.f;
#pragma unroll
    for (int i = 0; i < 16; ++i) { s0[i] = EXP2(fmaf(s0[i], SM_C, -mc)); s1[i] = EXP2(fmaf(s1[i], SM_C, -mc)); ls += s0[i] + s1[i]; }
    l += ls;
    const s16x8 p00 = pack8(s0, 0), p01 = pack8(s0, 8), p10 = pack8(s1, 0), p11 = pack8(s1, 8);
#pragma unroll
    for (int dt = 0; dt < 2; ++dt) { O[dt] = MFMA32(vf[dt][0], p00, O[dt]); O[dt] = MFMA32(vf[dt][1], p01, O[dt]); O[dt] = MFMA32(vf[dt][2], p10, O[dt]); O[dt] = MFMA32(vf[dt][3], p11, O[dt]); }
}
__device__ __forceinline__ void nsa_load_k(const bf16* Kt, int bgx, int j, int lane, s16x8 (&kf)[4][2]) {
    const GAS v4u* p = (const GAS v4u*)(Kt + ((size_t)bgx * 64 + j) * 4096) + lane;
#pragma unroll
    for (int ks = 0; ks < 4; ++ks) { kf[ks][0] = __builtin_bit_cast(s16x8, p[(ks * 2 + 0) * 64]); kf[ks][1] = __builtin_bit_cast(s16x8, p[(ks * 2 + 1) * 64]); }
}
__device__ __forceinline__ void nsa_load_v(const bf16* Vt, int bgx, int j, int lane, s16x8 (&vf)[2][4]) {
    const GAS v4u* p = (const GAS v4u*)(Vt + ((size_t)bgx * 64 + j) * 4096) + lane;
#pragma unroll
    for (int dt = 0; dt < 2; ++dt)
#pragma unroll
        for (int kk = 0; kk < 4; ++kk) vf[dt][kk] = __builtin_bit_cast(s16x8, p[(dt * 4 + kk) * 64]);
}

__device__ __forceinline__ void nsa_subunit(LAS unsigned char* lds, int bg, int qt, const bf16* proj, const bf16* kcb, const bf16* vctb, const bf16* Kt, const bf16* Vt, bf16* mixed, int tid_in, int wave) {
    int tid = tid_in; asm volatile("" : "+v"(tid)); const int lane = tid & 63;
    const int b = bg >> 1, g = bg & 1; const int t0 = qt * 64, bt = qt;
    const int r32 = lane & 31, h = lane >> 5, head = r32 >> 3, ql = lane & 7;
    const int t = t0 + 8 * wave + ql; const size_t trow = (size_t)(b * SEQ + t);
    {
        const bf16* ksrc = kcb + (size_t)bg * 256 * 64; const bf16* vsrc = vctb + (size_t)bg * 256 * 64;
#pragma unroll
        for (int i = 0; i < 4; ++i) { const int p = tid + i * NT;
            { const int row = p >> 3, c = p & 7; const v4u v = *(const GAS v4u*)(ksrc + row * 64 + 8 * c); *(LAS v4u*)(lds + A_KC + row * 144 + 16 * c) = v; }
            { const int n = p >> 3, c = p & 7; const v4u v = *(const GAS v4u*)(vsrc + n * 64 + 8 * c); LAS unsigned short* d = (LAS unsigned short*)(lds + A_VCT + (8 * c) * 536 + n * 2);
              d[0 * 268] = (unsigned short)(v.x & 0xffffu); d[1 * 268] = (unsigned short)(v.x >> 16); d[2 * 268] = (unsigned short)(v.y & 0xffffu); d[3 * 268] = (unsigned short)(v.y >> 16);
              d[4 * 268] = (unsigned short)(v.z & 0xffffu); d[5 * 268] = (unsigned short)(v.z >> 16); d[6 * 268] = (unsigned short)(v.w & 0xffffu); d[7 * 268] = (unsigned short)(v.w >> 16); } }
    }
    s16x8 qf[4];
    { const bf16* qp = proj + trow * PE + C_NQ + (g * 4 + head) * 64 + 8 * h;
#pragma unroll
      for (int ks = 0; ks < 4; ++ks) qf[ks] = __builtin_bit_cast(s16x8, *(const GAS v4u*)(qp + 16 * ks)); }
    __syncthreads();
    f32x16 OT[2];
#pragma unroll
    for (int i = 0; i < 16; ++i) { OT[0][i] = 0.f; OT[1][i] = 0.f; }
    unsigned long long selmask;
    {
        const int nmax = t >= 31 ? ((t - 31) >> 4) : -1;
        const int ntile = ((t0 + 63 - 31) >= 0) ? ((((t0 + 63 - 31) >> 4) + 1 + 31) >> 5) : 0;
        float m = -3.0e38f, l = 0.f;
        float imp[32];
#pragma unroll
        for (int k = 0; k < 32; ++k) imp[k] = 0.f;
        float carry = 0.f;
#pragma unroll
        for (int T = 0; T < 8; ++T) if (T < ntile) {
            f32x16 s;
#pragma unroll
            for (int i = 0; i < 16; ++i) s[i] = 0.f;
#pragma unroll
            for (int ks = 0; ks < 4; ++ks) s = MFMA32(lds_a128(lds + A_KC + (32 * T + r32) * 144 + (16 * ks + 8 * h) * 2), qf[ks], s);
            const int lim = nmax - 32 * T - 4 * h; float mx = -INFINITY;
#pragma unroll
            for (int i = 0; i < 16; ++i) { s[i] = (rowc(i) <= lim) ? s[i] : -INFINITY; mx = __builtin_elementwise_max(mx, s[i]); }
            mx = __builtin_elementwise_max(mx, __shfl_xor(mx, 32));
            if (__builtin_amdgcn_ballot_w64((mx - m) * SM_C > LAZY_TAU) != 0ull) {
                const float mn = __builtin_elementwise_max(m, mx); const float alpha = EXP2((m - mn) * SM_C); m = mn; l *= alpha; carry *= alpha;
#pragma unroll
                for (int k = 0; k < 4 * T; ++k) imp[k] *= alpha;
#pragma unroll
                for (int i = 0; i < 16; ++i) { OT[0][i] *= alpha; OT[1][i] *= alpha; }
            }
            const float mc = m * SM_C; float ls = 0.f;
#pragma unroll
            for (int i = 0; i < 16; ++i) { s[i] = EXP2(fmaf(s[i], SM_C, -mc)); ls += s[i]; }
            l += ls;
            float Gs[4], Xs[4];
#pragma unroll
            for (int rg = 0; rg < 4; ++rg) { Gs[rg] = (s[4 * rg] + s[4 * rg + 1]) + (s[4 * rg + 2] + s[4 * rg + 3]); Xs[rg] = __shfl_xor(s[4 * rg + 3], 32); }
#pragma unroll
            for (int rg = 0; rg < 4; ++rg) imp[4 * T + rg] = Gs[rg] + (h ? Xs[rg] : (rg ? Xs[rg > 0 ? rg - 1 : 0] : carry));
            carry = Xs[3];
            const s16x8 p0 = pack8(s, 0), p1 = pack8(s, 8);
#pragma unroll
            for (int dt = 0; dt < 2; ++dt) { const LAS unsigned char* vr = lds + A_VCT + (32 * dt + r32) * 536 + (32 * T + 4 * h) * 2;
                OT[dt] = MFMA32(lds_a64x2(vr), p0, OT[dt]); OT[dt] = MFMA32(lds_a64x2(vr + 32), p1, OT[dt]); }
        }
        l += __shfl_xor(l, 32);
        const float invl = l > 0.f ? __builtin_amdgcn_rcpf(l) : 0.f;
        {
            const float og = invl * sigmoidf_(bf2f(proj[trow * PE + C_NG + 0 * 8 + g * 4 + head]));
#pragma unroll
            for (int i = 0; i < 16; ++i) { OT[0][i] *= og; OT[1][i] *= og; }
        }
#pragma unroll
        for (int k = 0; k < 32; ++k) { float v = imp[k] * invl; v += __shfl_xor(v, 8); v += __shfl_xor(v, 16); imp[k] = v; }
        selmask = 1ull | (1ull << bt) | (bt >= 1 ? (1ull << (bt - 1)) : 0ull);
        {
            LAS unsigned char* ka = lds + A_K0 + wave * 4096 + lane * 16; LAS unsigned char* kb = lds + A_OT + wave * 4096 + lane * 16;
            const unsigned limu = bt >= 3 ? (unsigned)(bt - 2) : 0u;
#pragma unroll
            for (int g4 = 0; g4 < 8; ++g4) { v4u w; unsigned kk[4];
#pragma unroll
                for (int q = 0; q < 4; ++q) { const int k = 4 * g4 + q; const int j = 2 * k + h; kk[q] = ((unsigned)(j - 1) < limu) ? ((__builtin_bit_cast(unsigned, imp[k]) & ~127u) | (unsigned)(64 - j)) : 0u; }
                w.x = kk[0]; w.y = kk[1]; w.z = kk[2]; w.w = kk[3];
                *(LAS v4u*)((g4 < 4 ? ka : kb) + (g4 & 3) * 1024) = w; }
            const int rounds = 8 - (bt == 0 ? 1 : (bt == 1 ? 2 : 3));
#pragma unroll 1
            for (int rd = 0; rd < rounds; ++rd) {
                unsigned mxk = 0u;
#pragma unroll
                for (int g4 = 0; g4 < 8; ++g4) { const v4u w = *(const LAS v4u*)((g4 < 4 ? ka : kb) + (g4 & 3) * 1024);
                    mxk = __builtin_elementwise_max(mxk, w.x); mxk = __builtin_elementwise_max(mxk, w.y); mxk = __builtin_elementwise_max(mxk, w.z); mxk = __builtin_elementwise_max(mxk, w.w); }
                const unsigned gm = __builtin_elementwise_max(mxk, (unsigned)__shfl_xor((int)mxk, 32));
                if (__builtin_amdgcn_ballot_w64(gm != 0u) == 0ull) break;
                const int jb = 64 - (int)(gm & 127u);
                if (gm != 0u) { selmask |= 1ull << jb;
                    if ((jb & 1) == h) { const int k = jb >> 1; *(LAS unsigned*)((k < 16 ? ka : kb) + ((k >> 2) & 3) * 1024 + (k & 3) * 4) = 0u; } }
            }
        }
    }
    const int wlo = bt >= 8 ? bt - 8 : 0;
    {
        LAS v4u* otp = (LAS v4u*)(lds + A_OT + (wave * 64 + lane) * 64);
#pragma unroll
        for (int dt = 0; dt < 2; ++dt)
#pragma unroll
            for (int q = 0; q < 2; ++q) { v4u w; w.x = cvtpk(OT[dt][8 * q], OT[dt][8 * q + 1]); w.y = cvtpk(OT[dt][8 * q + 2], OT[dt][8 * q + 3]); w.z = cvtpk(OT[dt][8 * q + 4], OT[dt][8 * q + 5]); w.w = cvtpk(OT[dt][8 * q + 6], OT[dt][8 * q + 7]); otp[2 * dt + q] = w; }
    }
    const float gate_s = sigmoidf_(bf2f(proj[trow * PE + C_NG + 1 * 8 + g * 4 + head])), gate_w = sigmoidf_(bf2f(proj[trow * PE + C_NG + 2 * 8 + g * 4 + head]));
    unsigned long long wact = 0ull;
#pragma unroll 1
    for (int j = 0; j <= bt; ++j) if (__ballot((selmask >> j) & 1ull) != 0ull) wact |= 1ull << j;
    float m = -3.0e38f, l = 0.f;
    f32x16 O[2];
#pragma unroll
    for (int i = 0; i < 16; ++i) { O[0][i] = 0.f; O[1][i] = 0.f; }
    int cj = __ffsll((long long)wact) - 1; wact &= wact - 1ull; bool cwin = false; int wj = wlo;
    s16x8 kf[4][2], kn[4][2], vf[2][4];
    nsa_load_k(Kt, bg * 2 + 0, cj, lane, kf);
#pragma unroll 1
    for (;;) {
        int nj; bool nwin, nvalid = true;
        if (!cwin && wact != 0ull) { nj = __ffsll((long long)wact) - 1; wact &= wact - 1ull; nwin = false; }
        else if (wj <= bt) { nj = wj++; nwin = true; }
        else { nj = 0; nwin = true; nvalid = false; }
        nsa_load_v(Vt, bg * 2 + (cwin ? 1 : 0), cj, lane, vf);
        if (nvalid) nsa_load_k(Kt, bg * 2 + (nwin ? 1 : 0), nj, lane, kn);
        if (!cwin) {
            const bool en = (selmask >> cj) & 1ull;
            if (cj == bt) attn_block_rf<1>(kf, vf, qf, h, 64 * cj, 0, t, en, m, l, O);
            else attn_block_rf<2>(kf, vf, qf, h, 64 * cj, 0, t, en, m, l, O);
        } else {
            if (cj == bt || (bt >= 8 && cj == wlo)) attn_block_rf<1>(kf, vf, qf, h, 64 * cj, t - 511, t, true, m, l, O);
            else attn_block_rf<0>(kf, vf, qf, h, 64 * cj, 0, t, true, m, l, O);
        }
        if ((!cwin && nwin) || !nvalid) {
            const float lt = l + __shfl_xor(l, 32);
            const float gate = (cwin ? gate_w : gate_s) * __builtin_amdgcn_rcpf(lt);
            LAS v4u* otp = (LAS v4u*)(lds + A_OT + (wave * 64 + lane) * 64);
#pragma unroll
            for (int dt = 0; dt < 2; ++dt)
#pragma unroll
                for (int q = 0; q < 2; ++q) { const v4u w = otp[2 * dt + q];
                    const unsigned ww[4] = {w.x, w.y, w.z, w.w};
#pragma unroll
                    for (int k = 0; k < 4; ++k) { O[dt][8 * q + 2 * k] = bflo(ww[k]) + gate * O[dt][8 * q + 2 * k]; O[dt][8 * q + 2 * k + 1] = bfhi(ww[k]) + gate * O[dt][8 * q + 2 * k + 1]; } }
            if (!nvalid) break;
#pragma unroll
            for (int dt = 0; dt < 2; ++dt)
#pragma unroll
                for (int q = 0; q < 2; ++q) { v4u w; w.x = cvtpk(O[dt][8 * q], O[dt][8 * q + 1]); w.y = cvtpk(O[dt][8 * q + 2], O[dt][8 * q + 3]); w.z = cvtpk(O[dt][8 * q + 4], O[dt][8 * q + 5]); w.w = cvtpk(O[dt][8 * q + 6], O[dt][8 * q + 7]); otp[2 * dt + q] = w; }
#pragma unroll
            for (int i = 0; i < 16; ++i) { O[0][i] = 0.f; O[1][i] = 0.f; }
            m = -3.0e38f; l = 0.f;
        }
        cj = nj; cwin = nwin;
#pragma unroll
        for (int ks = 0; ks < 4; ++ks) { kf[ks][0] = kn[ks][0]; kf[ks][1] = kn[ks][1]; }
    }
    {
        bf16* op = mixed + trow * D + 512 + (g * 4 + head) * 64 + 4 * h;
#pragma unroll
        for (int dt = 0; dt < 2; ++dt)
#pragma unroll
            for (int rg = 0; rg < 4; ++rg) { v2u w; w.x = cvtpk(O[dt][4 * rg], O[dt][4 * rg + 1]); w.y = cvtpk(O[dt][4 * rg + 2], O[dt][4 * rg + 3]); *(GAS v2u*)(op + 32 * dt + 8 * rg) = w; }
    }
    __syncthreads();
}

__device__ __forceinline__ void kv_tile_item(LAS unsigned short* scr  , int item, const bf16* proj, bf16* Kt, bf16* Vt, int lane) {
    const int bgx = item >> 6, kb = item & 63; const int bg = bgx >> 1, x = bgx & 1; const int b = bg >> 1, g = bg & 1; const int r = lane & 31, h = lane >> 5;
    const bf16* ksrc = proj + (size_t)(b * SEQ + 64 * kb) * PE + (x ? C_KW : C_KS) + 64 * g;
    GAS v4u* kd = (GAS v4u*)(Kt + (size_t)item * 4096) + lane;
#pragma unroll
    for (int ks = 0; ks < 4; ++ks)
#pragma unroll
        for (int kt = 0; kt < 2; ++kt) kd[(ks * 2 + kt) * 64] = *(const GAS v4u*)(ksrc + (size_t)(32 * kt + r) * PE + 16 * ks + 8 * h);
    const bf16* vsrc = proj + (size_t)(b * SEQ + 64 * kb + lane) * PE + (x ? C_VW : C_VS) + 64 * g;
#pragma unroll
    for (int c = 0; c < 8; ++c) { const v4u v = *(const GAS v4u*)(vsrc + 8 * c); LAS unsigned* d = (LAS unsigned*)(scr + lane * 66 + 8 * c); d[0] = v.x; d[1] = v.y; d[2] = v.z; d[3] = v.w; }
    LDS_WAIT(); asm volatile("" ::: "memory");
    GAS v4u* vd = (GAS v4u*)(Vt + (size_t)item * 4096) + lane;
#pragma unroll
    for (int dt = 0; dt < 2; ++dt)
#pragma unroll
        for (int kk = 0; kk < 4; ++kk) { const int dim = 32 * dt + r, k0 = 16 * kk + 4 * h; v4u o;
            o.x = (unsigned)scr[(k0 + 0) * 66 + dim] | ((unsigned)scr[(k0 + 1) * 66 + dim] << 16); o.y = (unsigned)scr[(k0 + 2) * 66 + dim] | ((unsigned)scr[(k0 + 3) * 66 + dim] << 16);
            o.z = (unsigned)scr[(k0 + 8) * 66 + dim] | ((unsigned)scr[(k0 + 9) * 66 + dim] << 16); o.w = (unsigned)scr[(k0 + 10) * 66 + dim] | ((unsigned)scr[(k0 + 11) * 66 + dim] << 16);
            vd[(dt * 4 + kk) * 64] = o; }
    LDS_WAIT(); asm volatile("" ::: "memory");
}

__device__ __forceinline__ float gelu_tanh_f(float x) { const float u = 0.7978845608028654f * (x + 0.044715f * x * x * x); const float t = 1.0f - 2.0f * __builtin_amdgcn_rcpf(__expf(2.0f * u) + 1.0f); return 0.5f * x * (1.0f + t); }
__device__ __forceinline__ void compress_unit(LAS unsigned char* lds, int unit, const bf16* proj, const bf16* W1T  , const float* cbias  , const float* w2k, const float* w2v,
                                              bf16* kcb, bf16* vcb, int tid_in, int wave) {
    int tid = tid_in; asm volatile("" : "+v"(tid)); const int lane = tid & 63;
    const int kv = unit >> 7, bg = (unit >> 3) & 15, tile = unit & 7; const int b = bg >> 1, g = bg & 1;
    const int r32 = lane & 31, h = lane >> 5; const int i = 32 * tile + r32;
    const bf16* w1 = W1T + (size_t)kv * 64 * 2048; const int col = (kv ? C_VC : C_KC) + 64 * g;
    f32x16 acc0, acc1;
#pragma unroll
    for (int q = 0; q < 16; ++q) { acc0[q] = 0.f; acc1[q] = 0.f; }
#pragma unroll
    for (int ks = 0; ks < 16; ++ks) {
        int tok = 16 * i + 4 * wave + (ks >> 2); tok = tok > SEQ - 1 ? SEQ - 1 : tok;
        const s16x8 av = __builtin_bit_cast(s16x8, *(const GAS v4u*)(proj + (size_t)(b * SEQ + tok) * PE + col + 16 * (ks & 3) + 8 * h));
        const int k0 = 256 * wave + 16 * ks + 8 * h;
        const s16x8 b0 = __builtin_bit_cast(s16x8, *(const GAS v4u*)(w1 + (size_t)r32 * 2048 + k0)), b1 = __builtin_bit_cast(s16x8, *(const GAS v4u*)(w1 + (size_t)(32 + r32) * 2048 + k0));
        acc0 = MFMA32(av, b0, acc0); acc1 = MFMA32(av, b1, acc1);
    }
    LAS float* part = (LAS float*)lds;
    LAS float* hidl = (LAS float*)(lds + 65536);
#pragma unroll
    for (int q = 0; q < 16; ++q) { const int row = (q & 3) + 8 * (q >> 2) + 4 * h; part[(wave * 32 + row) * 64 + r32] = acc0[q]; part[(wave * 32 + row) * 64 + 32 + r32] = acc1[q]; }
    __syncthreads();
    const int il = tid >> 4, c4 = (tid & 15) * 4;
    {
        f32x4 s = (f32x4){0.f, 0.f, 0.f, 0.f};
#pragma unroll 8
        for (int ksg = 0; ksg < 32; ++ksg) s = s + *(const GAS f32x4*)(cbias + (kv * 32 + ksg) * 64 + c4);
#pragma unroll
        for (int w = 0; w < 8; ++w) s = s + *(const LAS f32x4*)(part + (w * 32 + il) * 64 + c4);
        *(LAS f32x4*)(hidl + il * 64 + c4) = (f32x4){gelu_tanh_f(s.x), gelu_tanh_f(s.y), gelu_tanh_f(s.z), gelu_tanh_f(s.w)};
    }
    __syncthreads();
    {
        const float* w2 = kv ? w2v : w2k; f32x4 o = (f32x4){0.f, 0.f, 0.f, 0.f};
#pragma unroll 8
        for (int c = 0; c < 64; ++c) { const float hv = hidl[il * 64 + c]; o = o + *(const GAS f32x4*)(w2 + c * 64 + c4) * hv; }
        const int irow = 32 * tile + il; if (irow == 255) o = (f32x4){0.f, 0.f, 0.f, 0.f};
        v2u w; w.x = cvtpk(o.x, o.y); w.y = cvtpk(o.z, o.w);
        *(GAS v2u*)((kv ? vcb : kcb) + ((size_t)bg * 256 + irow) * 64 + c4) = w;
    }
    __syncthreads();
}


typedef float f32x4v __attribute__((ext_vector_type(4)));
#define MFMA16(a, b, c) __builtin_amdgcn_mfma_f32_16x16x32_bf16((a), (b), (c), 0, 0, 0)
constexpr int R_QT = 0, R_KT = 8704, R_KTT = 17920, R_VTT = 30208, R_E = 42496, R_BUF = 43008;
constexpr int S_QT = 0, S_KT = 24576, S_V = 49152, S_E = 65536, S_PF = 66560, S_OB = 71680, S_END = 105472;
__device__ __forceinline__ unsigned off_b(unsigned row, unsigned ch) { return 256u * row + 16u * (ch ^ (((row & 3u) << 2) | ((row >> 2) & 3u))); }
__device__ __forceinline__ unsigned tr_addr(unsigned lane, unsigned c, unsigned ks, unsigned t) { const unsigned h = lane >> 5, blk = (lane >> 4) & 1u, q = (lane & 15u) >> 2, pp = lane & 3u; return off_b(16u * ks + 8u * h + 4u * t + q, 4u * c + 2u * blk + (pp >> 1)) + 8u * (pp & 1u); }
typedef short v4i16_t __attribute__((ext_vector_type(4)));
__device__ __forceinline__ s16x8 tr_frag(const LAS unsigned char* tile, unsigned lane, unsigned c, unsigned ks) {
    const v4i16_t a = __builtin_amdgcn_ds_read_tr16_b64_v4i16((LAS v4i16_t*)(tile + tr_addr(lane, c, ks, 0))), b = __builtin_amdgcn_ds_read_tr16_b64_v4i16((LAS v4i16_t*)(tile + tr_addr(lane, c, ks, 1)));
    s16x8 r; r[0] = a[0]; r[1] = a[1]; r[2] = a[2]; r[3] = a[3]; r[4] = b[0]; r[5] = b[1]; r[6] = b[2]; r[7] = b[3]; return r; }
constexpr float REC_SCALE = 0.08838834764831845f;

__device__ __forceinline__ s16x8 lds_2x64(const LAS unsigned char* p, const LAS unsigned char* q) { const v2u lo = *(const LAS v2u*)p, hi = *(const LAS v2u*)q; v4u w; w.x = lo.x; w.y = lo.y; w.z = hi.x; w.w = hi.y; return __builtin_bit_cast(s16x8, w); }

template <int MODE>
__device__ __forceinline__ void rec_prep_task(int task, bf16* proj, const float2* rope, const float* lb, float* Eg, int lane) {
    constexpr int NH = MODE ? 8 : 4, LDP = MODE ? PO : PE, CQ = MODE ? C_HQ : C_RQ, CK = MODE ? C_HF : C_RK, CV = MODE ? C_HI : C_RV;
    const int chunk = task & 127, bh = task >> 7; const int b = bh / NH, hd = bh % NH;
    const size_t row0 = (size_t)(b * SEQ + 32 * chunk);
    if (MODE == 1) {
        const float l0 = lb[hd * 128 + 2 * lane], l1 = lb[hd * 128 + 2 * lane + 1];
        float B0 = 0.f, B1 = 0.f;
        bf16* rp0 = proj + row0 * LDP + hd * 128 + 2 * lane;
        unsigned qw[32], fw[32];
#pragma unroll
        for (int t = 0; t < 32; ++t) { qw[t] = *(const GAS unsigned*)(rp0 + (size_t)t * LDP + CQ); fw[t] = *(const GAS unsigned*)(rp0 + (size_t)t * LDP + CK); }
        __builtin_amdgcn_sched_barrier(0);
#pragma unroll
        for (int t = 0; t < 32; ++t) {
            bf16* rp = rp0 + (size_t)t * LDP;
            const float f0 = bflo(fw[t]), f1 = bfhi(fw[t]), q0 = bflo(qw[t]), q1 = bfhi(qw[t]);
            const float s0 = sigmoidf_(f0), s1 = sigmoidf_(f1);
            B0 += __logf(l0 + (1.0f - l0) * s0); B1 += __logf(l1 + (1.0f - l1) * s1);
            const float e0 = __expf(B0), e1 = __expf(B1);
            const float qt0 = siluf_(q0) * REC_SCALE * e0, qt1 = siluf_(q1) * REC_SCALE * e1;
            const float kt0 = (1.0f - l0) * (1.0f - s0) * __builtin_amdgcn_rcpf(e0), kt1 = (1.0f - l1) * (1.0f - s1) * __builtin_amdgcn_rcpf(e1);
            *(GAS unsigned*)(rp + CQ) = pk2(qt0, qt1);
            const unsigned kw = pk2(kt0, kt1);
            *(GAS unsigned*)(rp + CK) = kw;
            if (t == 31) { *(GAS f32x2*)(Eg + ((size_t)bh * 128 + chunk) * 128 + 2 * lane) = (f32x2){e0, e1}; }
        }
    } else {
        const float gamma = 1.0f - exp2f(-5.0f - (float)hd); const float ginv = 1.0f / gamma;
        float gp = 1.0f, gi = 1.0f;
        bf16* rp0 = proj + row0 * LDP + hd * 128 + lane;
#pragma unroll
        for (int half = 0; half < 2; ++half) {
            unsigned short q1h[16], q2h[16], k1h[16], k2h[16]; float2 csh[16];
#pragma unroll
            for (int i = 0; i < 16; ++i) { const int t = 16 * half + i; const bf16* rp = rp0 + (size_t)t * LDP;
                q1h[i] = rp[CQ]; q2h[i] = rp[CQ + 64]; k1h[i] = rp[CK]; k2h[i] = rp[CK + 64]; csh[i] = rope[(32 * chunk + t) * 64 + lane]; }
            __builtin_amdgcn_sched_barrier(0);
#pragma unroll
            for (int i = 0; i < 16; ++i) { const int t = 16 * half + i; bf16* rp = rp0 + (size_t)t * LDP;
                gp *= gamma; gi *= ginv;
                const float2 cs = csh[i];
                const float q1 = bf2f(q1h[i]), q2 = bf2f(q2h[i]), k1 = bf2f(k1h[i]), k2 = bf2f(k2h[i]);
                const unsigned qa = f2bf((q1 * cs.x - q2 * cs.y) * gp), qb = f2bf((q1 * cs.y + q2 * cs.x) * gp);
                const unsigned ka = f2bf((k1 * cs.x - k2 * cs.y) * (REC_SCALE * gi)), kb = f2bf((k1 * cs.y + k2 * cs.x) * (REC_SCALE * gi));
                rp[CQ] = (bf16)qa; rp[CQ + 64] = (bf16)qb; rp[CK] = (bf16)ka; rp[CK + 64] = (bf16)kb;
            }
        }
    }
}


struct RecSet { v4u q[2], k[2], v[2]; f32x4v e; v4u g[2]; f32x4v ec[2]; };

template <int MODE, int SEGS>
__device__ __forceinline__ void rec_issue(RecSet& R, int c, int bh, int hd, size_t rowbase, const bf16* proj, const float* Eg, int hid) {
    constexpr int NCH = SEQ / 32 / SEGS, LDP = MODE ? PO : PE, CQ = MODE ? C_HQ : C_RQ, CK = MODE ? C_HF : C_RK, CV = MODE ? C_HI : C_RV, CG = MODE ? C_HG : C_RG;
    if (c + 2 < NCH) { const size_t r2 = rowbase + 32 * (c + 2);
#pragma unroll
        for (int i = 0; i < 2; ++i) { const int p = hid + 256 * i, tq = p >> 4, cq = p & 15;
            R.q[i] = *(const GAS v4u*)(proj + (r2 + tq) * LDP + CQ + hd * 128 + 8 * cq); R.k[i] = *(const GAS v4u*)(proj + (r2 + tq) * LDP + CK + hd * 128 + 8 * cq); } }
    if (c + 1 < NCH) { const size_t r1 = rowbase + 32 * (c + 1);
#pragma unroll
        for (int i = 0; i < 2; ++i) { const int p = hid + 256 * i, tq = p >> 4, cq = p & 15; R.v[i] = *(const GAS v4u*)(proj + (r1 + tq) * LDP + CV + hd * 128 + 8 * cq); }
        if (MODE == 1 && hid < 32) R.e = *(const GAS f32x4v*)(Eg + ((size_t)bh * 128 + c + 1) * 128 + 4 * hid);
        if (SEGS > 1) { const GAS f32x4v* ep = (const GAS f32x4v*)(Eg + ((size_t)bh * 128 + c + 1) * 128 + 8 * (hid & 15)); R.ec[0] = ep[0]; R.ec[1] = ep[1]; } }
    if (SEGS == 1 && c >= 1) { const GAS v4u* gp = (const GAS v4u*)(proj + (rowbase + 32 * (c - 1) + (hid >> 3)) * LDP + CG + hd * 128 + 16 * (hid & 7)); R.g[0] = gp[0]; R.g[1] = gp[1]; }
}
__device__ __forceinline__ v4u scale8(v4u q, const float (&f)[8]) {
    v4u o; o.x = pk2(bflo(q.x) * f[0], bfhi(q.x) * f[1]); o.y = pk2(bflo(q.y) * f[2], bfhi(q.y) * f[3]); o.z = pk2(bflo(q.z) * f[4], bfhi(q.z) * f[5]); o.w = pk2(bflo(q.w) * f[6], bfhi(q.w) * f[7]); return o; }
template <int MODE, int SEGS>
__device__ __forceinline__ void rec_stage(const RecSet& R, LAS unsigned char* lds, int c, int hid, float (&ecum)[8], bool fix, bf16* projw, int hd, size_t rowbase) {
    constexpr int NCH = SEQ / 32 / SEGS, LDP = MODE ? PO : PE, CQ = MODE ? C_HQ : C_RQ;
    if (SEGS > 1 && c + 1 < NCH) {
        ecum[0] *= R.ec[0][0]; ecum[1] *= R.ec[0][1]; ecum[2] *= R.ec[0][2]; ecum[3] *= R.ec[0][3]; ecum[4] *= R.ec[1][0]; ecum[5] *= R.ec[1][1]; ecum[6] *= R.ec[1][2]; ecum[7] *= R.ec[1][3]; }
    if (c + 2 < NCH) {
#pragma unroll
        for (int i = 0; i < 2; ++i) { const int p = hid + 256 * i; const unsigned o = off_b(p >> 4, p & 15);
            *(LAS v4u*)(lds + S_QT + ((c + 2) % 3) * 8192 + o) = R.q[i]; *(LAS v4u*)(lds + S_KT + ((c + 2) % 3) * 8192 + o) = R.k[i];
            if (SEGS > 1 && fix) *(GAS v4u*)(projw + (rowbase + 32 * (c + 2) + (p >> 4)) * LDP + CQ + hd * 128 + 8 * (p & 15)) = scale8(R.q[i], ecum); } }
    if (c + 1 < NCH) {
#pragma unroll
        for (int i = 0; i < 2; ++i) { const int p = hid + 256 * i; *(LAS v4u*)(lds + S_V + ((c + 1) & 1) * 8192 + off_b(p >> 4, p & 15)) = R.v[i]; }
        if (MODE == 1 && hid < 32) *(LAS f32x4v*)(lds + S_E + ((c + 1) & 1) * 512 + 16 * hid) = R.e; }
}
__device__ __forceinline__ void rec_store_raw(const LAS unsigned char* lds, int cp, int hd, size_t rowbase, bf16* mixed, int hid) {
    const int t = hid >> 3, seg = hid & 7;
    const LAS f32x4v* ob = (const LAS f32x4v*)(lds + S_OB + (cp & 1) * 16896 + t * 528 + seg * 64);
    const f32x4v o0 = ob[0], o1 = ob[1], o2 = ob[2], o3 = ob[3];
    GAS v4u* dst = (GAS v4u*)(mixed + (rowbase + 32 * cp + t) * D + hd * 128 + 16 * seg);
    dst[0] = (v4u){pk2(o0[0], o0[1]), pk2(o0[2], o0[3]), pk2(o1[0], o1[1]), pk2(o1[2], o1[3])}; dst[1] = (v4u){pk2(o2[0], o2[1]), pk2(o2[2], o2[3]), pk2(o3[0], o3[1]), pk2(o3[2], o3[3])};
}
__device__ __forceinline__ void rec_ptile3(LAS unsigned char* lds, int cn, int hw, int lane) {
    const int c16 = lane & 15, q4 = lane >> 4; const int si = hw == 2 ? 1 : 0, ti = hw == 0 ? 0 : 1;
    const LAS unsigned char* kb = lds + S_KT + (cn % 3) * 8192; const LAS unsigned char* qb = lds + S_QT + (cn % 3) * 8192;
    s16x8 ka[4], qa[4];
#pragma unroll
    for (int ks = 0; ks < 4; ++ks) { ka[ks] = lds_a128(kb + off_b(16 * si + c16, 4 * ks + q4)); qa[ks] = lds_a128(qb + off_b(16 * ti + c16, 4 * ks + q4)); }
    __builtin_amdgcn_sched_barrier(0);
    f32x4v p = (f32x4v){0.f, 0.f, 0.f, 0.f};
#pragma unroll
    for (int ks = 0; ks < 4; ++ks) p = MFMA16(ka[ks], qa[ks], p);
    if (hw != 1) {
#pragma unroll
        for (int r = 0; r < 4; ++r) p[r] = ((4 * q4 + r) <= c16) ? p[r] : 0.f;
    }
    v2u w; w.x = cvtpk(p[0], p[1]); w.y = cvtpk(p[2], p[3]);
    *(LAS v2u*)(lds + S_PF + (cn & 1) * 2560 + (16 * ti + c16) * 80 + (16 * si + 4 * q4) * 2) = w;
}
template <int MODE>
__device__ __forceinline__ void rec_finish(const LAS unsigned char* lds, int cp, const v4u (&g)[2], const float (&ngl)[16], int hd, size_t rowbase, bf16* mixed, int hid) {
    const int t = hid >> 3, seg = hid & 7;
    const LAS f32x4v* ob = (const LAS f32x4v*)(lds + S_OB + (cp & 1) * 16896 + t * 528 + seg * 64);
    f32x4v o[4];
#pragma unroll
    for (int i = 0; i < 4; ++i) o[i] = ob[i];
    float s1 = 0.f, s2 = 0.f;
#pragma unroll
    for (int i = 0; i < 4; ++i) { s1 += (o[i][0] + o[i][1]) + (o[i][2] + o[i][3]); s2 += (o[i][0] * o[i][0] + o[i][1] * o[i][1]) + (o[i][2] * o[i][2] + o[i][3] * o[i][3]); }
    s1 += __shfl_xor(s1, 1); s2 += __shfl_xor(s2, 1); s1 += __shfl_xor(s1, 2); s2 += __shfl_xor(s2, 2); s1 += __shfl_xor(s1, 4); s2 += __shfl_xor(s2, 4);
    float mu = 0.f, rs;
    if (MODE == 0) { mu = s1 * (1.f / 128.f); rs = __builtin_amdgcn_rsqf(fmaxf(s2 * (1.f / 128.f) - mu * mu, 0.f) + 1e-5f); }
    else rs = __builtin_amdgcn_rsqf(s2 * (1.f / 128.f) + RMS_EPS);
    v4u out[2];
#pragma unroll
    for (int hv = 0; hv < 2; ++hv) { unsigned w[4];
#pragma unroll
        for (int k = 0; k < 4; ++k) { const int e0 = 8 * hv + 2 * k; const unsigned gw = k == 0 ? g[hv].x : (k == 1 ? g[hv].y : (k == 2 ? g[hv].z : g[hv].w));
            const float a = o[e0 >> 2][e0 & 3], bq = o[(e0 + 1) >> 2][(e0 + 1) & 3]; float y0, y1;
            if (MODE == 0) { y0 = (a - mu) * rs * siluf_(bflo(gw)); y1 = (bq - mu) * rs * siluf_(bfhi(gw)); }
            else { y0 = a * rs * ngl[e0] * sigmoidf_(bflo(gw)); y1 = bq * rs * ngl[e0 + 1] * sigmoidf_(bfhi(gw)); }
            w[k] = pk2(y0, y1); }
        out[hv] = (v4u){w[0], w[1], w[2], w[3]}; }
    GAS v4u* dst = (GAS v4u*)(mixed + (rowbase + 32 * cp + t) * D + hd * 128 + 16 * seg);
    dst[0] = out[0]; dst[1] = out[1];
}

template <int MODE>
__device__ __forceinline__ void rec_compute(LAS unsigned char* lds, int c, f32x16 (&Sacc)[4], float egam, int w, int lane) {
    const int r32 = lane & 31, h = lane >> 5;
    const LAS unsigned char* qt = lds + S_QT + (c % 3) * 8192; const LAS unsigned char* ktl = lds + S_KT + (c % 3) * 8192; const LAS unsigned char* vtl = lds + S_V + (c & 1) * 8192;
    const LAS unsigned char* pf = lds + S_PF + (c & 1) * 2560 + r32 * 80 + 16 * h;
    const s16x8 pf0 = lds_a128(pf), pf1 = lds_a128(pf + 32);
    const s16x8 vf0 = tr_frag(vtl, lane, w, 0), vf1 = tr_frag(vtl, lane, w, 1);
    s16x8 qp[4][2];
#pragma unroll
    for (int dt = 0; dt < 4; ++dt)
#pragma unroll
        for (int sp = 0; sp < 2; ++sp) qp[dt][sp] = lds_2x64(qt + off_b(r32, 4 * dt + 2 * sp) + 8 * h, qt + off_b(r32, 4 * dt + 2 * sp + 1) + 8 * h);
    __builtin_amdgcn_sched_barrier(0);
    f32x16 o;
#pragma unroll
    for (int i = 0; i < 16; ++i) o[i] = 0.f;
    o = MFMA32(vf0, pf0, o); o = MFMA32(vf1, pf1, o);
#pragma unroll
    for (int dt = 0; dt < 4; ++dt)
#pragma unroll
        for (int sp = 0; sp < 2; ++sp) o = MFMA32(pack8(Sacc[dt], 8 * sp), qp[dt][sp], o);
    __builtin_amdgcn_sched_barrier(0);
    s16x8 kf[4][2];
#pragma unroll
    for (int dt = 0; dt < 4; ++dt) { kf[dt][0] = tr_frag(ktl, lane, dt, 0); kf[dt][1] = tr_frag(ktl, lane, dt, 1); }
    __builtin_amdgcn_sched_barrier(0);
#pragma unroll
    for (int dt = 0; dt < 4; ++dt) { Sacc[dt] = MFMA32(kf[dt][0], vf0, Sacc[dt]); Sacc[dt] = MFMA32(kf[dt][1], vf1, Sacc[dt]); }
    {
        LAS unsigned char* ob = lds + S_OB + (c & 1) * 16896 + r32 * 528 + (32 * w + 4 * h) * 4;
#pragma unroll
        for (int g = 0; g < 4; ++g) *(LAS f32x4v*)(ob + 32 * g) = (f32x4v){o[4 * g], o[4 * g + 1], o[4 * g + 2], o[4 * g + 3]};
    }
    if (MODE == 1) { const LAS unsigned char* eb = lds + S_E + (c & 1) * 512 + 16 * h;
#pragma unroll
        for (int dt = 0; dt < 4; ++dt)
#pragma unroll
            for (int g = 0; g < 4; ++g) { const f32x4v e4 = *(const LAS f32x4v*)(eb + (32 * dt + 8 * g) * 4);
                Sacc[dt][4 * g] *= e4[0]; Sacc[dt][4 * g + 1] *= e4[1]; Sacc[dt][4 * g + 2] *= e4[2]; Sacc[dt][4 * g + 3] *= e4[3]; }
    } else {
#pragma unroll
        for (int dt = 0; dt < 4; ++dt)
#pragma unroll
            for (int i = 0; i < 16; ++i) Sacc[dt][i] *= egam;
    }
}

#define REC_BAR() do { asm volatile("s_waitcnt lgkmcnt(0)" ::: "memory"); __builtin_amdgcn_s_barrier(); asm volatile("" ::: "memory"); } while (0)

template <int MODE, int SEGS>
__device__ __forceinline__ void rec_serial_unit(LAS unsigned char* lds, int unit, bf16* proj, const float* Eg0, const float* ng, bf16* mixed, float* Send, float* Dseg, int tid_in, int wave) {
    constexpr int NH = MODE ? 8 : 4, NCH = SEQ / 32 / SEGS, LDP = MODE ? PO : PE, CQ = MODE ? C_HQ : C_RQ, CK = MODE ? C_HF : C_RK, CV = MODE ? C_HI : C_RV;
    int tid = tid_in; asm volatile("" : "+v"(tid)); const int lane = tid & 63;
    const int bh = unit / SEGS, sg = unit % SEGS;
    const int b = bh / NH, hd = bh % NH; const size_t rowbase = (size_t)b * SEQ + (size_t)sg * NCH * 32;
    const float* Eg = Eg0 + (size_t)sg * NCH * 128;
    const bool fix = SEGS > 1 && sg > 0;
    float ecum[8] = {1.f, 1.f, 1.f, 1.f, 1.f, 1.f, 1.f, 1.f};
    {
        const int tq = tid >> 4, cq = tid & 15; const unsigned o = off_b(tq, cq);
        if (SEGS > 1) { const GAS f32x4v* ep = (const GAS f32x4v*)(Eg + ((size_t)bh * 128) * 128 + 8 * cq); const f32x4v e0 = ep[0], e1 = ep[1];
            ecum[0] = e0[0]; ecum[1] = e0[1]; ecum[2] = e0[2]; ecum[3] = e0[3]; ecum[4] = e1[0]; ecum[5] = e1[1]; ecum[6] = e1[2]; ecum[7] = e1[3]; }
#pragma unroll
        for (int cc = 0; cc < 2; ++cc) { const size_t r = rowbase + 32 * cc + tq;
            const v4u qv = *(const GAS v4u*)(proj + r * LDP + CQ + hd * 128 + 8 * cq);
            *(LAS v4u*)(lds + S_QT + cc * 8192 + o) = qv;
            if (SEGS > 1 && fix && cc == 1) *(GAS v4u*)(proj + r * LDP + CQ + hd * 128 + 8 * cq) = scale8(qv, ecum);
            *(LAS v4u*)(lds + S_KT + cc * 8192 + o) = *(const GAS v4u*)(proj + r * LDP + CK + hd * 128 + 8 * cq); }
        *(LAS v4u*)(lds + S_V + o) = *(const GAS v4u*)(proj + (rowbase + tq) * LDP + CV + hd * 128 + 8 * cq);
        if (MODE == 1 && tid < 32) *(LAS f32x4v*)(lds + S_E + 16 * tid) = *(const GAS f32x4v*)(Eg + ((size_t)bh * 128) * 128 + 4 * tid);
        if (tid < 128) { const int par = tid >> 6, t16 = (tid >> 2) & 15, q = tid & 3; unsigned z = 0u; asm volatile("" : "+v"(z)); *(LAS v2u*)(lds + S_PF + par * 2560 + t16 * 80 + 32 + 8 * q) = (v2u){z, z}; }
    }
    __syncthreads();
    if (wave >= 4 && wave < 7) rec_ptile3(lds, 0, wave - 4, lane);
    __syncthreads();
    if (wave < 4) {
        f32x16 Sacc[4];
#pragma unroll
        for (int dt = 0; dt < 4; ++dt)
#pragma unroll
            for (int i = 0; i < 16; ++i) Sacc[dt][i] = 0.f;
        const float egam = MODE ? 1.f : exp2f(32.0f * log2f(1.0f - exp2f(-5.0f - (float)hd)));
#pragma unroll 1
        for (int c = 0; c <= NCH; ++c) { if (c < NCH) rec_compute<MODE>(lds, c, Sacc, egam, wave, lane); REC_BAR(); }
        if (SEGS > 1 && sg + 1 < SEGS) {
            const int r32 = lane & 31, h = lane >> 5; float* sp = Send + ((size_t)(bh * (SEGS - 1) + sg) * 128) * 128 + 32 * wave + r32;
#pragma unroll
            for (int dt = 0; dt < 4; ++dt)
#pragma unroll
                for (int i = 0; i < 16; ++i) sp[(size_t)(32 * dt + (i & 3) + 8 * (i >> 2) + 4 * h) * 128] = Sacc[dt][i];
        }
    } else {
        const int hid = tid - 256, hw = wave - 4;
        RecSet RA, RB;
        float ngl[16];
#pragma unroll
        for (int i = 0; i < 16; ++i) ngl[i] = (MODE && SEGS == 1) ? ng[16 * (hid & 7) + i] : 1.f;
        rec_issue<MODE, SEGS>(RA, 0, bh, hd, rowbase, proj, Eg, hid); rec_issue<MODE, SEGS>(RB, 1, bh, hd, rowbase, proj, Eg, hid);
#pragma unroll 1
        for (int c = 0; c <= NCH; c += 2) {
            if (c >= 1) { if (SEGS == 1) rec_finish<MODE>(lds, c - 1, RA.g, ngl, hd, rowbase, mixed, hid); else rec_store_raw(lds, c - 1, hd, rowbase, mixed, hid); }
            if (hw < 3 && c + 1 < NCH) rec_ptile3(lds, c + 1, hw, lane);
            rec_stage<MODE, SEGS>(RA, lds, c, hid, ecum, fix, proj, hd, rowbase);
            if (c + 2 <= NCH) rec_issue<MODE, SEGS>(RA, c + 2, bh, hd, rowbase, proj, Eg, hid);
            REC_BAR();
            if (c + 1 <= NCH) {
                if (SEGS == 1) rec_finish<MODE>(lds, c, RB.g, ngl, hd, rowbase, mixed, hid); else rec_store_raw(lds, c, hd, rowbase, mixed, hid);
                if (hw < 3 && c + 2 < NCH) rec_ptile3(lds, c + 2, hw, lane);
                rec_stage<MODE, SEGS>(RB, lds, c + 1, hid, ecum, fix, proj, hd, rowbase);
                if (c + 3 <= NCH) rec_issue<MODE, SEGS>(RB, c + 3, bh, hd, rowbase, proj, Eg, hid);
                REC_BAR();
            }
        }
        if (SEGS > 1 && hid < 16) { float* dp = Dseg + (size_t)(bh * SEGS + sg) * 128 + 8 * hid;
            *(GAS f32x4v*)dp = (f32x4v){ecum[0], ecum[1], ecum[2], ecum[3]}; *(GAS f32x4v*)(dp + 4) = (f32x4v){ecum[4], ecum[5], ecum[6], ecum[7]}; }
    }
    __syncthreads();
}

__device__ __forceinline__ void rec_fix_unit(LAS unsigned char* lds, int unit, const bf16* proj, const float* Send, const float* Dseg, const float* ng, bf16* mixed, int tid_in, int wave) {
    int tid = tid_in; asm volatile("" : "+v"(tid)); const int lane = tid & 63;
    const int sg = unit & 3, bh = unit >> 2; const int b = bh >> 3, hd = bh & 7;
    const int r32 = lane & 31, h = lane >> 5;
    LAS unsigned char* ST = lds;
    if (sg > 0) {
        const int e = tid & 127, d0 = 32 * (tid >> 7); float sv[32], t1[32];
        const float* s0p = Send + ((size_t)(bh * 3 + 0) * 128 + d0) * 128 + e;
#pragma unroll
        for (int dd = 0; dd < 32; ++dd) sv[dd] = s0p[(size_t)dd * 128];
        __builtin_amdgcn_sched_barrier(0);
        if (sg >= 2) { const float* s1p = Send + ((size_t)(bh * 3 + 1) * 128 + d0) * 128 + e; const float* dp = Dseg + (size_t)(bh * 4 + 1) * 128 + d0;
#pragma unroll
            for (int dd = 0; dd < 32; ++dd) t1[dd] = s1p[(size_t)dd * 128];
            __builtin_amdgcn_sched_barrier(0);
#pragma unroll
            for (int dd = 0; dd < 32; ++dd) sv[dd] = dp[dd] * sv[dd] + t1[dd]; }
        if (sg >= 3) { const float* s2p = Send + ((size_t)(bh * 3 + 2) * 128 + d0) * 128 + e; const float* dp = Dseg + (size_t)(bh * 4 + 2) * 128 + d0;
#pragma unroll
            for (int dd = 0; dd < 32; ++dd) t1[dd] = s2p[(size_t)dd * 128];
            __builtin_amdgcn_sched_barrier(0);
#pragma unroll
            for (int dd = 0; dd < 32; ++dd) sv[dd] = dp[dd] * sv[dd] + t1[dd]; }
#pragma unroll
        for (int q = 0; q < 4; ++q) *(LAS v4u*)(ST + e * 272 + d0 * 2 + 16 * q) = (v4u){pk2(sv[8 * q], sv[8 * q + 1]), pk2(sv[8 * q + 2], sv[8 * q + 3]), pk2(sv[8 * q + 4], sv[8 * q + 5]), pk2(sv[8 * q + 6], sv[8 * q + 7])};
    }
    __syncthreads();
#pragma unroll 1
    for (int blk = 0; blk < 4; ++blk) {
        f32x16 O[4];
#pragma unroll
        for (int et = 0; et < 4; ++et)
#pragma unroll
            for (int i = 0; i < 16; ++i) O[et][i] = 0.f;
        const size_t trow = (size_t)b * SEQ + 1024 * sg + 256 * blk + 32 * wave + r32;
        if (sg > 0) {
            s16x8 qf[8];
            { const bf16* qp = proj + trow * PO + C_HQ + hd * 128 + 8 * h;
#pragma unroll
              for (int ks = 0; ks < 8; ++ks) qf[ks] = __builtin_bit_cast(s16x8, *(const GAS v4u*)(qp + 16 * ks)); }
#pragma unroll
            for (int et = 0; et < 4; ++et)
#pragma unroll
                for (int ks = 0; ks < 8; ++ks) O[et] = MFMA32(lds_a128(ST + (32 * et + r32) * 272 + (16 * ks + 8 * h) * 2), qf[ks], O[et]);
        }
        bf16* mp = mixed + trow * D + hd * 128 + 4 * h; const bf16* gp = proj + trow * PO + C_HG + hd * 128 + 4 * h;
        v2u ol[4][4], gl[4][4];
#pragma unroll
        for (int et = 0; et < 4; ++et)
#pragma unroll
            for (int g = 0; g < 4; ++g) { ol[et][g] = *(const GAS v2u*)(mp + 32 * et + 8 * g); gl[et][g] = *(const GAS v2u*)(gp + 32 * et + 8 * g); }
        __builtin_amdgcn_sched_barrier(0);
        float s2 = 0.f;
#pragma unroll
        for (int et = 0; et < 4; ++et)
#pragma unroll
            for (int g = 0; g < 4; ++g) { const v2u w = ol[et][g];
                O[et][4 * g] += bflo(w.x); O[et][4 * g + 1] += bfhi(w.x); O[et][4 * g + 2] += bflo(w.y); O[et][4 * g + 3] += bfhi(w.y);
                s2 += (O[et][4 * g] * O[et][4 * g] + O[et][4 * g + 1] * O[et][4 * g + 1]) + (O[et][4 * g + 2] * O[et][4 * g + 2] + O[et][4 * g + 3] * O[et][4 * g + 3]); }
        s2 += __shfl_xor(s2, 32);
        const float rs = __builtin_amdgcn_rsqf(s2 * (1.f / 128.f) + RMS_EPS);
#pragma unroll
        for (int et = 0; et < 4; ++et)
#pragma unroll
            for (int g = 0; g < 4; ++g) { const v2u gw = gl[et][g]; const f32x4v nv = *(const GAS f32x4v*)(ng + 32 * et + 8 * g + 4 * h);
                v2u w; w.x = pk2(O[et][4 * g] * rs * nv[0] * sigmoidf_(bflo(gw.x)), O[et][4 * g + 1] * rs * nv[1] * sigmoidf_(bfhi(gw.x)));
                w.y = pk2(O[et][4 * g + 2] * rs * nv[2] * sigmoidf_(bflo(gw.y)), O[et][4 * g + 3] * rs * nv[3] * sigmoidf_(bfhi(gw.y)));
                *(GAS v2u*)(mp + 32 * et + 8 * g) = w; }
    }
    __syncthreads();
}
struct Args { const float* in[19]; float* out; unsigned char* ws; int ph_lo, ph_hi, rep, pad; };
constexpr int NPH_LAYER = 11, NPHASES = 1 + DEPTH * NPH_LAYER;

__global__ void __launch_bounds__(NT, 2) trunk_fwd(Args args) {
    extern __shared__ __attribute__((aligned(16))) unsigned char lds_raw[];
    LAS unsigned char* lds = (LAS unsigned char*)lds_raw;
    volatile LAS unsigned* MISC = (volatile LAS unsigned*)(lds + MISC_OFF);
    const int tid0 = threadIdx.x; const int wave0 = __builtin_amdgcn_readfirstlane(tid0 >> 6); const int wave = wave0;
#define PHASE_TID() int tid; asm volatile("v_mbcnt_lo_u32_b32 %0, -1, 0\n\tv_mbcnt_hi_u32_b32 %0, -1, %0" : "=v"(tid)); tid |= wave0 << 6;     \
    const int lane = tid & 63; (void)lane; int wave = wave0; asm volatile("" : "+s"(wave)); (void)wave; \
    size_t wso = 0; asm volatile("" : "+s"(wso)); unsigned char* ws = args.ws + wso; gu32* ctl = (gu32*)(ws + WS_CTL); float2* rope = (float2*)(ws + WS_ROPE); float* lbv = (float*)(ws + WS_LB); \
    bf16* Hb = (bf16*)(ws + WS_H); bf16* proj = (bf16*)(ws + WS_PROJ); bf16* hid = (bf16*)(ws + WS_PROJ); bf16* mixed = (bf16*)(ws + WS_MIXED); float* rowss = (float*)(ws + WS_ROWSS); \
    bf16* kcb = (bf16*)(ws + WS_KCB); bf16* vctb = (bf16*)(ws + WS_VCTB); bf16* VTb = (bf16*)(ws + WS_VT); bf16* KTb = (bf16*)(ws + WS_KT); \
    (void)ctl; (void)rope; (void)lbv; (void)Hb; (void)proj; (void)hid; (void)mixed; (void)rowss; (void)kcb; (void)vctb; (void)VTb; (void)KTb
    const int G = gridDim.x; const int bx = blockIdx.x; const int vcu = (G % 8 == 0) ? (bx % 8) * (G / 8) + bx / 8 : bx;
    const int gw = vcu * NWAVES + wave, NGW = G * NWAVES;
    unsigned char* ws = args.ws;
    gu32* ctl = (gu32*)(ws + WS_CTL);
    for (int u = tid0; u < (LDS_BYTES - LDSCTL_OFF) / 4; u += NT) ((LAS unsigned*)(lds + LDSCTL_OFF))[u] = 0u;
    __syncthreads();
    XcdBarrier bar; bar.bar = (unsigned*)(ctl + CW_BAR); bar.x = 0; bar.st = nullptr;
#if ONE_LAUNCH
    bar = xcd_barrier_post((unsigned*)(ctl + CW_BAR), MISC + 8);
#define GRID_BAR() xcd_barrier(bar)
#else
#define GRID_BAR() do {} while (0)
#endif
    const int lo = args.ph_lo, hi = args.ph_hi;
#define IN(k) (lo <= (k) && (k) < hi)
    const float* x_in = args.in[0]; float* xres = args.out;
    float2* rope = (float2*)(ws + WS_ROPE); float* lbv = (float*)(ws + WS_LB); float* kcmp = (float*)(ws + WS_KCMP); unsigned long long* sel = (unsigned long long*)(ws + WS_SEL);
    bf16* Hb = (bf16*)(ws + WS_H); float* accn = (float*)(ws + WS_H); bf16* proj = (bf16*)(ws + WS_PROJ); bf16* hid = (bf16*)(ws + WS_PROJ); bf16* mixed = (bf16*)(ws + WS_MIXED);
    float* rowss = (float*)(ws + WS_ROWSS); bf16* kcb = (bf16*)(ws + WS_KCB); bf16* vctb = (bf16*)(ws + WS_VCTB); bf16* VTb = (bf16*)(ws + WS_VT); bf16* KTb = (bf16*)(ws + WS_KT);

    if (IN(0)) { PHASE_TID();
        LAS unsigned* scr = (LAS unsigned*)(lds + wave * 16384);
#if PROBE_ML
        const int pr = args.rep;
#else
        const int pr = 0;
#endif
        if (pr == 0 || pr == 1 || pr == 2) { convert_weights(args.in, ws, 0, scr, gw, NGW, lane); convert_weights(args.in, ws, 1, scr, gw, NGW, lane); }
        if (pr == 0 || pr == 1 || pr == 4) {
        for (int it = gw; it < 4 * 32; it += NGW) { const int m = it >> 5, r = it & 31; const int jj = m >> 1, kv = m & 1;
            tr_item64(args.in[kv ? 10 : 7] + (size_t)jj * 2048 * 64, 2048, 64, (bf16*)(ws + WS_W1T) + (size_t)m * 64 * 2048, r * 64, 0, 0, scr, lane); }
        for (int mt = gw; mt < 4 * 32; mt += NGW) { const int m = mt >> 5, ksg = mt & 31; const int jj = m >> 1, kv = m & 1;
            const float* pos = args.in[kv ? 9 : 6] + (size_t)jj * 2048 + 64 * ksg; const float* w1 = args.in[kv ? 10 : 7] + (size_t)jj * 2048 * 64 + (size_t)64 * ksg * 64;
            float acc = 0.f;
#pragma unroll 16
            for (int k = 0; k < 64; ++k) acc += pos[k] * w1[k * 64 + lane];
            ((float*)(ws + WS_CBIAS))[(m * 32 + ksg) * 64 + lane] = acc; }
        for (int idx = vcu * NT + tid; idx < SEQ * 64; idx += G * NT) { const int s = idx >> 6, i = idx & 63;
            const float inv = exp2f(-(float)i * (13.287712379549449f / 64.0f));
            double tt = (double)s * (double)inv * 0.15915494309189535; tt -= floor(tt); const float tf = (float)tt;
            rope[idx] = make_float2(__builtin_amdgcn_cosf(tf), __builtin_amdgcn_sinf(tf)); }
        for (int c = vcu * NT + tid; c < 1024; c += G * NT) { const float l0 = args.in[15][c], l1 = args.in[15][1024 + c]; lbv[c] = 0.f; lbv[1024 + c] = 1.0f / (1.0f + expf(l0 - l1)); }
        }
        if (pr == 0 || pr == 1 || pr == 3) {
        if (M % (G * 2 * NWAVES) == 0) { const int per = M / G; for (int m = vcu * per + wave; m < (vcu + 1) * per; m += 2 * NWAVES) rows2_to_bf16_ss(x_in + (size_t)m * D, x_in + (size_t)(m + NWAVES) * D, Hb + (size_t)m * D, Hb + (size_t)(m + NWAVES) * D, rowss, m, m + NWAVES, lane); }
        else if (M % G == 0) { const int per = M / G; for (int m = vcu * per + wave; m < (vcu + 1) * per; m += NWAVES) row_to_bf16_ss(x_in + (size_t)m * D, Hb + (size_t)m * D, rowss, m, lane); }
        else for (int m = gw; m < M; m += NGW) row_to_bf16_ss(x_in + (size_t)m * D, Hb + (size_t)m * D, rowss, m, lane);
        }
        __syncthreads();
        GRID_BAR();
    }

#pragma unroll 1
    for (int L = 0; L < DEPTH; ++L) {
        const int pb = 1 + L * NPH_LAYER; const int j = L >> 1; const bool even = (L & 1) == 0;
        if (IN(pb + 0)) { PHASE_TID();
            const int N = even ? PE : PO; const bf16* Wt = even ? (const bf16*)(ws + WS_WEIN) + (size_t)j * PE * D : (const bf16*)(ws + WS_WOIN) + (size_t)j * PO * D;
            pg8::Gemm g{Hb, Wt, M, N, D}; pg8::StaticOrder S; S.init(M, N, G, bx);
            build_rstd_table(lds, S, rowss, tid);
            pg8::EpiInProj E{proj, N, (const LAS int*)(lds + RS_TBL_OFF), (const LAS float*)(lds + RS_TAB_OFF), even ? 0 : 1, (const float*)rope, lbv + (size_t)j * 1024, (float*)(ws + WS_VT), PROBE_ML ? args.rep : 0};
#if PROBE_ML
            if (args.rep == 7 && (bx % 8) >= 4) S.nwg = 0;
            if (args.rep == 8 && (bx % 8) != 0) S.nwg = 0;
            if (args.rep == 10 || args.rep == 11) { const int ns = (bx % 8) * (args.rep == 10 ? 1 : 2); for (int i = 0; i < ns; ++i) __builtin_amdgcn_s_sleep(82); }
#endif
            pg8::gemm_phase<pg8::EpiInProj, pg8::StaticOrder, PG8_ALIGN, PG8_SP2>(lds, g, S, E, tid);
            GRID_BAR();
        }
        if (even && IN(pb + 1)) { PHASE_TID();
#if REC_NAIVE
            const int nret = (G > 64) ? 32 : 0;
            if (nret == 0 || vcu < nret) for (int u = vcu; u < 32; u += (nret ? nret : G)) recur_unit<0>(lds, u >> 2, u & 3, proj, PE, rope, nullptr, nullptr, mixed, tid, lane, wave);
            if (nret == 0 || vcu >= nret)
#else
            const int nret = 0;
#endif
            {
                LAS float* xs = (LAS float*)(lds + wave * 16384);
                const int w0 = nret ? (vcu - nret) * NWAVES + wave : gw, nw = nret ? (G - nret) * NWAVES : NGW;
                for (int item = w0; item < 16 * 2 * 64; item += nw) kv_tile_item((LAS unsigned short*)xs, item, proj, KTb, VTb, lane);
                __syncthreads();
                for (int u = vcu; u < 256; u += G) compress_unit(lds, u, proj, (const bf16*)(ws + WS_W1T) + (size_t)j * 2 * 64 * 2048, (const float*)(ws + WS_CBIAS) + j * 2 * 32 * 64, args.in[8] + (size_t)j * 4096, args.in[11] + (size_t)j * 4096, kcb, vctb, tid, wave);
            }
            __syncthreads();
            GRID_BAR();
        }
#if NSA_NAIVE
        if (even && IN(pb + 2)) { PHASE_TID();
            LAS float* wl = (LAS float*)(lds + wave * 4096);
            for (int task = gw; task < 16 * SEQ; task += NGW) cmp_attn_task(wl, task, proj, kcmp, accn, sel, lane);
            __syncthreads();
            GRID_BAR();
        }
        if (even && IN(pb + 3)) { PHASE_TID();
            LAS float* wl = (LAS float*)(lds + wave * 4096);
            for (int task = gw; task < 16 * SEQ; task += NGW) blk_attn_task<0>(wl, task, proj, sel, accn, mixed, lane);
            __syncthreads();
            GRID_BAR();
        }
        if (even && IN(pb + 4)) { PHASE_TID();
            LAS float* wl = (LAS float*)(lds + wave * 4096);
            for (int task = gw; task < 16 * SEQ; task += NGW) blk_attn_task<1>(wl, task, proj, sel, accn, mixed, lane);
            __syncthreads();
            GRID_BAR();
        }
#else
        if (even && IN(pb + 2)) { PHASE_TID();
            const int per = (G % 8 == 0 && G >= 64) ? G / 8 : 0;
            { const int ru0 = per ? (((vcu % per) % 8 == 0 && (vcu % per) / 8 < 4) ? (vcu / per) * 4 + (vcu % per) / 8 : BATCH * 4) : vcu, rstep = per ? BATCH * 4 : G;
              for (int u = ru0; u < BATCH * 4; u += rstep) rec_serial_unit<0, 1>(lds, u, proj, nullptr, nullptr, mixed, nullptr, nullptr, tid, wave); }
            const int xq = per ? vcu / per : 0; const unsigned nitem = per ? 128u : 1024u;
            for (;;) {
                if (tid == 0) MISC[0] = __hip_atomic_fetch_add((unsigned*)(ctl + CW_Q + 64 * (j * 8 + xq + 16 * args.rep)), 1u, __ATOMIC_RELAXED, __HIP_MEMORY_SCOPE_AGENT);
                __syncthreads();
                const unsigned it = MISC[0];
                __syncthreads();
                if (it >= nitem) break;
                nsa_subunit(lds, per ? 2 * xq + (int)(it & 1u) : (int)(it & 15u), 63 - (int)(per ? it >> 1 : it >> 4), proj, kcb, vctb, KTb, VTb, mixed, tid, wave);
            }
            __syncthreads();
            GRID_BAR();
        }
#endif
#if REC_NAIVE
        if (!even && IN(pb + 5)) { PHASE_TID();
            for (int u = vcu; u < 64; u += G) recur_unit<1>(lds, u >> 3, u & 7, proj, PO, nullptr, lbv + (size_t)j * 1024, args.in[14] + (size_t)j * 128, mixed, tid, lane, wave);
            __syncthreads();
            GRID_BAR();
        }
#else
        if (!even && IN(pb + 3)) { PHASE_TID();
            for (int u = vcu; u < BATCH * 8 * 4; u += G) rec_serial_unit<1, 4>(lds, u, proj, (const float*)(ws + WS_VT), nullptr, mixed, (float*)(ws + WS_VT + 4 * MiB), (float*)(ws + WS_KCB), tid, wave);
            __syncthreads();
            GRID_BAR();
        }
        if (!even && IN(pb + 5)) { PHASE_TID();
            for (int u = vcu; u < BATCH * 8 * 4; u += G) rec_fix_unit(lds, u, proj, (const float*)(ws + WS_VT + 4 * MiB), (const float*)(ws + WS_KCB), args.in[14] + (size_t)j * 128, mixed, tid, wave);
            __syncthreads();
            GRID_BAR();
        }
#endif
        if (IN(pb + 6)) { PHASE_TID();
            const bf16* Wt = even ? (const bf16*)(ws + WS_WEOUT) + (size_t)j * D * D : (const bf16*)(ws + WS_WOOUT) + (size_t)j * D * D;
            pg8::Gemm g{mixed, Wt, M, D, D}; pg8::StaticOrder S; S.init(M, D, G, bx);
            pg8::EpiResF32 E{Hb, D, (PROBE_ML && args.rep) ? 0.f : 1.f, rowss, M, PROBE_ML ? args.rep : 0};
            pg8::gemm_phase<pg8::EpiResF32, pg8::StaticOrder, PG8_ALIGN, PG8_SP2>(lds, g, S, E, tid);
            GRID_BAR();
        }
        if (IN(pb + 8)) { PHASE_TID();
            pg8::Gemm g{Hb, (const bf16*)(ws + WS_W13) + (size_t)L * FF2 * D, M, FF2, D}; pg8::StaticOrder S; S.init(M, FF2, G, bx);
            build_rstd_table(lds, S, rowss, tid);
            pg8::EpiSwiGLU E{hid, FF, (const LAS int*)(lds + RS_TBL_OFF), (const LAS float*)(lds + RS_TAB_OFF), PROBE_ML ? args.rep : 0};
            pg8::gemm_phase<pg8::EpiSwiGLU, pg8::StaticOrder, PG8_ALIGN, PG8_SP2>(lds, g, S, E, tid);
            GRID_BAR();
        }
        if (IN(pb + 9)) { PHASE_TID();
            pg8::Gemm g{hid, (const bf16*)(ws + WS_W2) + (size_t)L * D * FF, M, D, FF}; pg8::StaticOrder S; S.init(M, D, G, bx);
            pg8::EpiResF32 E{Hb, D, (PROBE_ML && args.rep) ? 0.f : 1.f, rowss, M, PROBE_ML ? args.rep : 0};
            pg8::gemm_phase<pg8::EpiResF32, pg8::StaticOrder, PG8_ALIGN, PG8_SP2>(lds, g, S, E, tid);
            GRID_BAR();
        }
        if (L + 1 == DEPTH && IN(pb + 10)) { PHASE_TID();
#if PROBE_ML
            if (args.rep == 5 || (args.rep == 9 && (bx % 8) == 0)) {
                typedef short bf16x8_ __attribute__((ext_vector_type(8)));
                bf16x8_ af[4], bfm[4];
                for (int i = 0; i < 4; ++i) { af[i] = *(const bf16x8_*)(Hb + (size_t)(gw * 64 + lane) * D + i * 8); bfm[i] = *(const bf16x8_*)(Hb + (size_t)(gw * 64 + lane) * D + 512 + i * 8); }
                f32x4 c[4][4];
                for (int i = 0; i < 4; ++i) for (int k = 0; k < 4; ++k) c[i][k] = (f32x4){0.f, 0.f, 0.f, 0.f};
#pragma unroll 1
                for (int it = 0; it < 4096; ++it) {
#pragma unroll
                    for (int i = 0; i < 4; ++i)
#pragma unroll
                        for (int k = 0; k < 4; ++k) c[i][k] = __builtin_amdgcn_mfma_f32_16x16x32_bf16(af[i], bfm[k], c[i][k], 0, 0, 0);
                }
                f32x4 sacc = (f32x4){0.f, 0.f, 0.f, 0.f};
                for (int i = 0; i < 4; ++i) for (int k = 0; k < 4; ++k) sacc += c[i][k];
                ((f32x4*)(ws + WS_CTL + 512 * 1024))[gw * 64 + lane] = sacc;
            } else if (args.rep == 9) {
            } else if (args.rep == 6) {
                float a = bf2f(Hb[(size_t)(gw * 64 + lane) * D]), b = 1.0000001f, c0 = 1e-9f;
#pragma unroll 1
                for (int it = 0; it < 131072 / 16; ++it) {
#pragma unroll
                    for (int k = 0; k < 16; ++k) asm volatile("v_fma_f32 %0, %0, %1, %2" : "+v"(a) : "v"(b), "v"(c0));
                }
                ((float*)(ws + WS_CTL + 512 * 1024))[gw * 64 + lane] = a;
            } else
#endif
            for (int m = gw; m < M; m += NGW) rms_row_bf16_to_f32(Hb + (size_t)m * D, args.in[3], xres + (size_t)m * D, lane);
        }
    }
#undef IN
}

extern "C" void kernel_launch(void* const* d_in, const int* in_sizes, int n_in, void* d_out, int out_size, void* d_ws, size_t ws_size, hipStream_t stream) {
    static int grid = 0;
    if (grid == 0) {
        if (n_in != 19 || in_sizes[0] != M * D || out_size != M * D || ws_size < WS_END) { fprintf(stderr, "kernel_launch: unexpected shapes/workspace (n_in %d, in0 %d, out %d, ws %zu); nothing launched\n", n_in, n_in > 0 ? in_sizes[0] : -1, out_size, ws_size); grid = -1; return; }
        int dev = 0, cus = 0;
        if (hipGetDevice(&dev) != hipSuccess || hipDeviceGetAttribute(&cus, hipDeviceAttributeMultiprocessorCount, dev) != hipSuccess) { grid = -1; return; }
        if (hipFuncSetAttribute((const void*)trunk_fwd, hipFuncAttributeMaxDynamicSharedMemorySize, LDS_BYTES) != hipSuccess) { fprintf(stderr, "kernel_launch: hipFuncSetAttribute failed\n"); grid = -1; return; }
        int per_cu = 0;
        if (hipOccupancyMaxActiveBlocksPerMultiprocessor(&per_cu, (const void*)trunk_fwd, NT, LDS_BYTES) != hipSuccess || per_cu < 1) fprintf(stderr, "kernel_launch: occupancy query reports %d\n", per_cu);
        (void)hipGetLastError();
        grid = cus;
    }
    if (grid < 0) return;
    (void)hipMemsetAsync((char*)d_ws + WS_CTL, 0, CTL_ZERO_BYTES, stream);
    Args a{};
    for (int i = 0; i < 19; ++i) a.in[i] = (const float*)d_in[i];
    a.out = (float*)d_out; a.ws = (unsigned char*)d_ws;
#if ONE_LAUNCH && !PROBE_ML
    a.ph_lo = 0; a.ph_hi = NPHASES;
    hipLaunchKernelGGL(trunk_fwd, dim3(grid), dim3(NT), LDS_BYTES, stream, a);
#else
#if ONE_LAUNCH
#define PROBE_RESET() (void)hipMemsetAsync((char*)d_ws + WS_CTL + CW_BAR * 4, 0, (CW_Q - CW_BAR) * 4, stream)
#else
#define PROBE_RESET() do {} while (0)
#endif
    for (int p = 0; p < NPHASES; ++p) {
        if (p > 0) { const int L = (p - 1) / NPH_LAYER, k = (p - 1) % NPH_LAYER; const bool even = (L & 1) == 0; if (even && (k == 5 || ((k == 3 || k == 4) && !NSA_NAIVE))) continue; if (!even && (k == 1 || k == 2 || k == 4)) continue; if (k == 7 || (k == 10 && L + 1 < DEPTH)) continue; }
        a.ph_lo = p; a.ph_hi = p + 1; a.rep = 0;
        PROBE_RESET();
        hipLaunchKernelGGL(trunk_fwd, dim3(grid), dim3(NT), LDS_BYTES, stream, a);
#ifdef REP_K
        if ((p == 0 && REP_K == -2) || (p > 0 && (p - 1) % NPH_LAYER == REP_K)) { a.rep = REP_MODE; PROBE_RESET(); hipLaunchKernelGGL(trunk_fwd, dim3(grid), dim3(NT), LDS_BYTES, stream, a); }
#endif
    }
#endif
}
```

```cpp
#include <hip/hip_runtime.h>
#include <cstdio>
#include <cstdint>

#ifndef ONE_LAUNCH
#define ONE_LAUNCH 1
#define PROBE_ML 0
#endif

namespace pg8 {
#define PG8_LAS __attribute__((address_space(3)))
typedef unsigned short bf16_t;
typedef short bf16x8 __attribute__((ext_vector_type(8)));
typedef float f32x4 __attribute__((ext_vector_type(4)));
typedef unsigned u32x4 __attribute__((ext_vector_type(4)));
constexpr int BM = 256, BK = 64, HALF = 128, HTB = HALF * BK * 2  , STAGE_BYTES = 8 * HTB, NXCD = 8, WGM = 8;

__host__ __device__ __forceinline__ int lds_byte(int r, int c) { const int st = (r >> 4) * 2 + (c >> 5), rr = r & 15, cc = c & 31, ob = rr * 64 + cc * 2; return st * 1024 + (ob ^ (((ob >> 9) & 1) << 5)); }
__host__ __device__ __forceinline__ void stage_rc(int b, int& R, int& C) { const int st = b / 1024, sb = b % 1024, swz = sb ^ (((sb >> 9) & 1) << 5); R = (st >> 1) * 16 + swz / 64; C = (st & 1) * 32 + (swz % 64) / 2; }
__host__ __device__ __forceinline__ int perm32(int rho) { const int n = rho >> 4, i = rho & 15; return 8 * (i >> 2) + 4 * n + (i & 3); }

struct Unit { int pm, pn; };
struct Gemm { const bf16_t* A; const bf16_t* Bt; int M, N, K; };

struct StaticOrder {
    int nM, nN, nwg, G, c;
    __host__ __device__ void init(int M, int N, int G_, int c_) { nM = M / BM; nN = N / BM; nwg = nM * nN; G = G_; c = c_; }
    __host__ __device__ bool next(int i, Unit& u) const {
        const long L = (long)i * G + c; if (L >= nwg) return false;
        int wgid = (int)L; { const int q = nwg / NXCD, r = nwg % NXCD, xcd = wgid % NXCD, off = wgid / NXCD; wgid = (xcd < r ? xcd * (q + 1) : r * (q + 1) + (xcd - r) * q) + off; }
        const int nig = WGM * nN, gid = wgid / nig, fm = gid * WGM, gsz = (nM - fm) < WGM ? (nM - fm) : WGM;
        u.pm = fm + ((wgid % nig) % gsz); u.pn = (wgid % nig) / gsz; return true;
    }
    __device__ __forceinline__ void a_ready(const Unit&) const {}
    __device__ __forceinline__ void done(const Unit&) const {}
};

#ifndef NST_INPROJ
#define NST_INPROJ (PROBE_ML ? 0 : 16)
#endif
__device__ __forceinline__ unsigned cvt_pk_bf16(float lo, float hi) { unsigned r; asm volatile("v_cvt_pk_bf16_f32 %0, %1, %2" : "=v"(r) : "v"(lo), "v"(hi)); return r; }
__device__ __forceinline__ float fast_silu(float x) { return x * __builtin_amdgcn_rcpf(1.0f + __expf(-x)); }

__device__ __forceinline__ void row_rstd8(const PG8_LAS int* tbl, const PG8_LAS float* rsl, const Unit& u, int rl0, float (&rs)[2][4]) {
    const PG8_LAS float* p = rsl + tbl[u.pm] * 256 + rl0;
#pragma unroll
    for (int ai = 0; ai < 2; ++ai)
#pragma unroll
        for (int m = 0; m < 4; ++m) rs[ai][m] = p[ai * HALF + m * 16];
}
struct EpiBf16Plain {
    static constexpr bool PERM = true, AFTER_DRAIN = false; static constexpr int NST = PROBE_ML ? 0 : 16;
    bf16_t* O; int ldc; const PG8_LAS int* tbl; const PG8_LAS float* rsl;
    __device__ __forceinline__ void operator()(const f32x4 (&acc)[2][2][4][2], const Unit& u, int wr, int wc, int fr, int fq) const {
        const int row0 = u.pm * BM + wr * 64 + fr, col0 = u.pn * BM + wc * 32 + 8 * fq;
        float rs[2][4]; row_rstd8(tbl, rsl, u, wr * 64 + fr, rs);
#pragma unroll
        for (int ai = 0; ai < 2; ++ai)
#pragma unroll
            for (int m = 0; m < 4; ++m) { bf16_t* rowp = O + (size_t)(row0 + ai * HALF + m * 16) * ldc + col0; const float r = rs[ai][m];
#pragma unroll
                for (int bj = 0; bj < 2; ++bj) { const f32x4 v0 = acc[ai][bj][m][0] * r, v1 = acc[ai][bj][m][1] * r;
                    u32x4 w; w.x = cvt_pk_bf16(v0[0], v0[1]); w.y = cvt_pk_bf16(v0[2], v0[3]); w.z = cvt_pk_bf16(v1[0], v1[1]); w.w = cvt_pk_bf16(v1[2], v1[3]);
                    *(u32x4*)(rowp + bj * HALF) = w; } }
    }
};

__device__ __forceinline__ float dpp_scan16(float x) {
    x += __builtin_bit_cast(float, __builtin_amdgcn_update_dpp(0, __builtin_bit_cast(int, x), 0x111, 0xf, 0xf, true));
    x += __builtin_bit_cast(float, __builtin_amdgcn_update_dpp(0, __builtin_bit_cast(int, x), 0x112, 0xf, 0xf, true));
    x += __builtin_bit_cast(float, __builtin_amdgcn_update_dpp(0, __builtin_bit_cast(int, x), 0x114, 0xf, 0xf, true));
    x += __builtin_bit_cast(float, __builtin_amdgcn_update_dpp(0, __builtin_bit_cast(int, x), 0x118, 0xf, 0xf, true));
    return x;
}
struct EpiInProj {
    static constexpr bool PERM = true, AFTER_DRAIN = false; static constexpr int NST = NST_INPROJ;
    bf16_t* O; int ldc; const PG8_LAS int* tbl; const PG8_LAS float* rsl;
    int mode; const float* rope; const float* lb; float* Eg; int dbg;
    __device__ __forceinline__ void operator()(const f32x4 (&acc)[2][2][4][2], const Unit& u, int wr, int wc, int fr, int fq) const {
        if (dbg == 3) return;
        const int row0 = u.pm * BM + wr * 64 + fr;
        float rs[2][4]; row_rstd8(tbl, rsl, u, wr * 64 + fr, rs);
        const int lane = (fq << 4) | fr;
        if (mode == 0 && u.pn < 4) {
            const int hd = u.pn; const int i0 = 16 * wc + 4 * fq;
            const float lg = __builtin_amdgcn_logf(1.0f - __builtin_amdgcn_exp2f(-5.0f - (float)hd));
            const int pos0 = row0 & 4095;
            const f32x4* cs = (const f32x4*)(rope + ((size_t)pos0 * 64 + i0) * 2); const f32x4* c16p = (const f32x4*)(rope + ((size_t)16 * 64 + i0) * 2); const f32x4* c128p = (const f32x4*)(rope + ((size_t)128 * 64 + i0) * 2);
            const f32x4 b01 = cs[0], b23 = cs[1], s01 = c16p[0], s23 = c16p[1], t01 = c128p[0], t23 = c128p[1];
            float cb[4] = {b01[0], b01[2], b23[0], b23[2]}, sb[4] = {b01[1], b01[3], b23[1], b23[3]};
            const float c16[4] = {s01[0], s01[2], s23[0], s23[2]}, s16[4] = {s01[1], s01[3], s23[1], s23[3]}, c128[4] = {t01[0], t01[2], t23[0], t23[2]}, s128[4] = {t01[1], t01[3], t23[1], t23[3]};
            float gpv[2], giv[2]; float k884 = 0.08838834764831845f; asm volatile("" : "+v"(k884));
#pragma unroll
            for (int par = 0; par < 2; ++par) { const float tl1 = (float)(fr + 16 * par + 1); gpv[par] = __builtin_amdgcn_exp2f(tl1 * lg); giv[par] = k884 * __builtin_amdgcn_exp2f(-tl1 * lg); }
            typedef unsigned u32x2 __attribute__((ext_vector_type(2)));
#pragma unroll
            for (int ai = 0; ai < 2; ++ai) {
                float c[4], sn[4];
#pragma unroll
                for (int k = 0; k < 4; ++k) { c[k] = cb[k]; sn[k] = sb[k]; }
#pragma unroll
                for (int m = 0; m < 4; ++m) { const int row = row0 + ai * HALF + m * 16; const float r = rs[ai][m];
#pragma unroll
                    for (int bj = 0; bj < 2; ++bj) { const f32x4 x1 = acc[ai][bj][m][0] * r, x2 = acc[ai][bj][m][1] * r; const float sc = bj ? giv[m & 1] : gpv[m & 1];
                        float a[4], b[4];
#pragma unroll
                        for (int k = 0; k < 4; ++k) { a[k] = (x1[k] * c[k] - x2[k] * sn[k]) * sc; b[k] = (x1[k] * sn[k] + x2[k] * c[k]) * sc; }
                        bf16_t* dst = O + (size_t)row * ldc + (bj ? 512 : 0) + hd * 128 + i0;
                        u32x2 w0; w0.x = cvt_pk_bf16(a[0], a[1]); w0.y = cvt_pk_bf16(a[2], a[3]); *(u32x2*)dst = w0;
                        u32x2 w1; w1.x = cvt_pk_bf16(b[0], b[1]); w1.y = cvt_pk_bf16(b[2], b[3]); *(u32x2*)(dst + 64) = w1; }
                    if (m < 3) {
#pragma unroll
                        for (int k = 0; k < 4; ++k) { const float cn = c[k] * c16[k] - sn[k] * s16[k]; sn[k] = sn[k] * c16[k] + c[k] * s16[k]; c[k] = cn; } }
                }
                if (ai == 0) {
#pragma unroll
                    for (int k = 0; k < 4; ++k) { const float cn = cb[k] * c128[k] - sb[k] * s128[k]; sb[k] = sb[k] * c128[k] + cb[k] * s128[k]; cb[k] = cn; } }
            }
        } else if (mode == 1 && u.pn < 8) {
            const int hd = u.pn; const int ch0 = 32 * wc + 8 * fq;
            const f32x4 lb0 = *(const f32x4*)(lb + hd * 128 + ch0), lb1 = *(const f32x4*)(lb + hd * 128 + ch0 + 4);
            float lw[8], oml[8];
#pragma unroll
            for (int k = 0; k < 8; ++k) { lw[k] = k < 4 ? lb0[k & 3] : lb1[k & 3]; oml[k] = 1.0f - lw[k]; }
            const int src15 = ((lane & 48) | 15) << 2;
#pragma unroll
            for (int ai = 0; ai < 2; ++ai)
#pragma unroll
                for (int mp = 0; mp < 2; ++mp) {
                    float carry[8];
#pragma unroll
                    for (int mm = 0; mm < 2; ++mm) { const int m = 2 * mp + mm; const int row = row0 + ai * HALF + m * 16; const float r = rs[ai][m];
                        const float rn = -1.4426950408889634f * r, rc = 0.08838834764831845f * r;
                        float B[8], sg[8], Ef[8];
#pragma unroll
                        for (int k = 0; k < 8; ++k) { Ef[k] = __builtin_amdgcn_exp2f(acc[ai][1][m][k >> 2][k & 3] * rn);
                            sg[k] = __builtin_amdgcn_rcpf(1.0f + Ef[k]); B[k] = __builtin_amdgcn_logf(fmaf(oml[k], sg[k], lw[k])); }
#pragma unroll
                        for (int k = 0; k < 8; ++k) B[k] += __builtin_bit_cast(float, __builtin_amdgcn_update_dpp(0, __builtin_bit_cast(int, B[k]), 0x111, 0xf, 0xf, true));
#pragma unroll
                        for (int k = 0; k < 8; ++k) B[k] += __builtin_bit_cast(float, __builtin_amdgcn_update_dpp(0, __builtin_bit_cast(int, B[k]), 0x112, 0xf, 0xf, true));
#pragma unroll
                        for (int k = 0; k < 8; ++k) B[k] += __builtin_bit_cast(float, __builtin_amdgcn_update_dpp(0, __builtin_bit_cast(int, B[k]), 0x114, 0xf, 0xf, true));
#pragma unroll
                        for (int k = 0; k < 8; ++k) B[k] += __builtin_bit_cast(float, __builtin_amdgcn_update_dpp(0, __builtin_bit_cast(int, B[k]), 0x118, 0xf, 0xf, true));
                        if (mm == 1) {
#pragma unroll
                            for (int k = 0; k < 8; ++k) B[k] += carry[k]; }
                        if (mm == 0) {
#pragma unroll
                            for (int k = 0; k < 8; ++k) carry[k] = __builtin_bit_cast(float, __builtin_amdgcn_ds_bpermute(src15, __builtin_bit_cast(int, B[k]))); }
                        float qt[8], kt[8], ev[8];
#pragma unroll
                        for (int k = 0; k < 8; ++k) { const float aq = acc[ai][0][m][k >> 2][k & 3];
                            const float e = __builtin_amdgcn_exp2f(B[k]), ei = __builtin_amdgcn_exp2f(-B[k]);
                            const float iq = __builtin_amdgcn_rcpf(1.0f + __builtin_amdgcn_exp2f(aq * rn));
                            qt[k] = (aq * rc) * (iq * e);
                            kt[k] = (oml[k] * Ef[k]) * (sg[k] * ei); ev[k] = e; }
                        bf16_t* dst = O + (size_t)row * ldc + hd * 128 + ch0;
                        u32x4 wq; wq.x = cvt_pk_bf16(qt[0], qt[1]); wq.y = cvt_pk_bf16(qt[2], qt[3]); wq.z = cvt_pk_bf16(qt[4], qt[5]); wq.w = cvt_pk_bf16(qt[6], qt[7]); *(u32x4*)dst = wq;
                        u32x4 wk; wk.x = cvt_pk_bf16(kt[0], kt[1]); wk.y = cvt_pk_bf16(kt[2], kt[3]); wk.z = cvt_pk_bf16(kt[4], kt[5]); wk.w = cvt_pk_bf16(kt[6], kt[7]); *(u32x4*)(dst + 1024) = wk;
                        if (mm == 1 && fr == 15) { float* ep = Eg + ((size_t)((row >> 12) * 8 + hd) * 128 + ((row & 4095) >> 5)) * 128 + ch0;
                            *(f32x4*)ep = (f32x4){ev[0], ev[1], ev[2], ev[3]}; *(f32x4*)(ep + 4) = (f32x4){ev[4], ev[5], ev[6], ev[7]}; } }
                }
        } else {
            const int col0 = u.pn * BM + wc * 32 + 8 * fq;
#pragma unroll
            for (int ai = 0; ai < 2; ++ai)
#pragma unroll
                for (int m = 0; m < 4; ++m) { bf16_t* rowp = O + (size_t)(row0 + ai * HALF + m * 16) * ldc + col0; const float r = rs[ai][m];
#pragma unroll
                    for (int bj = 0; bj < 2; ++bj) { const f32x4 v0 = acc[ai][bj][m][0] * r, v1 = acc[ai][bj][m][1] * r;
                        u32x4 w; w.x = cvt_pk_bf16(v0[0], v0[1]); w.y = cvt_pk_bf16(v0[2], v0[3]); w.z = cvt_pk_bf16(v1[0], v1[1]); w.w = cvt_pk_bf16(v1[2], v1[3]);
                        *(u32x4*)(rowp + bj * HALF) = w; } }
        }
    }
};
struct EpiResF32 {
    static constexpr bool PERM = true, AFTER_DRAIN = false; static constexpr int NST = PROBE_ML ? 0 : 16;
    bf16_t* xb; int ldc; float scale; float* rowss; int M_; int dbg;
    __device__ __forceinline__ void operator()(const f32x4 (&acc)[2][2][4][2], const Unit& u, int wr, int wc, int fr, int fq) const {
        if (dbg == 3) return;
        const int row0 = u.pm * BM + wr * 64 + fr, col0 = u.pn * BM + wc * 32 + 8 * fq;
        u32x4 r[2][4][2];
#pragma unroll
        for (int ai = 0; ai < 2; ++ai)
#pragma unroll
            for (int m = 0; m < 4; ++m) { const size_t ro = (size_t)(row0 + ai * HALF + m * 16) * ldc + col0;
#pragma unroll
                for (int bj = 0; bj < 2; ++bj) r[ai][m][bj] = *(const u32x4*)(xb + ro + bj * HALF); }
        __builtin_amdgcn_sched_barrier(0);
#pragma unroll
        for (int ai = 0; ai < 2; ++ai) {
#pragma unroll
            for (int m = 0; m < 4; ++m) { const size_t ro = (size_t)(row0 + ai * HALF + m * 16) * ldc + col0; float q = 0.f;
#pragma unroll
                for (int bj = 0; bj < 2; ++bj) { const u32x4 rw = r[ai][m][bj]; const unsigned rr[4] = {rw.x, rw.y, rw.z, rw.w}; unsigned ow[4];
#pragma unroll
                    for (int k = 0; k < 4; ++k) { const f32x4 a = acc[ai][bj][m][k >> 1];
                        const float lo = __builtin_bit_cast(float, rr[k] << 16) + a[2 * (k & 1)] * scale, hi = __builtin_bit_cast(float, rr[k] & 0xffff0000u) + a[2 * (k & 1) + 1] * scale;
                        const unsigned w = cvt_pk_bf16(lo, hi); ow[k] = w;
                        const float l2 = __builtin_bit_cast(float, w << 16), h2 = __builtin_bit_cast(float, w & 0xffff0000u); q += l2 * l2 + h2 * h2; }
                    u32x4 o; o.x = ow[0]; o.y = ow[1]; o.z = ow[2]; o.w = ow[3]; *(u32x4*)(xb + ro + bj * HALF) = o; }
                q += __shfl_xor(q, 16); q += __shfl_xor(q, 32);
                if (fq == 0) rowss[(size_t)(u.pn * 4 + wc) * M_ + row0 + ai * HALF + m * 16] = q; }
            __builtin_amdgcn_sched_barrier(0);
        }
    }
};
struct EpiSwiGLU {
    static constexpr bool PERM = true, AFTER_DRAIN = false; static constexpr int NST = PROBE_ML ? 0 : 8;
    bf16_t* O; int ldc; const PG8_LAS int* tbl; const PG8_LAS float* rsl; int dbg;
    __device__ __forceinline__ void operator()(const f32x4 (&acc)[2][2][4][2], const Unit& u, int wr, int wc, int fr, int fq) const {
        if (dbg == 3) return;
        const int row0 = u.pm * BM + wr * 64 + fr, col0 = u.pn * HALF + wc * 32 + 8 * fq;
        float rs[2][4]; row_rstd8(tbl, rsl, u, wr * 64 + fr, rs);
#pragma unroll
        for (int ai = 0; ai < 2; ++ai)
#pragma unroll
            for (int m = 0; m < 4; ++m) { bf16_t* rowp = O + (size_t)(row0 + ai * HALF + m * 16) * ldc + col0; const float r = rs[ai][m];
                const f32x4 g0 = acc[ai][0][m][0] * r, g1 = acc[ai][0][m][1] * r, u0 = acc[ai][1][m][0] * r, u1 = acc[ai][1][m][1] * r;
                u32x4 w; w.x = cvt_pk_bf16(fast_silu(g0[0]) * u0[0], fast_silu(g0[1]) * u0[1]); w.y = cvt_pk_bf16(fast_silu(g0[2]) * u0[2], fast_silu(g0[3]) * u0[3]);
                w.z = cvt_pk_bf16(fast_silu(g1[0]) * u1[0], fast_silu(g1[1]) * u1[1]); w.w = cvt_pk_bf16(fast_silu(g1[2]) * u1[2], fast_silu(g1[3]) * u1[3]);
                if (dbg != 2 || w.x == 0x12345u) *(u32x4*)rowp = w; }
    }
};

template <class Epi, class Sched, bool ALIGN_EPI = false, bool SP2 = false>
__device__ __forceinline__ void gemm_phase(PG8_LAS unsigned char* lds, const Gemm g, const Sched& S, const Epi& E, const int tid_in) {
    const int tid = tid_in, wid = __builtin_amdgcn_readfirstlane(tid >> 6), lane = tid & 63, wr = wid >> 2, wc = wid & 3, fr = lane & 15, fq = lane >> 4;
    const int K = g.K, nt = K / BK;
    constexpr bool RELAX = SP2 && ALIGN_EPI && (Epi::NST > 0);
    unsigned voffA[2], voffB[2];
#pragma unroll
    for (int i = 0; i < 2; ++i) { int R, C; stage_rc(tid * 16 + i * 8192, R, C); const int Rb = Epi::PERM ? ((R & ~31) + perm32(R & 31)) : R;
        voffA[i] = (unsigned)(R * K + C) * 2u; voffB[i] = (unsigned)(Rb * K + C) * 2u; }
    const size_t kstep = (size_t)(BK * 2);
    const size_t hstep = (size_t)HALF * K * 2;
    const size_t tstep = 2 * hstep;
    const unsigned ldsw = (unsigned)wid * 1024u;
    const int aoff = lds_byte(wr * 64 + fr, fq * 8), boff = lds_byte(wc * 32 + fr, fq * 8);
#define PG8_SA(b, h) (((b) * 2 + (h)) * HTB)
#define PG8_SB(b, h) ((4 + (b) * 2 + (h)) * HTB)
#define PG8_STAGE(bufoff, gbase, voff) do { _Pragma("unroll") for (int _i = 0; _i < 2; ++_i) \
        __builtin_amdgcn_global_load_lds((const unsigned*)((const char*)(gbase) + (voff)[_i]), (PG8_LAS unsigned*)(lds + (bufoff) + ldsw + _i * 8192), 16, 0, 0); } while (0)
#define PG8_LDA(dst, b, h) do { _Pragma("unroll") for (int m = 0; m < 4; ++m) _Pragma("unroll") for (int k = 0; k < 2; ++k) dst[m][k] = *(const PG8_LAS bf16x8*)(lds + PG8_SA(b, h) + aoff + m * 2048 + k * 1024); } while (0)
#define PG8_LDB(dst, b, h) do { _Pragma("unroll") for (int n = 0; n < 2; ++n) _Pragma("unroll") for (int k = 0; k < 2; ++k) dst[n][k] = *(const PG8_LAS bf16x8*)(lds + PG8_SB(b, h) + boff + n * 2048 + k * 1024); } while (0)
#define PG8_MMA(ai, bj, At, Bt) do { __builtin_amdgcn_s_setprio(1); _Pragma("unroll") for (int m = 0; m < 4; ++m) _Pragma("unroll") for (int n = 0; n < 2; ++n) _Pragma("unroll") for (int k = 0; k < 2; ++k) \
        acc[ai][bj][m][n] = __builtin_amdgcn_mfma_f32_16x16x32_bf16(Bt[n][k], At[m][k], acc[ai][bj][m][n], 0, 0, 0); __builtin_amdgcn_s_setprio(0); } while (0)
#define PG8_WAIT_V(n) asm volatile("s_waitcnt vmcnt(" #n ")" ::: "memory")
#define PG8_SPTR(p) asm volatile("" : "+s"(p))
#define PG8_WAIT_VN(n) asm volatile("s_waitcnt vmcnt(%0)" :: "n"(n) : "memory")
#define PG8_WAIT_L(n) asm volatile("s_waitcnt lgkmcnt(" #n ")" ::: "memory")
#define PG8_BAR __builtin_amdgcn_s_barrier()
#define PG8_SCHED __builtin_amdgcn_sched_barrier(0)
    Unit cur, nxt; int ui = 0;
    if (!S.next(0, cur)) return;
    f32x4 acc[2][2][4][2];
#pragma unroll
    for (int a = 0; a < 2; ++a)
#pragma unroll
        for (int b = 0; b < 2; ++b)
#pragma unroll
            for (int m = 0; m < 4; ++m)
#pragma unroll
                for (int n = 0; n < 2; ++n) acc[a][b][m][n] = (f32x4){0.f, 0.f, 0.f, 0.f};
    bf16x8 At[4][2], B0[2][2], B1[2][2];
    const char* cA = (const char*)g.A + (size_t)cur.pm * tstep; const char* cB = (const char*)g.Bt + (size_t)cur.pn * tstep;
    S.a_ready(cur);
    if constexpr (RELAX) {
        PG8_STAGE(PG8_SB(0, 0), cB, voffB); PG8_STAGE(PG8_SB(0, 1), cB + hstep, voffB); PG8_STAGE(PG8_SA(0, 0), cA, voffA); PG8_STAGE(PG8_SA(0, 1), cA + hstep, voffA);
        { const char* pb = cB + kstep; const char* pa = cA + kstep; const char* pbh = cB + hstep + kstep; const char* pah = cA + hstep + kstep; PG8_SPTR(pb); PG8_SPTR(pa); PG8_SPTR(pbh); PG8_SPTR(pah);
          PG8_STAGE(PG8_SB(1, 0), pb, voffB); PG8_STAGE(PG8_SA(1, 0), pa, voffA); PG8_STAGE(PG8_SB(1, 1), pbh, voffB); PG8_STAGE(PG8_SA(1, 1), pah, voffA); }
        PG8_WAIT_V(0); PG8_BAR;
        if (wr == 1) PG8_BAR;
    } else
    if constexpr (SP2) {
        PG8_STAGE(PG8_SB(0, 0), cB, voffB); PG8_STAGE(PG8_SB(0, 1), cB + hstep, voffB); PG8_STAGE(PG8_SA(0, 0), cA, voffA); PG8_STAGE(PG8_SA(0, 1), cA + hstep, voffA);
        if (wr == 1) PG8_BAR;
        PG8_WAIT_V(2); PG8_BAR;
        PG8_STAGE(PG8_SB(1, 0), cB + kstep, voffB); PG8_STAGE(PG8_SA(1, 0), cA + kstep, voffA); PG8_STAGE(PG8_SB(1, 1), cB + hstep + kstep, voffB);
        PG8_WAIT_V(6); PG8_BAR;
    } else {
        PG8_STAGE(PG8_SB(0, 0), cB, voffB); PG8_STAGE(PG8_SA(0, 0), cA, voffA); PG8_STAGE(PG8_SB(0, 1), cB + hstep, voffB); PG8_STAGE(PG8_SA(0, 1), cA + hstep, voffA);
        if (wr == 1) PG8_BAR;
        PG8_WAIT_V(4); PG8_BAR;
        PG8_STAGE(PG8_SB(1, 0), cB + kstep, voffB); PG8_STAGE(PG8_SA(1, 0), cA + kstep, voffA); PG8_STAGE(PG8_SB(1, 1), cB + hstep + kstep, voffB);
        PG8_WAIT_V(6); PG8_BAR;
    }
    for (;;) {
        const bool has_next = S.next(ui + 1, nxt);
        const char* nA = has_next ? (const char*)g.A + (size_t)nxt.pm * tstep : cA; const char* nB = has_next ? (const char*)g.Bt + (size_t)nxt.pn * tstep : cB;
#define PG8_BODY_SP2(W1, W2, W3, STAGE1) \
            PG8_LDB(B0, 0, 0); PG8_LDB(B1, 0, 1); PG8_SCHED; PG8_LDA(At, 0, 0); if (STAGE1) PG8_STAGE(PG8_SA(1, 1), a1 + hstep, voffA); \
            PG8_WAIT_VN(W1); PG8_WAIT_L(0); PG8_BAR; PG8_MMA(0, 0, At, B0); PG8_MMA(0, 1, At, B1); PG8_BAR; PG8_SCHED; \
            PG8_LDA(At, 0, 1); PG8_STAGE(PG8_SB(0, 0), b2, voffB); PG8_STAGE(PG8_SB(0, 1), b2 + hstep, voffB); PG8_STAGE(PG8_SA(0, 0), a2, voffA); \
            PG8_WAIT_VN(W2); PG8_WAIT_L(0); PG8_BAR; PG8_MMA(1, 0, At, B0); PG8_MMA(1, 1, At, B1); PG8_BAR; PG8_SCHED; \
            PG8_LDB(B0, 1, 0); PG8_LDB(B1, 1, 1); PG8_SCHED; PG8_LDA(At, 1, 0); PG8_STAGE(PG8_SA(0, 1), a2 + hstep, voffA); \
            PG8_WAIT_VN(W3); PG8_WAIT_L(0); PG8_BAR; PG8_MMA(0, 0, At, B0); PG8_MMA(0, 1, At, B1); PG8_BAR; PG8_SCHED; \
            PG8_LDA(At, 1, 1); PG8_STAGE(PG8_SB(1, 0), b3, voffB); PG8_STAGE(PG8_SB(1, 1), b3 + hstep, voffB); PG8_STAGE(PG8_SA(1, 0), a3, voffA); \
            PG8_WAIT_VN(8); PG8_WAIT_L(0); PG8_BAR; PG8_MMA(1, 0, At, B0); PG8_MMA(1, 1, At, B1); PG8_BAR; PG8_SCHED;
        if constexpr (RELAX) {
            { const char* a1 = cA + kstep; const char* a2 = cA + 2 * kstep; const char* b2 = cB + 2 * kstep; const char* a3 = a2 + kstep; const char* b3 = b2 + kstep; (void)a1;
              PG8_SPTR(a2); PG8_SPTR(b2); PG8_SPTR(a3); PG8_SPTR(b3);
              PG8_BODY_SP2(8 + Epi::NST, 8 + Epi::NST, 8 + Epi::NST, false) }
            for (int t = 2; t < nt; t += 2) {
                const bool last = (t == nt - 2);
                const char* a1 = cA + (size_t)(t + 1) * kstep;
                const char* a2 = last ? nA : cA + (size_t)(t + 2) * kstep; const char* b2 = last ? nB : cB + (size_t)(t + 2) * kstep;
                const char* a3 = a2 + kstep; const char* b3 = b2 + kstep;
                if (last && has_next) S.a_ready(nxt);
                PG8_BODY_SP2(8, 8, 8, true)
            }
        } else
        for (int t = 0; t < nt; t += 2) {
            const bool last = (t == nt - 2);
            const char* a1 = cA + (size_t)(t + 1) * kstep;
            const char* a2 = last ? nA : cA + (size_t)(t + 2) * kstep; const char* b2 = last ? nB : cB + (size_t)(t + 2) * kstep;
            const char* a3 = a2 + kstep; const char* b3 = b2 + kstep;
            if (last && has_next) S.a_ready(nxt);
            if constexpr (SP2) {
            PG8_LDB(B0, 0, 0); PG8_LDB(B1, 0, 1); PG8_SCHED; PG8_LDA(At, 0, 0); PG8_STAGE(PG8_SA(1, 1), a1 + hstep, voffA);
            PG8_WAIT_V(8); PG8_WAIT_L(0); PG8_BAR; PG8_MMA(0, 0, At, B0); PG8_MMA(0, 1, At, B1); PG8_BAR; PG8_SCHED;
            PG8_LDA(At, 0, 1); PG8_STAGE(PG8_SB(0, 0), b2, voffB); PG8_STAGE(PG8_SB(0, 1), b2 + hstep, voffB); PG8_STAGE(PG8_SA(0, 0), a2, voffA);
            PG8_WAIT_V(8); PG8_WAIT_L(0); PG8_BAR; PG8_MMA(1, 0, At, B0); PG8_MMA(1, 1, At, B1); PG8_BAR; PG8_SCHED;
            PG8_LDB(B0, 1, 0); PG8_LDB(B1, 1, 1); PG8_SCHED; PG8_LDA(At, 1, 0); PG8_STAGE(PG8_SA(0, 1), a2 + hstep, voffA);
            PG8_WAIT_V(8); PG8_WAIT_L(0); PG8_BAR; PG8_MMA(0, 0, At, B0); PG8_MMA(0, 1, At, B1); PG8_BAR; PG8_SCHED;
            PG8_LDA(At, 1, 1); PG8_STAGE(PG8_SB(1, 0), b3, voffB); PG8_STAGE(PG8_SB(1, 1), b3 + hstep, voffB); PG8_STAGE(PG8_SA(1, 0), a3, voffA);
            PG8_WAIT_V(8); PG8_WAIT_L(0); PG8_BAR; PG8_MMA(1, 0, At, B0); PG8_MMA(1, 1, At, B1); PG8_BAR; PG8_SCHED;
            } else {
            PG8_LDB(B0, 0, 0); PG8_SCHED; PG8_LDA(At, 0, 0); PG8_STAGE(PG8_SA(1, 1), a1 + hstep, voffA);
            PG8_WAIT_L(8); PG8_BAR; PG8_WAIT_L(0); PG8_MMA(0, 0, At, B0); PG8_BAR; PG8_SCHED;
            PG8_LDB(B1, 0, 1); PG8_STAGE(PG8_SB(0, 0), b2, voffB);
            PG8_BAR; PG8_WAIT_L(0); PG8_MMA(0, 1, At, B1); PG8_BAR;
            PG8_LDA(At, 0, 1); PG8_STAGE(PG8_SA(0, 0), a2, voffA);
            PG8_BAR; PG8_WAIT_L(0); PG8_MMA(1, 0, At, B0); PG8_BAR; PG8_SCHED;
            PG8_STAGE(PG8_SB(0, 1), b2 + hstep, voffB);
            PG8_WAIT_V(6); PG8_BAR; PG8_MMA(1, 1, At, B1); PG8_BAR;
            PG8_LDB(B0, 1, 0); PG8_SCHED; PG8_LDA(At, 1, 0); PG8_STAGE(PG8_SA(0, 1), a2 + hstep, voffA);
            PG8_WAIT_L(8); PG8_BAR; PG8_WAIT_L(0); PG8_MMA(0, 0, At, B0); PG8_BAR; PG8_SCHED;
            PG8_LDB(B1, 1, 1); PG8_STAGE(PG8_SB(1, 0), b3, voffB);
            PG8_BAR; PG8_WAIT_L(0); PG8_MMA(0, 1, At, B1); PG8_BAR;
            PG8_LDA(At, 1, 1); PG8_STAGE(PG8_SA(1, 0), a3, voffA);
            PG8_BAR; PG8_WAIT_L(0); PG8_MMA(1, 0, At, B0); PG8_BAR; PG8_SCHED;
            PG8_STAGE(PG8_SB(1, 1), b3 + hstep, voffB);
            PG8_WAIT_V(6); PG8_BAR; PG8_MMA(1, 1, At, B1); PG8_BAR;
            }
        }
        if constexpr (ALIGN_EPI) { if (wr == 0) PG8_BAR; }
        if constexpr (RELAX) { if (has_next) { const char* ps = nA + kstep + hstep; PG8_SPTR(ps); PG8_STAGE(PG8_SA(1, 1), ps, voffA); } asm volatile("" ::: "memory"); }
        if constexpr (!Epi::AFTER_DRAIN) { int te = tid; asm volatile("" : "+v"(te)); E(acc, cur, wr, wc, te & 15, (te & 63) >> 4); S.done(cur); }
        if (!has_next) break;
#pragma unroll
        for (int a = 0; a < 2; ++a)
#pragma unroll
            for (int b = 0; b < 2; ++b)
#pragma unroll
                for (int m = 0; m < 4; ++m)
#pragma unroll
                    for (int n = 0; n < 2; ++n) acc[a][b][m][n] = (f32x4){0.f, 0.f, 0.f, 0.f};
        cur = nxt; cA = nA; cB = nB; ++ui;
        if constexpr (ALIGN_EPI) { if (wr == 1) PG8_BAR; }
    }
    PG8_WAIT_V(0);
    if constexpr (!ALIGN_EPI) { if (wr == 0) PG8_BAR; }
    PG8_BAR;
    if constexpr (Epi::AFTER_DRAIN) { E.fused(acc, cur, wr, wc, fr, fq, lds, wid, lane); S.done(cur); }
#undef PG8_SA
#undef PG8_SB
#undef PG8_STAGE
#undef PG8_LDA
#undef PG8_LDB
#undef PG8_MMA
#undef PG8_WAIT_V
#undef PG8_WAIT_L
#undef PG8_BAR
#undef PG8_SCHED
#undef PG8_BODY_SP2
#undef PG8_WAIT_VN
#undef PG8_SPTR
}
}

#define PG8_SP2 true
#ifndef REP_MODE
#define REP_MODE 1
#endif
#ifndef NSA_NAIVE
#define NSA_NAIVE 0
#endif
#ifndef REC_NAIVE
#define REC_NAIVE 0
#endif
#define PG8_ALIGN true

constexpr int NWAVES = 8, NT = NWAVES * 64;
constexpr int BATCH = 8, SEQ = 4096, D = 1024, DEPTH = 4, M = BATCH * SEQ;
constexpr int EVEN_IN = 3352, PE = 3584;
constexpr int PO = 4096;
constexpr int FF = 2816, FF2 = 2 * FF;
constexpr int C_RQ = 0, C_RK = 512, C_RV = 1024, C_RG = 1536, C_NQ = 2048, C_KC = 2560, C_VC = 2688, C_KS = 2816, C_VS = 2944, C_KW = 3072, C_VW = 3200, C_NG = 3328;
constexpr int C_HQ = 0, C_HF = 1024, C_HI = 2048, C_HG = 3072;
constexpr int NCMP = 255;
constexpr float RMS_EPS = 1e-6f;

constexpr size_t MiB = 1u << 20;
constexpr size_t WS_CTL = 0, CTL_ZERO_BYTES = 1 * MiB;
constexpr size_t WS_ROPE = 1 * MiB;
constexpr size_t WS_LB = 3 * MiB;
constexpr size_t WS_KCMP = 4 * MiB;
constexpr size_t WS_CBIAS = 3 * MiB + 16 * 1024;
constexpr size_t WS_W1T = 4 * MiB;
constexpr size_t WS_ROWSS = 5 * MiB;
constexpr size_t WS_SEL = 6 * MiB;
constexpr size_t WS_WEIN = 8 * MiB;
constexpr size_t WS_WEOUT = 22 * MiB;
constexpr size_t WS_WOIN = 26 * MiB;
constexpr size_t WS_WOOUT = 42 * MiB;
constexpr size_t WS_W13 = 46 * MiB;
constexpr size_t WS_W2 = 90 * MiB;
constexpr size_t WS_H = 112 * MiB;
constexpr size_t WS_PROJ = 176 * MiB;
constexpr size_t WS_MIXED = 432 * MiB;
constexpr size_t WS_KCB = 7 * MiB;
constexpr size_t WS_VCTB = 7 * MiB + 512 * 1024;
constexpr size_t WS_VT = 496 * MiB;
constexpr size_t WS_KT = 400 * MiB;
constexpr size_t WS_END = 512 * MiB;
constexpr int CW_BAR = 4096, CW_Q = 8192;

constexpr int RING_BYTES = 131072;
constexpr int LDSCTL_OFF = 146944, MISC_OFF = LDSCTL_OFF + 320;
constexpr int LDS_BYTES = 147456;

#define GAS __attribute__((address_space(1)))
#define LAS __attribute__((address_space(3)))
typedef unsigned short bf16;
typedef unsigned v4u __attribute__((ext_vector_type(4)));
typedef unsigned v2u __attribute__((ext_vector_type(2)));
typedef float f32x4 __attribute__((ext_vector_type(4)));
typedef float f32x2 __attribute__((ext_vector_type(2)));
typedef GAS unsigned gu32;
#define RLX_AGENT __ATOMIC_RELAXED, __HIP_MEMORY_SCOPE_AGENT
#define LDS_WAIT() asm volatile("s_waitcnt lgkmcnt(0)" ::: "memory")
#define VM_WAIT() asm volatile("s_waitcnt vmcnt(0)" ::: "memory")
__device__ __forceinline__ unsigned f2bf(float f) { unsigned u = __builtin_bit_cast(unsigned, f); return (u + 0x7fffu + ((u >> 16) & 1u)) >> 16; }
typedef float f32x2_t __attribute__((ext_vector_type(2)));
typedef __bf16 bf16x2_t __attribute__((ext_vector_type(2)));
__device__ __forceinline__ unsigned pk2(float lo, float hi) { f32x2_t v = {lo, hi}; bf16x2_t r = __builtin_convertvector(v, bf16x2_t); return __builtin_bit_cast(unsigned, r); }
__device__ __forceinline__ float bf2f(unsigned v) { return __builtin_bit_cast(float, v << 16); }
__device__ __forceinline__ float bflo(unsigned w) { return __builtin_bit_cast(float, w << 16); }
__device__ __forceinline__ float bfhi(unsigned w) { return __builtin_bit_cast(float, w & 0xffff0000u); }
__device__ __forceinline__ float sigmoidf_(float x) { return __builtin_amdgcn_rcpf(1.0f + __expf(-x)); }
__device__ __forceinline__ float siluf_(float x) { return x * __builtin_amdgcn_rcpf(1.0f + __expf(-x)); }

#define XB_TMO      128
#define XB_XCNT(j)  (256  + 64 * (j))
#define XB_XSUB(j)  (1280 + 64 * (j))
#define XB_XGEN(j)  (2304 + 64 * (j))
#define XB_TOP      3328
#define XB_TOPGEN   3392
#define XCD_BAR_WORDS 3456
#define XB_SPIN_CAP (1u << 18)
__device__ __forceinline__ unsigned xb_ld(unsigned* p)              { return __hip_atomic_load(p, __ATOMIC_RELAXED, __HIP_MEMORY_SCOPE_AGENT); }
__device__ __forceinline__ unsigned xb_add(unsigned* p, unsigned v) { return __hip_atomic_fetch_add(p, v, __ATOMIC_RELAXED, __HIP_MEMORY_SCOPE_AGENT); }
__device__ __forceinline__ unsigned xb_xcc_id() { return (unsigned)__builtin_amdgcn_s_getreg((3 << 11) | 20) & 0xFu; }
#define XB_SPIN(cond, bar) do { unsigned _sp = 0; while (cond) { __builtin_amdgcn_s_sleep(1); \
    if ((++_sp & 255u) == 0u) { if (xb_ld(&(bar)[XB_TMO])) break; if (_sp > XB_SPIN_CAP) { atomicAdd(&(bar)[XB_TMO], 1u); break; } } } } while (0)
struct XcdBarrier { unsigned* bar; unsigned x; volatile LAS unsigned* st; };
__device__ __forceinline__ XcdBarrier xcd_barrier_post(unsigned* bar, volatile LAS unsigned* st) {
    XcdBarrier b; b.bar = bar; b.x = xb_xcc_id(); b.st = st;
    if (threadIdx.x == 0) (void)xb_add(&bar[XB_XCNT(b.x)], 1u);
    return b;
}
__device__ __forceinline__ void xcd_barrier_complete(unsigned* bar, unsigned x, unsigned& nloc, unsigned& nx) {
    const unsigned G = gridDim.x * gridDim.y * gridDim.z;
    unsigned sum, cnt, mine, sp = 0u;
    for (;;) {
        sum = 0u; cnt = 0u; mine = 0u;
        size_t xz = 0; asm volatile("" : "+v"(xz)); unsigned* xc = &bar[XB_XCNT(0)] + xz;
#pragma unroll
        for (unsigned j = 0; j < 16; ++j) { const unsigned c = xb_ld(&xc[64 * j]); sum += c; cnt += (c > 0u) ? 1u : 0u; mine = (j == x) ? c : mine; }
        if (sum == G) break;
        __builtin_amdgcn_s_sleep(1);
        if ((++sp & 255u) == 0u) { if (xb_ld(&bar[XB_TMO])) break; if (sp > XB_SPIN_CAP) { atomicAdd(&bar[XB_TMO], 1u); break; } }
    }
    nloc = mine > 0u ? mine : 1u; nx = cnt > 0u ? cnt : 1u;
}
__device__ __forceinline__ void xcd_barrier(const XcdBarrier& b) {
    asm volatile("s_waitcnt vmcnt(0)" ::: "memory");
    __syncthreads();
    if (threadIdx.x == 0) {
        unsigned* bar = b.bar;
        __builtin_amdgcn_s_waitcnt(0);
        unsigned nloc = b.st[0], nx = b.st[1];
        if (nloc == 0u) { xcd_barrier_complete(bar, b.x, nloc, nx); b.st[0] = nloc; b.st[1] = nx; }
        const unsigned old = xb_add(&bar[XB_XSUB(b.x)], 1u);
        const unsigned gen = old / nloc;
        if (old + 1u == (gen + 1u) * nloc) {
            __builtin_amdgcn_fence(__ATOMIC_RELEASE, "agent");
            asm volatile("s_waitcnt vmcnt(0)" ::: "memory");
            const unsigned og = xb_add(&bar[XB_TOP], 1u);
            const unsigned tg = og / nx;
            if (og + 1u == (tg + 1u) * nx) xb_add(&bar[XB_TOPGEN], 1u);
            else XB_SPIN(xb_ld(&bar[XB_TOPGEN]) == tg, bar);
            __builtin_amdgcn_fence(__ATOMIC_ACQUIRE, "agent");
            xb_add(&bar[XB_XGEN(b.x)], 1u);
            asm volatile("s_waitcnt vmcnt(0)" ::: "memory");
        } else {
            XB_SPIN(xb_ld(&bar[XB_XGEN(b.x)]) == gen, bar);
            __builtin_amdgcn_fence(__ATOMIC_ACQUIRE, "agent");
            asm volatile("s_waitcnt vmcnt(0)" ::: "memory");
        }
    }
    __syncthreads();
}

__device__ __forceinline__ float wave_sum(float v) {
#pragma unroll
    for (int o = 1; o < 64; o <<= 1) v += __shfl_xor(v, o);
    return v;
}
__device__ __forceinline__ float wave_max(float v) {
#pragma unroll
    for (int o = 1; o < 64; o <<= 1) v = fmaxf(v, __shfl_xor(v, o));
    return v;
}

__device__ __forceinline__ int inproj_row(int rmode, int cs) {
    if (rmode == 1 && cs < 1024) { const int isk = cs >> 9, hd = (cs & 511) >> 7, ch = cs & 127, half = ch >> 6, i = ch & 63; return 256 * hd + 128 * isk + 32 * (i >> 4) + 8 * ((i >> 2) & 3) + 4 * half + (i & 3); }
    if (rmode == 2 && cs < 2048) { const int isf = cs >> 10, hd = (cs & 1023) >> 7, ch = cs & 127; return 256 * hd + 128 * isf + ch; }
    return cs;
}
__device__ __forceinline__ void tr_item64(const float* W, int K, int N, bf16* WT, int k0, int n0, int drow0, LAS unsigned* scr, int lane, const float* gain = nullptr, int rmode = 0) {
    const int q = lane >> 4, nl4 = 4 * (lane & 15); const bool ok = n0 + nl4 < N;
    const GAS float* src = (const GAS float*)W + (size_t)(k0 + 2 * q) * N + n0 + nl4;
    f32x4 v[16]; f32x2 g[8];
#pragma unroll
    for (int j = 0; j < 16; ++j) { const int kr = 8 * (j >> 1) + (j & 1); v[j] = ok ? *(const GAS f32x4*)(src + (size_t)kr * N) : (f32x4){0.f, 0.f, 0.f, 0.f}; }
#pragma unroll
    for (int i = 0; i < 8; ++i) g[i] = gain ? *(const GAS f32x2*)((const GAS float*)gain + k0 + 2 * q + 8 * i) : (f32x2){1.0f, 1.0f};
    __builtin_amdgcn_sched_barrier(0);
#pragma unroll
    for (int i = 0; i < 8; ++i) { const f32x4 a = v[2 * i] * g[i].x, b = v[2 * i + 1] * g[i].y; LAS unsigned* d = scr + (4 * i + q) * 66 + nl4;
        v2u w0; w0.x = pk2(a.x, b.x); w0.y = pk2(a.y, b.y); v2u w1; w1.x = pk2(a.z, b.z); w1.y = pk2(a.w, b.w);
        *(LAS v2u*)d = w0; *(LAS v2u*)(d + 2) = w1; }
    LDS_WAIT(); asm volatile("" ::: "memory");
    const int c = lane & 7;
#pragma unroll
    for (int jj = 0; jj < 8; ++jj) { const int n = (lane >> 3) + 8 * jj; const LAS unsigned* sp = scr + (4 * c) * 66 + n;
        v4u o; o.x = sp[0]; o.y = sp[66]; o.z = sp[132]; o.w = sp[198];
        *(GAS v4u*)(WT + (size_t)(rmode ? inproj_row(rmode, n0 + n) : drow0 + n) * K + k0 + 8 * c) = o; }
    LDS_WAIT(); asm volatile("" ::: "memory");
}
__device__ __forceinline__ void rms_row_to_bf16(const float* xrow, const float* g, bf16* orow, int lane) {
    const GAS f32x4* xr = (const GAS f32x4*)xrow + lane; const GAS f32x4* gr = (const GAS f32x4*)g + lane;
    f32x4 v[4]; float s = 0.f;
#pragma unroll
    for (int j = 0; j < 4; ++j) { v[j] = xr[64 * j]; s += (v[j].x * v[j].x + v[j].y * v[j].y) + (v[j].z * v[j].z + v[j].w * v[j].w); }
    const float r = 1.0f / sqrtf(wave_sum(s) * (1.f / D) + RMS_EPS);
    GAS v2u* o8 = (GAS v2u*)orow + lane;
#pragma unroll
    for (int j = 0; j < 4; ++j) { const f32x4 gg = gr[64 * j]; v2u w; w.x = pk2(v[j].x * r * gg.x, v[j].y * r * gg.y); w.y = pk2(v[j].z * r * gg.z, v[j].w * r * gg.w); o8[64 * j] = w; }
}
__device__ __forceinline__ void row_to_bf16_ss(const float* xrow, bf16* orow, float* rowss, int m, int lane) {
    const GAS f32x4* xr = (const GAS f32x4*)xrow + lane;
    f32x4 v[4]; float s = 0.f;
#pragma unroll
    for (int j = 0; j < 4; ++j) { v[j] = xr[64 * j]; s += (v[j].x * v[j].x + v[j].y * v[j].y) + (v[j].z * v[j].z + v[j].w * v[j].w); }
    s = wave_sum(s);
    GAS v2u* o8 = (GAS v2u*)orow + lane;
#pragma unroll
    for (int j = 0; j < 4; ++j) { v2u w; w.x = pk2(v[j].x, v[j].y); w.y = pk2(v[j].z, v[j].w); o8[64 * j] = w; }
    if (lane < 16) rowss[(size_t)lane * M + m] = lane == 0 ? s : 0.f;
}
__device__ __forceinline__ void rows2_to_bf16_ss(const float* xa, const float* xb, bf16* oa, bf16* ob, float* rowss, int ma, int mb, int lane) {
    const GAS f32x4* xr0 = (const GAS f32x4*)xa + lane; const GAS f32x4* xr1 = (const GAS f32x4*)xb + lane;
    f32x4 v[2][4]; float s0 = 0.f, s1 = 0.f;
#pragma unroll
    for (int j = 0; j < 4; ++j) { v[0][j] = xr0[64 * j]; v[1][j] = xr1[64 * j]; }
#pragma unroll
    for (int j = 0; j < 4; ++j) { s0 += (v[0][j].x * v[0][j].x + v[0][j].y * v[0][j].y) + (v[0][j].z * v[0][j].z + v[0][j].w * v[0][j].w); s1 += (v[1][j].x * v[1][j].x + v[1][j].y * v[1][j].y) + (v[1][j].z * v[1][j].z + v[1][j].w * v[1][j].w); }
#pragma unroll
    for (int o = 1; o < 64; o <<= 1) { s0 += __shfl_xor(s0, o); s1 += __shfl_xor(s1, o); }
    GAS v2u* o0 = (GAS v2u*)oa + lane; GAS v2u* o1 = (GAS v2u*)ob + lane;
#pragma unroll
    for (int j = 0; j < 4; ++j) { v2u w; w.x = pk2(v[0][j].x, v[0][j].y); w.y = pk2(v[0][j].z, v[0][j].w); o0[64 * j] = w; v2u w2; w2.x = pk2(v[1][j].x, v[1][j].y); w2.y = pk2(v[1][j].z, v[1][j].w); o1[64 * j] = w2; }
    if (lane < 16) { rowss[(size_t)lane * M + ma] = lane == 0 ? s0 : 0.f; rowss[(size_t)lane * M + mb] = lane == 0 ? s1 : 0.f; }
}
__device__ __forceinline__ void rms_row_bf16_to_f32(const bf16* xrow, const float* g, float* orow, int lane) {
    const GAS v4u* xr = (const GAS v4u*)xrow + lane; const GAS f32x4* gr = (const GAS f32x4*)g + 2 * lane;
    v4u w[2]; float v[2][8]; float s = 0.f;
#pragma unroll
    for (int j = 0; j < 2; ++j) { w[j] = xr[64 * j]; const unsigned ww[4] = {w[j].x, w[j].y, w[j].z, w[j].w};
#pragma unroll
        for (int k = 0; k < 4; ++k) { v[j][2 * k] = bflo(ww[k]); v[j][2 * k + 1] = bfhi(ww[k]); s += v[j][2 * k] * v[j][2 * k] + v[j][2 * k + 1] * v[j][2 * k + 1]; } }
    const float r = __builtin_amdgcn_rsqf(wave_sum(s) * (1.f / D) + RMS_EPS);
    GAS f32x4* o = (GAS f32x4*)orow + 2 * lane;
#pragma unroll
    for (int j = 0; j < 2; ++j) { const f32x4 g0 = gr[128 * j], g1 = gr[128 * j + 1];
        o[128 * j] = (f32x4){v[j][0] * r * g0.x, v[j][1] * r * g0.y, v[j][2] * r * g0.z, v[j][3] * r * g0.w}; o[128 * j + 1] = (f32x4){v[j][4] * r * g1.x, v[j][5] * r * g1.y, v[j][6] * r * g1.z, v[j][7] * r * g1.w}; }
}
__device__ __forceinline__ void rms_row_to_f32(float* xrow, const float* g, int lane) {
    GAS f32x4* xr = (GAS f32x4*)xrow + lane; const GAS f32x4* gr = (const GAS f32x4*)g + lane;
    f32x4 v[4]; float s = 0.f;
#pragma unroll
    for (int j = 0; j < 4; ++j) { v[j] = xr[64 * j]; s += (v[j].x * v[j].x + v[j].y * v[j].y) + (v[j].z * v[j].z + v[j].w * v[j].w); }
    const float r = 1.0f / sqrtf(wave_sum(s) * (1.f / D) + RMS_EPS);
#pragma unroll
    for (int j = 0; j < 4; ++j) { const f32x4 gg = gr[64 * j]; xr[64 * j] = (f32x4){v[j].x * r * gg.x, v[j].y * r * gg.y, v[j].z * r * gg.z, v[j].w * r * gg.w}; }
}

__device__ __forceinline__ void convert_weights(const float* const* in, unsigned char* ws, int half, LAS unsigned* scr, int w0, int nw, int lane) {
    constexpr int I_EIN = 16 * 56, I_SQ = 16 * 16, I_OIN = 16 * 64, I_W1 = 16 * 44, I_W2 = 44 * 16;
    constexpr int NITEMS = I_EIN + I_SQ + I_OIN + I_SQ + 2 * I_W1 + 2 * I_W1 + 2 * I_W2;
    const int j = half;
    for (int it = w0; it < NITEMS; it += nw) {
        int r = it;
        if (r < I_EIN) { tr_item64(in[4] + (size_t)j * D * EVEN_IN, D, EVEN_IN, (bf16*)(ws + WS_WEIN) + (size_t)j * PE * D, (r / 56) * 64, (r % 56) * 64, (r % 56) * 64, scr, lane, in[1] + (size_t)(2 * j) * D, 1); continue; } r -= I_EIN;
        if (r < I_SQ) { tr_item64(in[5] + (size_t)j * D * D, D, D, (bf16*)(ws + WS_WEOUT) + (size_t)j * D * D, (r / 16) * 64, (r % 16) * 64, (r % 16) * 64, scr, lane); continue; } r -= I_SQ;
        if (r < I_OIN) { tr_item64(in[12] + (size_t)j * D * PO, D, PO, (bf16*)(ws + WS_WOIN) + (size_t)j * PO * D, (r / 64) * 64, (r % 64) * 64, (r % 64) * 64, scr, lane, in[1] + (size_t)(2 * j + 1) * D, 2); continue; } r -= I_OIN;
        if (r < I_SQ) { tr_item64(in[13] + (size_t)j * D * D, D, D, (bf16*)(ws + WS_WOOUT) + (size_t)j * D * D, (r / 16) * 64, (r % 16) * 64, (r % 16) * 64, scr, lane); continue; } r -= I_SQ;
        if (r < 4 * I_W1) { const int which = r / (2 * I_W1); r %= 2 * I_W1; const int l = 2 * half + r / I_W1; r %= I_W1; const int n0 = (r % 44) * 64;
            tr_item64(in[which ? 17 : 16] + (size_t)l * D * FF, D, FF, (bf16*)(ws + WS_W13) + (size_t)l * FF2 * D, (r / 44) * 64, n0, 256 * (n0 / 128) + (n0 % 128) + 128 * which, scr, lane, in[2] + (size_t)l * D); continue; } r -= 4 * I_W1;
        { const int l = 2 * half + r / I_W2; r %= I_W2; tr_item64(in[18] + (size_t)l * FF * D, FF, D, (bf16*)(ws + WS_W2) + (size_t)l * D * FF, (r / 16) * 64, (r % 16) * 64, (r % 16) * 64, scr, lane); }
    }
}

constexpr int RS_TBL_OFF = RING_BYTES, RS_TAB_OFF = RING_BYTES + 1024;
template <class Sched>
__device__ __forceinline__ void build_rstd_table(LAS unsigned char* lds, const Sched& S, const float* rowss, int tid) {
    LAS int* tbl = (LAS int*)(lds + RS_TBL_OFF); LAS float* rsl = (LAS float*)(lds + RS_TAB_OFF); LAS int* spm = tbl + 128;
    if (tid < 16) { pg8::Unit u; const bool ok = tid < 14 && S.next(tid, u); spm[tid] = ok ? u.pm : -1; if (ok) tbl[u.pm] = tid; }
    __syncthreads();
#pragma unroll 1
    for (int sl = tid >> 8; sl < 14; sl += 2) { const int pm = spm[sl]; if (pm < 0) break;
        const int row = pm * 256 + (tid & 255); float p[16];
#pragma unroll
        for (int pl = 0; pl < 16; ++pl) p[pl] = rowss[(size_t)pl * M + row];
        float q = 0.f;
#pragma unroll
        for (int pl = 0; pl < 16; ++pl) q += p[pl];
        rsl[sl * 256 + (tid & 255)] = __builtin_amdgcn_rsqf(q * (1.0f / 1024.0f) + RMS_EPS); }
    __syncthreads();
}

template <int MODE>
__device__ __forceinline__ void recur_unit(LAS unsigned char* lds, int b, int hd, const bf16* proj, int ldp, const float2* rope, const float* lb, const float* ng, bf16* mixed, int tid, int lane, int wave) {
    LAS float* sq = (LAS float*)lds;
    LAS float* sk = sq + 2048;
    LAS float* sv = sk + 2048;
    LAS float* so = sv + 2048;
    LAS float* sf = so + 2048;
    const int e = tid >> 2, ds = tid & 3;
    float S[32];
#pragma unroll
    for (int i = 0; i < 32; ++i) S[i] = 0.f;
    const float gamma = 1.0f - exp2f(-5.0f - (float)hd);
    for (int blk = 0; blk < SEQ / 16; ++blk) {
        {
            const int tt = tid >> 5, ii = tid & 31; const int pos = blk * 16 + tt; const size_t row = (size_t)(b * SEQ + pos) * ldp;
            if (MODE == 0) {
#pragma unroll
                for (int h2 = 0; h2 < 2; ++h2) { const int i = ii + 32 * h2; const float2 cs = rope[pos * 64 + i];
                    const float q1 = bf2f(proj[row + C_RQ + hd * 128 + i]), q2 = bf2f(proj[row + C_RQ + hd * 128 + i + 64]);
                    const float k1 = bf2f(proj[row + C_RK + hd * 128 + i]), k2 = bf2f(proj[row + C_RK + hd * 128 + i + 64]);
                    sq[tt * 128 + i] = q1 * cs.x - q2 * cs.y; sq[tt * 128 + i + 64] = q1 * cs.y + q2 * cs.x;
                    sk[tt * 128 + i] = (k1 * cs.x - k2 * cs.y) * 0.08838834764831845f; sk[tt * 128 + i + 64] = (k1 * cs.y + k2 * cs.x) * 0.08838834764831845f; }
#pragma unroll
                for (int h4 = 0; h4 < 4; ++h4) sv[tt * 128 + ii + 32 * h4] = bf2f(proj[row + C_RV + hd * 128 + ii + 32 * h4]);
            } else {
#pragma unroll
                for (int h4 = 0; h4 < 4; ++h4) { const int d = ii + 32 * h4; const float qp = bf2f(proj[row + C_HQ + hd * 128 + d]), fp = bf2f(proj[row + C_HF + hd * 128 + d]);
                    const float l = lb[hd * 128 + d]; const float sg = sigmoidf_(fp);
                    sq[tt * 128 + d] = siluf_(qp) * 0.08838834764831845f; sf[tt * 128 + d] = l + (1.0f - l) * sg; sk[tt * 128 + d] = (1.0f - l) * (1.0f - sg);
                    sv[tt * 128 + d] = bf2f(proj[row + C_HI + hd * 128 + d]); }
            }
        }
        __syncthreads();
#pragma unroll 1
        for (int tt = 0; tt < 16; ++tt) {
            const float ve = sv[tt * 128 + e]; float po = 0.f;
#pragma unroll
            for (int i4 = 0; i4 < 8; ++i4) {
                const f32x4 q4 = *(const LAS f32x4*)(sq + tt * 128 + ds * 32 + i4 * 4), k4 = *(const LAS f32x4*)(sk + tt * 128 + ds * 32 + i4 * 4);
                f32x4 f4; if (MODE == 1) f4 = *(const LAS f32x4*)(sf + tt * 128 + ds * 32 + i4 * 4); else f4 = (f32x4){gamma, gamma, gamma, gamma};
                S[i4 * 4 + 0] = f4.x * S[i4 * 4 + 0] + k4.x * ve; po += q4.x * S[i4 * 4 + 0];
                S[i4 * 4 + 1] = f4.y * S[i4 * 4 + 1] + k4.y * ve; po += q4.y * S[i4 * 4 + 1];
                S[i4 * 4 + 2] = f4.z * S[i4 * 4 + 2] + k4.z * ve; po += q4.z * S[i4 * 4 + 2];
                S[i4 * 4 + 3] = f4.w * S[i4 * 4 + 3] + k4.w * ve; po += q4.w * S[i4 * 4 + 3];
            }
            po += __shfl_xor(po, 1); po += __shfl_xor(po, 2);
            if (ds == 0) so[tt * 128 + e] = po;
        }
        __syncthreads();
        {
#pragma unroll
            for (int r = 0; r < 2; ++r) { const int tt = wave * 2 + r; const int pos = blk * 16 + tt; const size_t trow = (size_t)(b * SEQ + pos);
                const float o0 = so[tt * 128 + lane], o1 = so[tt * 128 + lane + 64];
                float y0, y1;
                if (MODE == 0) {
                    const float mu = wave_sum(o0 + o1) * (1.f / 128.f); const float d0 = o0 - mu, d1 = o1 - mu;
                    const float var = wave_sum(d0 * d0 + d1 * d1) * (1.f / 128.f); const float rs = 1.0f / sqrtf(var + 1e-5f);
                    y0 = d0 * rs * siluf_(bf2f(proj[trow * ldp + C_RG + hd * 128 + lane])); y1 = d1 * rs * siluf_(bf2f(proj[trow * ldp + C_RG + hd * 128 + lane + 64]));
                } else {
                    const float ms = wave_sum(o0 * o0 + o1 * o1) * (1.f / 128.f); const float rs = 1.0f / sqrtf(ms + RMS_EPS);
                    y0 = o0 * rs * ng[lane] * sigmoidf_(bf2f(proj[trow * ldp + C_HG + hd * 128 + lane])); y1 = o1 * rs * ng[lane + 64] * sigmoidf_(bf2f(proj[trow * ldp + C_HG + hd * 128 + lane + 64]));
                }
                mixed[trow * D + hd * 128 + lane] = (bf16)f2bf(y0); mixed[trow * D + hd * 128 + lane + 64] = (bf16)f2bf(y1); }
        }
    }
    __syncthreads();
}

__device__ __forceinline__ float gelu_tanh(float x) { const float u = 0.7978845608028654f * (x + 0.044715f * x * x * x); const float t = 1.0f - 2.0f / (__expf(2.0f * u) + 1.0f); return 0.5f * x * (1.0f + t); }

__device__ __forceinline__ void compress_task(LAS float* xs  , int task, const bf16* proj, const float* pos_k, const float* w1_k, const float* w2_k, const float* pos_v, const float* w1_v, const float* w2_v, float* kcmp, bf16* kcb, bf16* vctb, int lane) {
    const int kv = task / (16 * NCMP); const int rem = task % (16 * NCMP); const int bg = rem / NCMP, i = rem % NCMP; const int b = bg >> 1, g = bg & 1;
    const float* pos = kv ? pos_v : pos_k; const float* w1 = kv ? w1_v : w1_k; const float* w2 = kv ? w2_v : w2_k;
    const int col = (kv ? C_VC : C_KC) + 64 * g + lane;
#pragma unroll 4
    for (int l = 0; l < 32; ++l) xs[l * 64 + lane] = bf2f(proj[(size_t)(b * SEQ + 16 * i + l) * PE + col]) + pos[l * 64 + lane];
    LDS_WAIT(); asm volatile("" ::: "memory");
    float pre = 0.f;
#pragma unroll 4
    for (int k = 0; k < 2048; k += 4) { const f32x4 a = *(const LAS f32x4*)(xs + k);
        pre += a.x * w1[(k + 0) * 64 + lane]; pre += a.y * w1[(k + 1) * 64 + lane]; pre += a.z * w1[(k + 2) * 64 + lane]; pre += a.w * w1[(k + 3) * 64 + lane]; }
    xs[2048 + lane] = gelu_tanh(pre);
    LDS_WAIT(); asm volatile("" ::: "memory");
    float o = 0.f;
#pragma unroll 4
    for (int c = 0; c < 64; c += 4) { const f32x4 a = *(const LAS f32x4*)(xs + 2048 + c);
        o += a.x * w2[(c + 0) * 64 + lane]; o += a.y * w2[(c + 1) * 64 + lane]; o += a.z * w2[(c + 2) * 64 + lane]; o += a.w * w2[(c + 3) * 64 + lane]; }
    kcmp[((size_t)(kv * 16 + bg) * 256 + i) * 64 + lane] = o;
    (kv == 0 ? kcb : vctb)[((size_t)bg * 256 + i) * 64 + lane] = (bf16)f2bf(o);
    LDS_WAIT(); asm volatile("" ::: "memory");
}

__device__ __forceinline__ void cmp_attn_task(LAS float* wl  , int task, const bf16* proj, const float* kcmp, float* accn, unsigned long long* sel, int lane) {
    LAS float* q4 = wl; LAS float* pl = wl + 256; LAS float* cs = wl + 512;
    const int bg = task >> 12, t = task & 4095; const int b = bg >> 1, g = bg & 1; const size_t trow = (size_t)(b * SEQ + t);
    const float* kc = kcmp + (size_t)bg * 256 * 64; const float* vc = kcmp + (size_t)(16 + bg) * 256 * 64;
#pragma unroll
    for (int hh = 0; hh < 4; ++hh) q4[hh * 64 + lane] = bf2f(proj[trow * PE + C_NQ + (g * 4 + hh) * 64 + lane]) * 0.125f;
    const int nvalid = t >= 31 ? (((t - 31) >> 4) + 1 > NCMP ? NCMP : ((t - 31) >> 4) + 1) : 0;
    float c4[4] = {0.f, 0.f, 0.f, 0.f};
    LDS_WAIT(); asm volatile("" ::: "memory");
#pragma unroll 1
    for (int hh = 0; hh < 4; ++hh) {
        float s4[4]; float mx = -INFINITY;
#pragma unroll
        for (int r = 0; r < 4; ++r) { const int n = lane + 64 * r; float s = -INFINITY;
            if (64 * r < nvalid) { if (n < nvalid) { float a = 0.f; const GAS f32x4* kr = (const GAS f32x4*)(kc + (size_t)n * 64);
#pragma unroll 4
                    for (int c = 0; c < 16; ++c) { const f32x4 kk = kr[c]; const f32x4 qq = *(const LAS f32x4*)(q4 + hh * 64 + c * 4); a += kk.x * qq.x + kk.y * qq.y + kk.z * qq.z + kk.w * qq.w; }
                    s = a; } }
            s4[r] = s; mx = fmaxf(mx, s); }
        mx = wave_max(mx); if (!(mx > -INFINITY)) mx = 0.f;
        float sum = 0.f;
#pragma unroll
        for (int r = 0; r < 4; ++r) { s4[r] = (s4[r] > -INFINITY) ? __expf(s4[r] - mx) : 0.f; sum += s4[r]; }
        sum = wave_sum(sum); const float inv = 1.0f / fmaxf(sum, 1e-30f);
#pragma unroll
        for (int r = 0; r < 4; ++r) { s4[r] *= inv; c4[r] += s4[r]; pl[lane + 64 * r] = s4[r]; }
        LDS_WAIT(); asm volatile("" ::: "memory");
        float o = 0.f;
        for (int n = 0; n < nvalid; ++n) o += pl[n] * vc[(size_t)n * 64 + lane];
        const float gate = sigmoidf_(bf2f(proj[trow * PE + C_NG + 0 * 8 + g * 4 + hh]));
        accn[trow * 512 + (g * 4 + hh) * 64 + lane] = gate * o;
        LDS_WAIT(); asm volatile("" ::: "memory");
    }
#pragma unroll
    for (int r = 0; r < 4; ++r) cs[lane + 64 * r] = c4[r];
    LDS_WAIT(); asm volatile("" ::: "memory");
    float imp = 0.f;
#pragma unroll
    for (int dn = -1; dn <= 3; ++dn) { const int n = 4 * lane + dn; if (n >= 0 && n < NCMP) imp += cs[n]; }
    const int bt = t >> 6; const bool valid = lane <= bt; const bool forced = (lane == 0) || (bt - lane >= 0 && bt - lane < 2);
    float score = valid ? imp + (forced ? 1.0e4f : 0.f) : -1e30f;
    unsigned long long mask = 0ull;
#pragma unroll 1
    for (int k = 0; k < 8; ++k) { const float mv = wave_max(score); const unsigned long long bal = __ballot(score == mv); const int j = __ffsll((long long)bal) - 1; mask |= 1ull << j; if (lane == j) score = -INFINITY; }
    if (lane == 0) sel[(size_t)bg * SEQ + t] = mask;
    LDS_WAIT(); asm volatile("" ::: "memory");
}

template <int MODE>
__device__ __forceinline__ void blk_attn_task(LAS float* wl  , int task, const bf16* proj, const unsigned long long* sel, float* accn, bf16* mixed, int lane) {
    LAS float* q4 = wl; LAS float* p4 = wl + 256;
    const int bg = task >> 12, t = task & 4095; const int b = bg >> 1, g = bg & 1; const size_t trow = (size_t)(b * SEQ + t);
    const int kcol = (MODE == 0 ? C_KS : C_KW) + 64 * g, vcol = (MODE == 0 ? C_VS : C_VW) + 64 * g;
#pragma unroll
    for (int hh = 0; hh < 4; ++hh) q4[hh * 64 + lane] = bf2f(proj[trow * PE + C_NQ + (g * 4 + hh) * 64 + lane]) * 0.125f;
    LDS_WAIT(); asm volatile("" ::: "memory");
    const int bt = t >> 6;
    unsigned long long todo;
    if (MODE == 0) { todo = sel[(size_t)bg * SEQ + t]; todo &= (bt >= 63) ? ~0ull : ((1ull << (bt + 1)) - 1ull); }
    else { const int lo = (t - 511) > 0 ? ((t - 511) >> 6) : 0; todo = ((bt >= 63) ? ~0ull : ((1ull << (bt + 1)) - 1ull)) & ~((1ull << lo) - 1ull); }
    float m4[4] = {-INFINITY, -INFINITY, -INFINITY, -INFINITY}, l4[4] = {0.f, 0.f, 0.f, 0.f}, o4[4] = {0.f, 0.f, 0.f, 0.f};
    while (todo) {
        const int j = __ffsll((long long)todo) - 1; todo &= todo - 1ull;
        const int pos = 64 * j + lane; const bool valid = (pos <= t) && (MODE == 0 || (t - pos) < 512);
        const GAS v4u* kr = (const GAS v4u*)(proj + (size_t)(b * SEQ + pos) * PE + kcol);
        v4u kk[8];
#pragma unroll
        for (int c = 0; c < 8; ++c) kk[c] = kr[c];
#pragma unroll
        for (int hh = 0; hh < 4; ++hh) { float a = 0.f;
#pragma unroll
            for (int c = 0; c < 8; ++c) { const f32x4 qa = *(const LAS f32x4*)(q4 + hh * 64 + c * 8), qb = *(const LAS f32x4*)(q4 + hh * 64 + c * 8 + 4);
                a += bflo(kk[c].x) * qa.x + bfhi(kk[c].x) * qa.y + bflo(kk[c].y) * qa.z + bfhi(kk[c].y) * qa.w + bflo(kk[c].z) * qb.x + bfhi(kk[c].z) * qb.y + bflo(kk[c].w) * qb.z + bfhi(kk[c].w) * qb.w; }
            const float s = valid ? a : -INFINITY;
            const float mn = fmaxf(m4[hh], wave_max(s));
            const float sc = __expf(m4[hh] - mn); const float p = valid ? __expf(s - mn) : 0.f;
            l4[hh] = l4[hh] * sc + wave_sum(p); o4[hh] *= sc; m4[hh] = mn; p4[hh * 64 + lane] = p; }
        LDS_WAIT(); asm volatile("" ::: "memory");
        const bf16* vr = proj + (size_t)(b * SEQ + 64 * j) * PE + vcol + lane;
#pragma unroll 4
        for (int k4 = 0; k4 < 64; k4 += 4) {
            const float v0 = bf2f(vr[(size_t)(k4 + 0) * PE]), v1 = bf2f(vr[(size_t)(k4 + 1) * PE]), v2 = bf2f(vr[(size_t)(k4 + 2) * PE]), v3 = bf2f(vr[(size_t)(k4 + 3) * PE]);
#pragma unroll
            for (int hh = 0; hh < 4; ++hh) { const f32x4 pp = *(const LAS f32x4*)(p4 + hh * 64 + k4); o4[hh] += pp.x * v0 + pp.y * v1 + pp.z * v2 + pp.w * v3; }
        }
        LDS_WAIT(); asm volatile("" ::: "memory");
    }
#pragma unroll
    for (int hh = 0; hh < 4; ++hh) { const float gate = sigmoidf_(bf2f(proj[trow * PE + C_NG + (MODE == 0 ? 1 : 2) * 8 + g * 4 + hh])); const float o = gate * o4[hh] / l4[hh];
        const size_t idx = trow * 512 + (g * 4 + hh) * 64 + lane;
        if (MODE == 0) accn[idx] += o; else mixed[trow * D + 512 + (g * 4 + hh) * 64 + lane] = (bf16)f2bf(accn[idx] + o); }
}


typedef float f32x16 __attribute__((ext_vector_type(16)));
typedef short s16x8 __attribute__((ext_vector_type(8)));
typedef short s16x4 __attribute__((ext_vector_type(4)));
constexpr int A_KC = 0;
constexpr int A_VCT = 36864;
constexpr int A_K0 = 71168;
constexpr int A_V0 = 89600;
constexpr int A_OT = 107008;
constexpr int A_KSTRIDE = 9216, A_VSTRIDE = 8704;
#define EXP2(x) __builtin_amdgcn_exp2f(x)
constexpr float SM_C = 0.125f * 1.4426950408889634f;
constexpr float LAZY_TAU = 5.0f;

__device__ __forceinline__ unsigned cvtpk(float lo, float hi) { f32x2_t v = {lo, hi}; bf16x2_t b = __builtin_convertvector(v, bf16x2_t); return __builtin_bit_cast(unsigned, b); }
__device__ __forceinline__ s16x8 pack8(const f32x16& p, int o) {
    v4u w; w.x = cvtpk(p[o + 0], p[o + 1]); w.y = cvtpk(p[o + 2], p[o + 3]); w.z = cvtpk(p[o + 4], p[o + 5]); w.w = cvtpk(p[o + 6], p[o + 7]);
    return __builtin_bit_cast(s16x8, w);
}
__device__ __forceinline__ s16x8 lds_a128(const LAS unsigned char* p) { return *(const LAS s16x8*)p; }
__device__ __forceinline__ s16x8 lds_a64x2(const LAS unsigned char* p) {
    const v2u lo = *(const LAS v2u*)p, hi = *(const LAS v2u*)(p + 16); v4u w; w.x = lo.x; w.y = lo.y; w.z = hi.x; w.w = hi.y; return __builtin_bit_cast(s16x8, w);
}
#define MFMA32(a, b, c) __builtin_amdgcn_mfma_f32_32x32x16_bf16((a), (b), (c), 0, 0, 0)
constexpr int rowc(int r) { return (r & 3) + 8 * (r >> 2); }

template <int MASKED>
__device__ __forceinline__ void attn_block_rf(const s16x8 (&kf)[4][2], const s16x8 (&vf)[2][4], const s16x8 (&qf)[4], int h, int key0, int klo, int khi, bool en, float& m, float& l, f32x16 (&O)[2]) {
    f32x16 s0, s1;
#pragma unroll
    for (int i = 0; i < 16; ++i) { s0[i] = 0.f; s1[i] = 0.f; }
#pragma unroll
    for (int ks = 0; ks < 4; ++ks) { s0 = MFMA32(kf[ks][0], qf[ks], s0); s1 = MFMA32(kf[ks][1], qf[ks], s1); }
    if (MASKED == 1) {
        const int lo0 = klo - key0 - 4 * h, hi0 = khi - key0 - 4 * h;
#pragma unroll
        for (int i = 0; i < 16; ++i) { const int c = rowc(i);
            s0[i] = (en && c >= lo0 && c <= hi0) ? s0[i] : -INFINITY; s1[i] = (en && c + 32 >= lo0 && c + 32 <= hi0) ? s1[i] : -INFINITY; }
    }
    float mx = -INFINITY;
#pragma unroll
    for (int i = 0; i < 16; ++i) { mx = __builtin_elementwise_max(mx, s0[i]); mx = __builtin_elementwise_max(mx, s1[i]); }
    if (MASKED == 2) mx = en ? mx : -INFINITY;
    mx = __builtin_elementwise_max(mx, __shfl_xor(mx, 32));
    if (__builtin_amdgcn_ballot_w64((mx - m) * SM_C > LAZY_TAU) != 0ull) {
        const float mn = __builtin_elementwise_max(m, mx);
        const float alpha = EXP2((m - mn) * SM_C); m = mn; l *= alpha;
#pragma unroll
        for (int i = 0; i < 16; ++i) { O[0][i] *= alpha; O[1][i] *= alpha; }
    }
    const float mc = (MASKED == 2 && !en) ? INFINITY : m * SM_C;
    float ls = 0.f;
#pragma unroll
    for (int i = 0; i < 16; ++i) { s0[i] = EXP2(fmaf(s0[i], SM_C, -mc)); s1[i] = EXP2(fmaf(s1[i], SM_C, -mc)); ls += s0[i] + s1[i]; }
    l += ls;
    const s16x8 p00 = pack8(s0, 0), p01 = pack8(s0, 8), p10 = pack8(s1, 0), p11 = pack8(s1, 8);
#pragma unroll
    for (int dt = 0; dt < 2; ++dt) { O[dt] = MFMA32(vf[dt][0], p00, O[dt]); O[dt] = MFMA32(vf[dt][1], p01, O[dt]); O[dt] = MFMA32(vf[dt][2], p10, O[dt]); O[dt] = MFMA32(vf[dt][3], p11, O[dt]); }
}
__device__ __forceinline__ void nsa_load_k(const bf16* Kt, int bgx, int j, int lane, s16x8 (&kf)[4][2]) {
    const GAS v4u* p = (const GAS v4u*)(Kt + ((size_t)bgx * 64 + j) * 4096) + lane;
#pragma unroll
    for (int ks = 0; ks < 4; ++ks) { kf[ks][0] = __builtin_bit_cast(s16x8, p[(ks * 2 + 0) * 64]); kf[ks][1] = __builtin_bit_cast(s16x8, p[(ks * 2 + 1) * 64]); }
}
__device__ __forceinline__ void nsa_load_v(const bf16* Vt, int bgx, int j, int lane, s16x8 (&vf)[2][4]) {
    const GAS v4u* p = (const GAS v4u*)(Vt + ((size_t)bgx * 64 + j) * 4096) + lane;
#pragma unroll
    for (int dt = 0; dt < 2; ++dt)
#pragma unroll
        for (int kk = 0; kk < 4; ++kk) vf[dt][kk] = __builtin_bit_cast(s16x8, p[(dt * 4 + kk) * 64]);
}

__device__ __forceinline__ void nsa_subunit(LAS unsigned char* lds, int bg, int qt, const bf16* proj, const bf16* kcb, const bf16* vctb, const bf16* Kt, const bf16* Vt, bf16* mixed, int tid_in, int wave) {
    int tid = tid_in; asm volatile("" : "+v"(tid)); const int lane = tid & 63;
    const int b = bg >> 1, g = bg & 1; const int t0 = qt * 64, bt = qt;
    const int r32 = lane & 31, h = lane >> 5, head = r32 >> 3, ql = lane & 7;
    const int t = t0 + 8 * wave + ql; const size_t trow = (size_t)(b * SEQ + t);
    {
        const bf16* ksrc = kcb + (size_t)bg * 256 * 64; const bf16* vsrc = vctb + (size_t)bg * 256 * 64;
#pragma unroll
        for (int i = 0; i < 4; ++i) { const int p = tid + i * NT;
            { const int row = p >> 3, c = p & 7; const v4u v = *(const GAS v4u*)(ksrc + row * 64 + 8 * c); *(LAS v4u*)(lds + A_KC + row * 144 + 16 * c) = v; }
            { const int n = p >> 3, c = p & 7; const v4u v = *(const GAS v4u*)(vsrc + n * 64 + 8 * c); LAS unsigned short* d = (LAS unsigned short*)(lds + A_VCT + (8 * c) * 536 + n * 2);
              d[0 * 268] = (unsigned short)(v.x & 0xffffu); d[1 * 268] = (unsigned short)(v.x >> 16); d[2 * 268] = (unsigned short)(v.y & 0xffffu); d[3 * 268] = (unsigned short)(v.y >> 16);
              d[4 * 268] = (unsigned short)(v.z & 0xffffu); d[5 * 268] = (unsigned short)(v.z >> 16); d[6 * 268] = (unsigned short)(v.w & 0xffffu); d[7 * 268] = (unsigned short)(v.w >> 16); } }
    }
    s16x8 qf[4];
    { const bf16* qp = proj + trow * PE + C_NQ + (g * 4 + head) * 64 + 8 * h;
#pragma unroll
      for (int ks = 0; ks < 4; ++ks) qf[ks] = __builtin_bit_cast(s16x8, *(const GAS v4u*)(qp + 16 * ks)); }
    __syncthreads();
    f32x16 OT[2];
#pragma unroll
    for (int i = 0; i < 16; ++i) { OT[0][i] = 0.f; OT[1][i] = 0.f; }
    unsigned long long selmask;
    {
        const int nmax = t >= 31 ? ((t - 31) >> 4) : -1;
        const int ntile = ((t0 + 63 - 31) >= 0) ? ((((t0 + 63 - 31) >> 4) + 1 + 31) >> 5) : 0;
        float m = -3.0e38f, l = 0.f;
        float imp[32];
#pragma unroll
        for (int k = 0; k < 32; ++k) imp[k] = 0.f;
        float carry = 0.f;
#pragma unroll
        for (int T = 0; T < 8; ++T) if (T < ntile) {
            f32x16 s;
#pragma unroll
            for (int i = 0; i < 16; ++i) s[i] = 0.f;
#pragma unroll
            for (int ks = 0; ks < 4; ++ks) s = MFMA32(lds_a128(lds + A_KC + (32 * T + r32) * 144 + (16 * ks + 8 * h) * 2), qf[ks], s);
            const int lim = nmax - 32 * T - 4 * h; float mx = -INFINITY;
#pragma unroll
            for (int i = 0; i < 16; ++i) { s[i] = (rowc(i) <= lim) ? s[i] : -INFINITY; mx = __builtin_elementwise_max(mx, s[i]); }
            mx = __builtin_elementwise_max(mx, __shfl_xor(mx, 32));
            if (__builtin_amdgcn_ballot_w64((mx - m) * SM_C > LAZY_TAU) != 0ull) {
                const float mn = __builtin_elementwise_max(m, mx); const float alpha = EXP2((m - mn) * SM_C); m = mn; l *= alpha; carry *= alpha;
#pragma unroll
                for (int k = 0; k < 4 * T; ++k) imp[k] *= alpha;
#pragma unroll
                for (int i = 0; i < 16; ++i) { OT[0][i] *= alpha; OT[1][i] *= alpha; }
            }
            const float mc = m * SM_C; float ls = 0.f;
#pragma unroll
            for (int i = 0; i < 16; ++i) { s[i] = EXP2(fmaf(s[i], SM_C, -mc)); ls += s[i]; }
            l += ls;
            float Gs[4], Xs[4];
#pragma unroll
            for (int rg = 0; rg < 4; ++rg) { Gs[rg] = (s[4 * rg] + s[4 * rg + 1]) + (s[4 * rg + 2] + s[4 * rg + 3]); Xs[rg] = __shfl_xor(s[4 * rg + 3], 32); }
#pragma unroll
            for (int rg = 0; rg < 4; ++rg) imp[4 * T + rg] = Gs[rg] + (h ? Xs[rg] : (rg ? Xs[rg > 0 ? rg - 1 : 0] : carry));
            carry = Xs[3];
            const s16x8 p0 = pack8(s, 0), p1 = pack8(s, 8);
#pragma unroll
            for (int dt = 0; dt < 2; ++dt) { const LAS unsigned char* vr = lds + A_VCT + (32 * dt + r32) * 536 + (32 * T + 4 * h) * 2;
                OT[dt] = MFMA32(lds_a64x2(vr), p0, OT[dt]); OT[dt] = MFMA32(lds_a64x2(vr + 32), p1, OT[dt]); }
        }
        l += __shfl_xor(l, 32);
        const float invl = l > 0.f ? __builtin_amdgcn_rcpf(l) : 0.f;
        {
            const float og = invl * sigmoidf_(bf2f(proj[trow * PE + C_NG + 0 * 8 + g * 4 + head]));
#pragma unroll
            for (int i = 0; i < 16; ++i) { OT[0][i] *= og; OT[1][i] *= og; }
        }
#pragma unroll
        for (int k = 0; k < 32; ++k) { float v = imp[k] * invl; v += __shfl_xor(v, 8); v += __shfl_xor(v, 16); imp[k] = v; }
        selmask = 1ull | (1ull << bt) | (bt >= 1 ? (1ull << (bt - 1)) : 0ull);
        {
            LAS unsigned char* ka = lds + A_K0 + wave * 4096 + lane * 16; LAS unsigned char* kb = lds + A_OT + wave * 4096 + lane * 16;
            const unsigned limu = bt >= 3 ? (unsigned)(bt - 2) : 0u;
#pragma unroll
            for (int g4 = 0; g4 < 8; ++g4) { v4u w; unsigned kk[4];
#pragma unroll
                for (int q = 0; q < 4; ++q) { const int k = 4 * g4 + q; const int j = 2 * k + h; kk[q] = ((unsigned)(j - 1) < limu) ? ((__builtin_bit_cast(unsigned, imp[k]) & ~127u) | (unsigned)(64 - j)) : 0u; }
                w.x = kk[0]; w.y = kk[1]; w.z = kk[2]; w.w = kk[3];
                *(LAS v4u*)((g4 < 4 ? ka : kb) + (g4 & 3) * 1024) = w; }
            const int rounds = 8 - (bt == 0 ? 1 : (bt == 1 ? 2 : 3));
#pragma unroll 1
            for (int rd = 0; rd < rounds; ++rd) {
                unsigned mxk = 0u;
#pragma unroll
                for (int g4 = 0; g4 < 8; ++g4) { const v4u w = *(const LAS v4u*)((g4 < 4 ? ka : kb) + (g4 & 3) * 1024);
                    mxk = __builtin_elementwise_max(mxk, w.x); mxk = __builtin_elementwise_max(mxk, w.y); mxk = __builtin_elementwise_max(mxk, w.z); mxk = __builtin_elementwise_max(mxk, w.w); }
                const unsigned gm = __builtin_elementwise_max(mxk, (unsigned)__shfl_xor((int)mxk, 32));
                if (__builtin_amdgcn_ballot_w64(gm != 0u) == 0ull) break;
                const int jb = 64 - (int)(gm & 127u);
                if (gm != 0u) { selmask |= 1ull << jb;
                    if ((jb & 1) == h) { const int k = jb >> 1; *(LAS unsigned*)((k < 16 ? ka : kb) + ((k >> 2) & 3) * 1024 + (k & 3) * 4) = 0u; } }
            }
        }
    }
    const int wlo = bt >= 8 ? bt - 8 : 0;
    {
        LAS v4u* otp = (LAS v4u*)(lds + A_OT + (wave * 64 + lane) * 64);
#pragma unroll
        for (int dt = 0; dt < 2; ++dt)
#pragma unroll
            for (int q = 0; q < 2; ++q) { v4u w; w.x = cvtpk(OT[dt][8 * q], OT[dt][8 * q + 1]); w.y = cvtpk(OT[dt][8 * q + 2], OT[dt][8 * q + 3]); w.z = cvtpk(OT[dt][8 * q + 4], OT[dt][8 * q + 5]); w.w = cvtpk(OT[dt][8 * q + 6], OT[dt][8 * q + 7]); otp[2 * dt + q] = w; }
    }
    const float gate_s = sigmoidf_(bf2f(proj[trow * PE + C_NG + 1 * 8 + g * 4 + head])), gate_w = sigmoidf_(bf2f(proj[trow * PE + C_NG + 2 * 8 + g * 4 + head]));
    unsigned long long wact = 0ull;
#pragma unroll 1
    for (int j = 0; j <= bt; ++j) if (__ballot((selmask >> j) & 1ull) != 0ull) wact |= 1ull << j;
    float m = -3.0e38f, l = 0.f;
    f32x16 O[2];
#pragma unroll
    for (int i = 0; i < 16; ++i) { O[0][i] = 0.f; O[1][i] = 0.f; }
    int cj = __ffsll((long long)wact) - 1; wact &= wact - 1ull; bool cwin = false; int wj = wlo;
    s16x8 kf[4][2], kn[4][2], vf[2][4];
    nsa_load_k(Kt, bg * 2 + 0, cj, lane, kf);
#pragma unroll 1
    for (;;) {
        int nj; bool nwin, nvalid = true;
        if (!cwin && wact != 0ull) { nj = __ffsll((long long)wact) - 1; wact &= wact - 1ull; nwin = false; }
        else if (wj <= bt) { nj = wj++; nwin = true; }
        else { nj = 0; nwin = true; nvalid = false; }
        nsa_load_v(Vt, bg * 2 + (cwin ? 1 : 0), cj, lane, vf);
        if (nvalid) nsa_load_k(Kt, bg * 2 + (nwin ? 1 : 0), nj, lane, kn);
        if (!cwin) {
            const bool en = (selmask >> cj) & 1ull;
            if (cj == bt) attn_block_rf<1>(kf, vf, qf, h, 64 * cj, 0, t, en, m, l, O);
            else attn_block_rf<2>(kf, vf, qf, h, 64 * cj, 0, t, en, m, l, O);
        } else {
            if (cj == bt || (bt >= 8 && cj == wlo)) attn_block_rf<1>(kf, vf, qf, h, 64 * cj, t - 511, t, true, m, l, O);
            else attn_block_rf<0>(kf, vf, qf, h, 64 * cj, 0, t, true, m, l, O);
        }
        if ((!cwin && nwin) || !nvalid) {
            const float lt = l + __shfl_xor(l, 32);
            const float gate = (cwin ? gate_w : gate_s) * __builtin_amdgcn_rcpf(lt);
            LAS v4u* otp = (LAS v4u*)(lds + A_OT + (wave * 64 + lane) * 64);
#pragma unroll
            for (int dt = 0; dt < 2; ++dt)
#pragma unroll
                for (int q = 0; q < 2; ++q) { const v4u w = otp[2 * dt + q];
                    const unsigned ww[4] = {w.x, w.y, w.z, w.w};
#pragma unroll
                    for (int k = 0; k < 4; ++k) { O[dt][8 * q + 2 * k] = bflo(ww[k]) + gate * O[dt][8 * q + 2 * k]; O[dt][8 * q + 2 * k + 1] = bfhi(ww[k]) + gate * O[dt][8 * q + 2 * k + 1]; } }
            if (!nvalid) break;
#pragma unroll
            for (int dt = 0; dt < 2; ++dt)
#pragma unroll
                for (int q = 0; q < 2; ++q) { v4u w; w.x = cvtpk(O[dt][8 * q], O[dt][8 * q + 1]); w.y = cvtpk(O[dt][8 * q + 2], O[dt][8 * q + 3]); w.z = cvtpk(O[dt][8 * q + 4], O[dt][8 * q + 5]); w.w = cvtpk(O[dt][8 * q + 6], O[dt][8 * q + 7]); otp[2 * dt + q] = w; }
#pragma unroll
            for (int i = 0; i < 16; ++i) { O[0][i] = 0.f; O[1][i] = 0.f; }
            m = -3.0e38f; l = 0.f;
        }
        cj = nj; cwin = nwin;
#pragma unroll
        for (int ks = 0; ks < 4; ++ks) { kf[ks][0] = kn[ks][0]; kf[ks][1] = kn[ks][1]; }
    }
    {
        bf16* op = mixed + trow * D + 512 + (g * 4 + head) * 64 + 4 * h;
#pragma unroll
        for (int dt = 0; dt < 2; ++dt)
#pragma unroll
            for (int rg = 0; rg < 4; ++rg) { v2u w; w.x = cvtpk(O[dt][4 * rg], O[dt][4 * rg + 1]); w.y = cvtpk(O[dt][4 * rg + 2], O[dt][4 * rg + 3]); *(GAS v2u*)(op + 32 * dt + 8 * rg) = w; }
    }
    __syncthreads();
}

__device__ __forceinline__ void kv_tile_item(LAS unsigned short* scr  , int item, const bf16* proj, bf16* Kt, bf16* Vt, int lane) {
    const int bgx = item >> 6, kb = item & 63; const int bg = bgx >> 1, x = bgx & 1; const int b = bg >> 1, g = bg & 1; const int r = lane & 31, h = lane >> 5;
    const bf16* ksrc = proj + (size_t)(b * SEQ + 64 * kb) * PE + (x ? C_KW : C_KS) + 64 * g;
    GAS v4u* kd = (GAS v4u*)(Kt + (size_t)item * 4096) + lane;
#pragma unroll
    for (int ks = 0; ks < 4; ++ks)
#pragma unroll
        for (int kt = 0; kt < 2; ++kt) kd[(ks * 2 + kt) * 64] = *(const GAS v4u*)(ksrc + (size_t)(32 * kt + r) * PE + 16 * ks + 8 * h);
    const bf16* vsrc = proj + (size_t)(b * SEQ + 64 * kb + lane) * PE + (x ? C_VW : C_VS) + 64 * g;
#pragma unroll
    for (int c = 0; c < 8; ++c) { const v4u v = *(const GAS v4u*)(vsrc + 8 * c); LAS unsigned* d = (LAS unsigned*)(scr + lane * 66 + 8 * c); d[0] = v.x; d[1] = v.y; d[2] = v.z; d[3] = v.w; }
    LDS_WAIT(); asm volatile("" ::: "memory");
    GAS v4u* vd = (GAS v4u*)(Vt + (size_t)item * 4096) + lane;
#pragma unroll
    for (int dt = 0; dt < 2; ++dt)
#pragma unroll
        for (int kk = 0; kk < 4; ++kk) { const int dim = 32 * dt + r, k0 = 16 * kk + 4 * h; v4u o;
            o.x = (unsigned)scr[(k0 + 0) * 66 + dim] | ((unsigned)scr[(k0 + 1) * 66 + dim] << 16); o.y = (unsigned)scr[(k0 + 2) * 66 + dim] | ((unsigned)scr[(k0 + 3) * 66 + dim] << 16);
            o.z = (unsigned)scr[(k0 + 8) * 66 + dim] | ((unsigned)scr[(k0 + 9) * 66 + dim] << 16); o.w = (unsigned)scr[(k0 + 10) * 66 + dim] | ((unsigned)scr[(k0 + 11) * 66 + dim] << 16);
            vd[(dt * 4 + kk) * 64] = o; }
    LDS_WAIT(); asm volatile("" ::: "memory");
}

__device__ __forceinline__ float gelu_tanh_f(float x) { const float u = 0.7978845608028654f * (x + 0.044715f * x * x * x); const float t = 1.0f - 2.0f * __builtin_amdgcn_rcpf(__expf(2.0f * u) + 1.0f); return 0.5f * x * (1.0f + t); }
__device__ __forceinline__ void compress_unit(LAS unsigned char* lds, int unit, const bf16* proj, const bf16* W1T  , const float* cbias  , const float* w2k, const float* w2v,
                                              bf16* kcb, bf16* vcb, int tid_in, int wave) {
    int tid = tid_in; asm volatile("" : "+v"(tid)); const int lane = tid & 63;
    const int kv = unit >> 7, bg = (unit >> 3) & 15, tile = unit & 7; const int b = bg >> 1, g = bg & 1;
    const int r32 = lane & 31, h = lane >> 5; const int i = 32 * tile + r32;
    const bf16* w1 = W1T + (size_t)kv * 64 * 2048; const int col = (kv ? C_VC : C_KC) + 64 * g;
    LAS float* biasl = (LAS float*)(lds + 65536 + 8192);
    LAS float* w2l = (LAS float*)(lds + 65536 + 8192 + 256);
    {
        const float* w2 = kv ? w2v : w2k;
        const f32x4 wa = *(const GAS f32x4*)(w2 + tid * 4), wb = *(const GAS f32x4*)(w2 + 2048 + tid * 4);
        float bsum = 0.f;
        if (tid < 64) {
            float bp[32];
#pragma unroll
            for (int ksg = 0; ksg < 32; ++ksg) bp[ksg] = cbias[(kv * 32 + ksg) * 64 + tid];
#pragma unroll
            for (int ksg = 0; ksg < 32; ++ksg) bsum += bp[ksg];
            biasl[tid] = bsum;
        }
        *(LAS f32x4*)(w2l + tid * 4) = wa; *(LAS f32x4*)(w2l + 2048 + tid * 4) = wb;
    }
    f32x16 acc0, acc1;
#pragma unroll
    for (int q = 0; q < 16; ++q) { acc0[q] = 0.f; acc1[q] = 0.f; }
#pragma unroll
    for (int ks = 0; ks < 16; ++ks) {
        int tok = 16 * i + 4 * wave + (ks >> 2); tok = tok > SEQ - 1 ? SEQ - 1 : tok;
        const s16x8 av = __builtin_bit_cast(s16x8, *(const GAS v4u*)(proj + (size_t)(b * SEQ + tok) * PE + col + 16 * (ks & 3) + 8 * h));
        const int k0 = 256 * wave + 16 * ks + 8 * h;
        const s16x8 b0 = __builtin_bit_cast(s16x8, *(const GAS v4u*)(w1 + (size_t)r32 * 2048 + k0)), b1 = __builtin_bit_cast(s16x8, *(const GAS v4u*)(w1 + (size_t)(32 + r32) * 2048 + k0));
        acc0 = MFMA32(av, b0, acc0); acc1 = MFMA32(av, b1, acc1);
    }
    LAS float* part = (LAS float*)lds;
    LAS float* hidl = (LAS float*)(lds + 65536);
#pragma unroll
    for (int q = 0; q < 16; ++q) { const int row = (q & 3) + 8 * (q >> 2) + 4 * h; part[(wave * 32 + row) * 64 + r32] = acc0[q]; part[(wave * 32 + row) * 64 + 32 + r32] = acc1[q]; }
    __syncthreads();
    const int il = tid >> 4, c4 = (tid & 15) * 4;
    {
        f32x4 s = *(const LAS f32x4*)(biasl + c4);
#pragma unroll
        for (int w = 0; w < 8; ++w) s = s + *(const LAS f32x4*)(part + (w * 32 + il) * 64 + c4);
        *(LAS f32x4*)(hidl + il * 64 + c4) = (f32x4){gelu_tanh_f(s.x), gelu_tanh_f(s.y), gelu_tanh_f(s.z), gelu_tanh_f(s.w)};
    }
    __syncthreads();
    {
        f32x4 o = (f32x4){0.f, 0.f, 0.f, 0.f};
#pragma unroll 8
        for (int c = 0; c < 64; ++c) { const float hv = hidl[il * 64 + c]; o = o + *(const LAS f32x4*)(w2l + c * 64 + c4) * hv; }
        const int irow = 32 * tile + il; if (irow == 255) o = (f32x4){0.f, 0.f, 0.f, 0.f};
        v2u w; w.x = cvtpk(o.x, o.y); w.y = cvtpk(o.z, o.w);
        *(GAS v2u*)((kv ? vcb : kcb) + ((size_t)bg * 256 + irow) * 64 + c4) = w;
    }
    __syncthreads();
}


typedef float f32x4v __attribute__((ext_vector_type(4)));
#define MFMA16(a, b, c) __builtin_amdgcn_mfma_f32_16x16x32_bf16((a), (b), (c), 0, 0, 0)
constexpr int R_QT = 0, R_KT = 8704, R_KTT = 17920, R_VTT = 30208, R_E = 42496, R_BUF = 43008;
constexpr int S_QT = 0, S_KT = 24576, S_V = 49152, S_E = 65536, S_PF = 66560, S_OB = 71680, S_END = 105472;
__device__ __forceinline__ unsigned off_b(unsigned row, unsigned ch) { return 256u * row + 16u * (ch ^ (((row & 3u) << 2) | ((row >> 2) & 3u))); }
__device__ __forceinline__ unsigned tr_addr(unsigned lane, unsigned c, unsigned ks, unsigned t) { const unsigned h = lane >> 5, blk = (lane >> 4) & 1u, q = (lane & 15u) >> 2, pp = lane & 3u; return off_b(16u * ks + 8u * h + 4u * t + q, 4u * c + 2u * blk + (pp >> 1)) + 8u * (pp & 1u); }
typedef short v4i16_t __attribute__((ext_vector_type(4)));
__device__ __forceinline__ s16x8 tr_frag(const LAS unsigned char* tile, unsigned lane, unsigned c, unsigned ks) {
    const v4i16_t a = __builtin_amdgcn_ds_read_tr16_b64_v4i16((LAS v4i16_t*)(tile + tr_addr(lane, c, ks, 0))), b = __builtin_amdgcn_ds_read_tr16_b64_v4i16((LAS v4i16_t*)(tile + tr_addr(lane, c, ks, 1)));
    s16x8 r; r[0] = a[0]; r[1] = a[1]; r[2] = a[2]; r[3] = a[3]; r[4] = b[0]; r[5] = b[1]; r[6] = b[2]; r[7] = b[3]; return r; }
constexpr float REC_SCALE = 0.08838834764831845f;

__device__ __forceinline__ s16x8 lds_2x64(const LAS unsigned char* p, const LAS unsigned char* q) { const v2u lo = *(const LAS v2u*)p, hi = *(const LAS v2u*)q; v4u w; w.x = lo.x; w.y = lo.y; w.z = hi.x; w.w = hi.y; return __builtin_bit_cast(s16x8, w); }

template <int MODE>
__device__ __forceinline__ void rec_prep_task(int task, bf16* proj, const float2* rope, const float* lb, float* Eg, int lane) {
    constexpr int NH = MODE ? 8 : 4, LDP = MODE ? PO : PE, CQ = MODE ? C_HQ : C_RQ, CK = MODE ? C_HF : C_RK, CV = MODE ? C_HI : C_RV;
    const int chunk = task & 127, bh = task >> 7; const int b = bh / NH, hd = bh % NH;
    const size_t row0 = (size_t)(b * SEQ + 32 * chunk);
    if (MODE == 1) {
        const float l0 = lb[hd * 128 + 2 * lane], l1 = lb[hd * 128 + 2 * lane + 1];
        float B0 = 0.f, B1 = 0.f;
        bf16* rp0 = proj + row0 * LDP + hd * 128 + 2 * lane;
        unsigned qw[32], fw[32];
#pragma unroll
        for (int t = 0; t < 32; ++t) { qw[t] = *(const GAS unsigned*)(rp0 + (size_t)t * LDP + CQ); fw[t] = *(const GAS unsigned*)(rp0 + (size_t)t * LDP + CK); }
        __builtin_amdgcn_sched_barrier(0);
#pragma unroll
        for (int t = 0; t < 32; ++t) {
            bf16* rp = rp0 + (size_t)t * LDP;
            const float f0 = bflo(fw[t]), f1 = bfhi(fw[t]), q0 = bflo(qw[t]), q1 = bfhi(qw[t]);
            const float s0 = sigmoidf_(f0), s1 = sigmoidf_(f1);
            B0 += __logf(l0 + (1.0f - l0) * s0); B1 += __logf(l1 + (1.0f - l1) * s1);
            const float e0 = __expf(B0), e1 = __expf(B1);
            const float qt0 = siluf_(q0) * REC_SCALE * e0, qt1 = siluf_(q1) * REC_SCALE * e1;
            const float kt0 = (1.0f - l0) * (1.0f - s0) * __builtin_amdgcn_rcpf(e0), kt1 = (1.0f - l1) * (1.0f - s1) * __builtin_amdgcn_rcpf(e1);
            *(GAS unsigned*)(rp + CQ) = pk2(qt0, qt1);
            const unsigned kw = pk2(kt0, kt1);
            *(GAS unsigned*)(rp + CK) = kw;
            if (t == 31) { *(GAS f32x2*)(Eg + ((size_t)bh * 128 + chunk) * 128 + 2 * lane) = (f32x2){e0, e1}; }
        }
    } else {
        const float gamma = 1.0f - exp2f(-5.0f - (float)hd); const float ginv = 1.0f / gamma;
        float gp = 1.0f, gi = 1.0f;
        bf16* rp0 = proj + row0 * LDP + hd * 128 + lane;
#pragma unroll
        for (int half = 0; half < 2; ++half) {
            unsigned short q1h[16], q2h[16], k1h[16], k2h[16]; float2 csh[16];
#pragma unroll
            for (int i = 0; i < 16; ++i) { const int t = 16 * half + i; const bf16* rp = rp0 + (size_t)t * LDP;
                q1h[i] = rp[CQ]; q2h[i] = rp[CQ + 64]; k1h[i] = rp[CK]; k2h[i] = rp[CK + 64]; csh[i] = rope[(32 * chunk + t) * 64 + lane]; }
            __builtin_amdgcn_sched_barrier(0);
#pragma unroll
            for (int i = 0; i < 16; ++i) { const int t = 16 * half + i; bf16* rp = rp0 + (size_t)t * LDP;
                gp *= gamma; gi *= ginv;
                const float2 cs = csh[i];
                const float q1 = bf2f(q1h[i]), q2 = bf2f(q2h[i]), k1 = bf2f(k1h[i]), k2 = bf2f(k2h[i]);
                const unsigned qa = f2bf((q1 * cs.x - q2 * cs.y) * gp), qb = f2bf((q1 * cs.y + q2 * cs.x) * gp);
                const unsigned ka = f2bf((k1 * cs.x - k2 * cs.y) * (REC_SCALE * gi)), kb = f2bf((k1 * cs.y + k2 * cs.x) * (REC_SCALE * gi));
                rp[CQ] = (bf16)qa; rp[CQ + 64] = (bf16)qb; rp[CK] = (bf16)ka; rp[CK + 64] = (bf16)kb;
            }
        }
    }
}


struct RecSet { v4u q[2], k[2], v[2]; f32x4v e; v4u g[2]; f32x4v ec[2]; };

template <int MODE, int SEGS>
__device__ __forceinline__ void rec_issue(RecSet& R, int c, int bh, int hd, size_t rowbase, const bf16* proj, const float* Eg, int hid) {
    constexpr int NCH = SEQ / 32 / SEGS, LDP = MODE ? PO : PE, CQ = MODE ? C_HQ : C_RQ, CK = MODE ? C_HF : C_RK, CV = MODE ? C_HI : C_RV, CG = MODE ? C_HG : C_RG;
    if (c + 2 < NCH) { const size_t r2 = rowbase + 32 * (c + 2);
#pragma unroll
        for (int i = 0; i < 2; ++i) { const int p = hid + 256 * i, tq = p >> 4, cq = p & 15;
            R.q[i] = *(const GAS v4u*)(proj + (r2 + tq) * LDP + CQ + hd * 128 + 8 * cq); R.k[i] = *(const GAS v4u*)(proj + (r2 + tq) * LDP + CK + hd * 128 + 8 * cq); } }
    if (c + 1 < NCH) { const size_t r1 = rowbase + 32 * (c + 1);
#pragma unroll
        for (int i = 0; i < 2; ++i) { const int p = hid + 256 * i, tq = p >> 4, cq = p & 15; R.v[i] = *(const GAS v4u*)(proj + (r1 + tq) * LDP + CV + hd * 128 + 8 * cq); }
        if (MODE == 1 && hid < 32) R.e = *(const GAS f32x4v*)(Eg + ((size_t)bh * 128 + c + 1) * 128 + 4 * hid);
        if (SEGS > 1) { const GAS f32x4v* ep = (const GAS f32x4v*)(Eg + ((size_t)bh * 128 + c + 1) * 128 + 8 * (hid & 15)); R.ec[0] = ep[0]; R.ec[1] = ep[1]; } }
    if (SEGS == 1 && c >= 1) { const GAS v4u* gp = (const GAS v4u*)(proj + (rowbase + 32 * (c - 1) + (hid >> 3)) * LDP + CG + hd * 128 + 16 * (hid & 7)); R.g[0] = gp[0]; R.g[1] = gp[1]; }
}
__device__ __forceinline__ v4u scale8(v4u q, const float (&f)[8]) {
    v4u o; o.x = pk2(bflo(q.x) * f[0], bfhi(q.x) * f[1]); o.y = pk2(bflo(q.y) * f[2], bfhi(q.y) * f[3]); o.z = pk2(bflo(q.z) * f[4], bfhi(q.z) * f[5]); o.w = pk2(bflo(q.w) * f[6], bfhi(q.w) * f[7]); return o; }
template <int MODE, int SEGS>
__device__ __forceinline__ void rec_stage(const RecSet& R, LAS unsigned char* lds, int c, int hid, float (&ecum)[8], bool fix, bf16* projw, int hd, size_t rowbase) {
    constexpr int NCH = SEQ / 32 / SEGS, LDP = MODE ? PO : PE, CQ = MODE ? C_HQ : C_RQ;
    if (SEGS > 1 && c + 1 < NCH) {
        ecum[0] *= R.ec[0][0]; ecum[1] *= R.ec[0][1]; ecum[2] *= R.ec[0][2]; ecum[3] *= R.ec[0][3]; ecum[4] *= R.ec[1][0]; ecum[5] *= R.ec[1][1]; ecum[6] *= R.ec[1][2]; ecum[7] *= R.ec[1][3]; }
    if (c + 2 < NCH) {
#pragma unroll
        for (int i = 0; i < 2; ++i) { const int p = hid + 256 * i; const unsigned o = off_b(p >> 4, p & 15);
            *(LAS v4u*)(lds + S_QT + ((c + 2) % 3) * 8192 + o) = R.q[i]; *(LAS v4u*)(lds + S_KT + ((c + 2) % 3) * 8192 + o) = R.k[i];
            if (SEGS > 1 && fix) *(GAS v4u*)(projw + (rowbase + 32 * (c + 2) + (p >> 4)) * LDP + CQ + hd * 128 + 8 * (p & 15)) = scale8(R.q[i], ecum); } }
    if (c + 1 < NCH) {
#pragma unroll
        for (int i = 0; i < 2; ++i) { const int p = hid + 256 * i; *(LAS v4u*)(lds + S_V + ((c + 1) & 1) * 8192 + off_b(p >> 4, p & 15)) = R.v[i]; }
        if (MODE == 1 && hid < 32) *(LAS f32x4v*)(lds + S_E + ((c + 1) & 1) * 512 + 16 * hid) = R.e; }
}
__device__ __forceinline__ void rec_store_raw(const LAS unsigned char* lds, int cp, int hd, size_t rowbase, bf16* mixed, int hid) {
    const int t = hid >> 3, seg = hid & 7;
    const LAS f32x4v* ob = (const LAS f32x4v*)(lds + S_OB + (cp & 1) * 16896 + t * 528 + seg * 64);
    const f32x4v o0 = ob[0], o1 = ob[1], o2 = ob[2], o3 = ob[3];
    GAS v4u* dst = (GAS v4u*)(mixed + (rowbase + 32 * cp + t) * D + hd * 128 + 16 * seg);
    dst[0] = (v4u){pk2(o0[0], o0[1]), pk2(o0[2], o0[3]), pk2(o1[0], o1[1]), pk2(o1[2], o1[3])}; dst[1] = (v4u){pk2(o2[0], o2[1]), pk2(o2[2], o2[3]), pk2(o3[0], o3[1]), pk2(o3[2], o3[3])};
}
__device__ __forceinline__ void rec_ptile3(LAS unsigned char* lds, int cn, int hw, int lane) {
    const int c16 = lane & 15, q4 = lane >> 4; const int si = hw == 2 ? 1 : 0, ti = hw == 0 ? 0 : 1;
    const LAS unsigned char* kb = lds + S_KT + (cn % 3) * 8192; const LAS unsigned char* qb = lds + S_QT + (cn % 3) * 8192;
    s16x8 ka[4], qa[4];
#pragma unroll
    for (int ks = 0; ks < 4; ++ks) { ka[ks] = lds_a128(kb + off_b(16 * si + c16, 4 * ks + q4)); qa[ks] = lds_a128(qb + off_b(16 * ti + c16, 4 * ks + q4)); }
    __builtin_amdgcn_sched_barrier(0);
    f32x4v p = (f32x4v){0.f, 0.f, 0.f, 0.f};
#pragma unroll
    for (int ks = 0; ks < 4; ++ks) p = MFMA16(ka[ks], qa[ks], p);
    if (hw != 1) {
#pragma unroll
        for (int r = 0; r < 4; ++r) p[r] = ((4 * q4 + r) <= c16) ? p[r] : 0.f;
    }
    v2u w; w.x = cvtpk(p[0], p[1]); w.y = cvtpk(p[2], p[3]);
    *(LAS v2u*)(lds + S_PF + (cn & 1) * 2560 + (16 * ti + c16) * 80 + (16 * si + 4 * q4) * 2) = w;
}
template <int MODE>
__device__ __forceinline__ void rec_finish(const LAS unsigned char* lds, int cp, const v4u (&g)[2], const float (&ngl)[16], int hd, size_t rowbase, bf16* mixed, int hid) {
    const int t = hid >> 3, seg = hid & 7;
    const LAS f32x4v* ob = (const LAS f32x4v*)(lds + S_OB + (cp & 1) * 16896 + t * 528 + seg * 64);
    f32x4v o[4];
#pragma unroll
    for (int i = 0; i < 4; ++i) o[i] = ob[i];
    float s1 = 0.f, s2 = 0.f;
#pragma unroll
    for (int i = 0; i < 4; ++i) { s1 += (o[i][0] + o[i][1]) + (o[i][2] + o[i][3]); s2 += (o[i][0] * o[i][0] + o[i][1] * o[i][1]) + (o[i][2] * o[i][2] + o[i][3] * o[i][3]); }
    s1 += __shfl_xor(s1, 1); s2 += __shfl_xor(s2, 1); s1 += __shfl_xor(s1, 2); s2 += __shfl_xor(s2, 2); s1 += __shfl_xor(s1, 4); s2 += __shfl_xor(s2, 4);
    float mu = 0.f, rs;
    if (MODE == 0) { mu = s1 * (1.f / 128.f); rs = __builtin_amdgcn_rsqf(fmaxf(s2 * (1.f / 128.f) - mu * mu, 0.f) + 1e-5f); }
    else rs = __builtin_amdgcn_rsqf(s2 * (1.f / 128.f) + RMS_EPS);
    v4u out[2];
#pragma unroll
    for (int hv = 0; hv < 2; ++hv) { unsigned w[4];
#pragma unroll
        for (int k = 0; k < 4; ++k) { const int e0 = 8 * hv + 2 * k; const unsigned gw = k == 0 ? g[hv].x : (k == 1 ? g[hv].y : (k == 2 ? g[hv].z : g[hv].w));
            const float a = o[e0 >> 2][e0 & 3], bq = o[(e0 + 1) >> 2][(e0 + 1) & 3]; float y0, y1;
            if (MODE == 0) { y0 = (a - mu) * rs * siluf_(bflo(gw)); y1 = (bq - mu) * rs * siluf_(bfhi(gw)); }
            else { y0 = a * rs * ngl[e0] * sigmoidf_(bflo(gw)); y1 = bq * rs * ngl[e0 + 1] * sigmoidf_(bfhi(gw)); }
            w[k] = pk2(y0, y1); }
        out[hv] = (v4u){w[0], w[1], w[2], w[3]}; }
    GAS v4u* dst = (GAS v4u*)(mixed + (rowbase + 32 * cp + t) * D + hd * 128 + 16 * seg);
    dst[0] = out[0]; dst[1] = out[1];
}

template <int MODE>
__device__ __forceinline__ void rec_compute(LAS unsigned char* lds, int c, f32x16 (&Sacc)[4], float egam, int w, int lane) {
    const int r32 = lane & 31, h = lane >> 5;
    const LAS unsigned char* qt = lds + S_QT + (c % 3) * 8192; const LAS unsigned char* ktl = lds + S_KT + (c % 3) * 8192; const LAS unsigned char* vtl = lds + S_V + (c & 1) * 8192;
    const LAS unsigned char* pf = lds + S_PF + (c & 1) * 2560 + r32 * 80 + 16 * h;
    const s16x8 pf0 = lds_a128(pf), pf1 = lds_a128(pf + 32);
    const s16x8 vf0 = tr_frag(vtl, lane, w, 0), vf1 = tr_frag(vtl, lane, w, 1);
    s16x8 qp[4][2];
#pragma unroll
    for (int dt = 0; dt < 4; ++dt)
#pragma unroll
        for (int sp = 0; sp < 2; ++sp) qp[dt][sp] = lds_2x64(qt + off_b(r32, 4 * dt + 2 * sp) + 8 * h, qt + off_b(r32, 4 * dt + 2 * sp + 1) + 8 * h);
    __builtin_amdgcn_sched_barrier(0);
    f32x16 o;
#pragma unroll
    for (int i = 0; i < 16; ++i) o[i] = 0.f;
    o = MFMA32(vf0, pf0, o); o = MFMA32(vf1, pf1, o);
#pragma unroll
    for (int dt = 0; dt < 4; ++dt)
#pragma unroll
        for (int sp = 0; sp < 2; ++sp) o = MFMA32(pack8(Sacc[dt], 8 * sp), qp[dt][sp], o);
    __builtin_amdgcn_sched_barrier(0);
    s16x8 kf[4][2];
#pragma unroll
    for (int dt = 0; dt < 4; ++dt) { kf[dt][0] = tr_frag(ktl, lane, dt, 0); kf[dt][1] = tr_frag(ktl, lane, dt, 1); }
    __builtin_amdgcn_sched_barrier(0);
#pragma unroll
    for (int dt = 0; dt < 4; ++dt) { Sacc[dt] = MFMA32(kf[dt][0], vf0, Sacc[dt]); Sacc[dt] = MFMA32(kf[dt][1], vf1, Sacc[dt]); }
    {
        LAS unsigned char* ob = lds + S_OB + (c & 1) * 16896 + r32 * 528 + (32 * w + 4 * h) * 4;
#pragma unroll
        for (int g = 0; g < 4; ++g) *(LAS f32x4v*)(ob + 32 * g) = (f32x4v){o[4 * g], o[4 * g + 1], o[4 * g + 2], o[4 * g + 3]};
    }
    if (MODE == 1) { const LAS unsigned char* eb = lds + S_E + (c & 1) * 512 + 16 * h;
#pragma unroll
        for (int dt = 0; dt < 4; ++dt)
#pragma unroll
            for (int g = 0; g < 4; ++g) { const f32x4v e4 = *(const LAS f32x4v*)(eb + (32 * dt + 8 * g) * 4);
                Sacc[dt][4 * g] *= e4[0]; Sacc[dt][4 * g + 1] *= e4[1]; Sacc[dt][4 * g + 2] *= e4[2]; Sacc[dt][4 * g + 3] *= e4[3]; }
    } else {
#pragma unroll
        for (int dt = 0; dt < 4; ++dt)
#pragma unroll
            for (int i = 0; i < 16; ++i) Sacc[dt][i] *= egam;
    }
}

#define REC_BAR() do { asm volatile("s_waitcnt lgkmcnt(0)" ::: "memory"); __builtin_amdgcn_s_barrier(); asm volatile("" ::: "memory"); } while (0)

template <int MODE, int SEGS>
__device__ __forceinline__ void rec_serial_unit(LAS unsigned char* lds, int unit, bf16* proj, const float* Eg0, const float* ng, bf16* mixed, float* Send, float* Dseg, int tid_in, int wave) {
    constexpr int NH = MODE ? 8 : 4, NCH = SEQ / 32 / SEGS, LDP = MODE ? PO : PE, CQ = MODE ? C_HQ : C_RQ, CK = MODE ? C_HF : C_RK, CV = MODE ? C_HI : C_RV;
    int tid = tid_in; asm volatile("" : "+v"(tid)); const int lane = tid & 63;
    const int bh = unit / SEGS, sg = unit % SEGS;
    const int b = bh / NH, hd = bh % NH; const size_t rowbase = (size_t)b * SEQ + (size_t)sg * NCH * 32;
    const float* Eg = Eg0 + (size_t)sg * NCH * 128;
    const bool fix = SEGS > 1 && sg > 0;
    float ecum[8] = {1.f, 1.f, 1.f, 1.f, 1.f, 1.f, 1.f, 1.f};
    {
        const int tq = tid >> 4, cq = tid & 15; const unsigned o = off_b(tq, cq);
        if (SEGS > 1) { const GAS f32x4v* ep = (const GAS f32x4v*)(Eg + ((size_t)bh * 128) * 128 + 8 * cq); const f32x4v e0 = ep[0], e1 = ep[1];
            ecum[0] = e0[0]; ecum[1] = e0[1]; ecum[2] = e0[2]; ecum[3] = e0[3]; ecum[4] = e1[0]; ecum[5] = e1[1]; ecum[6] = e1[2]; ecum[7] = e1[3]; }
#pragma unroll
        for (int cc = 0; cc < 2; ++cc) { const size_t r = rowbase + 32 * cc + tq;
            const v4u qv = *(const GAS v4u*)(proj + r * LDP + CQ + hd * 128 + 8 * cq);
            *(LAS v4u*)(lds + S_QT + cc * 8192 + o) = qv;
            if (SEGS > 1 && fix && cc == 1) *(GAS v4u*)(proj + r * LDP + CQ + hd * 128 + 8 * cq) = scale8(qv, ecum);
            *(LAS v4u*)(lds + S_KT + cc * 8192 + o) = *(const GAS v4u*)(proj + r * LDP + CK + hd * 128 + 8 * cq); }
        *(LAS v4u*)(lds + S_V + o) = *(const GAS v4u*)(proj + (rowbase + tq) * LDP + CV + hd * 128 + 8 * cq);
        if (MODE == 1 && tid < 32) *(LAS f32x4v*)(lds + S_E + 16 * tid) = *(const GAS f32x4v*)(Eg + ((size_t)bh * 128) * 128 + 4 * tid);
        if (tid < 128) { const int par = tid >> 6, t16 = (tid >> 2) & 15, q = tid & 3; unsigned z = 0u; asm volatile("" : "+v"(z)); *(LAS v2u*)(lds + S_PF + par * 2560 + t16 * 80 + 32 + 8 * q) = (v2u){z, z}; }
    }
    __syncthreads();
    if (wave >= 4 && wave < 7) rec_ptile3(lds, 0, wave - 4, lane);
    __syncthreads();
    if (wave < 4) {
        f32x16 Sacc[4];
#pragma unroll
        for (int dt = 0; dt < 4; ++dt)
#pragma unroll
            for (int i = 0; i < 16; ++i) Sacc[dt][i] = 0.f;
        const float egam = MODE ? 1.f : exp2f(32.0f * log2f(1.0f - exp2f(-5.0f - (float)hd)));
#pragma unroll 1
        for (int c = 0; c <= NCH; ++c) { if (c < NCH) rec_compute<MODE>(lds, c, Sacc, egam, wave, lane); REC_BAR(); }
        if (SEGS > 1 && sg + 1 < SEGS) {
            const int r32 = lane & 31, h = lane >> 5; float* sp = Send + ((size_t)(bh * (SEGS - 1) + sg) * 128) * 128 + 32 * wave + r32;
#pragma unroll
            for (int dt = 0; dt < 4; ++dt)
#pragma unroll
                for (int i = 0; i < 16; ++i) sp[(size_t)(32 * dt + (i & 3) + 8 * (i >> 2) + 4 * h) * 128] = Sacc[dt][i];
        }
    } else {
        const int hid = tid - 256, hw = wave - 4;
        RecSet RA, RB;
        float ngl[16];
#pragma unroll
        for (int i = 0; i < 16; ++i) ngl[i] = (MODE && SEGS == 1) ? ng[16 * (hid & 7) + i] : 1.f;
        rec_issue<MODE, SEGS>(RA, 0, bh, hd, rowbase, proj, Eg, hid); rec_issue<MODE, SEGS>(RB, 1, bh, hd, rowbase, proj, Eg, hid);
#pragma unroll 1
        for (int c = 0; c <= NCH; c += 2) {
            if (c >= 1) { if (SEGS == 1) rec_finish<MODE>(lds, c - 1, RA.g, ngl, hd, rowbase, mixed, hid); else rec_store_raw(lds, c - 1, hd, rowbase, mixed, hid); }
            if (hw < 3 && c + 1 < NCH) rec_ptile3(lds, c + 1, hw, lane);
            rec_stage<MODE, SEGS>(RA, lds, c, hid, ecum, fix, proj, hd, rowbase);
            if (c + 2 <= NCH) rec_issue<MODE, SEGS>(RA, c + 2, bh, hd, rowbase, proj, Eg, hid);
            REC_BAR();
            if (c + 1 <= NCH) {
                if (SEGS == 1) rec_finish<MODE>(lds, c, RB.g, ngl, hd, rowbase, mixed, hid); else rec_store_raw(lds, c, hd, rowbase, mixed, hid);
                if (hw < 3 && c + 2 < NCH) rec_ptile3(lds, c + 2, hw, lane);
                rec_stage<MODE, SEGS>(RB, lds, c + 1, hid, ecum, fix, proj, hd, rowbase);
                if (c + 3 <= NCH) rec_issue<MODE, SEGS>(RB, c + 3, bh, hd, rowbase, proj, Eg, hid);
                REC_BAR();
            }
        }
        if (SEGS > 1 && hid < 16) { float* dp = Dseg + (size_t)(bh * SEGS + sg) * 128 + 8 * hid;
            *(GAS f32x4v*)dp = (f32x4v){ecum[0], ecum[1], ecum[2], ecum[3]}; *(GAS f32x4v*)(dp + 4) = (f32x4v){ecum[4], ecum[5], ecum[6], ecum[7]}; }
    }
    __syncthreads();
}

__device__ __forceinline__ void rec_fix_unit(LAS unsigned char* lds, int unit, const bf16* proj, const float* Send, const float* Dseg, const float* ng, bf16* mixed, int tid_in, int wave) {
    int tid = tid_in; asm volatile("" : "+v"(tid)); const int lane = tid & 63;
    const int sg = unit & 3, bh = unit >> 2; const int b = bh >> 3, hd = bh & 7;
    const int r32 = lane & 31, h = lane >> 5;
    LAS unsigned char* ST = lds;
    if (sg > 0) {
        const int e = tid & 127, d0 = 32 * (tid >> 7); float sv[32], t1[32];
        const float* s0p = Send + ((size_t)(bh * 3 + 0) * 128 + d0) * 128 + e;
#pragma unroll
        for (int dd = 0; dd < 32; ++dd) sv[dd] = s0p[(size_t)dd * 128];
        __builtin_amdgcn_sched_barrier(0);
        if (sg >= 2) { const float* s1p = Send + ((size_t)(bh * 3 + 1) * 128 + d0) * 128 + e; const float* dp = Dseg + (size_t)(bh * 4 + 1) * 128 + d0;
#pragma unroll
            for (int dd = 0; dd < 32; ++dd) t1[dd] = s1p[(size_t)dd * 128];
            __builtin_amdgcn_sched_barrier(0);
#pragma unroll
            for (int dd = 0; dd < 32; ++dd) sv[dd] = dp[dd] * sv[dd] + t1[dd]; }
        if (sg >= 3) { const float* s2p = Send + ((size_t)(bh * 3 + 2) * 128 + d0) * 128 + e; const float* dp = Dseg + (size_t)(bh * 4 + 2) * 128 + d0;
#pragma unroll
            for (int dd = 0; dd < 32; ++dd) t1[dd] = s2p[(size_t)dd * 128];
            __builtin_amdgcn_sched_barrier(0);
#pragma unroll
            for (int dd = 0; dd < 32; ++dd) sv[dd] = dp[dd] * sv[dd] + t1[dd]; }
#pragma unroll
        for (int q = 0; q < 4; ++q) *(LAS v4u*)(ST + e * 272 + d0 * 2 + 16 * q) = (v4u){pk2(sv[8 * q], sv[8 * q + 1]), pk2(sv[8 * q + 2], sv[8 * q + 3]), pk2(sv[8 * q + 4], sv[8 * q + 5]), pk2(sv[8 * q + 6], sv[8 * q + 7])};
    }
    __syncthreads();
#pragma unroll 1
    for (int blk = 0; blk < 4; ++blk) {
        f32x16 O[4];
#pragma unroll
        for (int et = 0; et < 4; ++et)
#pragma unroll
            for (int i = 0; i < 16; ++i) O[et][i] = 0.f;
        const size_t trow = (size_t)b * SEQ + 1024 * sg + 256 * blk + 32 * wave + r32;
        if (sg > 0) {
            s16x8 qf[8];
            { const bf16* qp = proj + trow * PO + C_HQ + hd * 128 + 8 * h;
#pragma unroll
              for (int ks = 0; ks < 8; ++ks) qf[ks] = __builtin_bit_cast(s16x8, *(const GAS v4u*)(qp + 16 * ks)); }
#pragma unroll
            for (int et = 0; et < 4; ++et)
#pragma unroll
                for (int ks = 0; ks < 8; ++ks) O[et] = MFMA32(lds_a128(ST + (32 * et + r32) * 272 + (16 * ks + 8 * h) * 2), qf[ks], O[et]);
        }
        bf16* mp = mixed + trow * D + hd * 128 + 4 * h; const bf16* gp = proj + trow * PO + C_HG + hd * 128 + 4 * h;
        v2u ol[4][4], gl[4][4];
#pragma unroll
        for (int et = 0; et < 4; ++et)
#pragma unroll
            for (int g = 0; g < 4; ++g) { ol[et][g] = *(const GAS v2u*)(mp + 32 * et + 8 * g); gl[et][g] = *(const GAS v2u*)(gp + 32 * et + 8 * g); }
        __builtin_amdgcn_sched_barrier(0);
        float s2 = 0.f;
#pragma unroll
        for (int et = 0; et < 4; ++et)
#pragma unroll
            for (int g = 0; g < 4; ++g) { const v2u w = ol[et][g];
                O[et][4 * g] += bflo(w.x); O[et][4 * g + 1] += bfhi(w.x); O[et][4 * g + 2] += bflo(w.y); O[et][4 * g + 3] += bfhi(w.y);
                s2 += (O[et][4 * g] * O[et][4 * g] + O[et][4 * g + 1] * O[et][4 * g + 1]) + (O[et][4 * g + 2] * O[et][4 * g + 2] + O[et][4 * g + 3] * O[et][4 * g + 3]); }
        s2 += __shfl_xor(s2, 32);
        const float rs = __builtin_amdgcn_rsqf(s2 * (1.f / 128.f) + RMS_EPS);
#pragma unroll
        for (int et = 0; et < 4; ++et)
#pragma unroll
            for (int g = 0; g < 4; ++g) { const v2u gw = gl[et][g]; const f32x4v nv = *(const GAS f32x4v*)(ng + 32 * et + 8 * g + 4 * h);
                v2u w; w.x = pk2(O[et][4 * g] * rs * nv[0] * sigmoidf_(bflo(gw.x)), O[et][4 * g + 1] * rs * nv[1] * sigmoidf_(bfhi(gw.x)));
                w.y = pk2(O[et][4 * g + 2] * rs * nv[2] * sigmoidf_(bflo(gw.y)), O[et][4 * g + 3] * rs * nv[3] * sigmoidf_(bfhi(gw.y)));
                *(GAS v2u*)(mp + 32 * et + 8 * g) = w; }
    }
    __syncthreads();
}
struct Args { const float* in[19]; float* out; unsigned char* ws; int ph_lo, ph_hi, rep, pad; };
constexpr int NPH_LAYER = 11, NPHASES = 1 + DEPTH * NPH_LAYER;

__global__ void __launch_bounds__(NT, 2) trunk_fwd(Args args) {
    extern __shared__ __attribute__((aligned(16))) unsigned char lds_raw[];
    LAS unsigned char* lds = (LAS unsigned char*)lds_raw;
    volatile LAS unsigned* MISC = (volatile LAS unsigned*)(lds + MISC_OFF);
    const int tid0 = threadIdx.x; const int wave0 = __builtin_amdgcn_readfirstlane(tid0 >> 6); const int wave = wave0;
#define PHASE_TID() int tid; asm volatile("v_mbcnt_lo_u32_b32 %0, -1, 0\n\tv_mbcnt_hi_u32_b32 %0, -1, %0" : "=v"(tid)); tid |= wave0 << 6;     \
    const int lane = tid & 63; (void)lane; int wave = wave0; asm volatile("" : "+s"(wave)); (void)wave; \
    size_t wso = 0; asm volatile("" : "+s"(wso)); unsigned char* ws = args.ws + wso; gu32* ctl = (gu32*)(ws + WS_CTL); float2* rope = (float2*)(ws + WS_ROPE); float* lbv = (float*)(ws + WS_LB); \
    bf16* Hb = (bf16*)(ws + WS_H); bf16* proj = (bf16*)(ws + WS_PROJ); bf16* hid = (bf16*)(ws + WS_PROJ); bf16* mixed = (bf16*)(ws + WS_MIXED); float* rowss = (float*)(ws + WS_ROWSS); \
    bf16* kcb = (bf16*)(ws + WS_KCB); bf16* vctb = (bf16*)(ws + WS_VCTB); bf16* VTb = (bf16*)(ws + WS_VT); bf16* KTb = (bf16*)(ws + WS_KT); \
    (void)ctl; (void)rope; (void)lbv; (void)Hb; (void)proj; (void)hid; (void)mixed; (void)rowss; (void)kcb; (void)vctb; (void)VTb; (void)KTb
    const int G = gridDim.x; const int bx = blockIdx.x; const int vcu = (G % 8 == 0) ? (bx % 8) * (G / 8) + bx / 8 : bx;
    const int gw = vcu * NWAVES + wave, NGW = G * NWAVES;
    unsigned char* ws = args.ws;
    gu32* ctl = (gu32*)(ws + WS_CTL);
    for (int u = tid0; u < (LDS_BYTES - LDSCTL_OFF) / 4; u += NT) ((LAS unsigned*)(lds + LDSCTL_OFF))[u] = 0u;
    __syncthreads();
    XcdBarrier bar; bar.bar = (unsigned*)(ctl + CW_BAR); bar.x = 0; bar.st = nullptr;
#if ONE_LAUNCH
    bar = xcd_barrier_post((unsigned*)(ctl + CW_BAR), MISC + 8);
#define GRID_BAR() xcd_barrier(bar)
#else
#define GRID_BAR() do {} while (0)
#endif
    const int lo = args.ph_lo, hi = args.ph_hi;
#define IN(k) (lo <= (k) && (k) < hi)
    const float* x_in = args.in[0]; float* xres = args.out;
    float2* rope = (float2*)(ws + WS_ROPE); float* lbv = (float*)(ws + WS_LB); float* kcmp = (float*)(ws + WS_KCMP); unsigned long long* sel = (unsigned long long*)(ws + WS_SEL);
    bf16* Hb = (bf16*)(ws + WS_H); float* accn = (float*)(ws + WS_H); bf16* proj = (bf16*)(ws + WS_PROJ); bf16* hid = (bf16*)(ws + WS_PROJ); bf16* mixed = (bf16*)(ws + WS_MIXED);
    float* rowss = (float*)(ws + WS_ROWSS); bf16* kcb = (bf16*)(ws + WS_KCB); bf16* vctb = (bf16*)(ws + WS_VCTB); bf16* VTb = (bf16*)(ws + WS_VT); bf16* KTb = (bf16*)(ws + WS_KT);

    if (IN(0)) { PHASE_TID();
        LAS unsigned* scr = (LAS unsigned*)(lds + wave * 16384);
#if PROBE_ML
        const int pr = args.rep;
#else
        const int pr = 0;
#endif
        if (pr == 0 || pr == 1 || pr == 2) { convert_weights(args.in, ws, 0, scr, gw, NGW, lane); convert_weights(args.in, ws, 1, scr, gw, NGW, lane); }
        if (pr == 0 || pr == 1 || pr == 4) {
        for (int it = gw; it < 4 * 32; it += NGW) { const int m = it >> 5, r = it & 31; const int jj = m >> 1, kv = m & 1;
            tr_item64(args.in[kv ? 10 : 7] + (size_t)jj * 2048 * 64, 2048, 64, (bf16*)(ws + WS_W1T) + (size_t)m * 64 * 2048, r * 64, 0, 0, scr, lane); }
        for (int mt = gw; mt < 4 * 32; mt += NGW) { const int m = mt >> 5, ksg = mt & 31; const int jj = m >> 1, kv = m & 1;
            const float* pos = args.in[kv ? 9 : 6] + (size_t)jj * 2048 + 64 * ksg; const float* w1 = args.in[kv ? 10 : 7] + (size_t)jj * 2048 * 64 + (size_t)64 * ksg * 64;
            float acc = 0.f;
#pragma unroll 16
            for (int k = 0; k < 64; ++k) acc += pos[k] * w1[k * 64 + lane];
            ((float*)(ws + WS_CBIAS))[(m * 32 + ksg) * 64 + lane] = acc; }
        for (int idx = vcu * NT + tid; idx < SEQ * 64; idx += G * NT) { const int s = idx >> 6, i = idx & 63;
            const float inv = exp2f(-(float)i * (13.287712379549449f / 64.0f));
            double tt = (double)s * (double)inv * 0.15915494309189535; tt -= floor(tt); const float tf = (float)tt;
            rope[idx] = make_float2(__builtin_amdgcn_cosf(tf), __builtin_amdgcn_sinf(tf)); }
        for (int c = vcu * NT + tid; c < 1024; c += G * NT) { const float l0 = args.in[15][c], l1 = args.in[15][1024 + c]; lbv[c] = 0.f; lbv[1024 + c] = 1.0f / (1.0f + expf(l0 - l1)); }
        }
        if (pr == 0 || pr == 1 || pr == 3) {
        if (M % (G * 2 * NWAVES) == 0) { const int per = M / G; for (int m = vcu * per + wave; m < (vcu + 1) * per; m += 2 * NWAVES) rows2_to_bf16_ss(x_in + (size_t)m * D, x_in + (size_t)(m + NWAVES) * D, Hb + (size_t)m * D, Hb + (size_t)(m + NWAVES) * D, rowss, m, m + NWAVES, lane); }
        else if (M % G == 0) { const int per = M / G; for (int m = vcu * per + wave; m < (vcu + 1) * per; m += NWAVES) row_to_bf16_ss(x_in + (size_t)m * D, Hb + (size_t)m * D, rowss, m, lane); }
        else for (int m = gw; m < M; m += NGW) row_to_bf16_ss(x_in + (size_t)m * D, Hb + (size_t)m * D, rowss, m, lane);
        }
        __syncthreads();
        GRID_BAR();
    }

#pragma unroll 1
    for (int L = 0; L < DEPTH; ++L) {
        const int pb = 1 + L * NPH_LAYER; const int j = L >> 1; const bool even = (L & 1) == 0;
        if (IN(pb + 0)) { PHASE_TID();
            const int N = even ? PE : PO; const bf16* Wt = even ? (const bf16*)(ws + WS_WEIN) + (size_t)j * PE * D : (const bf16*)(ws + WS_WOIN) + (size_t)j * PO * D;
            pg8::Gemm g{Hb, Wt, M, N, D}; pg8::StaticOrder S; S.init(M, N, G, bx);
            build_rstd_table(lds, S, rowss, tid);
            pg8::EpiInProj E{proj, N, (const LAS int*)(lds + RS_TBL_OFF), (const LAS float*)(lds + RS_TAB_OFF), even ? 0 : 1, (const float*)rope, lbv + (size_t)j * 1024, (float*)(ws + WS_VT), PROBE_ML ? args.rep : 0};
#if PROBE_ML
            if (args.rep == 7 && (bx % 8) >= 4) S.nwg = 0;
            if (args.rep == 8 && (bx % 8) != 0) S.nwg = 0;
            if (args.rep == 10 || args.rep == 11) { const int ns = (bx % 8) * (args.rep == 10 ? 1 : 2); for (int i = 0; i < ns; ++i) __builtin_amdgcn_s_sleep(82); }
#endif
            pg8::gemm_phase<pg8::EpiInProj, pg8::StaticOrder, PG8_ALIGN, PG8_SP2>(lds, g, S, E, tid);
            GRID_BAR();
        }
        if (even && IN(pb + 1)) { PHASE_TID();
#if REC_NAIVE
            const int nret = (G > 64) ? 32 : 0;
            if (nret == 0 || vcu < nret) for (int u = vcu; u < 32; u += (nret ? nret : G)) recur_unit<0>(lds, u >> 2, u & 3, proj, PE, rope, nullptr, nullptr, mixed, tid, lane, wave);
            if (nret == 0 || vcu >= nret)
#else
            const int nret = 0;
#endif
            {
                LAS float* xs = (LAS float*)(lds + wave * 16384);
                const int w0 = nret ? (vcu - nret) * NWAVES + wave : gw, nw = nret ? (G - nret) * NWAVES : NGW;
                for (int item = w0; item < 16 * 2 * 64; item += nw) kv_tile_item((LAS unsigned short*)xs, item, proj, KTb, VTb, lane);
                __syncthreads();
                for (int u = vcu; u < 256; u += G) compress_unit(lds, u, proj, (const bf16*)(ws + WS_W1T) + (size_t)j * 2 * 64 * 2048, (const float*)(ws + WS_CBIAS) + j * 2 * 32 * 64, args.in[8] + (size_t)j * 4096, args.in[11] + (size_t)j * 4096, kcb, vctb, tid, wave);
            }
            __syncthreads();
            GRID_BAR();
        }
#if NSA_NAIVE
        if (even && IN(pb + 2)) { PHASE_TID();
            LAS float* wl = (LAS float*)(lds + wave * 4096);
            for (int task = gw; task < 16 * SEQ; task += NGW) cmp_attn_task(wl, task, proj, kcmp, accn, sel, lane);
            __syncthreads();
            GRID_BAR();
        }
        if (even && IN(pb + 3)) { PHASE_TID();
            LAS float* wl = (LAS float*)(lds + wave * 4096);
            for (int task = gw; task < 16 * SEQ; task += NGW) blk_attn_task<0>(wl, task, proj, sel, accn, mixed, lane);
            __syncthreads();
            GRID_BAR();
        }
        if (even && IN(pb + 4)) { PHASE_TID();
            LAS float* wl = (LAS float*)(lds + wave * 4096);
            for (int task = gw; task < 16 * SEQ; task += NGW) blk_attn_task<1>(wl, task, proj, sel, accn, mixed, lane);
            __syncthreads();
            GRID_BAR();
        }
#else
        if (even && IN(pb + 2)) { PHASE_TID();
            const int per = (G % 8 == 0 && G >= 64) ? G / 8 : 0;
            { const int ru0 = per ? (((vcu % per) % 8 == 0 && (vcu % per) / 8 < 4) ? (vcu / per) * 4 + (vcu % per) / 8 : BATCH * 4) : vcu, rstep = per ? BATCH * 4 : G;
              for (int u = ru0; u < ((PROBE_ML && args.rep == 3) ? 0 : BATCH * 4); u += rstep) rec_serial_unit<0, 1>(lds, u, proj, nullptr, nullptr, mixed, nullptr, nullptr, tid, wave); }
            const int xq = per ? vcu / per : 0; const unsigned nitem = (PROBE_ML && args.rep == 2) ? 0u : (per ? 128u : 1024u);
            for (;;) {
                if (tid == 0) MISC[0] = __hip_atomic_fetch_add((unsigned*)(ctl + CW_Q + 64 * (j * 8 + xq + 16 * args.rep)), 1u, __ATOMIC_RELAXED, __HIP_MEMORY_SCOPE_AGENT);
                __syncthreads();
                const unsigned it = MISC[0];
                __syncthreads();
                if (it >= nitem) break;
                nsa_subunit(lds, per ? 2 * xq + (int)(it & 1u) : (int)(it & 15u), 63 - (int)(per ? it >> 1 : it >> 4), proj, kcb, vctb, KTb, VTb, mixed, tid, wave);
            }
            __syncthreads();
            GRID_BAR();
        }
#endif
#if REC_NAIVE
        if (!even && IN(pb + 5)) { PHASE_TID();
            for (int u = vcu; u < 64; u += G) recur_unit<1>(lds, u >> 3, u & 7, proj, PO, nullptr, lbv + (size_t)j * 1024, args.in[14] + (size_t)j * 128, mixed, tid, lane, wave);
            __syncthreads();
            GRID_BAR();
        }
#else
        if (!even && IN(pb + 3)) { PHASE_TID();
            for (int u = vcu; u < BATCH * 8 * 4; u += G) rec_serial_unit<1, 4>(lds, u, proj, (const float*)(ws + WS_VT), nullptr, mixed, (float*)(ws + WS_VT + 4 * MiB), (float*)(ws + WS_KCB), tid, wave);
            __syncthreads();
            GRID_BAR();
        }
        if (!even && IN(pb + 5)) { PHASE_TID();
            for (int u = vcu; u < BATCH * 8 * 4; u += G) rec_fix_unit(lds, u, proj, (const float*)(ws + WS_VT + 4 * MiB), (const float*)(ws + WS_KCB), args.in[14] + (size_t)j * 128, mixed, tid, wave);
            __syncthreads();
            GRID_BAR();
        }
#endif
        if (IN(pb + 6)) { PHASE_TID();
            const bf16* Wt = even ? (const bf16*)(ws + WS_WEOUT) + (size_t)j * D * D : (const bf16*)(ws + WS_WOOUT) + (size_t)j * D * D;
            pg8::Gemm g{mixed, Wt, M, D, D}; pg8::StaticOrder S; S.init(M, D, G, bx);
            pg8::EpiResF32 E{Hb, D, (PROBE_ML && args.rep) ? 0.f : 1.f, rowss, M, PROBE_ML ? args.rep : 0};
            pg8::gemm_phase<pg8::EpiResF32, pg8::StaticOrder, PG8_ALIGN, PG8_SP2>(lds, g, S, E, tid);
            GRID_BAR();
        }
        if (IN(pb + 8)) { PHASE_TID();
            pg8::Gemm g{Hb, (const bf16*)(ws + WS_W13) + (size_t)L * FF2 * D, M, FF2, D}; pg8::StaticOrder S; S.init(M, FF2, G, bx);
            build_rstd_table(lds, S, rowss, tid);
            pg8::EpiSwiGLU E{hid, FF, (const LAS int*)(lds + RS_TBL_OFF), (const LAS float*)(lds + RS_TAB_OFF), PROBE_ML ? args.rep : 0};
            pg8::gemm_phase<pg8::EpiSwiGLU, pg8::StaticOrder, PG8_ALIGN, PG8_SP2>(lds, g, S, E, tid);
            GRID_BAR();
        }
        if (IN(pb + 9)) { PHASE_TID();
            pg8::Gemm g{hid, (const bf16*)(ws + WS_W2) + (size_t)L * D * FF, M, D, FF}; pg8::StaticOrder S; S.init(M, D, G, bx);
            pg8::EpiResF32 E{Hb, D, (PROBE_ML && args.rep) ? 0.f : 1.f, rowss, M, PROBE_ML ? args.rep : 0};
            pg8::gemm_phase<pg8::EpiResF32, pg8::StaticOrder, PG8_ALIGN, PG8_SP2>(lds, g, S, E, tid);
            GRID_BAR();
        }
        if (L + 1 == DEPTH && IN(pb + 10)) { PHASE_TID();
#if PROBE_ML
            if (args.rep == 5 || (args.rep == 9 && (bx % 8) == 0)) {
                typedef short bf16x8_ __attribute__((ext_vector_type(8)));
                bf16x8_ af[4], bfm[4];
                for (int i = 0; i < 4; ++i) { af[i] = *(const bf16x8_*)(Hb + (size_t)(gw * 64 + lane) * D + i * 8); bfm[i] = *(const bf16x8_*)(Hb + (size_t)(gw * 64 + lane) * D + 512 + i * 8); }
                f32x4 c[4][4];
                for (int i = 0; i < 4; ++i) for (int k = 0; k < 4; ++k) c[i][k] = (f32x4){0.f, 0.f, 0.f, 0.f};
#pragma unroll 1
                for (int it = 0; it < 4096; ++it) {
#pragma unroll
                    for (int i = 0; i < 4; ++i)
#pragma unroll
                        for (int k = 0; k < 4; ++k) c[i][k] = __builtin_amdgcn_mfma_f32_16x16x32_bf16(af[i], bfm[k], c[i][k], 0, 0, 0);
                }
                f32x4 sacc = (f32x4){0.f, 0.f, 0.f, 0.f};
                for (int i = 0; i < 4; ++i) for (int k = 0; k < 4; ++k) sacc += c[i][k];
                ((f32x4*)(ws + WS_CTL + 512 * 1024))[gw * 64 + lane] = sacc;
            } else if (args.rep == 9) {
            } else if (args.rep == 6) {
                float a = bf2f(Hb[(size_t)(gw * 64 + lane) * D]), b = 1.0000001f, c0 = 1e-9f;
#pragma unroll 1
                for (int it = 0; it < 131072 / 16; ++it) {
#pragma unroll
                    for (int k = 0; k < 16; ++k) asm volatile("v_fma_f32 %0, %0, %1, %2" : "+v"(a) : "v"(b), "v"(c0));
                }
                ((float*)(ws + WS_CTL + 512 * 1024))[gw * 64 + lane] = a;
            } else
#endif
            for (int m = gw; m < M; m += NGW) rms_row_bf16_to_f32(Hb + (size_t)m * D, args.in[3], xres + (size_t)m * D, lane);
        }
    }
#undef IN
}

extern "C" void kernel_launch(void* const* d_in, const int* in_sizes, int n_in, void* d_out, int out_size, void* d_ws, size_t ws_size, hipStream_t stream) {
    static int grid = 0;
    if (grid == 0) {
        if (n_in != 19 || in_sizes[0] != M * D || out_size != M * D || ws_size < WS_END) { fprintf(stderr, "kernel_launch: unexpected shapes/workspace (n_in %d, in0 %d, out %d, ws %zu); nothing launched\n", n_in, n_in > 0 ? in_sizes[0] : -1, out_size, ws_size); grid = -1; return; }
        int dev = 0, cus = 0;
        if (hipGetDevice(&dev) != hipSuccess || hipDeviceGetAttribute(&cus, hipDeviceAttributeMultiprocessorCount, dev) != hipSuccess) { grid = -1; return; }
        if (hipFuncSetAttribute((const void*)trunk_fwd, hipFuncAttributeMaxDynamicSharedMemorySize, LDS_BYTES) != hipSuccess) { fprintf(stderr, "kernel_launch: hipFuncSetAttribute failed\n"); grid = -1; return; }
        int per_cu = 0;
        if (hipOccupancyMaxActiveBlocksPerMultiprocessor(&per_cu, (const void*)trunk_fwd, NT, LDS_BYTES) != hipSuccess || per_cu < 1) fprintf(stderr, "kernel_launch: occupancy query reports %d\n", per_cu);
        (void)hipGetLastError();
        grid = cus;
    }
    if (grid < 0) return;
    (void)hipMemsetAsync((char*)d_ws + WS_CTL, 0, CTL_ZERO_BYTES, stream);
    Args a{};
    for (int i = 0; i < 19; ++i) a.in[i] = (const float*)d_in[i];
    a.out = (float*)d_out; a.ws = (unsigned char*)d_ws;
#if ONE_LAUNCH && !PROBE_ML
    a.ph_lo = 0; a.ph_hi = NPHASES;
    hipLaunchKernelGGL(trunk_fwd, dim3(grid), dim3(NT), LDS_BYTES, stream, a);
#else
#if ONE_LAUNCH
#define PROBE_RESET() (void)hipMemsetAsync((char*)d_ws + WS_CTL + CW_BAR * 4, 0, (CW_Q - CW_BAR) * 4, stream)
#else
#define PROBE_RESET() do {} while (0)
#endif
    for (int p = 0; p < NPHASES; ++p) {
        if (p > 0) { const int L = (p - 1) / NPH_LAYER, k = (p - 1) % NPH_LAYER; const bool even = (L & 1) == 0; if (even && (k == 5 || ((k == 3 || k == 4) && !NSA_NAIVE))) continue; if (!even && (k == 1 || k == 2 || k == 4)) continue; if (k == 7 || (k == 10 && L + 1 < DEPTH)) continue; }
        a.ph_lo = p; a.ph_hi = p + 1; a.rep = 0;
        PROBE_RESET();
        hipLaunchKernelGGL(trunk_fwd, dim3(grid), dim3(NT), LDS_BYTES, stream, a);
#ifdef REP_K
        if ((p == 0 && REP_K == -2) || (p > 0 && (p - 1) % NPH_LAYER == REP_K)) { a.rep = REP_MODE; PROBE_RESET(); hipLaunchKernelGGL(trunk_fwd, dim3(grid), dim3(NT), LDS_BYTES, stream, a); }
#endif
    }
#endif
}
```
